# Optimizing an MI355X kernel written in HIP

```python
import jax, jax.numpy as jnp
from jax import lax
import numpy as np

D_MODEL = 2048
BATCH = 2
SEQ = 16384
DEPTH = 4

N_MIXERS = 2
N_MLA_LAYERS = (DEPTH + 1) // 2
N_GDN_LAYERS = DEPTH // 2
NORM_EPS = 1e-6
PLE_DIM = 256
MLA_HEADS = 16
MLA_Q_LORA = 512
MLA_KV_LORA = 512
MLA_NOPE = 128
MLA_ROPE = 64
MLA_QK = MLA_NOPE + MLA_ROPE
MLA_V = 128
ROPE_THETA = 10000.0
ATTN_BLOCK = 128
MLA_IN_DIM = MLA_Q_LORA + MLA_KV_LORA + MLA_ROPE
GDN_QK_HEADS = 16
GDN_V_HEADS = 32
GDN_DK = 128
GDN_DV = 128
GDN_CONV = 4
GDN_CHUNK = 64
GDN_KEY_DIM = GDN_QK_HEADS * GDN_DK
GDN_VAL_DIM = GDN_V_HEADS * GDN_DV
GDN_CONV_DIM = 2 * GDN_KEY_DIM + GDN_VAL_DIM
GDN_IN_DIM = GDN_CONV_DIM + GDN_VAL_DIM + 2 * GDN_V_HEADS
D_FF = -((-8 * D_MODEL) // (3 * 256)) * 256

kernel_name = 'hybrid_mla_gdn_swiglu_ple_trunk'


def rms_norm(x, w):
    xf = x.astype(jnp.float32)
    y = xf * lax.rsqrt(jnp.mean(xf * xf, axis=-1, keepdims=True) + NORM_EPS)
    return (y * w.astype(jnp.float32)).astype(x.dtype)


def l2_norm(x):
    xf = x.astype(jnp.float32)
    return xf * lax.rsqrt(jnp.sum(xf * xf, axis=-1, keepdims=True) + NORM_EPS)


def rope_tables(positions, dtype):
    inv_freq = ROPE_THETA ** (-jnp.arange(0, MLA_ROPE, 2, dtype=jnp.float32) / MLA_ROPE)
    ang = positions.astype(jnp.float32)[..., None] * inv_freq
    return jnp.cos(ang)[:, :, None, :].astype(dtype), jnp.sin(ang)[:, :, None, :].astype(dtype)


def apply_rope(x, cos, sin):
    x1, x2 = jnp.split(x, 2, axis=-1)
    return jnp.concatenate([x1 * cos - x2 * sin, x2 * cos + x1 * sin], axis=-1)


def causal_block_attention(q, k, v, scale):
    B, S, H, Dqk = q.shape
    Dv = v.shape[-1]
    nb = S // ATTN_BLOCK
    q_blocks = q.reshape(B, nb, ATTN_BLOCK, H, Dqk).transpose(1, 0, 2, 3, 4)
    k_idx = jnp.arange(S)

    def one_block(args):
        qb, blk = args
        s = jnp.einsum('bqhd,bkhd->bhqk', qb, k).astype(jnp.float32) * scale
        q_idx = blk * ATTN_BLOCK + jnp.arange(ATTN_BLOCK)
        s = jnp.where(k_idx[None, :] <= q_idx[:, None], s, -jnp.inf)
        pr = jax.nn.softmax(s, axis=-1).astype(v.dtype)
        return jnp.einsum('bhqk,bkhd->bqhd', pr, v)

    o = lax.map(one_block, (q_blocks, jnp.arange(nb)))
    return o.transpose(1, 0, 2, 3, 4).reshape(B, S, H, Dv)


def mla_mixer(hn, cos, sin, w_in, q_lat_norm, kv_lat_norm, w_uq, w_ukv, q_norm, k_norm, w_o):
    B, S, _ = hn.shape
    c = hn @ w_in
    q_lat, kv_lat, k_pe = jnp.split(c, [MLA_Q_LORA, MLA_Q_LORA + MLA_KV_LORA], axis=-1)
    q = (rms_norm(q_lat, q_lat_norm) @ w_uq).reshape(B, S, MLA_HEADS, MLA_QK)
    kv = (rms_norm(kv_lat, kv_lat_norm) @ w_ukv).reshape(B, S, MLA_HEADS, MLA_NOPE + MLA_V)
    k_nope, v = jnp.split(kv, [MLA_NOPE], axis=-1)
    k_pe = jnp.broadcast_to(k_pe[:, :, None, :], (B, S, MLA_HEADS, MLA_ROPE))
    k = jnp.concatenate([k_nope, k_pe], axis=-1)
    q = rms_norm(q, q_norm)
    k = rms_norm(k, k_norm)
    q = jnp.concatenate([q[..., :MLA_NOPE], apply_rope(q[..., MLA_NOPE:], cos, sin)], axis=-1)
    k = jnp.concatenate([k[..., :MLA_NOPE], apply_rope(k[..., MLA_NOPE:], cos, sin)], axis=-1)
    o = causal_block_attention(q, k, v, MLA_QK ** -0.5)
    return o.reshape(B, S, MLA_HEADS * MLA_V) @ w_o


def causal_depthwise_conv(x, w):
    S = x.shape[1]
    xp = jnp.pad(x, ((0, 0), (GDN_CONV - 1, 0), (0, 0)))
    y = xp[:, 0:S] * w[0]
    for j in range(1, GDN_CONV):
        y = y + xp[:, j:j + S] * w[j]
    return y


def chunk_gated_delta_rule(q, k, v, g, beta):
    B, S, H, Dk = q.shape
    Dv = v.shape[-1]
    C = GDN_CHUNK
    N = S // C
    f32 = jnp.float32

    def to_chunks(t):
        return t.astype(f32).reshape(B, N, C, H, -1).transpose(0, 3, 1, 2, 4)

    q, k, v = to_chunks(q), to_chunks(k), to_chunks(v)
    g = g.astype(f32).reshape(B, N, C, H).transpose(0, 3, 1, 2)
    beta = beta.astype(f32).reshape(B, N, C, H).transpose(0, 3, 1, 2)
    g = jnp.cumsum(g, axis=-1)
    k_beta = k * beta[..., None]
    v_beta = v * beta[..., None]
    tril = jnp.tril(jnp.ones((C, C), dtype=bool))
    strict = jnp.tril(jnp.ones((C, C), dtype=bool), -1)
    diff = g[..., :, None] - g[..., None, :]
    decay = jnp.where(tril, jnp.exp(jnp.where(tril, diff, 0.0)), 0.0)
    L = jnp.where(strict, jnp.einsum('bhncd,bhnsd->bhncs', k_beta, k) * decay, 0.0)
    A = L + jnp.eye(C, dtype=f32)
    rhs = jnp.concatenate([v_beta, k_beta * jnp.exp(g)[..., None]], axis=-1)
    sol = lax.linalg.triangular_solve(A, rhs, left_side=True, lower=True, unit_diagonal=True)
    u, w = sol[..., :Dv], sol[..., Dv:]
    intra = jnp.where(tril, jnp.einsum('bhncd,bhnsd->bhncs', q, k) * decay, 0.0)

    def step(state, inp):
        q_c, k_c, u_c, w_c, g_c, a_c = inp
        v_new = u_c - jnp.einsum('bhcd,bhde->bhce', w_c, state)
        o = (jnp.einsum('bhcd,bhde->bhce', q_c * jnp.exp(g_c)[..., None], state)
             + jnp.einsum('bhcs,bhse->bhce', a_c, v_new))
        g_last = g_c[..., -1]
        k_dec = k_c * jnp.exp(g_last[..., None] - g_c)[..., None]
        state = state * jnp.exp(g_last)[..., None, None] + jnp.einsum('bhcd,bhce->bhde', k_dec, v_new)
        return state, o

    xs = tuple(jnp.moveaxis(t, 2, 0) for t in (q, k, u, w, g, intra))
    state0 = jnp.zeros((B, H, Dk, Dv), dtype=f32)
    _, o = lax.scan(step, state0, xs)
    return o.transpose(1, 0, 3, 2, 4).reshape(B, S, H, Dv)


def gdn_mixer(hn, w_in, conv_w, a_log, dt_bias, out_norm, w_out):
    B, S, _ = hn.shape
    proj = hn @ w_in
    qkv, z, b, a = jnp.split(
        proj, [GDN_CONV_DIM, GDN_CONV_DIM + GDN_VAL_DIM, GDN_CONV_DIM + GDN_VAL_DIM + GDN_V_HEADS], axis=-1)
    qkv = jax.nn.silu(causal_depthwise_conv(qkv, conv_w))
    q, k, v = jnp.split(qkv, [GDN_KEY_DIM, 2 * GDN_KEY_DIM], axis=-1)
    rep = GDN_V_HEADS // GDN_QK_HEADS
    q = jnp.repeat(l2_norm(q.reshape(B, S, GDN_QK_HEADS, GDN_DK)), rep, axis=2) * (GDN_DK ** -0.5)
    k = jnp.repeat(l2_norm(k.reshape(B, S, GDN_QK_HEADS, GDN_DK)), rep, axis=2)
    v = v.reshape(B, S, GDN_V_HEADS, GDN_DV)
    beta = jax.nn.sigmoid(b.astype(jnp.float32))
    g = -jnp.exp(a_log.astype(jnp.float32)) * jax.nn.softplus(a.astype(jnp.float32) + dt_bias.astype(jnp.float32))
    o = chunk_gated_delta_rule(q, k, v, g, beta).astype(hn.dtype)
    o = rms_norm(o, out_norm) * jax.nn.silu(z.reshape(B, S, GDN_V_HEADS, GDN_DV))
    return o.reshape(B, S, GDN_VAL_DIM) @ w_out


def swiglu_ffn(hn, w_gate_up, w_down):
    gate, up = jnp.split(hn @ w_gate_up, 2, axis=-1)
    return (jax.nn.silu(gate) * up) @ w_down


def per_layer_embedding(h, p_i, w_proj, emb_norm, gate_norm, w_gate):
    e = rms_norm(p_i @ w_proj, emb_norm)
    gate = jax.nn.sigmoid(rms_norm(h, gate_norm) @ w_gate)
    return e * gate


def setup_inputs(seed: int = 0) -> dict:
    key = jax.random.key(seed)
    ks = jax.random.split(key, 32)
    counter = [0]

    def nxt():
        kk = ks[counter[0]]
        counter[0] += 1
        return kk

    def dense(shape, fan_in):
        return jax.random.normal(nxt(), shape, jnp.float32) * (fan_in ** -0.5)

    def gain(shape):
        return 1.0 + 0.02 * jax.random.normal(nxt(), shape, jnp.float32)

    x = jax.random.normal(nxt(), (BATCH, SEQ, D_MODEL), jnp.float32)
    p = jax.random.normal(nxt(), (DEPTH, BATCH, SEQ, PLE_DIM), jnp.float32)
    offsets = jax.random.randint(nxt(), (BATCH, 1), 0, 4096, dtype=jnp.int32)
    positions = offsets + jnp.arange(SEQ, dtype=jnp.int32)[None, :]

    mixer_norm = gain((DEPTH, D_MODEL))
    mla_w_in = dense((N_MLA_LAYERS, D_MODEL, MLA_IN_DIM), D_MODEL)
    mla_q_lat_norm = gain((N_MLA_LAYERS, MLA_Q_LORA))
    mla_kv_lat_norm = gain((N_MLA_LAYERS, MLA_KV_LORA))
    mla_w_uq = dense((N_MLA_LAYERS, MLA_Q_LORA, MLA_HEADS * MLA_QK), MLA_Q_LORA)
    mla_w_ukv = dense((N_MLA_LAYERS, MLA_KV_LORA, MLA_HEADS * (MLA_NOPE + MLA_V)), MLA_KV_LORA)
    mla_q_norm = gain((N_MLA_LAYERS, MLA_QK))
    mla_k_norm = gain((N_MLA_LAYERS, MLA_QK))
    mla_w_o = dense((N_MLA_LAYERS, MLA_HEADS * MLA_V, D_MODEL), MLA_HEADS * MLA_V)

    gdn_w_in = dense((N_GDN_LAYERS, D_MODEL, GDN_IN_DIM), D_MODEL)
    gdn_conv_w = dense((N_GDN_LAYERS, GDN_CONV, GDN_CONV_DIM), GDN_CONV)
    gdn_a_log = jnp.log(jax.random.uniform(nxt(), (N_GDN_LAYERS, GDN_V_HEADS), jnp.float32, 1.0, 16.0))
    dt = jnp.exp(jax.random.uniform(nxt(), (N_GDN_LAYERS, GDN_V_HEADS), jnp.float32,
                                    float(np.log(1e-3)), float(np.log(1e-1))))
    gdn_dt_bias = dt + jnp.log(-jnp.expm1(-dt))
    gdn_out_norm = gain((N_GDN_LAYERS, GDN_DV))
    gdn_w_out = dense((N_GDN_LAYERS, GDN_VAL_DIM, D_MODEL), GDN_VAL_DIM)

    ffn_norm = gain((DEPTH, D_MODEL))
    ffn_w_gate_up = dense((DEPTH, D_MODEL, 2 * D_FF), D_MODEL)
    ffn_w_down = dense((DEPTH, D_FF, D_MODEL), D_FF)

    ple_w_proj = dense((DEPTH, PLE_DIM, D_MODEL), PLE_DIM)
    ple_norm = gain((DEPTH, D_MODEL))
    ple_gate_norm = gain((DEPTH, D_MODEL))
    ple_w_gate = dense((DEPTH, D_MODEL, D_MODEL), D_MODEL)

    return {'x': x, 'p': p, 'positions': positions, 'mixer_norm': mixer_norm,
            'mla_w_in': mla_w_in, 'mla_q_lat_norm': mla_q_lat_norm, 'mla_kv_lat_norm': mla_kv_lat_norm,
            'mla_w_uq': mla_w_uq, 'mla_w_ukv': mla_w_ukv, 'mla_q_norm': mla_q_norm, 'mla_k_norm': mla_k_norm,
            'mla_w_o': mla_w_o,
            'gdn_w_in': gdn_w_in, 'gdn_conv_w': gdn_conv_w, 'gdn_a_log': gdn_a_log, 'gdn_dt_bias': gdn_dt_bias,
            'gdn_out_norm': gdn_out_norm, 'gdn_w_out': gdn_w_out,
            'ffn_norm': ffn_norm, 'ffn_w_gate_up': ffn_w_gate_up, 'ffn_w_down': ffn_w_down,
            'ple_w_proj': ple_w_proj, 'ple_norm': ple_norm, 'ple_gate_norm': ple_gate_norm, 'ple_w_gate': ple_w_gate}


def reference(x, p, positions, mixer_norm,
              mla_w_in, mla_q_lat_norm, mla_kv_lat_norm, mla_w_uq, mla_w_ukv, mla_q_norm, mla_k_norm, mla_w_o,
              gdn_w_in, gdn_conv_w, gdn_a_log, gdn_dt_bias, gdn_out_norm, gdn_w_out,
              ffn_norm, ffn_w_gate_up, ffn_w_down,
              ple_w_proj, ple_norm, ple_gate_norm, ple_w_gate):
    cos, sin = rope_tables(positions, x.dtype)
    h = x
    for i in range(DEPTH):
        j = i // N_MIXERS
        hn = rms_norm(h, mixer_norm[i])
        if i % N_MIXERS == 0:
            h = h + mla_mixer(hn, cos, sin, mla_w_in[j], mla_q_lat_norm[j], mla_kv_lat_norm[j],
                              mla_w_uq[j], mla_w_ukv[j], mla_q_norm[j], mla_k_norm[j], mla_w_o[j])
        else:
            h = h + gdn_mixer(hn, gdn_w_in[j], gdn_conv_w[j], gdn_a_log[j], gdn_dt_bias[j],
                              gdn_out_norm[j], gdn_w_out[j])
        h = h + swiglu_ffn(rms_norm(h, ffn_norm[i]), ffn_w_gate_up[i], ffn_w_down[i])
        h = h + per_layer_embedding(h, p[i], ple_w_proj[i], ple_norm[i], ple_gate_norm[i], ple_w_gate[i])
    return h
```

```cpp
#include <hip/hip_runtime.h>
#include <cstdio>
#include <cstdint>

#define GAS __attribute__((address_space(1)))
#define LAS __attribute__((address_space(3)))
typedef unsigned short bf16;
typedef unsigned v4u __attribute__((ext_vector_type(4)));
typedef unsigned v2u __attribute__((ext_vector_type(2)));
typedef float f32x4 __attribute__((ext_vector_type(4)));
typedef float f32x16 __attribute__((ext_vector_type(16)));
typedef short bf16x8 __attribute__((ext_vector_type(8)));
typedef short s16x4 __attribute__((ext_vector_type(4)));

constexpr int NB = 2, SEQ = 16384, NT = NB * SEQ, DM = 2048, DEPTH = 4;
constexpr float NORM_EPS = 1e-6f;
constexpr int PLE_DIM = 256;
constexpr int MLA_H = 16, MLA_QL = 512, MLA_KVL = 512, MLA_NOPE = 128, MLA_ROPE = 64, MLA_QK = 192, MLA_V = 128;
constexpr int MLA_IN = MLA_QL + MLA_KVL + MLA_ROPE, MLA_IN_PAD = 1280;
constexpr int GDN_HQK = 16, GDN_HV = 32, GDN_DK = 128, GDN_DV = 128, GDN_KEY = 2048, GDN_VAL = 4096, GDN_CONV = 8192;
constexpr int GDN_MAIN = GDN_CONV + GDN_VAL;
constexpr int GDN_IN = GDN_MAIN + 64, GDN_IN_PAD = GDN_MAIN + 256;
constexpr int NCHUNK = SEQ / 64;
constexpr int DFF = 5632;

constexpr size_t MiB = 1u << 20;
constexpr size_t WS_CTL = 0, CTL_ZERO_BYTES = 64 * 1024;
constexpr size_t WS_WMIX = 1 * MiB, WS_WGU = 66 * MiB, WS_WDN = 110 * MiB, WS_WPP = 132 * MiB, WS_WPG = 133 * MiB, WS_ROPE = 141 * MiB;
constexpr size_t WS_A0 = 149 * MiB, WS_A1 = 277 * MiB, WS_END = 1277 * MiB;
constexpr size_t WM_GDN_IN = 0, WM_GDN_OUT = 49 * MiB;
constexpr size_t WM_MLA_IN = 0, WM_MLA_UQ = 5 * MiB, WM_MLA_UKV = 8 * MiB, WM_MLA_O = 12 * MiB;
constexpr size_t A1_C = 0, A1_QKVN = 160 * MiB, A1_KPE = 224 * MiB, A1_QRAW = 232 * MiB, A1_KVRAW = 424 * MiB, A1_KF = 680 * MiB, A1_VF = 872 * MiB, A1_QF = 0;
constexpr size_t A1_PROJ = 0, A1_BA = 768 * MiB, A1_HALO = 776 * MiB, A1_GC = 800 * MiB, A1_INTRA = 804 * MiB;
constexpr size_t A1_ACT = 0, A1_PBF = 352 * MiB, A1_E = 368 * MiB, A1_RSTDE = 496 * MiB;
constexpr int CW_BAR = 1024;

constexpr int LDS_BYTES = 147456;
constexpr int MISC_OFF = LDS_BYTES - 256;
constexpr int NWAVES = 8;

#define LDS_WAIT() asm volatile("s_waitcnt lgkmcnt(0)" ::: "memory")
#define VM_WAIT() asm volatile("s_waitcnt vmcnt(0)" ::: "memory")
__device__ __forceinline__ unsigned f2bf(float f) { unsigned u = __builtin_bit_cast(unsigned, f); return (u + 0x7fffu + ((u >> 16) & 1u)) >> 16; }
__device__ __forceinline__ unsigned pk2(float lo, float hi) { return f2bf(lo) | (f2bf(hi) << 16); }
__device__ __forceinline__ float bf2f(unsigned short b) { return __uint_as_float(((unsigned)b) << 16); }
__device__ __forceinline__ float bflo(unsigned w) { return __uint_as_float(w << 16); }
__device__ __forceinline__ float bfhi(unsigned w) { return __uint_as_float(w & 0xffff0000u); }
__device__ __forceinline__ float wave_sum(float v) {
#pragma unroll
    for (int o = 1; o < 64; o <<= 1) v += __shfl_xor(v, o);
    return v;
}
__device__ __forceinline__ float fsigmoid(float x) { return 1.0f / (1.0f + __expf(-x)); }
__device__ __forceinline__ float fsilu(float x) { return x / (1.0f + __expf(-x)); }

namespace pg8 {
#define PG8_LAS __attribute__((address_space(3)))
typedef unsigned short bf16_t;
typedef short bf16x8 __attribute__((ext_vector_type(8)));
typedef float f32x4 __attribute__((ext_vector_type(4)));
typedef unsigned u32x4 __attribute__((ext_vector_type(4)));
constexpr int BM = 256, BK = 64, HALF = 128, HTB = HALF * BK * 2  , STAGE_BYTES = 8 * HTB, NXCD = 8, WGM = 8;

__host__ __device__ __forceinline__ int lds_byte(int r, int c) { const int st = (r >> 4) * 2 + (c >> 5), rr = r & 15, cc = c & 31, ob = rr * 64 + cc * 2; return st * 1024 + (ob ^ (((ob >> 9) & 1) << 5)); }
__host__ __device__ __forceinline__ void stage_rc(int b, int& R, int& C) { const int st = b / 1024, sb = b % 1024, swz = sb ^ (((sb >> 9) & 1) << 5); R = (st >> 1) * 16 + swz / 64; C = (st & 1) * 32 + (swz % 64) / 2; }
__host__ __device__ __forceinline__ int perm32(int rho) { const int n = rho >> 4, i = rho & 15; return 8 * (i >> 2) + 4 * n + (i & 3); }

struct Unit { int pm, pn; };
struct Gemm { const bf16_t* A; const bf16_t* Bt; int M, N, K, lda, ldb; };

struct StaticOrder {
    int nM, nN, nwg, G, c;
    __host__ __device__ void init(int M, int N, int G_, int c_) { nM = M / BM; nN = N / BM; nwg = nM * nN; G = G_; c = c_; }
    __host__ __device__ bool next(int i, Unit& u) const {
        const long L = (long)i * G + c; if (L >= nwg) return false;
        int wgid = (int)L; { const int q = nwg / NXCD, r = nwg % NXCD, xcd = wgid % NXCD, off = wgid / NXCD; wgid = (xcd < r ? xcd * (q + 1) : r * (q + 1) + (xcd - r) * q) + off; }
        const int nig = WGM * nN, gid = wgid / nig, fm = gid * WGM, gsz = (nM - fm) < WGM ? (nM - fm) : WGM;
        u.pm = fm + ((wgid % nig) % gsz); u.pn = (wgid % nig) / gsz; return true;
    }
    __device__ __forceinline__ void a_ready(const Unit&) const {}
    __device__ __forceinline__ void done(const Unit&) const {}
};

__device__ __forceinline__ unsigned cvt_pk_bf16(float lo, float hi) { unsigned r; asm volatile("v_cvt_pk_bf16_f32 %0, %1, %2" : "=v"(r) : "v"(lo), "v"(hi)); return r; }
__device__ __forceinline__ float fast_sigmoid(float x) { return __builtin_amdgcn_rcpf(1.0f + __builtin_amdgcn_exp2f(-1.4426950408889634f * x)); }

struct EpiF32Plain {
    static constexpr bool PERM = false, AFTER_DRAIN = false;
    float* C; int ldc;
    __device__ __forceinline__ void operator()(const f32x4 (&acc)[2][2][4][2], const Unit& u, int wr, int wc, int fr, int fq) const {
        const int row0 = u.pm * BM + wr * 64 + fr, col0 = u.pn * BM + wc * 32 + 4 * fq;
#pragma unroll
        for (int ai = 0; ai < 2; ++ai)
#pragma unroll
            for (int m = 0; m < 4; ++m) { float* rowp = C + (size_t)(row0 + ai * HALF + m * 16) * ldc + col0;
#pragma unroll
                for (int bj = 0; bj < 2; ++bj)
#pragma unroll
                    for (int n = 0; n < 2; ++n) *(f32x4*)(rowp + bj * HALF + n * 16) = acc[ai][bj][m][n]; }
    }
};
struct EpiBf16Plain {
    static constexpr bool PERM = true, AFTER_DRAIN = false;
    bf16_t* O; int ldc;
    __device__ __forceinline__ void operator()(const f32x4 (&acc)[2][2][4][2], const Unit& u, int wr, int wc, int fr, int fq) const {
        const int row0 = u.pm * BM + wr * 64 + fr, col0 = u.pn * BM + wc * 32 + 8 * fq;
#pragma unroll
        for (int ai = 0; ai < 2; ++ai)
#pragma unroll
            for (int m = 0; m < 4; ++m) { bf16_t* rowp = O + (size_t)(row0 + ai * HALF + m * 16) * ldc + col0;
#pragma unroll
                for (int bj = 0; bj < 2; ++bj) { const f32x4 v0 = acc[ai][bj][m][0], v1 = acc[ai][bj][m][1];
                    u32x4 w; w.x = cvt_pk_bf16(v0[0], v0[1]); w.y = cvt_pk_bf16(v0[2], v0[3]); w.z = cvt_pk_bf16(v1[0], v1[1]); w.w = cvt_pk_bf16(v1[2], v1[3]);
                    *(u32x4*)(rowp + bj * HALF) = w; } }
    }
};
struct EpiGdnProj {
    static constexpr bool PERM = true, AFTER_DRAIN = false;
    bf16_t* O; int ldc; float* BA; int ntile_bf;
    __device__ __forceinline__ void operator()(const f32x4 (&acc)[2][2][4][2], const Unit& u, int wr, int wc, int fr, int fq) const {
        const int row0 = u.pm * BM + wr * 64 + fr;
        if (u.pn < ntile_bf) {
            const int col0 = u.pn * BM + wc * 32 + 8 * fq;
#pragma unroll
            for (int ai = 0; ai < 2; ++ai)
#pragma unroll
                for (int m = 0; m < 4; ++m) { bf16_t* rowp = O + (size_t)(row0 + ai * HALF + m * 16) * ldc + col0;
#pragma unroll
                    for (int bj = 0; bj < 2; ++bj) { const f32x4 v0 = acc[ai][bj][m][0], v1 = acc[ai][bj][m][1];
                        u32x4 w; w.x = cvt_pk_bf16(v0[0], v0[1]); w.y = cvt_pk_bf16(v0[2], v0[3]); w.z = cvt_pk_bf16(v1[0], v1[1]); w.w = cvt_pk_bf16(v1[2], v1[3]);
                        *(u32x4*)(rowp + bj * HALF) = w; } }
        } else if (wc < 2) {
            const int col0 = wc * 32 + 8 * fq;
#pragma unroll
            for (int ai = 0; ai < 2; ++ai)
#pragma unroll
                for (int m = 0; m < 4; ++m) { float* rowp = BA + (size_t)(row0 + ai * HALF + m * 16) * 64 + col0;
                    *(f32x4*)(rowp) = acc[ai][0][m][0]; *(f32x4*)(rowp + 4) = acc[ai][0][m][1]; }
        }
    }
};
struct EpiSiluMul {
    static constexpr bool PERM = true, AFTER_DRAIN = false;
    bf16_t* O; int ldc;
    __device__ __forceinline__ void operator()(const f32x4 (&acc)[2][2][4][2], const Unit& u, int wr, int wc, int fr, int fq) const {
        const int row0 = u.pm * BM + wr * 64 + fr, col0 = u.pn * HALF + wc * 32 + 8 * fq;
#pragma unroll
        for (int ai = 0; ai < 2; ++ai)
#pragma unroll
            for (int m = 0; m < 4; ++m) { bf16_t* rowp = O + (size_t)(row0 + ai * HALF + m * 16) * ldc + col0;
                f32x4 r0, r1;
#pragma unroll
                for (int j = 0; j < 4; ++j) { const float g0 = acc[ai][0][m][0][j], g1 = acc[ai][0][m][1][j];
                    r0[j] = g0 * fast_sigmoid(g0) * acc[ai][1][m][0][j]; r1[j] = g1 * fast_sigmoid(g1) * acc[ai][1][m][1][j]; }
                u32x4 w; w.x = cvt_pk_bf16(r0[0], r0[1]); w.y = cvt_pk_bf16(r0[2], r0[3]); w.z = cvt_pk_bf16(r1[0], r1[1]); w.w = cvt_pk_bf16(r1[2], r1[3]);
                *(u32x4*)(rowp) = w; }
    }
};
struct EpiResid {
    static constexpr bool PERM = false, AFTER_DRAIN = false;
    const float* base; float* out; int ldc;
    __device__ __forceinline__ void operator()(const f32x4 (&acc)[2][2][4][2], const Unit& u, int wr, int wc, int fr, int fq) const {
        const int row0 = u.pm * BM + wr * 64 + fr, col0 = u.pn * BM + wc * 32 + 4 * fq;
#pragma unroll
        for (int ai = 0; ai < 2; ++ai)
#pragma unroll
            for (int m = 0; m < 4; ++m) { const size_t off = (size_t)(row0 + ai * HALF + m * 16) * ldc + col0;
#pragma unroll
                for (int bj = 0; bj < 2; ++bj)
#pragma unroll
                    for (int n = 0; n < 2; ++n) { const f32x4 bs = *(const f32x4*)(base + off + bj * HALF + n * 16); *(f32x4*)(out + off + bj * HALF + n * 16) = bs + acc[ai][bj][m][n]; }
                if (m & 1) asm volatile("" ::: "memory"); }
    }
};
struct EpiPleGate {
    static constexpr bool PERM = false, AFTER_DRAIN = false;
    const float* base; float* out; int ldc; const bf16_t* e; const float* rstd; const float* wn;
    __device__ __forceinline__ void operator()(const f32x4 (&acc)[2][2][4][2], const Unit& u, int wr, int wc, int fr, int fq) const {
        const int row0 = u.pm * BM + wr * 64 + fr, col0 = u.pn * BM + wc * 32 + 4 * fq;
        f32x4 wv[2][2];
#pragma unroll
        for (int bj = 0; bj < 2; ++bj)
#pragma unroll
            for (int n = 0; n < 2; ++n) wv[bj][n] = *(const f32x4*)(wn + col0 + bj * HALF + n * 16);
#pragma unroll
        for (int ai = 0; ai < 2; ++ai)
#pragma unroll
            for (int m = 0; m < 4; ++m) { const int row = row0 + ai * HALF + m * 16; const size_t off = (size_t)row * ldc + col0; const float rs = rstd[row];
#pragma unroll
                for (int bj = 0; bj < 2; ++bj)
#pragma unroll
                    for (int n = 0; n < 2; ++n) { const f32x4 bs = *(const f32x4*)(base + off + bj * HALF + n * 16);
                        const unsigned long long ev = *(const unsigned long long*)(e + off + bj * HALF + n * 16);
                        f32x4 ef; ef[0] = __uint_as_float((unsigned)(ev & 0xffffu) << 16); ef[1] = __uint_as_float((unsigned)(ev >> 16) << 16);
                        ef[2] = __uint_as_float((unsigned)((ev >> 32) & 0xffffu) << 16); ef[3] = __uint_as_float((unsigned)(ev >> 48) << 16);
                        const f32x4 a = acc[ai][bj][m][n]; f32x4 o;
#pragma unroll
                        for (int j = 0; j < 4; ++j) o[j] = bs[j] + ef[j] * rs * wv[bj][n][j] * fast_sigmoid(a[j]);
                        *(f32x4*)(out + off + bj * HALF + n * 16) = o; }
                if (m & 1) asm volatile("" ::: "memory"); }
    }
};

template <class Epi, class Sched, bool ALIGN_EPI = false, bool SP2 = false>
__device__ __forceinline__ void gemm_phase(PG8_LAS unsigned char* lds, const Gemm g, const Sched& S, const Epi& E) {
    int tid_ = threadIdx.x; asm volatile("" : "+v"(tid_));
    const int tid = tid_, wid = __builtin_amdgcn_readfirstlane(tid >> 6), lane = tid & 63, wr = wid >> 2, wc = wid & 3, fr = lane & 15, fq = lane >> 4;
    const int K = g.K, nt = K / BK;
    unsigned voffA[2], voffB[2];
#pragma unroll
    for (int i = 0; i < 2; ++i) { int R, C; stage_rc(tid * 16 + i * 8192, R, C); const int Rb = Epi::PERM ? ((R & ~31) + perm32(R & 31)) : R;
        voffA[i] = (unsigned)(R * g.lda + C) * 2u; voffB[i] = (unsigned)(Rb * g.ldb + C) * 2u; }
    const size_t kstep = (size_t)(BK * 2);
    const size_t hstepA = (size_t)HALF * g.lda * 2, hstepB = (size_t)HALF * g.ldb * 2;
    const size_t tstepA = 2 * hstepA, tstepB = 2 * hstepB;
    const unsigned ldsw = (unsigned)wid * 1024u;
    const int aoff = lds_byte(wr * 64 + fr, fq * 8), boff = lds_byte(wc * 32 + fr, fq * 8);
#define PG8_SA(b, h) (((b) * 2 + (h)) * HTB)
#define PG8_SB(b, h) ((4 + (b) * 2 + (h)) * HTB)
#define PG8_STAGE(bufoff, gbase, voff) do { _Pragma("unroll") for (int _i = 0; _i < 2; ++_i) \
        __builtin_amdgcn_global_load_lds((const unsigned*)((const char*)(gbase) + (voff)[_i]), (PG8_LAS unsigned*)(lds + (bufoff) + ldsw + _i * 8192), 16, 0, 0); } while (0)
#define PG8_LDA(dst, b, h) do { _Pragma("unroll") for (int m = 0; m < 4; ++m) _Pragma("unroll") for (int k = 0; k < 2; ++k) dst[m][k] = *(const PG8_LAS bf16x8*)(lds + PG8_SA(b, h) + aoff + m * 2048 + k * 1024); } while (0)
#define PG8_LDB(dst, b, h) do { _Pragma("unroll") for (int n = 0; n < 2; ++n) _Pragma("unroll") for (int k = 0; k < 2; ++k) dst[n][k] = *(const PG8_LAS bf16x8*)(lds + PG8_SB(b, h) + boff + n * 2048 + k * 1024); } while (0)
#define PG8_MMA(ai, bj, At, Bt) do { __builtin_amdgcn_s_setprio(1); _Pragma("unroll") for (int m = 0; m < 4; ++m) _Pragma("unroll") for (int n = 0; n < 2; ++n) _Pragma("unroll") for (int k = 0; k < 2; ++k) \
        acc[ai][bj][m][n] = __builtin_amdgcn_mfma_f32_16x16x32_bf16(Bt[n][k], At[m][k], acc[ai][bj][m][n], 0, 0, 0); __builtin_amdgcn_s_setprio(0); } while (0)
#define PG8_WAIT_V(n) asm volatile("s_waitcnt vmcnt(" #n ")" ::: "memory")
#define PG8_WAIT_L(n) asm volatile("s_waitcnt lgkmcnt(" #n ")" ::: "memory")
#define PG8_BAR __builtin_amdgcn_s_barrier()
#define PG8_SCHED __builtin_amdgcn_sched_barrier(0)
    Unit cur, nxt; int ui = 0;
    if (!S.next(0, cur)) return;
    f32x4 acc[2][2][4][2];
#pragma unroll
    for (int a = 0; a < 2; ++a)
#pragma unroll
        for (int b = 0; b < 2; ++b)
#pragma unroll
            for (int m = 0; m < 4; ++m)
#pragma unroll
                for (int n = 0; n < 2; ++n) acc[a][b][m][n] = (f32x4){0.f, 0.f, 0.f, 0.f};
    bf16x8 At[4][2], B0[2][2], B1[2][2];
    const char* cA = (const char*)g.A + (size_t)cur.pm * tstepA; const char* cB = (const char*)g.Bt + (size_t)cur.pn * tstepB;
    S.a_ready(cur);
    if constexpr (SP2) {
        PG8_STAGE(PG8_SB(0, 0), cB, voffB); PG8_STAGE(PG8_SB(0, 1), cB + hstepB, voffB); PG8_STAGE(PG8_SA(0, 0), cA, voffA); PG8_STAGE(PG8_SA(0, 1), cA + hstepA, voffA);
        if (wr == 1) PG8_BAR;
        PG8_WAIT_V(2); PG8_BAR;
        PG8_STAGE(PG8_SB(1, 0), cB + kstep, voffB); PG8_STAGE(PG8_SA(1, 0), cA + kstep, voffA); PG8_STAGE(PG8_SB(1, 1), cB + hstepB + kstep, voffB);
        PG8_WAIT_V(6); PG8_BAR;
    } else {
        PG8_STAGE(PG8_SB(0, 0), cB, voffB); PG8_STAGE(PG8_SA(0, 0), cA, voffA); PG8_STAGE(PG8_SB(0, 1), cB + hstepB, voffB); PG8_STAGE(PG8_SA(0, 1), cA + hstepA, voffA);
        if (wr == 1) PG8_BAR;
        PG8_WAIT_V(4); PG8_BAR;
        PG8_STAGE(PG8_SB(1, 0), cB + kstep, voffB); PG8_STAGE(PG8_SA(1, 0), cA + kstep, voffA); PG8_STAGE(PG8_SB(1, 1), cB + hstepB + kstep, voffB);
        PG8_WAIT_V(6); PG8_BAR;
    }
    for (;;) {
        const bool has_next = S.next(ui + 1, nxt);
        const char* nA = has_next ? (const char*)g.A + (size_t)nxt.pm * tstepA : cA; const char* nB = has_next ? (const char*)g.Bt + (size_t)nxt.pn * tstepB : cB;
        for (int t = 0; t < nt; t += 2) {
            const bool last = (t == nt - 2);
            const char* a1 = cA + (size_t)(t + 1) * kstep;
            const char* a2 = last ? nA : cA + (size_t)(t + 2) * kstep; const char* b2 = last ? nB : cB + (size_t)(t + 2) * kstep;
            const char* a3 = a2 + kstep; const char* b3 = b2 + kstep;
            if (last && has_next) S.a_ready(nxt);
            if constexpr (SP2) {
            PG8_LDB(B0, 0, 0); PG8_LDB(B1, 0, 1); PG8_SCHED; PG8_LDA(At, 0, 0); PG8_STAGE(PG8_SA(1, 1), a1 + hstepA, voffA);
            PG8_WAIT_V(8); PG8_WAIT_L(0); PG8_BAR; PG8_MMA(0, 0, At, B0); PG8_MMA(0, 1, At, B1); PG8_BAR; PG8_SCHED;
            PG8_LDA(At, 0, 1); PG8_STAGE(PG8_SB(0, 0), b2, voffB); PG8_STAGE(PG8_SB(0, 1), b2 + hstepB, voffB); PG8_STAGE(PG8_SA(0, 0), a2, voffA);
            PG8_WAIT_V(8); PG8_WAIT_L(0); PG8_BAR; PG8_MMA(1, 0, At, B0); PG8_MMA(1, 1, At, B1); PG8_BAR; PG8_SCHED;
            PG8_LDB(B0, 1, 0); PG8_LDB(B1, 1, 1); PG8_SCHED; PG8_LDA(At, 1, 0); PG8_STAGE(PG8_SA(0, 1), a2 + hstepA, voffA);
            PG8_WAIT_V(8); PG8_WAIT_L(0); PG8_BAR; PG8_MMA(0, 0, At, B0); PG8_MMA(0, 1, At, B1); PG8_BAR; PG8_SCHED;
            PG8_LDA(At, 1, 1); PG8_STAGE(PG8_SB(1, 0), b3, voffB); PG8_STAGE(PG8_SB(1, 1), b3 + hstepB, voffB); PG8_STAGE(PG8_SA(1, 0), a3, voffA);
            PG8_WAIT_V(8); PG8_WAIT_L(0); PG8_BAR; PG8_MMA(1, 0, At, B0); PG8_MMA(1, 1, At, B1); PG8_BAR; PG8_SCHED;
            } else {
            PG8_LDB(B0, 0, 0); PG8_SCHED; PG8_LDA(At, 0, 0); PG8_STAGE(PG8_SA(1, 1), a1 + hstepA, voffA);
            PG8_WAIT_L(8); PG8_BAR; PG8_WAIT_L(0); PG8_MMA(0, 0, At, B0); PG8_BAR; PG8_SCHED;
            PG8_LDB(B1, 0, 1); PG8_STAGE(PG8_SB(0, 0), b2, voffB);
            PG8_BAR; PG8_WAIT_L(0); PG8_MMA(0, 1, At, B1); PG8_BAR;
            PG8_LDA(At, 0, 1); PG8_STAGE(PG8_SA(0, 0), a2, voffA);
            PG8_BAR; PG8_WAIT_L(0); PG8_MMA(1, 0, At, B0); PG8_BAR; PG8_SCHED;
            PG8_STAGE(PG8_SB(0, 1), b2 + hstepB, voffB);
            PG8_WAIT_V(6); PG8_BAR; PG8_MMA(1, 1, At, B1); PG8_BAR;
            PG8_LDB(B0, 1, 0); PG8_SCHED; PG8_LDA(At, 1, 0); PG8_STAGE(PG8_SA(0, 1), a2 + hstepA, voffA);
            PG8_WAIT_L(8); PG8_BAR; PG8_WAIT_L(0); PG8_MMA(0, 0, At, B0); PG8_BAR; PG8_SCHED;
            PG8_LDB(B1, 1, 1); PG8_STAGE(PG8_SB(1, 0), b3, voffB);
            PG8_BAR; PG8_WAIT_L(0); PG8_MMA(0, 1, At, B1); PG8_BAR;
            PG8_LDA(At, 1, 1); PG8_STAGE(PG8_SA(1, 0), a3, voffA);
            PG8_BAR; PG8_WAIT_L(0); PG8_MMA(1, 0, At, B0); PG8_BAR; PG8_SCHED;
            PG8_STAGE(PG8_SB(1, 1), b3 + hstepB, voffB);
            PG8_WAIT_V(6); PG8_BAR; PG8_MMA(1, 1, At, B1); PG8_BAR;
            }
        }
        if constexpr (ALIGN_EPI) { if (wr == 0) PG8_BAR; }
        if constexpr (!Epi::AFTER_DRAIN) { E(acc, cur, wr, wc, fr, fq); S.done(cur); }
        if (!has_next) break;
#pragma unroll
        for (int a = 0; a < 2; ++a)
#pragma unroll
            for (int b = 0; b < 2; ++b)
#pragma unroll
                for (int m = 0; m < 4; ++m)
#pragma unroll
                    for (int n = 0; n < 2; ++n) acc[a][b][m][n] = (f32x4){0.f, 0.f, 0.f, 0.f};
        cur = nxt; cA = nA; cB = nB; ++ui;
        if constexpr (ALIGN_EPI) { if (wr == 1) PG8_BAR; }
    }
    PG8_WAIT_V(0);
    if constexpr (!ALIGN_EPI) { if (wr == 0) PG8_BAR; }
    PG8_BAR;
    if constexpr (Epi::AFTER_DRAIN) { E.fused(acc, cur, wr, wc, fr, fq, lds, wid, lane); S.done(cur); }
#undef PG8_SA
#undef PG8_SB
#undef PG8_STAGE
#undef PG8_LDA
#undef PG8_LDB
#undef PG8_MMA
#undef PG8_WAIT_V
#undef PG8_WAIT_L
#undef PG8_BAR
#undef PG8_SCHED
}
}
#define XB_TMO      128
#define XB_XCNT(j)  (256  + 64 * (j))
#define XB_XSUB(j)  (1280 + 64 * (j))
#define XB_XGEN(j)  (2304 + 64 * (j))
#define XB_TOP      3328
#define XB_TOPGEN   3392
#define XCD_BAR_WORDS 3456
#define XB_SPIN_CAP (1u << 18)

__device__ __forceinline__ unsigned xb_ld(unsigned* p)              { return __hip_atomic_load(p, __ATOMIC_RELAXED, __HIP_MEMORY_SCOPE_AGENT); }
__device__ __forceinline__ unsigned xb_add(unsigned* p, unsigned v) { return __hip_atomic_fetch_add(p, v, __ATOMIC_RELAXED, __HIP_MEMORY_SCOPE_AGENT); }
__device__ __forceinline__ unsigned xb_xcc_id() { return (unsigned)__builtin_amdgcn_s_getreg((3 << 11) | 20) & 0xFu; }
#define XB_SPIN(cond, bar) do { unsigned _sp = 0; while (cond) { __builtin_amdgcn_s_sleep(1); \
    if ((++_sp & 255u) == 0u) { if (xb_ld(&(bar)[XB_TMO])) break; if (_sp > XB_SPIN_CAP) { atomicAdd(&(bar)[XB_TMO], 1u); break; } } } } while (0)

struct XcdBarrier {
    unsigned* bar; unsigned x;
    volatile LAS unsigned* st;
};

__device__ __forceinline__ XcdBarrier xcd_barrier_post(unsigned* bar, volatile LAS unsigned* st) {
    XcdBarrier b; b.bar = bar; b.x = xb_xcc_id(); b.st = st;
    if (threadIdx.x == 0) (void)xb_add(&bar[XB_XCNT(b.x)], 1u);
    return b;
}
__device__ __forceinline__ void xcd_barrier_complete(unsigned* bar, unsigned x, unsigned& nloc, unsigned& nx) {
    const unsigned G = gridDim.x * gridDim.y * gridDim.z;
    unsigned sum, cnt, mine, sp = 0u;
    for (;;) {
        sum = 0u; cnt = 0u; mine = 0u;
#pragma unroll
        for (unsigned j = 0; j < 16; ++j) { const unsigned c = xb_ld(&bar[XB_XCNT(j)]); sum += c; cnt += (c > 0u) ? 1u : 0u; mine = (j == x) ? c : mine; }
        if (sum == G) break;
        __builtin_amdgcn_s_sleep(1);
        if ((++sp & 255u) == 0u) { if (xb_ld(&bar[XB_TMO])) break; if (sp > XB_SPIN_CAP) { atomicAdd(&bar[XB_TMO], 1u); break; } }
    }
    nloc = mine > 0u ? mine : 1u; nx = cnt > 0u ? cnt : 1u;
}

__device__ __forceinline__ void xcd_barrier(const XcdBarrier& b) {
    asm volatile("s_waitcnt vmcnt(0)" ::: "memory");
    __syncthreads();
    if (threadIdx.x == 0) {
        unsigned* bar = b.bar;
        __builtin_amdgcn_s_waitcnt(0);
        unsigned nloc = b.st[0], nx = b.st[1];
        if (nloc == 0u) { xcd_barrier_complete(bar, b.x, nloc, nx); b.st[0] = nloc; b.st[1] = nx; }
        const unsigned old = xb_add(&bar[XB_XSUB(b.x)], 1u);
        const unsigned gen = old / nloc;
        if (old + 1u == (gen + 1u) * nloc) {
            __builtin_amdgcn_fence(__ATOMIC_RELEASE, "agent");
            asm volatile("s_waitcnt vmcnt(0)" ::: "memory");
            const unsigned og = xb_add(&bar[XB_TOP], 1u);
            const unsigned tg = og / nx;
            if (og + 1u == (tg + 1u) * nx) xb_add(&bar[XB_TOPGEN], 1u);
            else XB_SPIN(xb_ld(&bar[XB_TOPGEN]) == tg, bar);
            __builtin_amdgcn_fence(__ATOMIC_ACQUIRE, "agent");
            xb_add(&bar[XB_XGEN(b.x)], 1u);
            asm volatile("s_waitcnt vmcnt(0)" ::: "memory");
        } else {
            XB_SPIN(xb_ld(&bar[XB_XGEN(b.x)]) == gen, bar);
            __builtin_amdgcn_fence(__ATOMIC_ACQUIRE, "agent");
            asm volatile("s_waitcnt vmcnt(0)" ::: "memory");
        }
    }
    __syncthreads();
}
template <int MODE>
__device__ __forceinline__ void transpose_item(const float* W, int K, int N, bf16* WT, int row_off, LAS float* scr, int item, int lane) {
    const int nblk = N / 32, kb = item / nblk, nb = item % nblk, k0 = 64 * kb, n0 = 32 * nb;
#pragma unroll 8
    for (int i = 0; i < 32; ++i) { const int kk = 2 * i + (lane >> 5); scr[kk * 33 + (lane & 31)] = W[(size_t)(k0 + kk) * N + n0 + (lane & 31)]; }
    LDS_WAIT(); asm volatile("" ::: "memory");
    int d0;
    if (MODE == 0) d0 = row_off + n0;
    else { const int half = n0 >= DFF ? 1 : 0, nn = n0 - half * DFF; d0 = (nn >> 7) * 256 + half * 128 + (nn & 127); }
    const int c = lane & 7;
#pragma unroll
    for (int j = 0; j < 4; ++j) { const int n = (lane >> 3) + 8 * j; const LAS float* s = scr + (8 * c) * 33 + n;
        v4u o; o.x = pk2(s[0 * 33], s[1 * 33]); o.y = pk2(s[2 * 33], s[3 * 33]); o.z = pk2(s[4 * 33], s[5 * 33]); o.w = pk2(s[6 * 33], s[7 * 33]);
        *(v4u*)(WT + (size_t)(d0 + n) * K + k0 + 8 * c) = o; }
    LDS_WAIT(); asm volatile("" ::: "memory");
}
template <int MODE>
__device__ __forceinline__ void convert_matrix(const float* W, int K, int N, bf16* WT, int row_off, LAS float* scr, int gw, int NGW, int lane) {
    const int nitems = (K / 64) * (N / 32);
    for (int it = gw; it < nitems; it += NGW) transpose_item<MODE>(W, K, N, WT, row_off, scr, it, lane);
}
__device__ __forceinline__ void zero_rows(bf16* WT, int K, int row0, int nrows, int gtid, int NGT) {
    const size_t n16 = (size_t)nrows * K / 8; v4u* p = (v4u*)(WT + (size_t)row0 * K);
    unsigned z = 0u; asm volatile("" : "+v"(z));
    for (size_t i = gtid; i < n16; i += NGT) p[i] = (v4u){z, z, z, z};
}
__device__ __forceinline__ void rms_row_2048(const float* xrow, const float* w, bf16* orow, int lane) {
    const f32x4* xr = (const f32x4*)xrow + lane; f32x4 v[8]; float s = 0.f;
#pragma unroll
    for (int j = 0; j < 8; ++j) { v[j] = xr[64 * j]; s += (v[j].x * v[j].x + v[j].y * v[j].y) + (v[j].z * v[j].z + v[j].w * v[j].w); }
    const float rstd = rsqrtf(wave_sum(s) * (1.f / 2048.f) + NORM_EPS);
    const f32x4* wr = (const f32x4*)w + lane; v2u* o8 = (v2u*)orow + lane;
#pragma unroll
    for (int j = 0; j < 8; ++j) { const f32x4 g = wr[64 * j]; v2u o; o.x = pk2(v[j].x * rstd * g.x, v[j].y * rstd * g.y); o.y = pk2(v[j].z * rstd * g.z, v[j].w * rstd * g.w); o8[64 * j] = o; }
}
__device__ __forceinline__ void phase_rmsnorm(const float* h, const float* w, bf16* hn, int gw, int NGW, int lane) {
    for (int m = gw; m < NT; m += NGW) rms_row_2048(h + (size_t)m * DM, w, hn + (size_t)m * DM, lane);
}
__device__ __forceinline__ void phase_rope_table(const int* positions, float* cs, int gtid, int NGT) {
    for (int idx = gtid; idx < NT * 32; idx += NGT) {
        const int t = idx >> 5, i = idx & 31;
        const float inv_freq = __builtin_amdgcn_exp2f(-(float)i * (13.287712379549449f / 32.0f));
        const float ang = (float)positions[t] * inv_freq;
        const double rev = (double)ang * 0.15915494309189535; const double fr = rev - floor(rev);
        const float x = (float)(fr * 6.283185307179586);
        cs[(size_t)t * 64 + i] = cosf(x); cs[(size_t)t * 64 + 32 + i] = sinf(x);
    }
}
__device__ __forceinline__ void phase_mla_latnorm(const float* c, const float* wq, const float* wkv, bf16* qkvn, float* kpe, int gw, int NGW, int lane) {
    for (int m = gw; m < NT; m += NGW) {
        const f32x4* cr = (const f32x4*)(c + (size_t)m * MLA_IN_PAD);
        f32x4 a0 = cr[lane], a1 = cr[64 + lane], b0 = cr[128 + lane], b1 = cr[192 + lane];
        float sa = (a0.x * a0.x + a0.y * a0.y) + (a0.z * a0.z + a0.w * a0.w) + (a1.x * a1.x + a1.y * a1.y) + (a1.z * a1.z + a1.w * a1.w);
        float sb = (b0.x * b0.x + b0.y * b0.y) + (b0.z * b0.z + b0.w * b0.w) + (b1.x * b1.x + b1.y * b1.y) + (b1.z * b1.z + b1.w * b1.w);
        const float ra = rsqrtf(wave_sum(sa) * (1.f / 512.f) + NORM_EPS), rb = rsqrtf(wave_sum(sb) * (1.f / 512.f) + NORM_EPS);
        const f32x4 wa0 = ((const f32x4*)wq)[lane], wa1 = ((const f32x4*)wq)[64 + lane], wb0 = ((const f32x4*)wkv)[lane], wb1 = ((const f32x4*)wkv)[64 + lane];
        v2u* o = (v2u*)(qkvn + (size_t)m * 1024); v2u t;
        t.x = pk2(a0.x * ra * wa0.x, a0.y * ra * wa0.y); t.y = pk2(a0.z * ra * wa0.z, a0.w * ra * wa0.w); o[lane] = t;
        t.x = pk2(a1.x * ra * wa1.x, a1.y * ra * wa1.y); t.y = pk2(a1.z * ra * wa1.z, a1.w * ra * wa1.w); o[64 + lane] = t;
        t.x = pk2(b0.x * rb * wb0.x, b0.y * rb * wb0.y); t.y = pk2(b0.z * rb * wb0.z, b0.w * rb * wb0.w); o[128 + lane] = t;
        t.x = pk2(b1.x * rb * wb1.x, b1.y * rb * wb1.y); t.y = pk2(b1.z * rb * wb1.z, b1.w * rb * wb1.w); o[192 + lane] = t;
        if (lane < 16) ((f32x4*)(kpe + (size_t)m * 64))[lane] = cr[256 + lane];
    }
}
__device__ __forceinline__ void phase_mla_finalize(const bf16* qraw, const bf16* kvraw, const float* kpe, const float* cs, const float* qnw, const float* knw,
                                                   bf16* qf, bf16* kf, bf16* vf, int gw, int NGW, int lane) {
    const float wq0 = qnw[lane], wq1 = qnw[64 + lane], wq2 = qnw[128 + lane], wk0 = knw[lane], wk1 = knw[64 + lane], wk2 = knw[128 + lane];
    for (int m = gw; m < NT; m += NGW) {
        const int b = m / SEQ, s = m % SEQ;
        const float cv = cs[(size_t)m * 64 + (lane & 31)], sv = cs[(size_t)m * 64 + 32 + (lane & 31)];
        const float pe = kpe[(size_t)m * 64 + lane];
        const bf16* qr = qraw + (size_t)m * (MLA_H * MLA_QK); const bf16* kr = kvraw + (size_t)m * (MLA_H * 256);
        for (int h = 0; h < MLA_H; ++h) {
            const size_t ob = ((size_t)(b * MLA_H + h) * SEQ + s);
            float x0 = bf2f(qr[h * 192 + lane]), x1 = bf2f(qr[h * 192 + 64 + lane]), x2 = bf2f(qr[h * 192 + 128 + lane]);
            float rs = rsqrtf(wave_sum(x0 * x0 + x1 * x1 + x2 * x2) * (1.f / 192.f) + NORM_EPS);
            x0 *= rs * wq0; x1 *= rs * wq1; x2 *= rs * wq2;
            float pr = __shfl_xor(x2, 32);
            float r2 = lane < 32 ? x2 * cv - pr * sv : x2 * cv + pr * sv;
            bf16* qo = qf + ob * MLA_QK; qo[lane] = (bf16)f2bf(x0); qo[64 + lane] = (bf16)f2bf(x1); qo[128 + lane] = (bf16)f2bf(r2);
            float k0 = bf2f(kr[h * 256 + lane]), k1 = bf2f(kr[h * 256 + 64 + lane]), k2 = pe;
            rs = rsqrtf(wave_sum(k0 * k0 + k1 * k1 + k2 * k2) * (1.f / 192.f) + NORM_EPS);
            k0 *= rs * wk0; k1 *= rs * wk1; k2 *= rs * wk2;
            pr = __shfl_xor(k2, 32);
            r2 = lane < 32 ? k2 * cv - pr * sv : k2 * cv + pr * sv;
            bf16* ko = kf + ob * MLA_QK; ko[lane] = (bf16)f2bf(k0); ko[64 + lane] = (bf16)f2bf(k1); ko[128 + lane] = (bf16)f2bf(r2);
            bf16* vo = vf + ob * MLA_V; vo[lane] = kr[h * 256 + 128 + lane]; vo[64 + lane] = kr[h * 256 + 192 + lane];
        }
    }
}
__device__ __forceinline__ void phase_cvt_bf16(const float* src, bf16* dst, size_t n, int gtid, int NGT) {
    const size_t n8 = n / 8;
    for (size_t i = gtid; i < n8; i += NGT) { const f32x4 a = ((const f32x4*)src)[2 * i], b = ((const f32x4*)src)[2 * i + 1];
        v4u o; o.x = pk2(a.x, a.y); o.y = pk2(a.z, a.w); o.z = pk2(b.x, b.y); o.w = pk2(b.z, b.w); ((v4u*)dst)[i] = o; }
}
__device__ __forceinline__ void phase_rstd_e(const bf16* e, float* rstd, int gw, int NGW, int lane) {
    for (int m = gw; m < NT; m += NGW) {
        const v4u* er = (const v4u*)(e + (size_t)m * DM) + lane; float s = 0.f;
#pragma unroll
        for (int j = 0; j < 4; ++j) { const v4u w = er[64 * j];
            const float a0 = bflo(w.x), a1 = bfhi(w.x), a2 = bflo(w.y), a3 = bfhi(w.y), a4 = bflo(w.z), a5 = bfhi(w.z), a6 = bflo(w.w), a7 = bfhi(w.w);
            s += (a0 * a0 + a1 * a1) + (a2 * a2 + a3 * a3) + (a4 * a4 + a5 * a5) + (a6 * a6 + a7 * a7); }
        s = wave_sum(s);
        if (lane == 0) rstd[m] = rsqrtf(s * (1.f / 2048.f) + NORM_EPS);
    }
}

namespace attn {
constexpr int DQK = 192, DV = 128, QBLK = 32, KVBLK = 64, QB = 256;
constexpr int SHM_V = KVBLK * DV * 2, SHM_K = KVBLK * DQK * 2;
constexpr int OFF_V = 0, OFF_K = 2 * SHM_V, OFF_WS = OFF_K + 2 * SHM_K;
constexpr int OFF_Q = OFF_WS + NWAVES * 64 * 4;
constexpr int ATTN_LDS = OFF_Q + NWAVES * 4096;
constexpr float SCALE = 0.07216878364870322f;
constexpr float THR = 8.f;
#define SBAR() __builtin_amdgcn_sched_barrier(0)
__device__ __forceinline__ int v_rd_base(int lane) { return ((lane & 3) << 3) | (((lane >> 2) & 3) << 6) | (((lane >> 4) & 1) << 5) | (((lane >> 5) & 1) << 8); }
constexpr int v_rd_off(int d0, int ks, int half) { return d0 * 512 + ks * 4096 + half * 2048; }
__device__ __forceinline__ int crow(int r, int hi) { return (r & 3) + 8 * (r >> 2) + 4 * hi; }
__device__ __forceinline__ unsigned cvtpk(float lo, float hi) { unsigned r; asm volatile("v_cvt_pk_bf16_f32 %0, %1, %2" : "=v"(r) : "v"(lo), "v"(hi)); return r; }
__device__ __forceinline__ void mask_tile(f32x16& p0, f32x16& p1, int dq) {
    const float NEG = -__builtin_inff();
#pragma unroll
    for (int r = 0; r < 16; ++r) { const int c = (r & 3) + 8 * (r >> 2);
        if (dq - c < 0) p0[r] = NEG;
        if (dq - c - 32 < 0) p1[r] = NEG; }
}
__device__ __forceinline__ void partialSM(f32x16& p0, f32x16& p1, float& m_reg, float& mn, float& alpha) {
    float pmax = p0[0];
#pragma unroll
    for (int r = 1; r < 16; ++r) pmax = fmaxf(pmax, p0[r]);
#pragma unroll
    for (int r = 0; r < 16; ++r) pmax = fmaxf(pmax, p1[r]);
    { auto rr = __builtin_amdgcn_permlane32_swap(__float_as_uint(pmax), __float_as_uint(pmax), false, false);
      pmax = fmaxf(__uint_as_float(rr[0]), __uint_as_float(rr[1])); }
    constexpr float C2 = 1.4426950408889634f * SCALE;
    if (__builtin_expect(__all((pmax - m_reg) * SCALE <= THR), 1)) { mn = m_reg; alpha = 1.f; }
    else { mn = fmaxf(m_reg, pmax); alpha = __builtin_amdgcn_exp2f((m_reg - mn) * C2); m_reg = mn; }
    const float mnL = -mn * C2;
#pragma unroll
    for (int r = 0; r < 16; ++r) p0[r] = fmaf(p0[r], C2, mnL);
#pragma unroll
    for (int r = 0; r < 16; ++r) p1[r] = fmaf(p1[r], C2, mnL);
#pragma unroll
    for (int r = 0; r < 16; ++r) p0[r] = __builtin_amdgcn_exp2f(p0[r]);
}
__device__ __forceinline__ void finishSM(f32x16& p0, f32x16& p1, float alpha, float& l_reg, bf16x8& pa0, bf16x8& pa1, bf16x8& pa2, bf16x8& pa3) {
#pragma unroll
    for (int r = 0; r < 16; ++r) p1[r] = __builtin_amdgcn_exp2f(p1[r]);
    float ps = 0;
#pragma unroll
    for (int r = 0; r < 16; ++r) ps += p0[r];
#pragma unroll
    for (int r = 0; r < 16; ++r) ps += p1[r];
    { auto rr = __builtin_amdgcn_permlane32_swap(__float_as_uint(ps), __float_as_uint(ps), false, false);
      ps = __uint_as_float(rr[0]) + __uint_as_float(rr[1]); }
    l_reg = l_reg * alpha + ps;
#define PK4(P, B_, OUT) do { unsigned a0 = cvtpk(P[B_+0], P[B_+1]), a1 = cvtpk(P[B_+2], P[B_+3]);                          \
        unsigned b0 = cvtpk(P[B_+4], P[B_+5]), b1 = cvtpk(P[B_+6], P[B_+7]);                                             \
        auto r0 = __builtin_amdgcn_permlane32_swap(a0, b0, false, false); auto r1 = __builtin_amdgcn_permlane32_swap(a1, b1, false, false); \
        v4u w = {r0[0], r1[0], r0[1], r1[1]}; OUT = *reinterpret_cast<bf16x8*>(&w); } while (0)
    PK4(p0, 0, pa0); PK4(p0, 8, pa1); PK4(p1, 0, pa2); PK4(p1, 8, pa3);
#undef PK4
}
__device__ __forceinline__ int k_off(int row, int ch) { return row * 384 + ((ch ^ ((row >> 1) & 7)) << 4); }
template <int KB>
__device__ __forceinline__ void qkt(f32x16& p0, f32x16& p1, const LAS char* lds, int r32, int hi, const bf16x8* qr, const LAS char* qs) {
    p0 = f32x16{}; p1 = f32x16{};
    const LAS char* kb[4];
#pragma unroll
    for (int dd = 0; dd < 4; ++dd) kb[dd] = lds + OFF_K + KB * SHM_K + k_off(r32, dd * 2 + hi);
#pragma unroll
    for (int d0 = 0; d0 < 12; ++d0) { const LAS char* a = kb[d0 & 3] + (d0 >> 2) * 128;
        bf16x8 b0 = *reinterpret_cast<const LAS bf16x8*>(a);
        bf16x8 b1 = *reinterpret_cast<const LAS bf16x8*>(a + 32 * 384);
        const bf16x8 qv = d0 < 8 ? qr[d0 < 8 ? d0 : 0] : *reinterpret_cast<const LAS bf16x8*>(qs + (d0 - 8) * 1024);
        p0 = __builtin_amdgcn_mfma_f32_32x32x16_bf16(b0, qv, p0, 0, 0, 0);
        p1 = __builtin_amdgcn_mfma_f32_32x32x16_bf16(b1, qv, p1, 0, 0, 0); }
}
template <int VB>
__device__ __forceinline__ void pv_tile(f32x16* o, int vb0, bf16x8 pa0, bf16x8 pa1, bf16x8 pa2, bf16x8 pa3) {
#define TRRD(dst, off) asm volatile("ds_read_b64_tr_b16 %0, %1 offset:%2" : "=&v"(dst) : "v"(vb0), "i"(off) : "memory")
#define PV_D0(d0) do { s16x4 l0, l1, l2, l3, h0, h1, h2, h3; constexpr int b_ = OFF_V + VB * SHM_V + v_rd_off(d0, 0, 0); \
        TRRD(l0, b_); TRRD(h0, b_ + 2048); TRRD(l1, b_ + 4096); TRRD(h1, b_ + 6144); TRRD(l2, b_ + 8192); TRRD(h2, b_ + 10240); TRRD(l3, b_ + 12288); TRRD(h3, b_ + 14336); \
        asm volatile("s_waitcnt lgkmcnt(0)" ::: "memory"); SBAR(); \
        o[d0] = __builtin_amdgcn_mfma_f32_32x32x16_bf16(pa0, (bf16x8){l0[0], l0[1], l0[2], l0[3], h0[0], h0[1], h0[2], h0[3]}, o[d0], 0, 0, 0);   \
        o[d0] = __builtin_amdgcn_mfma_f32_32x32x16_bf16(pa1, (bf16x8){l1[0], l1[1], l1[2], l1[3], h1[0], h1[1], h1[2], h1[3]}, o[d0], 0, 0, 0);   \
        o[d0] = __builtin_amdgcn_mfma_f32_32x32x16_bf16(pa2, (bf16x8){l2[0], l2[1], l2[2], l2[3], h2[0], h2[1], h2[2], h2[3]}, o[d0], 0, 0, 0);   \
        o[d0] = __builtin_amdgcn_mfma_f32_32x32x16_bf16(pa3, (bf16x8){l3[0], l3[1], l3[2], l3[3], h3[0], h3[1], h3[2], h3[3]}, o[d0], 0, 0, 0); } while (0)
    PV_D0(0); PV_D0(1); PV_D0(2); PV_D0(3);
#undef PV_D0
#undef TRRD
}
__device__ __forceinline__ void attn_block(const bf16* Q, const bf16* Kh, const bf16* Vh, bf16* O, int ldo, int P0, LAS char* lds, int tid, int wid, int lane) {
    const int r32 = lane & 31, hi = lane >> 5;
    const int NTL = (P0 + QB) / KVBLK;
    const int qlo = P0 + wid * QBLK, qm = qlo + r32 - 4 * hi;
    LAS float* ws = (LAS float*)(lds + OFF_WS) + wid * 64; LAS float* li_l = ws; LAS float* al_l = ws + 32;
    unsigned ksrc[3], vsrc[2];
#pragma unroll
    for (int i = 0; i < 3; ++i) { const int p = i * 512 + tid, row = p / 24, pc = p % 24, c = pc ^ ((row >> 1) & 7); ksrc[i] = (unsigned)(row * 384 + c * 16); }
#pragma unroll
    for (int i = 0; i < 2; ++i) { const int p = i * 512 + tid; const int kk = ((p >> 7) << 3) | ((p >> 2) & 7), c = (((p >> 5) & 3) << 5) | ((p & 3) << 3);
        const int k = (kk & ~0xC) | ((kk & 4) << 1) | ((kk & 8) >> 1); vsrc[i] = (unsigned)(k * 256 + c * 2); }
#define ISSUE_TILE(t, slot) do { const char* kg_ = (const char*)Kh + (size_t)(t) * (KVBLK * 384); const char* vg_ = (const char*)Vh + (size_t)(t) * (KVBLK * 256); \
        _Pragma("unroll") for (int i_ = 0; i_ < 3; ++i_) __builtin_amdgcn_global_load_lds((const unsigned*)(kg_ + ksrc[i_]), (LAS unsigned*)(lds + OFF_K + (slot) * SHM_K + i_ * 8192 + wid * 1024), 16, 0, 0); \
        _Pragma("unroll") for (int i_ = 0; i_ < 2; ++i_) __builtin_amdgcn_global_load_lds((const unsigned*)(vg_ + vsrc[i_]), (LAS unsigned*)(lds + OFF_V + (slot) * SHM_V + i_ * 8192 + wid * 1024), 16, 0, 0); } while (0)
    ISSUE_TILE(0, 0);
    bf16x8 qr[8];
    LAS char* qs = lds + OFF_Q + wid * 4096 + lane * 16;
#pragma unroll
    for (int d0 = 0; d0 < 8; ++d0) qr[d0] = *reinterpret_cast<const bf16x8*>(Q + (size_t)(wid * QBLK + r32) * DQK + d0 * 16 + hi * 8);
#pragma unroll
    for (int d0 = 8; d0 < 12; ++d0) *reinterpret_cast<LAS bf16x8*>(qs + (d0 - 8) * 1024) = *reinterpret_cast<const bf16x8*>(Q + (size_t)(wid * QBLK + r32) * DQK + d0 * 16 + hi * 8);
    float m_reg = -1e30f, l_reg = 0; f32x16 o[4] = {};
    const int vb0 = (int)(uintptr_t)(lds) + v_rd_base(lane);
    VM_WAIT(); __syncthreads();
#define RESC(a) do { if (__any((a) < 1.f)) { if (hi == 0) al_l[r32] = (a); asm volatile("s_waitcnt lgkmcnt(0)" ::: "memory");              \
                     _Pragma("unroll") for (int d_ = 0; d_ < 4; ++d_) _Pragma("unroll") for (int r = 0; r < 16; ++r) o[d_][r] *= al_l[crow(r, hi)]; } } while (0)
#define STEP(t, SLOT) do { \
        if ((t) + 1 < NTL) ISSUE_TILE((t) + 1, (SLOT) ^ 1); \
        const int kb_ = (t) * KVBLK; \
        if (kb_ <= qlo + QBLK - 1) {                                          \
            f32x16 p0, p1; float mn, al; bf16x8 pa0, pa1, pa2, pa3; \
            qkt<SLOT>(p0, p1, lds, r32, hi, qr, qs); \
            if (kb_ + KVBLK - 1 > qlo) mask_tile(p0, p1, qm - kb_); \
            partialSM(p0, p1, m_reg, mn, al); RESC(al); \
            finishSM(p0, p1, al, l_reg, pa0, pa1, pa2, pa3); SBAR(); \
            pv_tile<SLOT>(o, vb0, pa0, pa1, pa2, pa3); } \
        VM_WAIT(); __syncthreads(); } while (0)
    for (int t = 0; t < NTL; t += 2) { STEP(t, 0); STEP(t + 1, 1); }
#undef STEP
#undef RESC
#undef ISSUE_TILE
    if (hi == 0) li_l[r32] = l_reg; asm volatile("s_waitcnt lgkmcnt(0)" ::: "memory");
    float rli[16];
#pragma unroll
    for (int r = 0; r < 16; ++r) rli[r] = __builtin_amdgcn_rcpf(li_l[crow(r, hi)]);
    bf16* Ow = O + (size_t)(wid * QBLK) * ldo;
#pragma unroll
    for (int r = 0; r < 16; ++r) { const int orow = crow(r, hi);
#pragma unroll
        for (int d0 = 0; d0 < 4; ++d0) { const float v = o[d0][r] * rli[r]; const float vn = __shfl_xor(v, 1);
            if ((r32 & 1) == 0) *(unsigned*)(Ow + (size_t)orow * ldo + d0 * 32 + r32) = cvtpk(v, vn); } }
    __syncthreads();
}
__device__ __forceinline__ void attn_phase(const bf16* qf, const bf16* kf, const bf16* vf, bf16* o, LAS char* lds, int vcu, int G, int tid, int wid, int lane) {
    constexpr int NQB = SEQ / QB, NPAIR = NQB / 2, TOTAL = NB * MLA_H * NPAIR;
    for (int L = vcu; L < TOTAL; L += G) {
        const int bh = L / NPAIR, x = L % NPAIR, b = bh / MLA_H, h = bh % MLA_H;
        const bf16* Kh = kf + (size_t)bh * SEQ * DQK; const bf16* Vh = vf + (size_t)bh * SEQ * DV;
#pragma unroll 1
        for (int pass = 0; pass < 2; ++pass) {
            const int qb = pass ? (NQB - 1 - x) : x, P0 = qb * QB;
            attn_block(qf + ((size_t)bh * SEQ + P0) * DQK, Kh, Vh, o + ((size_t)b * SEQ + P0) * (MLA_H * MLA_V) + h * MLA_V, MLA_H * MLA_V, P0, lds, tid, wid, lane);
        }
    }
}
#undef SBAR
}

namespace gdn {
__device__ __forceinline__ int crow(int r, int hi) { return (r & 3) + 8 * (r >> 2) + 4 * hi; }
__device__ __forceinline__ unsigned off_b(unsigned row, unsigned ch) { return 256u * row + 16u * (ch ^ (((row & 3) << 2) | ((row >> 2) & 3))); }
#define MFMA32(a, b, c) __builtin_amdgcn_mfma_f32_32x32x16_bf16((a), (b), (c), 0, 0, 0)
#define TR_ISSUE(lo, hi_, a0, a1) asm volatile("ds_read_b64_tr_b16 %0, %2\n\tds_read_b64_tr_b16 %1, %3" : "=&v"(lo), "=&v"(hi_) : "v"(a0), "v"(a1) : "memory")
#define TR_CAT(lo, hi_) ((bf16x8){lo[0], lo[1], lo[2], lo[3], hi_[0], hi_[1], hi_[2], hi_[3]})
__device__ __forceinline__ float softplus_f(float x) { return fmaxf(x, 0.f) + log1pf(__expf(-fabsf(x))); }

__device__ __forceinline__ void phase_halo(const bf16* proj, bf16* halo, int vcu, int G, int tid) {
    for (int u = vcu; u < NB * NCHUNK * 3; u += G) {
        const int j = u % 3, cn = u / 3, n = cn % NCHUNK, b = cn / NCHUNK;
        if (n == 0) continue;
        const v4u* src = (const v4u*)(proj + (size_t)(b * SEQ + 64 * n - 3 + j) * GDN_MAIN); v4u* dst = (v4u*)(halo + (size_t)u * GDN_CONV);
        dst[tid] = src[tid]; dst[512 + tid] = src[512 + tid];
    }
}
__device__ __forceinline__ void phase_conv(bf16* proj, const bf16* halo, const float* convw, int vcu, int G, int tid) {
    const int r = tid >> 3, pc = tid & 7;
    for (int u = vcu; u < NB * NCHUNK * 64; u += G) {
        const int hg = u & 63, cn = u >> 6, n = cn % NCHUNK, b = cn / NCHUNK;
        const int ch0 = hg * 128 + pc * 16;
        v4u x[4][2];
#pragma unroll
        for (int j = 0; j < 4; ++j) { const int rr = r - 3 + j;
            if (rr >= 0) { const v4u* p = (const v4u*)(proj + (size_t)(b * SEQ + 64 * n + rr) * GDN_MAIN + ch0); x[j][0] = p[0]; x[j][1] = p[1]; }
            else if (n > 0) { const v4u* p = (const v4u*)(halo + (size_t)(cn * 3 + 3 + rr) * GDN_CONV + ch0); x[j][0] = p[0]; x[j][1] = p[1]; }
            else { unsigned z = 0u; asm volatile("" : "+v"(z)); x[j][0] = (v4u){z, z, z, z}; x[j][1] = (v4u){z, z, z, z}; } }
        VM_WAIT(); __syncthreads();
        float y[16]; float ss = 0.f;
#pragma unroll
        for (int hlf = 0; hlf < 2; ++hlf) {
            float acc[8];
#pragma unroll
            for (int e = 0; e < 8; ++e) acc[e] = 0.f;
#pragma unroll
            for (int j = 0; j < 4; ++j) { const f32x4 w0 = *(const f32x4*)(convw + j * GDN_CONV + ch0 + hlf * 8), w1 = *(const f32x4*)(convw + j * GDN_CONV + ch0 + hlf * 8 + 4);
                const v4u xv = x[j][hlf];
                acc[0] += w0.x * bflo(xv.x); acc[1] += w0.y * bfhi(xv.x); acc[2] += w0.z * bflo(xv.y); acc[3] += w0.w * bfhi(xv.y);
                acc[4] += w1.x * bflo(xv.z); acc[5] += w1.y * bfhi(xv.z); acc[6] += w1.z * bflo(xv.w); acc[7] += w1.w * bfhi(xv.w); }
#pragma unroll
            for (int e = 0; e < 8; ++e) { const float s = fsilu(acc[e]); y[hlf * 8 + e] = s; ss += s * s; }
        }
        float scale = 1.f;
        if (hg < 32) { ss += __shfl_xor(ss, 1); ss += __shfl_xor(ss, 2); ss += __shfl_xor(ss, 4); scale = rsqrtf(ss + NORM_EPS); if (hg < 16) scale *= 0.08838834764831845f; }
        v4u o0, o1;
        o0.x = pk2(y[0] * scale, y[1] * scale); o0.y = pk2(y[2] * scale, y[3] * scale); o0.z = pk2(y[4] * scale, y[5] * scale); o0.w = pk2(y[6] * scale, y[7] * scale);
        o1.x = pk2(y[8] * scale, y[9] * scale); o1.y = pk2(y[10] * scale, y[11] * scale); o1.z = pk2(y[12] * scale, y[13] * scale); o1.w = pk2(y[14] * scale, y[15] * scale);
        v4u* po = (v4u*)(proj + (size_t)(b * SEQ + 64 * n + r) * GDN_MAIN + ch0); po[0] = o0; po[1] = o1;
    }
}
constexpr int P_KT = 0, P_QT = 16384, P_KK = 32768, P_QK = 49152, P_L = 65536, P_G = 98304, P_B = 98816;
__device__ __forceinline__ void phase_prep(const bf16* proj, const float* ba, const float* a_log, const float* dt_bias, bf16* TB, bf16* INTRA, float* gc,
                                           LAS unsigned char* lds, int vcu, int G, int tid, int wid, int lane) {
    const int r32 = lane & 31, hi = lane >> 5;
    for (int u = vcu; u < NB * NCHUNK * GDN_HQK; u += G) {
        const int hq = u & 15, cn = u >> 4, n = cn % NCHUNK, b = cn / NCHUNK; const size_t tok0 = (size_t)b * SEQ + 64 * n;
#pragma unroll
        for (int i = 0; i < 2; ++i) { const int idx = tid + 512 * i, row = idx >> 4, ch = idx & 15;
            const v4u kv = *(const v4u*)(proj + (tok0 + row) * GDN_MAIN + GDN_KEY + hq * 128 + ch * 8), qv = *(const v4u*)(proj + (tok0 + row) * GDN_MAIN + hq * 128 + ch * 8);
            *(LAS v4u*)(lds + P_KT + off_b(row, ch)) = kv; *(LAS v4u*)(lds + P_QT + off_b(row, ch)) = qv; }
        if (wid < 2) {
            const int h = 2 * hq + wid; const float av = ba[(tok0 + lane) * 64 + 32 + h], bv = ba[(tok0 + lane) * 64 + h];
            float g = -__expf(a_log[h]) * softplus_f(av + dt_bias[h]);
#pragma unroll
            for (int o = 1; o < 64; o <<= 1) { const float t = __shfl_up(g, o); if (lane >= o) g += t; }
            ((LAS float*)(lds + P_G))[wid * 64 + lane] = g; ((LAS float*)(lds + P_B))[wid * 64 + lane] = fsigmoid(bv);
            gc[((size_t)(b * GDN_HV + h)) * SEQ + 64 * n + lane] = g;
        }
        __syncthreads();
        {
            const int it = (wid >> 1) & 1, jt = wid & 1;
            if (!(it == 0 && jt == 1)) {
                const LAS unsigned char* As = lds + (wid < 4 ? P_KT : P_QT); const LAS unsigned char* Bs = lds + P_KT;
                f32x16 acc = {};
#pragma unroll
                for (int ks = 0; ks < 8; ++ks) { const bf16x8 a = *(const LAS bf16x8*)(As + off_b(32 * it + r32, 2 * ks + hi)), bb = *(const LAS bf16x8*)(Bs + off_b(32 * jt + r32, 2 * ks + hi));
                    acc = MFMA32(a, bb, acc); }
                LAS float* dst = (LAS float*)(lds + (wid < 4 ? P_KK : P_QK));
#pragma unroll
                for (int r = 0; r < 16; ++r) dst[(32 * it + crow(r, hi)) * 64 + 32 * jt + r32] = acc[r];
            }
        }
        __syncthreads();
        if (wid < 2) {
            const int h = 2 * hq + wid; const LAS float* Gv = (const LAS float*)(lds + P_G) + wid * 64; const LAS float* Bv = (const LAS float*)(lds + P_B) + wid * 64;
            const LAS float* KK = (const LAS float*)(lds + P_KK); LAS float* L = (LAS float*)(lds + P_L) + wid * 4096;
            const float gj = Gv[lane], bj = Bv[lane];
#pragma unroll 4
            for (int i = 0; i < 64; ++i) { const float v = Bv[i] * KK[i * 64 + lane] * __expf(Gv[i] - gj); L[i * 64 + lane] = (lane < i) ? v : 0.f; }
            LDS_WAIT();
            float Tc[64];
#pragma unroll
            for (int i = 0; i < 64; ++i) Tc[i] = 0.f;
#pragma unroll
            for (int i = 0; i < 64; ++i) {
                float acc = (lane == i) ? 1.f : 0.f;
#pragma unroll
                for (int jj = 0; jj < i; jj += 4) { const f32x4 l4 = *(const LAS f32x4*)(L + i * 64 + jj);
                    acc -= l4.x * Tc[jj]; acc -= l4.y * Tc[jj + 1]; acc -= l4.z * Tc[jj + 2]; acc -= l4.w * Tc[jj + 3]; }
                Tc[i] = acc;
            }
            bf16* dst = TB + ((size_t)(b * GDN_HV + h) * NCHUNK + n) * 4096;
#pragma unroll
            for (int i = 0; i < 64; ++i) dst[i * 64 + lane] = (bf16)f2bf(Tc[i] * bj);
        } else if (wid < 4) {
            const int vh = wid - 2, h = 2 * hq + vh; const LAS float* Gv = (const LAS float*)(lds + P_G) + vh * 64; const LAS float* QK = (const LAS float*)(lds + P_QK);
            const float gj = Gv[lane]; bf16* dst = INTRA + ((size_t)(b * GDN_HV + h) * NCHUNK + n) * 4096;
#pragma unroll 4
            for (int i = 0; i < 64; ++i) { const float v = QK[i * 64 + lane] * __expf(Gv[i] - gj); dst[i * 64 + lane] = (bf16)f2bf((lane <= i) ? v : 0.f); }
        }
        __syncthreads();
    }
}
constexpr int SB_SZ = 55552, S_KT = 0, S_QT = 16384, S_TT = 32768, S_IT = 41984, S_VT = 51200, S_GG = 55296;
constexpr int S_ST = 2 * SB_SZ, S_XT = S_ST + 8192, S_VNT = S_XT + 4096, S_VST = S_VNT + 4096, SCAN_LDS = S_VST + 4096;
#define TRI(lo, hi_, base, o0, o1) asm volatile("ds_read_b64_tr_b16 %0, %2 offset:%3\n\tds_read_b64_tr_b16 %1, %2 offset:%4" : "=&v"(lo), "=&v"(hi_) : "v"(base), "i"(o0), "i"(o1) : "memory")
#define TRW4(a, b, c, d, e, f, g_, h_) asm volatile("s_waitcnt lgkmcnt(0)" : "+v"(a), "+v"(b), "+v"(c), "+v"(d), "+v"(e), "+v"(f), "+v"(g_), "+v"(h_) :: "memory")
__device__ __forceinline__ void phase_scan(bf16* proj_, const bf16* TB_, const bf16* INTRA_, const float* gc_, LAS unsigned char* lds, int vcu, int G, int tid, int wid, int lane) {
    GAS bf16* proj = (GAS bf16*)proj_; const GAS bf16* TB = (const GAS bf16*)TB_; const GAS bf16* INTRA = (const GAS bf16*)INTRA_; const GAS float* gc = (const GAS float*)gc_;
    const int r32 = lane & 31, hi = lane >> 5, blk = (lane >> 4) & 1, q4 = (lane & 15) >> 2, p4 = lane & 3;
    const unsigned ldsb = (unsigned)(uintptr_t)lds;
    for (int u = vcu; u < NB * GDN_HV * 4; u += G) {
        const int sl = u & 3, bh = u >> 2, h = bh % GDN_HV, b = bh / GDN_HV, hq = h >> 1, e0 = sl * 32;
        v4u sk[2], sq[2], st, si, sv; float sg;
#define SCAN_LOAD(n_) do { const size_t tok0_ = (size_t)b * SEQ + 64 * (n_); \
            _Pragma("unroll") for (int i_ = 0; i_ < 2; ++i_) { const int idx_ = tid + 512 * i_, row_ = idx_ >> 4, ch_ = idx_ & 15; \
                sk[i_] = *(const GAS v4u*)(proj + (tok0_ + row_) * GDN_MAIN + GDN_KEY + hq * 128 + ch_ * 8); sq[i_] = *(const GAS v4u*)(proj + (tok0_ + row_) * GDN_MAIN + hq * 128 + ch_ * 8); } \
            { const size_t mb_ = ((size_t)bh * NCHUNK + (n_)) * 4096 + (tid >> 3) * 64 + (tid & 7) * 8; st = *(const GAS v4u*)(TB + mb_); si = *(const GAS v4u*)(INTRA + mb_); } \
            if (tid < 256) sv = *(const GAS v4u*)(proj + (tok0_ + (tid >> 2)) * GDN_MAIN + GDN_CONV / 2 + h * 128 + e0 + (tid & 3) * 8); \
            if (tid < 64) sg = gc[(size_t)bh * SEQ + 64 * (n_) + tid]; } while (0)
#define SCAN_WRITE(buf_) do { LAS unsigned char* B_ = lds + (buf_) * SB_SZ; \
            _Pragma("unroll") for (int i_ = 0; i_ < 2; ++i_) { const int idx_ = tid + 512 * i_, row_ = idx_ >> 4, ch_ = idx_ & 15; \
                *(LAS v4u*)(B_ + S_KT + off_b(row_, ch_)) = sk[i_]; *(LAS v4u*)(B_ + S_QT + off_b(row_, ch_)) = sq[i_]; } \
            *(LAS v4u*)(B_ + S_TT + (tid >> 3) * 144 + (tid & 7) * 16) = st; *(LAS v4u*)(B_ + S_IT + (tid >> 3) * 144 + (tid & 7) * 16) = si; \
            if (tid < 256) *(LAS v4u*)(B_ + S_VT + (tid >> 2) * 64 + (tid & 3) * 16) = sv; \
            if (tid < 64) ((LAS float*)(B_ + S_GG))[tid] = sg; } while (0)
        SCAN_LOAD(0);
        { unsigned z = 0u; asm volatile("" : "+v"(z)); for (int i = tid; i < 8192 / 16; i += 512) *(LAS v4u*)(lds + S_ST + i * 16) = (v4u){z, z, z, z}; }
        VM_WAIT(); SCAN_WRITE(0);
        f32x16 Sacc = {};
        __syncthreads();
        const unsigned sb = ldsb + S_ST + (unsigned)((8 * hi + q4) * 64 + (16 * blk + 4 * p4) * 2);
        const unsigned fx16 = (unsigned)(((((r32 & 3) << 2) | ((r32 >> 2) & 3)) ^ hi) << 4);
        for (int n = 0; n < NCHUNK; ++n) {
            const int buf = n & 1; LAS unsigned char* B = lds + buf * SB_SZ; const LAS float* GG = (const LAS float*)(B + S_GG);
            if (n + 1 < NCHUNK) SCAN_LOAD(n + 1);
            f32x16 acc = {};
            if (wid < 4) {
                const LAS unsigned char* Ar = B + (wid < 2 ? S_KT : S_QT) + 256 * (32 * (wid & 1) + r32);
#define STG1(K0) do { s16x4 l0, h0, l1, h1, l2, h2, l3, h3; \
                    TRI(l0, h0, sb, (K0 + 0) * 1024, (K0 + 0) * 1024 + 256); TRI(l1, h1, sb, (K0 + 1) * 1024, (K0 + 1) * 1024 + 256); \
                    TRI(l2, h2, sb, (K0 + 2) * 1024, (K0 + 2) * 1024 + 256); TRI(l3, h3, sb, (K0 + 3) * 1024, (K0 + 3) * 1024 + 256); \
                    const bf16x8 a0 = *(const LAS bf16x8*)(Ar + ((32u * (K0 + 0)) ^ fx16)), a1 = *(const LAS bf16x8*)(Ar + ((32u * (K0 + 1)) ^ fx16)), \
                                 a2 = *(const LAS bf16x8*)(Ar + ((32u * (K0 + 2)) ^ fx16)), a3 = *(const LAS bf16x8*)(Ar + ((32u * (K0 + 3)) ^ fx16)); \
                    TRW4(l0, h0, l1, h1, l2, h2, l3, h3); \
                    acc = MFMA32(a0, TR_CAT(l0, h0), acc); acc = MFMA32(a1, TR_CAT(l1, h1), acc); acc = MFMA32(a2, TR_CAT(l2, h2), acc); acc = MFMA32(a3, TR_CAT(l3, h3), acc); } while (0)
                STG1(0); STG1(4);
#undef STG1
                if (wid < 2) {
#pragma unroll
                    for (int r = 0; r < 16; ++r) { const int c = 32 * wid + crow(r, hi);
                        const float v = bf2f(*(const LAS unsigned short*)(B + S_VT + c * 64 + r32 * 2));
                        *(LAS unsigned short*)(lds + S_XT + c * 64 + r32 * 2) = (unsigned short)f2bf(v - __expf(GG[c]) * acc[r]); }
                }
            }
            __syncthreads();
            const float gl = GG[63];
#define STG34(ACC, Aimg, OFFB, ct) do { s16x4 l0, h0, l1, h1, l2, h2, l3, h3; const LAS unsigned char* Ar_ = B + (Aimg) + (32 * (ct) + r32) * 144 + 16 * hi; \
                    TRI(l0, h0, sb, (OFFB) + 0, (OFFB) + 256); TRI(l1, h1, sb, (OFFB) + 1024, (OFFB) + 1280); TRI(l2, h2, sb, (OFFB) + 2048, (OFFB) + 2304); TRI(l3, h3, sb, (OFFB) + 3072, (OFFB) + 3328); \
                    const bf16x8 a0 = *(const LAS bf16x8*)(Ar_), a1 = *(const LAS bf16x8*)(Ar_ + 32), a2 = *(const LAS bf16x8*)(Ar_ + 64), a3 = *(const LAS bf16x8*)(Ar_ + 96); \
                    TRW4(l0, h0, l1, h1, l2, h2, l3, h3); \
                    ACC = MFMA32(a0, TR_CAT(l0, h0), ACC); ACC = MFMA32(a1, TR_CAT(l1, h1), ACC); \
                    if ((ct) > 0) { ACC = MFMA32(a2, TR_CAT(l2, h2), ACC); ACC = MFMA32(a3, TR_CAT(l3, h3), ACC); } } while (0)
            if (wid < 2) {
                f32x16 a3_ = {};
                STG34(a3_, S_TT, S_XT - S_ST, wid);
#pragma unroll
                for (int r = 0; r < 16; ++r) { const int c = 32 * wid + crow(r, hi);
                    *(LAS unsigned short*)(lds + S_VNT + c * 64 + r32 * 2) = (unsigned short)f2bf(a3_[r]);
                    *(LAS unsigned short*)(lds + S_VST + c * 64 + r32 * 2) = (unsigned short)f2bf(a3_[r] * __expf(gl - GG[c])); }
            }
            __syncthreads();
            if (wid == 2 || wid == 3) {
                const int ct = wid - 2;
#pragma unroll
                for (int r = 0; r < 16; ++r) acc[r] *= __expf(GG[32 * ct + crow(r, hi)]);
                STG34(acc, S_IT, S_VNT - S_ST, ct);
                GAS bf16* og = proj + ((size_t)b * SEQ + 64 * n + 32 * ct) * GDN_MAIN + GDN_CONV / 2 + h * 128 + e0 + r32;
#pragma unroll
                for (int r = 0; r < 16; ++r) og[(size_t)crow(r, hi) * GDN_MAIN] = (bf16)f2bf(acc[r]);
            } else if (wid >= 4) {
                const int dt = wid - 4; const float egl = __expf(gl);
#pragma unroll
                for (int r = 0; r < 16; ++r) Sacc[r] *= egl;
                const unsigned chk = (unsigned)(4 * dt + 2 * blk + (p4 >> 1));
                const unsigned kb0 = ldsb + buf * SB_SZ + S_KT + 256u * (8 * hi + q4) + 16u * (chk ^ (unsigned)((q4 << 2) | ((2 * hi) & 3))) + 8u * (p4 & 1);
                const unsigned kb1 = ldsb + buf * SB_SZ + S_KT + 256u * (8 * hi + 4 + q4) + 16u * (chk ^ (unsigned)((q4 << 2) | ((2 * hi + 1) & 3))) + 8u * (p4 & 1);
                s16x4 l0, h0, l1, h1, l2, h2, l3, h3, al0, ah0, al1, ah1, al2, ah2, al3, ah3;
                TRI(l0, h0, sb, (S_VST - S_ST) + 0, (S_VST - S_ST) + 256); TRI(l1, h1, sb, (S_VST - S_ST) + 1024, (S_VST - S_ST) + 1280);
                TRI(l2, h2, sb, (S_VST - S_ST) + 2048, (S_VST - S_ST) + 2304); TRI(l3, h3, sb, (S_VST - S_ST) + 3072, (S_VST - S_ST) + 3328);
#define TRK(lo, hi_, o) asm volatile("ds_read_b64_tr_b16 %0, %2 offset:%4\n\tds_read_b64_tr_b16 %1, %3 offset:%4" : "=&v"(lo), "=&v"(hi_) : "v"(kb0), "v"(kb1), "i"(o) : "memory")
                TRK(al0, ah0, 0); TRK(al1, ah1, 4096); TRK(al2, ah2, 8192); TRK(al3, ah3, 12288);
#undef TRK
                TRW4(l0, h0, l1, h1, l2, h2, l3, h3); TRW4(al0, ah0, al1, ah1, al2, ah2, al3, ah3);
                Sacc = MFMA32(TR_CAT(al0, ah0), TR_CAT(l0, h0), Sacc); Sacc = MFMA32(TR_CAT(al1, ah1), TR_CAT(l1, h1), Sacc);
                Sacc = MFMA32(TR_CAT(al2, ah2), TR_CAT(l2, h2), Sacc); Sacc = MFMA32(TR_CAT(al3, ah3), TR_CAT(l3, h3), Sacc);
#pragma unroll
                for (int r = 0; r < 16; ++r) *(LAS unsigned short*)(lds + S_ST + (32 * dt + crow(r, hi)) * 64 + r32 * 2) = (unsigned short)f2bf(Sacc[r]);
            }
#undef STG34
            if (n + 1 < NCHUNK) { VM_WAIT(); SCAN_WRITE(buf ^ 1); }
            __syncthreads();
        }
#undef SCAN_LOAD
#undef SCAN_WRITE
    }
}
#undef TRI
#undef TRW4
__device__ __forceinline__ void phase_gate(bf16* proj, const float* out_norm, int gw, int NGW, int lane) {
    const float w0 = out_norm[2 * lane], w1 = out_norm[2 * lane + 1];
    for (int m = gw; m < NT; m += NGW) {
        unsigned* orow = (unsigned*)(proj + (size_t)m * GDN_MAIN + GDN_CONV / 2); unsigned* zrow = (unsigned*)(proj + (size_t)m * GDN_MAIN + GDN_CONV);
#pragma unroll 4
        for (int h = 0; h < GDN_HV; ++h) {
            const unsigned ow = orow[h * 64 + lane], zw = zrow[h * 64 + lane];
            const float o0 = bflo(ow), o1 = bfhi(ow), z0 = bflo(zw), z1 = bfhi(zw);
            const float rs = rsqrtf(wave_sum(o0 * o0 + o1 * o1) * (1.f / 128.f) + NORM_EPS);
            zrow[h * 64 + lane] = pk2(o0 * rs * w0 * fsilu(z0), o1 * rs * w1 * fsilu(z1));
        }
    }
}
#undef MFMA32
#undef TR_ISSUE
#undef TR_CAT
}

struct Args { const void* in[25]; float* out; unsigned char* ws; };
__global__ void __launch_bounds__(NWAVES * 64, 2) mk_fwd(Args a) {
    extern __shared__ __attribute__((aligned(16))) unsigned char lds_raw[];
    LAS unsigned char* lds = (LAS unsigned char*)lds_raw;
    const int tid0 = threadIdx.x;
    const int G = gridDim.x, bx = blockIdx.x, vcu = (G % 8 == 0) ? (bx % 8) * (G / 8) + bx / 8 : bx;
    const int NGW = G * NWAVES, NGT = G * NWAVES * 64;
    volatile LAS unsigned* MISC = (volatile LAS unsigned*)(lds + MISC_OFF);
    if (tid0 < 64) MISC[tid0] = 0u;
    __syncthreads();
    const void* const* kargs0 = (const void* const*)__builtin_amdgcn_kernarg_segment_ptr();
    XcdBarrier bar = xcd_barrier_post((unsigned*)(a.ws + WS_CTL) + CW_BAR, MISC + 8);
#define GRID_BAR() xcd_barrier(bar)
#define PH() int tid = tid0; asm volatile("" : "+v"(tid)); const int lane = tid & 63, wave = __builtin_amdgcn_readfirstlane(tid >> 6); \
             const int gw = vcu * NWAVES + wave, gtid = vcu * (NWAVES * 64) + tid; (void)lane; (void)wave; (void)gw; (void)gtid; \
             const void* const* kp = kargs0; asm volatile("" : "+s"(kp)); unsigned char* ws = (unsigned char*)(GAS unsigned char*)kp[26]; float* out = (float*)(GAS float*)kp[25]; \
             unsigned char* wmix = ws + WS_WMIX; bf16* A0 = (bf16*)(ws + WS_A0); unsigned char* A1 = ws + WS_A1; const float* hin = layer == 0 ? (const float*)(const GAS float*)kp[0] : out; \
             LAS float* scr = (LAS float*)(lds + wave * 16384); \
             (void)out; (void)wmix; (void)A0; (void)A1; (void)hin; (void)scr
#define IN(i) ((const float*)(const GAS float*)kp[i])
#define GEMM(EPI, Aptr, Bptr, N_, K_, lda_, ldb_, ...) do { pg8::Gemm g{(const bf16*)(Aptr), (const bf16*)(Bptr), NT, (N_), (K_), (lda_), (ldb_)}; pg8::StaticOrder S; S.init(NT, (N_), G, bx); \
             pg8::EPI E{__VA_ARGS__}; pg8::gemm_phase<pg8::EPI, pg8::StaticOrder, true, true>(lds, g, S, E); } while (0)
    { const int layer = 0; PH(); phase_rope_table((const int*)(const GAS int*)kp[2], (float*)(ws + WS_ROPE), gtid, NGT); }
    for (int layer = 0; layer < DEPTH; ++layer) {
        const int j = layer >> 1; const bool is_mla = (layer & 1) == 0;
        if (is_mla) {
            { PH(); convert_matrix<0>(IN(4) + (size_t)j * DM * MLA_IN, DM, MLA_IN, (bf16*)(wmix + WM_MLA_IN), 0, scr, gw, NGW, lane); }
            { PH(); zero_rows((bf16*)(wmix + WM_MLA_IN), DM, MLA_IN, MLA_IN_PAD - MLA_IN, gtid, NGT); }
            { PH(); convert_matrix<0>(IN(7) + (size_t)j * MLA_QL * (MLA_H * MLA_QK), MLA_QL, MLA_H * MLA_QK, (bf16*)(wmix + WM_MLA_UQ), 0, scr, gw, NGW, lane); }
            { PH(); convert_matrix<0>(IN(8) + (size_t)j * MLA_KVL * (MLA_H * 256), MLA_KVL, MLA_H * 256, (bf16*)(wmix + WM_MLA_UKV), 0, scr, gw, NGW, lane); }
            { PH(); convert_matrix<0>(IN(11) + (size_t)j * DM * DM, DM, DM, (bf16*)(wmix + WM_MLA_O), 0, scr, gw, NGW, lane); }
        } else {
            { PH(); convert_matrix<0>(IN(12) + (size_t)j * DM * GDN_IN, DM, GDN_IN, (bf16*)(wmix + WM_GDN_IN), 0, scr, gw, NGW, lane); }
            { PH(); zero_rows((bf16*)(wmix + WM_GDN_IN), DM, GDN_IN, GDN_IN_PAD - GDN_IN, gtid, NGT); }
            { PH(); convert_matrix<0>(IN(17) + (size_t)j * GDN_VAL * DM, GDN_VAL, DM, (bf16*)(wmix + WM_GDN_OUT), 0, scr, gw, NGW, lane); }
        }
        { PH(); convert_matrix<1>(IN(19) + (size_t)layer * DM * (2 * DFF), DM, 2 * DFF, (bf16*)(ws + WS_WGU), 0, scr, gw, NGW, lane); }
        { PH(); convert_matrix<0>(IN(20) + (size_t)layer * DFF * DM, DFF, DM, (bf16*)(ws + WS_WDN), 0, scr, gw, NGW, lane); }
        { PH(); convert_matrix<0>(IN(21) + (size_t)layer * PLE_DIM * DM, PLE_DIM, DM, (bf16*)(ws + WS_WPP), 0, scr, gw, NGW, lane); }
        { PH(); convert_matrix<0>(IN(24) + (size_t)layer * DM * DM, DM, DM, (bf16*)(ws + WS_WPG), 0, scr, gw, NGW, lane); }
        { PH(); phase_rmsnorm(hin, IN(3) + layer * DM, A0, gw, NGW, lane); }
        GRID_BAR();
        if (is_mla) {
            { PH(); GEMM(EpiF32Plain, A0, wmix + WM_MLA_IN, MLA_IN_PAD, DM, DM, DM, (float*)(A1 + A1_C), MLA_IN_PAD); }
            GRID_BAR();
            { PH(); phase_mla_latnorm((const float*)(A1 + A1_C), IN(5) + j * MLA_QL, IN(6) + j * MLA_KVL, (bf16*)(A1 + A1_QKVN), (float*)(A1 + A1_KPE), gw, NGW, lane); }
            GRID_BAR();
            { PH(); GEMM(EpiBf16Plain, A1 + A1_QKVN, wmix + WM_MLA_UQ, MLA_H * MLA_QK, MLA_QL, 1024, MLA_QL, (bf16*)(A1 + A1_QRAW), MLA_H * MLA_QK); }
            { PH(); GEMM(EpiBf16Plain, (bf16*)(A1 + A1_QKVN) + MLA_QL, wmix + WM_MLA_UKV, MLA_H * 256, MLA_KVL, 1024, MLA_KVL, (bf16*)(A1 + A1_KVRAW), MLA_H * 256); }
            GRID_BAR();
            { PH(); phase_mla_finalize((const bf16*)(A1 + A1_QRAW), (const bf16*)(A1 + A1_KVRAW), (const float*)(A1 + A1_KPE), (const float*)(ws + WS_ROPE), IN(9) + j * MLA_QK, IN(10) + j * MLA_QK,
                                       (bf16*)(A1 + A1_QF), (bf16*)(A1 + A1_KF), (bf16*)(A1 + A1_VF), gw, NGW, lane); }
            GRID_BAR();
            { PH(); attn::attn_phase((const bf16*)(A1 + A1_QF), (const bf16*)(A1 + A1_KF), (const bf16*)(A1 + A1_VF), A0, (LAS char*)lds, vcu, G, tid, wave, lane); }
            GRID_BAR();
            { PH(); GEMM(EpiResid, A0, wmix + WM_MLA_O, DM, DM, DM, DM, hin, out, DM); }
            GRID_BAR();
        } else {
            { PH(); GEMM(EpiGdnProj, A0, wmix + WM_GDN_IN, GDN_IN_PAD, DM, DM, DM, (bf16*)(A1 + A1_PROJ), GDN_MAIN, (float*)(A1 + A1_BA), GDN_MAIN / 256); }
            GRID_BAR();
            { PH(); gdn::phase_halo((const bf16*)(A1 + A1_PROJ), (bf16*)(A1 + A1_HALO), vcu, G, tid); }
            GRID_BAR();
            { PH(); gdn::phase_conv((bf16*)(A1 + A1_PROJ), (const bf16*)(A1 + A1_HALO), IN(13) + (size_t)j * 4 * GDN_CONV, vcu, G, tid); }
            GRID_BAR();
            { PH(); gdn::phase_prep((const bf16*)(A1 + A1_PROJ), (const float*)(A1 + A1_BA), IN(14) + j * GDN_HV, IN(15) + j * GDN_HV, A0, (bf16*)(A1 + A1_INTRA), (float*)(A1 + A1_GC), lds, vcu, G, tid, wave, lane); }
            GRID_BAR();
            { PH(); gdn::phase_scan((bf16*)(A1 + A1_PROJ), A0, (const bf16*)(A1 + A1_INTRA), (const float*)(A1 + A1_GC), lds, vcu, G, tid, wave, lane); }
            GRID_BAR();
            { PH(); gdn::phase_gate((bf16*)(A1 + A1_PROJ), IN(16) + j * GDN_DV, gw, NGW, lane); }
            GRID_BAR();
            { PH(); GEMM(EpiResid, (bf16*)(A1 + A1_PROJ) + GDN_CONV, wmix + WM_GDN_OUT, DM, GDN_VAL, GDN_MAIN, GDN_VAL, hin, out, DM); }
            GRID_BAR();
        }
        { PH(); phase_rmsnorm(out, IN(18) + layer * DM, A0, gw, NGW, lane); }
        { PH(); phase_cvt_bf16(IN(1) + (size_t)layer * NT * PLE_DIM, (bf16*)(A1 + A1_PBF), (size_t)NT * PLE_DIM, gtid, NGT); }
        GRID_BAR();
        { PH(); GEMM(EpiSiluMul, A0, ws + WS_WGU, 2 * DFF, DM, DM, DM, (bf16*)(A1 + A1_ACT), DFF); }
        { PH(); GEMM(EpiBf16Plain, A1 + A1_PBF, ws + WS_WPP, DM, PLE_DIM, PLE_DIM, PLE_DIM, (bf16*)(A1 + A1_E), DM); }
        GRID_BAR();
        { PH(); GEMM(EpiResid, A1 + A1_ACT, ws + WS_WDN, DM, DFF, DFF, DFF, out, out, DM); }
        GRID_BAR();
        { PH(); phase_rmsnorm(out, IN(23) + layer * DM, A0, gw, NGW, lane); }
        { PH(); phase_rstd_e((const bf16*)(A1 + A1_E), (float*)(A1 + A1_RSTDE), gw, NGW, lane); }
        GRID_BAR();
        { PH(); GEMM(EpiPleGate, A0, ws + WS_WPG, DM, DM, DM, DM, out, out, DM, (const bf16*)(A1 + A1_E), (const float*)(A1 + A1_RSTDE), IN(22) + layer * DM); }
        GRID_BAR();
    }
}

extern "C" void kernel_launch(void* const* d_in, const int* in_sizes, int n_in, void* d_out, int out_size, void* d_ws, size_t ws_size, hipStream_t stream) {
    static int grid = 0;
    if (grid == 0) {
        if (n_in != 25 || out_size != NT * DM || ws_size < WS_END) { fprintf(stderr, "kernel_launch: unexpected shapes: n_in %d out %d ws %zu (need %zu)\n", n_in, out_size, ws_size, (size_t)WS_END); grid = -1; return; }
        int dev = 0, cus = 0, per_cu = 0;
        if (hipGetDevice(&dev) != hipSuccess || hipDeviceGetAttribute(&cus, hipDeviceAttributeMultiprocessorCount, dev) != hipSuccess) { grid = -1; return; }
        if (hipFuncSetAttribute((const void*)mk_fwd, hipFuncAttributeMaxDynamicSharedMemorySize, LDS_BYTES) != hipSuccess) { fprintf(stderr, "kernel_launch: hipFuncSetAttribute failed\n"); grid = -1; return; }
        if (hipOccupancyMaxActiveBlocksPerMultiprocessor(&per_cu, (const void*)mk_fwd, NWAVES * 64, LDS_BYTES) != hipSuccess || per_cu < 1) { fprintf(stderr, "kernel_launch: occupancy query says %d\n", per_cu); grid = -1; (void)hipGetLastError(); return; }
        grid = cus;
    }
    if (grid < 0) return;
    if (hipMemsetAsync((char*)d_ws + WS_CTL, 0, CTL_ZERO_BYTES, stream) != hipSuccess) return;
    Args a{};
    for (int i = 0; i < 25; ++i) a.in[i] = d_in[i];
    a.out = (float*)d_out; a.ws = (unsigned char*)d_ws;
    hipLaunchKernelGGL(mk_fwd, dim3(grid), dim3(NWAVES * 64), LDS_BYTES, stream, a);
}
```

```cpp
#include <hip/hip_runtime.h>
#include <cstdio>
#include <cstdint>

#ifndef PROBE_SCAN
#define PROBE_SCAN (0)
#endif
#ifndef PROBE_ATTN
#define PROBE_ATTN (0)
#endif
#ifndef PROBE_MASK
#define PROBE_MASK (0)
#endif

#define GAS __attribute__((address_space(1)))
#define LAS __attribute__((address_space(3)))
typedef unsigned short bf16;
typedef unsigned v4u __attribute__((ext_vector_type(4)));
typedef unsigned v2u __attribute__((ext_vector_type(2)));
typedef float f32x4 __attribute__((ext_vector_type(4)));
typedef float f32x16 __attribute__((ext_vector_type(16)));
typedef short bf16x8 __attribute__((ext_vector_type(8)));
typedef short s16x4 __attribute__((ext_vector_type(4)));

constexpr int NB = 2, SEQ = 16384, NT = NB * SEQ, DM = 2048, DEPTH = 4;
constexpr float NORM_EPS = 1e-6f;
constexpr int PLE_DIM = 256;
constexpr int MLA_H = 16, MLA_QL = 512, MLA_KVL = 512, MLA_NOPE = 128, MLA_ROPE = 64, MLA_QK = 192, MLA_V = 128;
constexpr int MLA_IN = MLA_QL + MLA_KVL + MLA_ROPE, MLA_IN_PAD = 1280;
constexpr int GDN_HQK = 16, GDN_HV = 32, GDN_DK = 128, GDN_DV = 128, GDN_KEY = 2048, GDN_VAL = 4096, GDN_CONV = 8192;
constexpr int GDN_MAIN = GDN_CONV + GDN_VAL;
constexpr int GDN_IN = GDN_MAIN + 64, GDN_IN_PAD = GDN_MAIN + 256;
constexpr int NCHUNK = SEQ / 64;
constexpr int DFF = 5632;

constexpr size_t MiB = 1u << 20;
constexpr size_t WS_CTL = 0, CTL_ZERO_BYTES = 64 * 1024;
constexpr size_t WS_WMIX = 1 * MiB, WS_WGU = 66 * MiB, WS_WDN = 110 * MiB, WS_WPP = 132 * MiB, WS_WPG = 133 * MiB, WS_ROPE = 141 * MiB;
constexpr size_t WS_A0 = 149 * MiB, WS_A1 = 277 * MiB, WS_SS = 1277 * MiB, WS_PBF = 1289 * MiB, WS_END = 1305 * MiB;
constexpr size_t A1_HBX = 872 * MiB;
constexpr size_t WM_GDN_IN = 0, WM_GDN_OUT = 49 * MiB;
constexpr size_t WM_MLA_IN = 0, WM_MLA_UQ = 5 * MiB, WM_MLA_UKV = 8 * MiB, WM_MLA_O = 12 * MiB;
constexpr size_t A1_C = 0, A1_QKVN = 160 * MiB, A1_KPE = 224 * MiB, A1_QRAW = 232 * MiB, A1_KVRAW = 424 * MiB, A1_KF = 680 * MiB, A1_VF = 872 * MiB, A1_QF = 0;
constexpr size_t A1_PROJ = 0, A1_BA = 768 * MiB, A1_HALO = 776 * MiB, A1_GC = 800 * MiB, A1_INTRA = 804 * MiB;
constexpr size_t A1_ACT = 0, A1_E = 368 * MiB, A1_RSTDE = 496 * MiB;
constexpr int CW_BAR = 1024;

constexpr int LDS_BYTES = 147456;
constexpr int MISC_OFF = LDS_BYTES - 256;
constexpr int NWAVES = 8;

#define LDS_WAIT() asm volatile("s_waitcnt lgkmcnt(0)" ::: "memory")
#define VM_WAIT() asm volatile("s_waitcnt vmcnt(0)" ::: "memory")
__device__ __forceinline__ unsigned pk2(float lo, float hi) { unsigned r; asm("v_cvt_pk_bf16_f32 %0, %1, %2" : "=v"(r) : "v"(lo), "v"(hi)); return r; }
__device__ __forceinline__ unsigned f2bf(float f) { return pk2(f, f) & 0xffffu; }
typedef _Float16 h16x2 __attribute__((ext_vector_type(2)));
__device__ __forceinline__ unsigned pkh2(float lo, float hi) { const h16x2 v = {(_Float16)lo, (_Float16)hi}; return __builtin_bit_cast(unsigned, v); }
__device__ __forceinline__ float bf2f(unsigned short b) { return __uint_as_float(((unsigned)b) << 16); }
__device__ __forceinline__ float bflo(unsigned w) { return __uint_as_float(w << 16); }
__device__ __forceinline__ float bfhi(unsigned w) { return __uint_as_float(w & 0xffff0000u); }
__device__ __forceinline__ float shx(float v, int mask, int lane) { return __builtin_bit_cast(float, __builtin_amdgcn_ds_bpermute((lane ^ mask) << 2, __builtin_bit_cast(int, v))); }
__device__ __forceinline__ float wave_sum(float v, int lane) {
#pragma unroll
    for (int o = 1; o < 64; o <<= 1) v += shx(v, o, lane);
    return v;
}
__device__ __forceinline__ float fsigmoid(float x) { return __builtin_amdgcn_rcpf(1.0f + __builtin_amdgcn_exp2f(-1.4426950408889634f * x)); }
__device__ __forceinline__ float fsilu(float x) { return x * fsigmoid(x); }

namespace pg8 {
#define PG8_LAS __attribute__((address_space(3)))
typedef unsigned short bf16_t;
typedef short bf16x8 __attribute__((ext_vector_type(8)));
typedef float f32x4 __attribute__((ext_vector_type(4)));
typedef unsigned u32x4 __attribute__((ext_vector_type(4)));
constexpr int BM = 256, BK = 64, HALF = 128, HTB = HALF * BK * 2  , STAGE_BYTES = 8 * HTB, NXCD = 8, WGM = 8;

__host__ __device__ __forceinline__ int lds_byte(int r, int c) { const int st = (r >> 4) * 2 + (c >> 5), rr = r & 15, cc = c & 31, ob = rr * 64 + cc * 2; return st * 1024 + (ob ^ (((ob >> 9) & 1) << 5)); }
__host__ __device__ __forceinline__ void stage_rc(int b, int& R, int& C) { const int st = b / 1024, sb = b % 1024, swz = sb ^ (((sb >> 9) & 1) << 5); R = (st >> 1) * 16 + swz / 64; C = (st & 1) * 32 + (swz % 64) / 2; }
__host__ __device__ __forceinline__ int perm32(int rho) { const int n = rho >> 4, i = rho & 15; return 8 * (i >> 2) + 4 * n + (i & 3); }

struct Unit { int pm, pn; };
struct Gemm { const bf16_t* A; const bf16_t* Bt; int M, N, K, lda, ldb; };

struct StaticOrder {
    int nM, nN, nwg, G, c;
    __host__ __device__ void init(int M, int N, int G_, int c_) { nM = M / BM; nN = N / BM; nwg = nM * nN; G = G_; c = c_; }
    __host__ __device__ bool next(int i, Unit& u) const {
        const long L = (long)i * G + c; if (L >= nwg) return false;
        int wgid = (int)L; { const int q = nwg / NXCD, r = nwg % NXCD, xcd = wgid % NXCD, off = wgid / NXCD; wgid = (xcd < r ? xcd * (q + 1) : r * (q + 1) + (xcd - r) * q) + off; }
        const int nig = WGM * nN, gid = wgid / nig, fm = gid * WGM, gsz = (nM - fm) < WGM ? (nM - fm) : WGM;
        u.pm = fm + ((wgid % nig) % gsz); u.pn = (wgid % nig) / gsz; return true;
    }
    __device__ __forceinline__ void a_ready(const Unit&) const {}
    __device__ __forceinline__ void done(const Unit&) const {}
};

__device__ __forceinline__ unsigned cvt_pk_bf16(float lo, float hi) { unsigned r; asm volatile("v_cvt_pk_bf16_f32 %0, %1, %2" : "=v"(r) : "v"(lo), "v"(hi)); return r; }
typedef float f32x2 __attribute__((ext_vector_type(2)));
__device__ __forceinline__ float fast_sigmoid(float x) { return __builtin_amdgcn_rcpf(1.0f + __builtin_amdgcn_exp2f(-1.4426950408889634f * x)); }

__device__ __forceinline__ float sum_fq(float s) {
    { const auto r = __builtin_amdgcn_permlane16_swap(__float_as_uint(s), __float_as_uint(s), false, false); s = __uint_as_float(r[0]) + __uint_as_float(r[1]); }
    { const auto r = __builtin_amdgcn_permlane32_swap(__float_as_uint(s), __float_as_uint(s), false, false); s = __uint_as_float(r[0]) + __uint_as_float(r[1]); }
    return s;
}
__device__ __forceinline__ float row_rstd(const float* ssp, int row, int fq) {
    const f32x4 a = *(const f32x4*)(ssp + (size_t)row * 32 + fq * 8), b = *(const f32x4*)(ssp + (size_t)row * 32 + fq * 8 + 4);
    float s = ((a[0] + a[1]) + (a[2] + a[3])) + ((b[0] + b[1]) + (b[2] + b[3]));
    s = sum_fq(s);
    return rsqrtf(s * (1.f / 2048.f) + 1e-6f);
}

struct EpiF32Plain {
    static constexpr bool PERM = false, AFTER_DRAIN = false;
    float* C; int ldc; const float* ss;
    __device__ __forceinline__ void operator()(const f32x4 (&acc)[2][2][4][2], const Unit& u, int wr, int wc, int fr, int fq) const {
        const int row0 = u.pm * BM + wr * 64 + fr, col0 = u.pn * BM + wc * 32 + 4 * fq;
#pragma unroll
        for (int ai = 0; ai < 2; ++ai)
#pragma unroll
            for (int m = 0; m < 4; ++m) { const int row = row0 + ai * HALF + m * 16; float* rowp = C + (size_t)row * ldc + col0; const float rs = row_rstd(ss, row, fq);
#pragma unroll
                for (int bj = 0; bj < 2; ++bj)
#pragma unroll
                    for (int n = 0; n < 2; ++n) *(f32x4*)(rowp + bj * HALF + n * 16) = acc[ai][bj][m][n] * rs; }
    }
};
struct EpiMlaIn {
    static constexpr bool PERM = true, AFTER_DRAIN = false;
    bf16_t* O; float* KPE; float* ssl; const float* ss;
    __device__ __forceinline__ void operator()(const f32x4 (&acc)[2][2][4][2], const Unit& u, int wr, int wc, int fr, int fq) const {
        const int row0 = u.pm * BM + wr * 64 + fr;
        if (u.pn < 4) {
            const int col0 = u.pn * BM + wc * 32 + 8 * fq;
#pragma unroll
            for (int ai = 0; ai < 2; ++ai)
#pragma unroll
                for (int m = 0; m < 4; ++m) { const int row = row0 + ai * HALF + m * 16; bf16_t* rowp = O + (size_t)row * 1024 + col0; const float rs = row_rstd(ss, row, fq); float sq = 0.f;
#pragma unroll
                    for (int bj = 0; bj < 2; ++bj) { const f32x4 v0 = acc[ai][bj][m][0] * rs, v1 = acc[ai][bj][m][1] * rs;
                        u32x4 w; w.x = cvt_pk_bf16(v0[0], v0[1]); w.y = cvt_pk_bf16(v0[2], v0[3]); w.z = cvt_pk_bf16(v1[0], v1[1]); w.w = cvt_pk_bf16(v1[2], v1[3]);
                        *(u32x4*)(rowp + bj * HALF) = w;
                        sq += ((v0[0] * v0[0] + v0[1] * v0[1]) + (v0[2] * v0[2] + v0[3] * v0[3])) + ((v1[0] * v1[0] + v1[1] * v1[1]) + (v1[2] * v1[2] + v1[3] * v1[3])); }
                    sq = sum_fq(sq);
                    if (fq == 0) ssl[(size_t)row * 16 + u.pn * 4 + wc] = sq; }
        } else if (wc < 2) {
            const int col0 = wc * 32 + 8 * fq;
#pragma unroll
            for (int ai = 0; ai < 2; ++ai)
#pragma unroll
                for (int m = 0; m < 4; ++m) { const int row = row0 + ai * HALF + m * 16; float* rowp = KPE + (size_t)row * 64 + col0; const float rs = row_rstd(ss, row, fq);
                    *(f32x4*)(rowp) = acc[ai][0][m][0] * rs; *(f32x4*)(rowp + 4) = acc[ai][0][m][1] * rs; }
        }
    }
};
struct EpiBf16Lat {
    static constexpr bool PERM = true, AFTER_DRAIN = false;
    bf16_t* O; int ldc; const float* ssl; int slot0;
    __device__ __forceinline__ void operator()(const f32x4 (&acc)[2][2][4][2], const Unit& u, int wr, int wc, int fr, int fq) const {
        const int row0 = u.pm * BM + wr * 64 + fr, col0 = u.pn * BM + wc * 32 + 8 * fq;
#pragma unroll
        for (int ai = 0; ai < 2; ++ai)
#pragma unroll
            for (int m = 0; m < 4; ++m) { const int row = row0 + ai * HALF + m * 16; bf16_t* rowp = O + (size_t)row * ldc + col0;
                const f32x2 pr = *(const f32x2*)(ssl + (size_t)row * 16 + slot0 + 2 * fq); float s = pr[0] + pr[1]; s = sum_fq(s);
                const float rs = rsqrtf(s * (1.f / 512.f) + 1e-6f);
#pragma unroll
                for (int bj = 0; bj < 2; ++bj) { const f32x4 v0 = acc[ai][bj][m][0] * rs, v1 = acc[ai][bj][m][1] * rs;
                    u32x4 w; w.x = cvt_pk_bf16(v0[0], v0[1]); w.y = cvt_pk_bf16(v0[2], v0[3]); w.z = cvt_pk_bf16(v1[0], v1[1]); w.w = cvt_pk_bf16(v1[2], v1[3]);
                    *(u32x4*)(rowp + bj * HALF) = w; } }
    }
};
struct EpiBf16Plain {
    static constexpr bool PERM = true, AFTER_DRAIN = false;
    bf16_t* O; int ldc;
    __device__ __forceinline__ void operator()(const f32x4 (&acc)[2][2][4][2], const Unit& u, int wr, int wc, int fr, int fq) const {
        const int row0 = u.pm * BM + wr * 64 + fr, col0 = u.pn * BM + wc * 32 + 8 * fq;
#pragma unroll
        for (int ai = 0; ai < 2; ++ai)
#pragma unroll
            for (int m = 0; m < 4; ++m) { bf16_t* rowp = O + (size_t)(row0 + ai * HALF + m * 16) * ldc + col0;
#pragma unroll
                for (int bj = 0; bj < 2; ++bj) { const f32x4 v0 = acc[ai][bj][m][0], v1 = acc[ai][bj][m][1];
                    u32x4 w; w.x = cvt_pk_bf16(v0[0], v0[1]); w.y = cvt_pk_bf16(v0[2], v0[3]); w.z = cvt_pk_bf16(v1[0], v1[1]); w.w = cvt_pk_bf16(v1[2], v1[3]);
                    *(u32x4*)(rowp + bj * HALF) = w; } }
    }
};
struct EpiGdnProj {
    static constexpr bool PERM = true, AFTER_DRAIN = false;
    bf16_t* O; int ldc; float* BA; int ntile_bf; const float* ss; bf16_t* halo;
    __device__ __forceinline__ void operator()(const f32x4 (&acc)[2][2][4][2], const Unit& u, int wr, int wc, int fr, int fq) const {
        const int row0 = u.pm * BM + wr * 64 + fr;
        if (u.pn < ntile_bf) {
            const int col0 = u.pn * BM + wc * 32 + 8 * fq;
#pragma unroll
            for (int ai = 0; ai < 2; ++ai)
#pragma unroll
                for (int m = 0; m < 4; ++m) { const int row = row0 + ai * HALF + m * 16; bf16_t* rowp = O + (size_t)row * ldc + col0; const float rs = row_rstd(ss, row, fq);
#pragma unroll
                    for (int bj = 0; bj < 2; ++bj) { const f32x4 v0 = acc[ai][bj][m][0] * rs, v1 = acc[ai][bj][m][1] * rs;
                        u32x4 w; w.x = cvt_pk_bf16(v0[0], v0[1]); w.y = cvt_pk_bf16(v0[2], v0[3]); w.z = cvt_pk_bf16(v1[0], v1[1]); w.w = cvt_pk_bf16(v1[2], v1[3]);
                        *(u32x4*)(rowp + bj * HALF) = w;
                        if ((row & 63) >= 61 && u.pn < 32 && ((row >> 6) & 255) != 255) *(u32x4*)(halo + ((size_t)((row >> 6) + 1) * 3 + (row & 63) - 61) * 8192 + col0 + bj * HALF) = w; } }
        } else if (wc < 2) {
            const int col0 = wc * 32 + 8 * fq;
#pragma unroll
            for (int ai = 0; ai < 2; ++ai)
#pragma unroll
                for (int m = 0; m < 4; ++m) { const int row = row0 + ai * HALF + m * 16; float* rowp = BA + (size_t)row * 64 + col0; const float rs = row_rstd(ss, row, fq);
                    *(f32x4*)(rowp) = acc[ai][0][m][0] * rs; *(f32x4*)(rowp + 4) = acc[ai][0][m][1] * rs; }
        }
    }
};
struct EpiSiluMul {
    static constexpr bool PERM = true, AFTER_DRAIN = false;
    bf16_t* O; int ldc; const float* ss;
    __device__ __forceinline__ void operator()(const f32x4 (&acc)[2][2][4][2], const Unit& u, int wr, int wc, int fr, int fq) const {
        const int row0 = u.pm * BM + wr * 64 + fr, col0 = u.pn * HALF + wc * 32 + 8 * fq;
#pragma unroll
        for (int ai = 0; ai < 2; ++ai)
#pragma unroll
            for (int m = 0; m < 4; ++m) { const int row = row0 + ai * HALF + m * 16; bf16_t* rowp = O + (size_t)row * ldc + col0; const float rs = row_rstd(ss, row, fq);
                f32x4 r0, r1;
#pragma unroll
                for (int j = 0; j < 4; ++j) { const float g0 = acc[ai][0][m][0][j] * rs, g1 = acc[ai][0][m][1][j] * rs;
                    r0[j] = g0 * fast_sigmoid(g0) * (acc[ai][1][m][0][j] * rs); r1[j] = g1 * fast_sigmoid(g1) * (acc[ai][1][m][1][j] * rs); }
                u32x4 w; w.x = cvt_pk_bf16(r0[0], r0[1]); w.y = cvt_pk_bf16(r0[2], r0[3]); w.z = cvt_pk_bf16(r1[0], r1[1]); w.w = cvt_pk_bf16(r1[2], r1[3]);
                *(u32x4*)(rowp) = w; }
    }
};
typedef _Float16 h2_t __attribute__((ext_vector_type(2)));
__device__ __forceinline__ unsigned pkh(float a, float b) { const h2_t v = {(_Float16)a, (_Float16)b}; return __builtin_bit_cast(unsigned, v); }
__device__ __forceinline__ float hlo(unsigned w) { return (float)__builtin_bit_cast(h2_t, w)[0]; }
__device__ __forceinline__ float hhi(unsigned w) { return (float)__builtin_bit_cast(h2_t, w)[1]; }
struct EpiResid {
    static constexpr bool PERM = true, AFTER_DRAIN = false;
    const bf16_t* base16; bf16_t* out16; int ldc; float* ssout;
    __device__ __forceinline__ void operator()(const f32x4 (&acc)[2][2][4][2], const Unit& u, int wr, int wc, int fr, int fq) const {
        const int row0 = u.pm * BM + wr * 64 + fr, col0 = u.pn * BM + wc * 32 + 8 * fq;
#pragma unroll
        for (int ai = 0; ai < 2; ++ai) {
            u32x4 bs[4][2];
#pragma unroll
            for (int m = 0; m < 4; ++m) { const size_t off = (size_t)(row0 + ai * HALF + m * 16) * ldc + col0; bs[m][0] = *(const u32x4*)(base16 + off); bs[m][1] = *(const u32x4*)(base16 + off + HALF); }
#pragma unroll
            for (int m = 0; m < 4; ++m) { const int row = row0 + ai * HALF + m * 16; const size_t off = (size_t)row * ldc + col0; float sq = 0.f;
#pragma unroll
                for (int bj = 0; bj < 2; ++bj) { const u32x4 b = bs[m][bj]; const f32x4 a0 = acc[ai][bj][m][0], a1 = acc[ai][bj][m][1];
                    const float o0 = hlo(b.x) + a0[0], o1 = hhi(b.x) + a0[1], o2 = hlo(b.y) + a0[2], o3 = hhi(b.y) + a0[3], o4 = hlo(b.z) + a1[0], o5 = hhi(b.z) + a1[1], o6 = hlo(b.w) + a1[2], o7 = hhi(b.w) + a1[3];
                    u32x4 hw; hw.x = pkh(o0, o1); hw.y = pkh(o2, o3); hw.z = pkh(o4, o5); hw.w = pkh(o6, o7); *(u32x4*)(out16 + off + bj * HALF) = hw;
                    sq += ((o0 * o0 + o1 * o1) + (o2 * o2 + o3 * o3)) + ((o4 * o4 + o5 * o5) + (o6 * o6 + o7 * o7)); }
                sq = sum_fq(sq);
                if (fq == 0) ssout[(size_t)row * 32 + u.pn * 4 + wc] = sq; }
            asm volatile("" ::: "memory");
        }
    }
};
template <bool FINAL> struct EpiPleGate {
    static constexpr bool PERM = true, AFTER_DRAIN = false;
    const bf16_t* base16; bf16_t* out16; float* outf; int ldc; const bf16_t* e; const float* rstd; const float* wn; const float* ssin; float* ssout;
    __device__ __forceinline__ void operator()(const f32x4 (&acc)[2][2][4][2], const Unit& u, int wr, int wc, int fr, int fq) const {
        const int row0 = u.pm * BM + wr * 64 + fr, col0 = u.pn * BM + wc * 32 + 8 * fq;
#pragma unroll
        for (int am = 0; am < 4; ++am) { const int ai = am >> 1;
            u32x4 bs[4][2], ev[4][2]; float rs[4], ri[4];
#pragma unroll
            for (int m = 2 * (am & 1); m < 2 * (am & 1) + 2; ++m) { const int row = row0 + ai * HALF + m * 16; const size_t off = (size_t)row * ldc + col0; rs[m] = rstd[row]; ri[m] = row_rstd(ssin, row, fq);
#pragma unroll
                for (int bj = 0; bj < 2; ++bj) { bs[m][bj] = *(const u32x4*)(base16 + off + bj * HALF); ev[m][bj] = *(const u32x4*)(e + off + bj * HALF); } }
#pragma unroll
            for (int m = 2 * (am & 1); m < 2 * (am & 1) + 2; ++m) { const int row = row0 + ai * HALF + m * 16; const size_t off = (size_t)row * ldc + col0; float sq = 0.f;
#pragma unroll
                for (int bj = 0; bj < 2; ++bj) { const f32x4 w0 = *(const f32x4*)(wn + col0 + bj * HALF), w1 = *(const f32x4*)(wn + col0 + bj * HALF + 4); const u32x4 ew = ev[m][bj], b = bs[m][bj];
                    const f32x4 a0 = acc[ai][bj][m][0], a1 = acc[ai][bj][m][1]; const float rsv = rs[m], riv = ri[m];
                    const float o0 = hlo(b.x) + __uint_as_float(ew.x << 16) * rsv * w0[0] * fast_sigmoid(a0[0] * riv), o1 = hhi(b.x) + __uint_as_float(ew.x & 0xffff0000u) * rsv * w0[1] * fast_sigmoid(a0[1] * riv);
                    const float o2 = hlo(b.y) + __uint_as_float(ew.y << 16) * rsv * w0[2] * fast_sigmoid(a0[2] * riv), o3 = hhi(b.y) + __uint_as_float(ew.y & 0xffff0000u) * rsv * w0[3] * fast_sigmoid(a0[3] * riv);
                    const float o4 = hlo(b.z) + __uint_as_float(ew.z << 16) * rsv * w1[0] * fast_sigmoid(a1[0] * riv), o5 = hhi(b.z) + __uint_as_float(ew.z & 0xffff0000u) * rsv * w1[1] * fast_sigmoid(a1[1] * riv);
                    const float o6 = hlo(b.w) + __uint_as_float(ew.w << 16) * rsv * w1[2] * fast_sigmoid(a1[2] * riv), o7 = hhi(b.w) + __uint_as_float(ew.w & 0xffff0000u) * rsv * w1[3] * fast_sigmoid(a1[3] * riv);
                    if constexpr (FINAL) { *(f32x4*)(outf + off + bj * HALF) = (f32x4){o0, o1, o2, o3}; *(f32x4*)(outf + off + bj * HALF + 4) = (f32x4){o4, o5, o6, o7}; }
                    else { u32x4 hw; hw.x = pkh(o0, o1); hw.y = pkh(o2, o3); hw.z = pkh(o4, o5); hw.w = pkh(o6, o7); *(u32x4*)(out16 + off + bj * HALF) = hw;
                        sq += ((o0 * o0 + o1 * o1) + (o2 * o2 + o3 * o3)) + ((o4 * o4 + o5 * o5) + (o6 * o6 + o7 * o7)); } }
                if constexpr (!FINAL) { sq = sum_fq(sq); if (fq == 0) ssout[(size_t)row * 32 + u.pn * 4 + wc] = sq; } }
            asm volatile("" ::: "memory");
        }
    }
};

typedef _Float16 f16x8 __attribute__((ext_vector_type(8)));
template <bool F16> __device__ __forceinline__ f32x4 mma16(bf16x8 b, bf16x8 a, f32x4 c) {
    if constexpr (F16) return __builtin_amdgcn_mfma_f32_16x16x32_f16(__builtin_bit_cast(f16x8, b), __builtin_bit_cast(f16x8, a), c, 0, 0, 0);
    else return __builtin_amdgcn_mfma_f32_16x16x32_bf16(b, a, c, 0, 0, 0);
}
template <class Epi, class Sched, bool ALIGN_EPI = false, bool SP2 = false, bool F16 = false>
__device__ __forceinline__ void gemm_phase(PG8_LAS unsigned char* lds, const Gemm g, const Sched& S, const Epi& E, const int tid_in  ) {
    int tid_ = tid_in; asm volatile("" : "+v"(tid_));
    const int tid = tid_, wid = __builtin_amdgcn_readfirstlane(tid >> 6), lane = tid & 63, wr = wid >> 2, wc = wid & 3, fr = lane & 15, fq = lane >> 4;
    const int K = g.K, nt = K / BK;
    unsigned voffA[2], voffB[2];
#pragma unroll
    for (int i = 0; i < 2; ++i) { int R, C; stage_rc(tid * 16 + i * 8192, R, C); const int Rb = Epi::PERM ? ((R & ~31) + perm32(R & 31)) : R;
        voffA[i] = (unsigned)(R * g.lda + C) * 2u; voffB[i] = (unsigned)(Rb * g.ldb + C) * 2u; }
    const size_t kstep = (size_t)(BK * 2);
    const size_t hstepA = (size_t)HALF * g.lda * 2, hstepB = (size_t)HALF * g.ldb * 2;
    const size_t tstepA = 2 * hstepA, tstepB = 2 * hstepB;
    const unsigned ldsw = (unsigned)wid * 1024u;
    const int aoff = lds_byte(wr * 64 + fr, fq * 8), boff = lds_byte(wc * 32 + fr, fq * 8);
#define PG8_SA(b, h) (((b) * 2 + (h)) * HTB)
#define PG8_SB(b, h) ((4 + (b) * 2 + (h)) * HTB)
#define PG8_STAGE(bufoff, gbase, voff) do { _Pragma("unroll") for (int _i = 0; _i < 2; ++_i) \
        __builtin_amdgcn_global_load_lds((const unsigned*)((const char*)(gbase) + (voff)[_i]), (PG8_LAS unsigned*)(lds + (bufoff) + ldsw + _i * 8192), 16, 0, 0); } while (0)
#define PG8_LDA(dst, b, h) do { _Pragma("unroll") for (int m = 0; m < 4; ++m) _Pragma("unroll") for (int k = 0; k < 2; ++k) dst[m][k] = *(const PG8_LAS bf16x8*)(lds + PG8_SA(b, h) + aoff + m * 2048 + k * 1024); } while (0)
#define PG8_LDB(dst, b, h) do { _Pragma("unroll") for (int n = 0; n < 2; ++n) _Pragma("unroll") for (int k = 0; k < 2; ++k) dst[n][k] = *(const PG8_LAS bf16x8*)(lds + PG8_SB(b, h) + boff + n * 2048 + k * 1024); } while (0)
#define PG8_MMA(ai, bj, At, Bt) do { __builtin_amdgcn_s_setprio(1); _Pragma("unroll") for (int m = 0; m < 4; ++m) _Pragma("unroll") for (int n = 0; n < 2; ++n) _Pragma("unroll") for (int k = 0; k < 2; ++k) \
        acc[ai][bj][m][n] = mma16<F16>(Bt[n][k], At[m][k], acc[ai][bj][m][n]); __builtin_amdgcn_s_setprio(0); } while (0)
#define PG8_WAIT_V(n) asm volatile("s_waitcnt vmcnt(" #n ")" ::: "memory")
#define PG8_WAIT_L(n) asm volatile("s_waitcnt lgkmcnt(" #n ")" ::: "memory")
#define PG8_BAR __builtin_amdgcn_s_barrier()
#define PG8_SCHED __builtin_amdgcn_sched_barrier(0)
    Unit cur, nxt; int ui = 0;
    if (!S.next(0, cur)) return;
    f32x4 acc[2][2][4][2];
#pragma unroll
    for (int a = 0; a < 2; ++a)
#pragma unroll
        for (int b = 0; b < 2; ++b)
#pragma unroll
            for (int m = 0; m < 4; ++m)
#pragma unroll
                for (int n = 0; n < 2; ++n) acc[a][b][m][n] = (f32x4){0.f, 0.f, 0.f, 0.f};
    bf16x8 At[4][2], B0[2][2], B1[2][2];
    const char* cA = (const char*)g.A + (size_t)cur.pm * tstepA; const char* cB = (const char*)g.Bt + (size_t)cur.pn * tstepB;
    S.a_ready(cur);
    if constexpr (SP2) {
        PG8_STAGE(PG8_SB(0, 0), cB, voffB); PG8_STAGE(PG8_SB(0, 1), cB + hstepB, voffB); PG8_STAGE(PG8_SA(0, 0), cA, voffA); PG8_STAGE(PG8_SA(0, 1), cA + hstepA, voffA);
        if (wr == 1) PG8_BAR;
        PG8_WAIT_V(2); PG8_BAR;
        PG8_STAGE(PG8_SB(1, 0), cB + kstep, voffB); PG8_STAGE(PG8_SA(1, 0), cA + kstep, voffA); PG8_STAGE(PG8_SB(1, 1), cB + hstepB + kstep, voffB);
        PG8_WAIT_V(6); PG8_BAR;
    } else {
        PG8_STAGE(PG8_SB(0, 0), cB, voffB); PG8_STAGE(PG8_SA(0, 0), cA, voffA); PG8_STAGE(PG8_SB(0, 1), cB + hstepB, voffB); PG8_STAGE(PG8_SA(0, 1), cA + hstepA, voffA);
        if (wr == 1) PG8_BAR;
        PG8_WAIT_V(4); PG8_BAR;
        PG8_STAGE(PG8_SB(1, 0), cB + kstep, voffB); PG8_STAGE(PG8_SA(1, 0), cA + kstep, voffA); PG8_STAGE(PG8_SB(1, 1), cB + hstepB + kstep, voffB);
        PG8_WAIT_V(6); PG8_BAR;
    }
    for (;;) {
        const bool has_next = S.next(ui + 1, nxt);
        const char* nA = has_next ? (const char*)g.A + (size_t)nxt.pm * tstepA : cA; const char* nB = has_next ? (const char*)g.Bt + (size_t)nxt.pn * tstepB : cB;
        for (int t = 0; t < nt; t += 2) {
            const bool last = (t == nt - 2);
            const char* a1 = cA + (size_t)(t + 1) * kstep;
            const char* a2 = last ? nA : cA + (size_t)(t + 2) * kstep; const char* b2 = last ? nB : cB + (size_t)(t + 2) * kstep;
            const char* a3 = a2 + kstep; const char* b3 = b2 + kstep;
            if (last && has_next) S.a_ready(nxt);
            if constexpr (SP2) {
            PG8_LDB(B0, 0, 0); PG8_LDB(B1, 0, 1); PG8_SCHED; PG8_LDA(At, 0, 0); PG8_STAGE(PG8_SA(1, 1), a1 + hstepA, voffA);
            PG8_WAIT_V(8); PG8_WAIT_L(0); PG8_BAR; PG8_MMA(0, 0, At, B0); PG8_MMA(0, 1, At, B1); PG8_BAR; PG8_SCHED;
            PG8_LDA(At, 0, 1); PG8_STAGE(PG8_SB(0, 0), b2, voffB); PG8_STAGE(PG8_SB(0, 1), b2 + hstepB, voffB); PG8_STAGE(PG8_SA(0, 0), a2, voffA);
            PG8_WAIT_V(8); PG8_WAIT_L(0); PG8_BAR; PG8_MMA(1, 0, At, B0); PG8_MMA(1, 1, At, B1); PG8_BAR; PG8_SCHED;
            PG8_LDB(B0, 1, 0); PG8_LDB(B1, 1, 1); PG8_SCHED; PG8_LDA(At, 1, 0); PG8_STAGE(PG8_SA(0, 1), a2 + hstepA, voffA);
            PG8_WAIT_V(8); PG8_WAIT_L(0); PG8_BAR; PG8_MMA(0, 0, At, B0); PG8_MMA(0, 1, At, B1); PG8_BAR; PG8_SCHED;
            PG8_LDA(At, 1, 1); PG8_STAGE(PG8_SB(1, 0), b3, voffB); PG8_STAGE(PG8_SB(1, 1), b3 + hstepB, voffB); PG8_STAGE(PG8_SA(1, 0), a3, voffA);
            PG8_WAIT_V(8); PG8_WAIT_L(0); PG8_BAR; PG8_MMA(1, 0, At, B0); PG8_MMA(1, 1, At, B1); PG8_BAR; PG8_SCHED;
            } else {
            PG8_LDB(B0, 0, 0); PG8_SCHED; PG8_LDA(At, 0, 0); PG8_STAGE(PG8_SA(1, 1), a1 + hstepA, voffA);
            PG8_WAIT_L(8); PG8_BAR; PG8_WAIT_L(0); PG8_MMA(0, 0, At, B0); PG8_BAR; PG8_SCHED;
            PG8_LDB(B1, 0, 1); PG8_STAGE(PG8_SB(0, 0), b2, voffB);
            PG8_BAR; PG8_WAIT_L(0); PG8_MMA(0, 1, At, B1); PG8_BAR;
            PG8_LDA(At, 0, 1); PG8_STAGE(PG8_SA(0, 0), a2, voffA);
            PG8_BAR; PG8_WAIT_L(0); PG8_MMA(1, 0, At, B0); PG8_BAR; PG8_SCHED;
            PG8_STAGE(PG8_SB(0, 1), b2 + hstepB, voffB);
            PG8_WAIT_V(6); PG8_BAR; PG8_MMA(1, 1, At, B1); PG8_BAR;
            PG8_LDB(B0, 1, 0); PG8_SCHED; PG8_LDA(At, 1, 0); PG8_STAGE(PG8_SA(0, 1), a2 + hstepA, voffA);
            PG8_WAIT_L(8); PG8_BAR; PG8_WAIT_L(0); PG8_MMA(0, 0, At, B0); PG8_BAR; PG8_SCHED;
            PG8_LDB(B1, 1, 1); PG8_STAGE(PG8_SB(1, 0), b3, voffB);
            PG8_BAR; PG8_WAIT_L(0); PG8_MMA(0, 1, At, B1); PG8_BAR;
            PG8_LDA(At, 1, 1); PG8_STAGE(PG8_SA(1, 0), a3, voffA);
            PG8_BAR; PG8_WAIT_L(0); PG8_MMA(1, 0, At, B0); PG8_BAR; PG8_SCHED;
            PG8_STAGE(PG8_SB(1, 1), b3 + hstepB, voffB);
            PG8_WAIT_V(6); PG8_BAR; PG8_MMA(1, 1, At, B1); PG8_BAR;
            }
        }
        if constexpr (ALIGN_EPI) { if (wr == 0) PG8_BAR; }
        if constexpr (!Epi::AFTER_DRAIN) { E(acc, cur, wr, wc, fr, fq); S.done(cur); }
        if (!has_next) break;
#pragma unroll
        for (int a = 0; a < 2; ++a)
#pragma unroll
            for (int b = 0; b < 2; ++b)
#pragma unroll
                for (int m = 0; m < 4; ++m)
#pragma unroll
                    for (int n = 0; n < 2; ++n) acc[a][b][m][n] = (f32x4){0.f, 0.f, 0.f, 0.f};
        cur = nxt; cA = nA; cB = nB; ++ui;
        if constexpr (ALIGN_EPI) { if (wr == 1) PG8_BAR; }
    }
    PG8_WAIT_V(0);
    if constexpr (!ALIGN_EPI) { if (wr == 0) PG8_BAR; }
    PG8_BAR;
    if constexpr (Epi::AFTER_DRAIN) { E.fused(acc, cur, wr, wc, fr, fq, lds, wid, lane); S.done(cur); }
#undef PG8_SA
#undef PG8_SB
#undef PG8_STAGE
#undef PG8_LDA
#undef PG8_LDB
#undef PG8_MMA
#undef PG8_WAIT_V
#undef PG8_WAIT_L
#undef PG8_BAR
#undef PG8_SCHED
}
}
#define XB_TMO      128
#define XB_XCNT(j)  (256  + 64 * (j))
#define XB_XSUB(j)  (1280 + 64 * (j))
#define XB_XGEN(j)  (2304 + 64 * (j))
#define XB_TOP      3328
#define XB_TOPGEN   3392
#define XCD_BAR_WORDS 3456
#define XB_SPIN_CAP (1u << 18)

__device__ __forceinline__ unsigned xb_ld(unsigned* p)              { return __hip_atomic_load(p, __ATOMIC_RELAXED, __HIP_MEMORY_SCOPE_AGENT); }
__device__ __forceinline__ unsigned xb_add(unsigned* p, unsigned v) { return __hip_atomic_fetch_add(p, v, __ATOMIC_RELAXED, __HIP_MEMORY_SCOPE_AGENT); }
__device__ __forceinline__ unsigned xb_xcc_id() { return (unsigned)__builtin_amdgcn_s_getreg((3 << 11) | 20) & 0xFu; }
#define XB_SPIN(cond, bar) do { unsigned _sp = 0; while (cond) { __builtin_amdgcn_s_sleep(1); \
    if ((++_sp & 255u) == 0u) { if (xb_ld(&(bar)[XB_TMO])) break; if (_sp > XB_SPIN_CAP) { atomicAdd(&(bar)[XB_TMO], 1u); break; } } } } while (0)

struct XcdBarrier {
    unsigned* bar; unsigned x;
    volatile LAS unsigned* st;
};

__device__ __forceinline__ XcdBarrier xcd_barrier_post(unsigned* bar, volatile LAS unsigned* st) {
    XcdBarrier b; b.bar = bar; b.x = xb_xcc_id(); b.st = st;
    if (threadIdx.x == 0) (void)xb_add(&bar[XB_XCNT(b.x)], 1u);
    return b;
}
__device__ __forceinline__ void xcd_barrier_complete(unsigned* bar, unsigned x, unsigned& nloc, unsigned& nx) {
    const unsigned G = gridDim.x * gridDim.y * gridDim.z;
    unsigned sum, cnt, mine, sp = 0u;
    for (;;) {
        sum = 0u; cnt = 0u; mine = 0u;
#pragma unroll
        for (unsigned j = 0; j < 16; ++j) { const unsigned c = xb_ld(&bar[XB_XCNT(j)]); sum += c; cnt += (c > 0u) ? 1u : 0u; mine = (j == x) ? c : mine; }
        if (sum == G) break;
        __builtin_amdgcn_s_sleep(1);
        if ((++sp & 255u) == 0u) { if (xb_ld(&bar[XB_TMO])) break; if (sp > XB_SPIN_CAP) { atomicAdd(&bar[XB_TMO], 1u); break; } }
    }
    nloc = mine > 0u ? mine : 1u; nx = cnt > 0u ? cnt : 1u;
}

__device__ __forceinline__ void xcd_barrier(const XcdBarrier& b, const int tid_in  ) {
    asm volatile("s_waitcnt vmcnt(0)" ::: "memory");
    __syncthreads();
    if (tid_in == 0) {
        unsigned* bar = b.bar;
        __builtin_amdgcn_s_waitcnt(0);
        unsigned nloc = b.st[0], nx = b.st[1];
        if (nloc == 0u) { xcd_barrier_complete(bar, b.x, nloc, nx); b.st[0] = nloc; b.st[1] = nx; }
        const unsigned old = xb_add(&bar[XB_XSUB(b.x)], 1u);
        const unsigned gen = old / nloc;
        if (old + 1u == (gen + 1u) * nloc) {
            __builtin_amdgcn_fence(__ATOMIC_RELEASE, "agent");
            asm volatile("s_waitcnt vmcnt(0)" ::: "memory");
            const unsigned og = xb_add(&bar[XB_TOP], 1u);
            const unsigned tg = og / nx;
            if (og + 1u == (tg + 1u) * nx) xb_add(&bar[XB_TOPGEN], 1u);
            else XB_SPIN(xb_ld(&bar[XB_TOPGEN]) == tg, bar);
            __builtin_amdgcn_fence(__ATOMIC_ACQUIRE, "agent");
            xb_add(&bar[XB_XGEN(b.x)], 1u);
            asm volatile("s_waitcnt vmcnt(0)" ::: "memory");
        } else {
            XB_SPIN(xb_ld(&bar[XB_XGEN(b.x)]) == gen, bar);
            __builtin_amdgcn_fence(__ATOMIC_ACQUIRE, "agent");
            asm volatile("s_waitcnt vmcnt(0)" ::: "memory");
        }
    }
    __syncthreads();
}
template <int MODE, bool F16>
__device__ __forceinline__ void transpose_item(const float* W, const float* ksc, int K, int N, bf16* WT, int row_off, LAS float* scr_, int item, int lane) {
    LAS unsigned char* scr = (LAS unsigned char*)scr_;
    const int nblk = N / 64, kb = item / nblk, nb = item % nblk, k0 = 64 * kb, n0 = 64 * nb;
    const int n4 = lane & 15, kq = lane >> 4;
#pragma unroll 4
    for (int i = 0; i < 16; ++i) { const int kk = 4 * i + kq; const f32x4 v = *(const f32x4*)(W + (size_t)(k0 + kk) * N + n0 + 4 * n4); const float sc = ksc ? ksc[k0 + kk] : 1.f;
        const unsigned p01 = F16 ? pkh2(v.x * sc, v.y * sc) : pk2(v.x * sc, v.y * sc), p23 = F16 ? pkh2(v.z * sc, v.w * sc) : pk2(v.z * sc, v.w * sc);
        LAS unsigned char* d = scr + (4 * n4) * 144 + (((kk >> 3) ^ (n4 & 7)) << 4) + (kk & 7) * 2;
        *(LAS unsigned short*)(d) = (unsigned short)p01; *(LAS unsigned short*)(d + 144) = (unsigned short)(p01 >> 16);
        *(LAS unsigned short*)(d + 288) = (unsigned short)p23; *(LAS unsigned short*)(d + 432) = (unsigned short)(p23 >> 16); }
    LDS_WAIT(); asm volatile("" ::: "memory");
    int d0;
    if (MODE == 0) d0 = row_off + n0;
    else { const int half = n0 >= DFF ? 1 : 0, nn = n0 - half * DFF; d0 = (nn >> 7) * 256 + half * 128 + (nn & 127); }
#pragma unroll
    for (int t = 0; t < 8; ++t) { const int idx = lane + 64 * t, n = idx >> 3, c = idx & 7;
        const v4u o = *(const LAS v4u*)(scr + n * 144 + ((c ^ ((n >> 2) & 7)) << 4));
        *(v4u*)(WT + (size_t)(d0 + n) * K + k0 + 8 * c) = o; }
    LDS_WAIT(); asm volatile("" ::: "memory");
}
template <int MODE, bool F16 = false>
__device__ __forceinline__ void convert_matrix(const float* W, const float* ksc, int K, int N, bf16* WT, int row_off, LAS float* scr, int gw, int NGW, int lane) {
    const int nitems = (K / 64) * (N / 64);
    for (int it = gw; it < nitems; it += NGW) transpose_item<MODE, F16>(W, ksc, K, N, WT, row_off, scr, it, lane);
}
__device__ __forceinline__ void zero_rows(bf16* WT, int K, int row0, int nrows, int gtid, int NGT) {
    const size_t n16 = (size_t)nrows * K / 8; v4u* p = (v4u*)(WT + (size_t)row0 * K);
    unsigned z = 0u; asm volatile("" : "+v"(z));
    for (size_t i = gtid; i < n16; i += NGT) p[i] = (v4u){z, z, z, z};
}
__device__ __forceinline__ void phase_cast_ss(const float* h, bf16* hb, float* ss, int gw, int NGW, int lane) {
    for (int m = gw; m < NT; m += NGW) {
        const f32x4* xr = (const f32x4*)(h + (size_t)m * DM) + lane; v2u* o8 = (v2u*)(hb + (size_t)m * DM) + lane; float s = 0.f;
#pragma unroll
        for (int j = 0; j < 8; ++j) { const f32x4 v = xr[64 * j]; s += (v.x * v.x + v.y * v.y) + (v.z * v.z + v.w * v.w); v2u o; o.x = pkh2(v.x, v.y); o.y = pkh2(v.z, v.w); o8[64 * j] = o; }
        s = wave_sum(s, lane);
        if (lane < 32) ss[(size_t)m * 32 + lane] = lane == 0 ? s : 0.f;
    }
}
__device__ __forceinline__ void zero_f32(float* p, int n, int gtid, int NGT) { float z = 0.f; asm volatile("" : "+v"(z)); for (int i = gtid; i < n; i += NGT) p[i] = z; }
__device__ __forceinline__ void phase_rope_table(const int* positions, float* cs, int gtid, int NGT) {
    for (int idx = gtid; idx < NT * 32; idx += NGT) {
        const int t = idx >> 5, i = idx & 31;
        const float inv_freq = __builtin_amdgcn_exp2f(-(float)i * (13.287712379549449f / 32.0f));
        const float ang = (float)positions[t] * inv_freq;
        const double rev = (double)ang * 0.15915494309189535; const double fr = rev - floor(rev);
        const float x = (float)(fr * 6.283185307179586);
        cs[(size_t)t * 64 + i] = cosf(x); cs[(size_t)t * 64 + 32 + i] = sinf(x);
    }
}
__device__ __forceinline__ void phase_mla_latnorm(const float* c, const float* wq, const float* wkv, bf16* qkvn, float* kpe, int gw, int NGW, int lane) {
    for (int m = gw; m < NT; m += NGW) {
        const f32x4* cr = (const f32x4*)(c + (size_t)m * MLA_IN_PAD);
        f32x4 a0 = cr[lane], a1 = cr[64 + lane], b0 = cr[128 + lane], b1 = cr[192 + lane];
        float sa = (a0.x * a0.x + a0.y * a0.y) + (a0.z * a0.z + a0.w * a0.w) + (a1.x * a1.x + a1.y * a1.y) + (a1.z * a1.z + a1.w * a1.w);
        float sb = (b0.x * b0.x + b0.y * b0.y) + (b0.z * b0.z + b0.w * b0.w) + (b1.x * b1.x + b1.y * b1.y) + (b1.z * b1.z + b1.w * b1.w);
        const float ra = rsqrtf(wave_sum(sa, lane) * (1.f / 512.f) + NORM_EPS), rb = rsqrtf(wave_sum(sb, lane) * (1.f / 512.f) + NORM_EPS);
        const f32x4 wa0 = ((const f32x4*)wq)[lane], wa1 = ((const f32x4*)wq)[64 + lane], wb0 = ((const f32x4*)wkv)[lane], wb1 = ((const f32x4*)wkv)[64 + lane];
        v2u* o = (v2u*)(qkvn + (size_t)m * 1024); v2u t;
        t.x = pk2(a0.x * ra * wa0.x, a0.y * ra * wa0.y); t.y = pk2(a0.z * ra * wa0.z, a0.w * ra * wa0.w); o[lane] = t;
        t.x = pk2(a1.x * ra * wa1.x, a1.y * ra * wa1.y); t.y = pk2(a1.z * ra * wa1.z, a1.w * ra * wa1.w); o[64 + lane] = t;
        t.x = pk2(b0.x * rb * wb0.x, b0.y * rb * wb0.y); t.y = pk2(b0.z * rb * wb0.z, b0.w * rb * wb0.w); o[128 + lane] = t;
        t.x = pk2(b1.x * rb * wb1.x, b1.y * rb * wb1.y); t.y = pk2(b1.z * rb * wb1.z, b1.w * rb * wb1.w); o[192 + lane] = t;
        if (lane < 16) ((f32x4*)(kpe + (size_t)m * 64))[lane] = cr[256 + lane];
    }
}
__device__ __forceinline__ void phase_mla_finalize_kv(const bf16* kvraw, const float* kpe, const float* cs, const float* knw, bf16* kf, bf16* vf, int gw, int NGW, int lane) {
    const int g = lane >> 4, i = lane & 15, isv = g & 1;
    float wk[8], wpe[8];
#pragma unroll
    for (int e = 0; e < 8; ++e) { wk[e] = knw[8 * i + e]; wpe[e] = knw[128 + 8 * (i & 7) + e]; }
    for (int m = gw; m < NT; m += NGW) {
        const int b = m / SEQ, s = m % SEQ;
        const float pv = kpe[(size_t)m * 64 + lane]; const float pess = wave_sum(pv * pv, lane);
        float pe[8], cv[8], sv[8];
        { const f32x4 a0 = *(const f32x4*)(kpe + (size_t)m * 64 + 8 * (i & 7)), a1 = *(const f32x4*)(kpe + (size_t)m * 64 + 8 * (i & 7) + 4);
          const f32x4 c0 = *(const f32x4*)(cs + (size_t)m * 64 + 8 * (i & 3)), c1 = *(const f32x4*)(cs + (size_t)m * 64 + 8 * (i & 3) + 4);
          const f32x4 s0 = *(const f32x4*)(cs + (size_t)m * 64 + 32 + 8 * (i & 3)), s1 = *(const f32x4*)(cs + (size_t)m * 64 + 32 + 8 * (i & 3) + 4);
#pragma unroll
          for (int e = 0; e < 4; ++e) { pe[e] = a0[e]; pe[4 + e] = a1[e]; cv[e] = c0[e]; cv[4 + e] = c1[e]; sv[e] = s0[e]; sv[4 + e] = s1[e]; } }
        const bf16* kr = kvraw + (size_t)m * (MLA_H * 256);
#pragma unroll 2
        for (int hp = 0; hp < MLA_H / 2; ++hp) {
            const int h = 2 * hp + (g >> 1); const size_t ob = ((size_t)(b * MLA_H + h) * SEQ + s);
            const v4u raw = *(const v4u*)(kr + h * 256 + isv * 128 + 8 * i);
            float x[8]; x[0] = bflo(raw.x); x[1] = bfhi(raw.x); x[2] = bflo(raw.y); x[3] = bfhi(raw.y); x[4] = bflo(raw.z); x[5] = bfhi(raw.z); x[6] = bflo(raw.w); x[7] = bfhi(raw.w);
            float ss = 0.f;
#pragma unroll
            for (int e = 0; e < 8; ++e) ss += x[e] * x[e];
            ss += shx(ss, 1, lane); ss += shx(ss, 2, lane); ss += shx(ss, 4, lane); ss += shx(ss, 8, lane);
            float rs = rsqrtf((ss + pess) * (1.f / 192.f) + NORM_EPS);
            const float rso = shx(rs, 16, lane); if (isv) rs = rso;
            if (!isv) { v4u o; o.x = pk2(x[0] * rs * wk[0], x[1] * rs * wk[1]); o.y = pk2(x[2] * rs * wk[2], x[3] * rs * wk[3]); o.z = pk2(x[4] * rs * wk[4], x[5] * rs * wk[5]); o.w = pk2(x[6] * rs * wk[6], x[7] * rs * wk[7]);
                *(v4u*)(kf + ob * MLA_QK + 8 * i) = o; }
            else *(v4u*)(vf + ob * MLA_V + 8 * i) = raw;
            float y[8], yp[8];
#pragma unroll
            for (int e = 0; e < 8; ++e) { y[e] = pe[e] * rs * wpe[e]; yp[e] = shx(y[e], 4, lane); }
            if (isv && i < 8) { float r[8];
#pragma unroll
                for (int e = 0; e < 8; ++e) r[e] = (i < 4) ? y[e] * cv[e] - yp[e] * sv[e] : y[e] * cv[e] + yp[e] * sv[e];
                v4u o; o.x = pk2(r[0], r[1]); o.y = pk2(r[2], r[3]); o.z = pk2(r[4], r[5]); o.w = pk2(r[6], r[7]);
                *(v4u*)(kf + ob * MLA_QK + 128 + 8 * i) = o; }
        }
    }
}
__device__ __forceinline__ void phase_cvt_bf16(const float* src, bf16* dst, size_t n, int gtid, int NGT) {
    const size_t n8 = n / 8;
    for (size_t i = gtid; i < n8; i += NGT) { const f32x4 a = ((const f32x4*)src)[2 * i], b = ((const f32x4*)src)[2 * i + 1];
        v4u o; o.x = pk2(a.x, a.y); o.y = pk2(a.z, a.w); o.z = pk2(b.x, b.y); o.w = pk2(b.z, b.w); ((v4u*)dst)[i] = o; }
}
__device__ __forceinline__ void phase_rstd_e(const bf16* e, float* rstd, int gw, int NGW, int lane) {
    for (int m = gw; m < NT; m += NGW) {
        const v4u* er = (const v4u*)(e + (size_t)m * DM) + lane; float s = 0.f;
#pragma unroll
        for (int j = 0; j < 4; ++j) { const v4u w = er[64 * j];
            const float a0 = bflo(w.x), a1 = bfhi(w.x), a2 = bflo(w.y), a3 = bfhi(w.y), a4 = bflo(w.z), a5 = bfhi(w.z), a6 = bflo(w.w), a7 = bfhi(w.w);
            s += (a0 * a0 + a1 * a1) + (a2 * a2 + a3 * a3) + (a4 * a4 + a5 * a5) + (a6 * a6 + a7 * a7); }
        s = wave_sum(s, lane);
        if (lane == 0) rstd[m] = rsqrtf(s * (1.f / 2048.f) + NORM_EPS);
    }
}

namespace attn {
constexpr int DQK = 192, DV = 128, QBLK = 32, KVBLK = 64, QB = 256;
constexpr int SHM_V = KVBLK * DV * 2, SHM_K = KVBLK * DQK * 2;
constexpr int OFF_V = 0, OFF_K = 2 * SHM_V, OFF_WS = OFF_K + 2 * SHM_K;
constexpr int OFF_Q = OFF_WS + NWAVES * 64 * 4;
constexpr int ATTN_LDS = OFF_Q + NWAVES * 4096;
constexpr float SCALE = 0.07216878364870322f;
constexpr float THR = 8.f;
#define SBAR() __builtin_amdgcn_sched_barrier(0)
__device__ __forceinline__ int v_rd_base(int lane) { return ((lane & 3) << 3) | (((lane >> 2) & 3) << 6) | (((lane >> 4) & 1) << 5) | (((lane >> 5) & 1) << 8); }
constexpr int v_rd_off(int d0, int ks, int half) { return d0 * 512 + ks * 4096 + half * 2048; }
__device__ __forceinline__ int crow(int r, int hi) { return (r & 3) + 8 * (r >> 2) + 4 * hi; }
__device__ __forceinline__ unsigned cvtpk(float lo, float hi) { unsigned r; asm volatile("v_cvt_pk_bf16_f32 %0, %1, %2" : "=v"(r) : "v"(lo), "v"(hi)); return r; }
__device__ __forceinline__ void mask_tile(f32x16& p0, f32x16& p1, int dq) {
    const float NEG = -__builtin_inff();
#pragma unroll
    for (int r = 0; r < 16; ++r) { const int c = (r & 3) + 8 * (r >> 2);
        if (dq - c < 0) p0[r] = NEG;
        if (dq - c - 32 < 0) p1[r] = NEG; }
}
__device__ __forceinline__ void partialSM(f32x16& p0, f32x16& p1, float& m_reg, float& mn, float& alpha) {
    float pmax = p0[0];
#pragma unroll
    for (int r = 1; r < 16; ++r) pmax = fmaxf(pmax, p0[r]);
#pragma unroll
    for (int r = 0; r < 16; ++r) pmax = fmaxf(pmax, p1[r]);
    { auto rr = __builtin_amdgcn_permlane32_swap(__float_as_uint(pmax), __float_as_uint(pmax), false, false);
      pmax = fmaxf(__uint_as_float(rr[0]), __uint_as_float(rr[1])); }
    constexpr float C2 = 1.4426950408889634f * SCALE;
    if (__builtin_expect(__all((pmax - m_reg) * SCALE <= THR), 1)) { mn = m_reg; alpha = 1.f; }
    else { mn = fmaxf(m_reg, pmax); alpha = __builtin_amdgcn_exp2f((m_reg - mn) * C2); m_reg = mn; }
    const float mnL = -mn * C2;
#pragma unroll
    for (int r = 0; r < 16; ++r) p0[r] = fmaf(p0[r], C2, mnL);
#pragma unroll
    for (int r = 0; r < 16; ++r) p1[r] = fmaf(p1[r], C2, mnL);
#pragma unroll
    for (int r = 0; r < 16; ++r) p0[r] = __builtin_amdgcn_exp2f(p0[r]);
}
__device__ __forceinline__ void finishSM(f32x16& p0, f32x16& p1, float alpha, float& l_reg, bf16x8& pa0, bf16x8& pa1, bf16x8& pa2, bf16x8& pa3) {
#pragma unroll
    for (int r = 0; r < 16; ++r) p1[r] = __builtin_amdgcn_exp2f(p1[r]);
    float ps = 0;
#pragma unroll
    for (int r = 0; r < 16; ++r) ps += p0[r];
#pragma unroll
    for (int r = 0; r < 16; ++r) ps += p1[r];
    { auto rr = __builtin_amdgcn_permlane32_swap(__float_as_uint(ps), __float_as_uint(ps), false, false);
      ps = __uint_as_float(rr[0]) + __uint_as_float(rr[1]); }
    l_reg = l_reg * alpha + ps;
#define PK4(P, B_, OUT) do { unsigned a0 = cvtpk(P[B_+0], P[B_+1]), a1 = cvtpk(P[B_+2], P[B_+3]);                          \
        unsigned b0 = cvtpk(P[B_+4], P[B_+5]), b1 = cvtpk(P[B_+6], P[B_+7]);                                             \
        auto r0 = __builtin_amdgcn_permlane32_swap(a0, b0, false, false); auto r1 = __builtin_amdgcn_permlane32_swap(a1, b1, false, false); \
        v4u w = {r0[0], r1[0], r0[1], r1[1]}; OUT = *reinterpret_cast<bf16x8*>(&w); } while (0)
    PK4(p0, 0, pa0); PK4(p0, 8, pa1); PK4(p1, 0, pa2); PK4(p1, 8, pa3);
#undef PK4
}
__device__ __forceinline__ int k_off(int row, int ch) { return row * 384 + ((ch ^ ((row >> 1) & 7)) << 4); }
template <int KB>
__device__ __forceinline__ void qkt(f32x16& p0, f32x16& p1, const LAS char* lds, int r32, int hi, const bf16x8* qr, const LAS char* qs) {
    p0 = f32x16{}; p1 = f32x16{};
    const LAS char* kb[4];
#pragma unroll
    for (int dd = 0; dd < 4; ++dd) kb[dd] = lds + OFF_K + KB * SHM_K + k_off(r32, dd * 2 + hi);
#if PROBE_MASK
#pragma unroll
    for (int d0 = 0; d0 < 12; ++d0) { const LAS char* a = kb[d0 & 3] + (d0 >> 2) * 128;
        bf16x8 b0 = *reinterpret_cast<const LAS bf16x8*>(a);
        bf16x8 b1 = *reinterpret_cast<const LAS bf16x8*>(a + 32 * 384);
        const bf16x8 qv = d0 < 8 ? qr[d0 < 8 ? d0 : 0] : *reinterpret_cast<const LAS bf16x8*>(qs + (d0 - 8) * 1024);
        p0 = __builtin_amdgcn_mfma_f32_32x32x16_bf16(b0, qv, p0, 0, 0, 0);
        p1 = __builtin_amdgcn_mfma_f32_32x32x16_bf16(b1, qv, p1, 0, 0, 0); }
#else
    bf16x8 kf[2][4], qx[2][2];
#define QKT_LOAD(i_, buf_) do { _Pragma("unroll") for (int e_ = 0; e_ < 2; ++e_) { const int d0_ = 2 * (i_) + e_; const LAS char* a_ = kb[d0_ & 3] + (d0_ >> 2) * 128; \
        kf[buf_][2 * e_] = *reinterpret_cast<const LAS bf16x8*>(a_); kf[buf_][2 * e_ + 1] = *reinterpret_cast<const LAS bf16x8*>(a_ + 32 * 384); \
        if (d0_ >= 8) qx[buf_][e_] = *reinterpret_cast<const LAS bf16x8*>(qs + (d0_ - 8) * 1024); } } while (0)
    QKT_LOAD(0, 0);
#pragma unroll
    for (int i = 0; i < 6; ++i) {
        if (i < 5) QKT_LOAD(i + 1, (i + 1) & 1);
        __builtin_amdgcn_sched_barrier(0);
#pragma unroll
        for (int e = 0; e < 2; ++e) { const int d0 = 2 * i + e; const bf16x8 qv = d0 < 8 ? qr[d0 < 8 ? d0 : 0] : qx[i & 1][e];
            p0 = __builtin_amdgcn_mfma_f32_32x32x16_bf16(kf[i & 1][2 * e], qv, p0, 0, 0, 0);
            p1 = __builtin_amdgcn_mfma_f32_32x32x16_bf16(kf[i & 1][2 * e + 1], qv, p1, 0, 0, 0); }
        __builtin_amdgcn_sched_barrier(0);
    }
#undef QKT_LOAD
#endif
}
template <int VB>
__device__ __forceinline__ void pv_tile(f32x16* o, int vb0, bf16x8 pa0, bf16x8 pa1, bf16x8 pa2, bf16x8 pa3) {
#define TRRD(dst, off) asm volatile("ds_read_b64_tr_b16 %0, %1 offset:%2" : "=&v"(dst) : "v"(vb0), "i"(off) : "memory")
#define PV_RD(S, d0) do { constexpr int b_ = OFF_V + VB * SHM_V + v_rd_off(d0, 0, 0); \
        TRRD(S[0], b_); TRRD(S[1], b_ + 2048); TRRD(S[2], b_ + 4096); TRRD(S[3], b_ + 6144); TRRD(S[4], b_ + 8192); TRRD(S[5], b_ + 10240); TRRD(S[6], b_ + 12288); TRRD(S[7], b_ + 14336); } while (0)
#define PV_MM(S, d0) do { \
        o[d0] = __builtin_amdgcn_mfma_f32_32x32x16_bf16(pa0, (bf16x8){S[0][0], S[0][1], S[0][2], S[0][3], S[1][0], S[1][1], S[1][2], S[1][3]}, o[d0], 0, 0, 0);   \
        o[d0] = __builtin_amdgcn_mfma_f32_32x32x16_bf16(pa1, (bf16x8){S[2][0], S[2][1], S[2][2], S[2][3], S[3][0], S[3][1], S[3][2], S[3][3]}, o[d0], 0, 0, 0);   \
        o[d0] = __builtin_amdgcn_mfma_f32_32x32x16_bf16(pa2, (bf16x8){S[4][0], S[4][1], S[4][2], S[4][3], S[5][0], S[5][1], S[5][2], S[5][3]}, o[d0], 0, 0, 0);   \
        o[d0] = __builtin_amdgcn_mfma_f32_32x32x16_bf16(pa3, (bf16x8){S[6][0], S[6][1], S[6][2], S[6][3], S[7][0], S[7][1], S[7][2], S[7][3]}, o[d0], 0, 0, 0); } while (0)
#define PV_WAIT8(S) asm volatile("s_waitcnt lgkmcnt(8)" : "+v"(S[0]), "+v"(S[1]), "+v"(S[2]), "+v"(S[3]), "+v"(S[4]), "+v"(S[5]), "+v"(S[6]), "+v"(S[7]) :: "memory")
#define PV_WAIT0(S) asm volatile("s_waitcnt lgkmcnt(0)" : "+v"(S[0]), "+v"(S[1]), "+v"(S[2]), "+v"(S[3]), "+v"(S[4]), "+v"(S[5]), "+v"(S[6]), "+v"(S[7]) :: "memory")
    s16x4 sa[8], sb[8];
    PV_RD(sa, 0);
    PV_RD(sb, 1); PV_WAIT8(sa); SBAR(); PV_MM(sa, 0); SBAR();
    PV_RD(sa, 2); PV_WAIT8(sb); SBAR(); PV_MM(sb, 1); SBAR();
    PV_RD(sb, 3); PV_WAIT8(sa); SBAR(); PV_MM(sa, 2); SBAR();
    PV_WAIT0(sb); SBAR(); PV_MM(sb, 3);
#undef PV_RD
#undef PV_MM
#undef PV_WAIT8
#undef PV_WAIT0
#undef TRRD
}
template <int VB, int KB, bool DO_PV, bool DO_QK>
__device__ __forceinline__ void mseg(f32x16* o, int vb0, bf16x8 pa0, bf16x8 pa1, bf16x8 pa2, bf16x8 pa3, f32x16& p0, f32x16& p1, int ldsa, int r32, int hi, const bf16x8* qr, int qsa) {
#define TRRD(dst, off) asm volatile("ds_read_b64_tr_b16 %0, %1 offset:%2" : "=&v"(dst) : "v"(vb0), "i"(off) : "memory")
#define PV_RD(S, d0) do { constexpr int b_ = OFF_V + VB * SHM_V + v_rd_off(d0, 0, 0); \
        TRRD(S[0], b_); TRRD(S[1], b_ + 2048); TRRD(S[2], b_ + 4096); TRRD(S[3], b_ + 6144); TRRD(S[4], b_ + 8192); TRRD(S[5], b_ + 10240); TRRD(S[6], b_ + 12288); TRRD(S[7], b_ + 14336); } while (0)
#define PV_MM(S, d0) do { \
        o[d0] = __builtin_amdgcn_mfma_f32_32x32x16_bf16(pa0, (bf16x8){S[0][0], S[0][1], S[0][2], S[0][3], S[1][0], S[1][1], S[1][2], S[1][3]}, o[d0], 0, 0, 0);   \
        o[d0] = __builtin_amdgcn_mfma_f32_32x32x16_bf16(pa1, (bf16x8){S[2][0], S[2][1], S[2][2], S[2][3], S[3][0], S[3][1], S[3][2], S[3][3]}, o[d0], 0, 0, 0);   \
        o[d0] = __builtin_amdgcn_mfma_f32_32x32x16_bf16(pa2, (bf16x8){S[4][0], S[4][1], S[4][2], S[4][3], S[5][0], S[5][1], S[5][2], S[5][3]}, o[d0], 0, 0, 0);   \
        o[d0] = __builtin_amdgcn_mfma_f32_32x32x16_bf16(pa3, (bf16x8){S[6][0], S[6][1], S[6][2], S[6][3], S[7][0], S[7][1], S[7][2], S[7][3]}, o[d0], 0, 0, 0); } while (0)
#define PV_WAIT8(S) asm volatile("s_waitcnt lgkmcnt(8)" : "+v"(S[0]), "+v"(S[1]), "+v"(S[2]), "+v"(S[3]), "+v"(S[4]), "+v"(S[5]), "+v"(S[6]), "+v"(S[7]) :: "memory")
#define PV_WAIT0(S) asm volatile("s_waitcnt lgkmcnt(0)" : "+v"(S[0]), "+v"(S[1]), "+v"(S[2]), "+v"(S[3]), "+v"(S[4]), "+v"(S[5]), "+v"(S[6]), "+v"(S[7]) :: "memory")
#define KRD(dst, base, off) asm volatile("ds_read_b128 %0, %1 offset:%2" : "=&v"(dst) : "v"(base), "i"(off) : "memory")
#define QK_LD4(B, da, db) do { KRD(kf[B][0], kb[(da) & 3], ((da) >> 2) * 128); KRD(kf[B][1], kb[(da) & 3], ((da) >> 2) * 128 + 12288); \
                               KRD(kf[B][2], kb[(db) & 3], ((db) >> 2) * 128); KRD(kf[B][3], kb[(db) & 3], ((db) >> 2) * 128 + 12288); } while (0)
#define QK_LD6(B, da, db) do { QK_LD4(B, da, db); KRD(qx[B][0], qsa, ((da) - 8) * 1024); KRD(qx[B][1], qsa, ((db) - 8) * 1024); } while (0)
#define QK_W(N, B)  asm volatile("s_waitcnt lgkmcnt(" #N ")" : "+v"(kf[B][0]), "+v"(kf[B][1]), "+v"(kf[B][2]), "+v"(kf[B][3]) :: "memory")
#define QK_WQ(N, B) asm volatile("s_waitcnt lgkmcnt(" #N ")" : "+v"(kf[B][0]), "+v"(kf[B][1]), "+v"(kf[B][2]), "+v"(kf[B][3]), "+v"(qx[B][0]), "+v"(qx[B][1]) :: "memory")
#define QK_MM(B, qa, qb) do { p0 = __builtin_amdgcn_mfma_f32_32x32x16_bf16(kf[B][0], qa, p0, 0, 0, 0); p1 = __builtin_amdgcn_mfma_f32_32x32x16_bf16(kf[B][1], qa, p1, 0, 0, 0); \
                              p0 = __builtin_amdgcn_mfma_f32_32x32x16_bf16(kf[B][2], qb, p0, 0, 0, 0); p1 = __builtin_amdgcn_mfma_f32_32x32x16_bf16(kf[B][3], qb, p1, 0, 0, 0); } while (0)
    s16x4 sa[8], sb[8]; bf16x8 kf[2][4], qx[2][2]; int kb[4];
    if (DO_QK) {
#pragma unroll
        for (int dd = 0; dd < 4; ++dd) kb[dd] = ldsa + OFF_K + KB * SHM_K + k_off(r32, dd * 2 + hi);
    }
    if (DO_PV) {
        PV_RD(sa, 0);
        PV_RD(sb, 1); PV_WAIT8(sa); SBAR(); PV_MM(sa, 0); SBAR();
        PV_RD(sa, 2); PV_WAIT8(sb); SBAR(); PV_MM(sb, 1); SBAR();
        PV_RD(sb, 3); PV_WAIT8(sa); SBAR(); PV_MM(sa, 2); SBAR();
        if (DO_QK) { QK_LD4(0, 0, 1); QK_LD4(1, 2, 3); PV_WAIT8(sb); } else PV_WAIT0(sb);
        SBAR(); PV_MM(sb, 3); SBAR();
    } else if (DO_QK) { QK_LD4(0, 0, 1); QK_LD4(1, 2, 3); }
    if (DO_QK) {
        p0 = f32x16{}; p1 = f32x16{};
        QK_W(4, 0); SBAR(); QK_MM(0, qr[0], qr[1]); SBAR(); QK_LD4(0, 4, 5);
        QK_W(4, 1); SBAR(); QK_MM(1, qr[2], qr[3]); SBAR(); QK_LD4(1, 6, 7);
        QK_W(4, 0); SBAR(); QK_MM(0, qr[4], qr[5]); SBAR(); QK_LD6(0, 8, 9);
        QK_W(6, 1); SBAR(); QK_MM(1, qr[6], qr[7]); SBAR(); QK_LD6(1, 10, 11);
        QK_WQ(6, 0); SBAR(); QK_MM(0, qx[0][0], qx[0][1]); SBAR();
        QK_WQ(0, 1); SBAR(); QK_MM(1, qx[1][0], qx[1][1]); SBAR();
    }
#undef TRRD
#undef PV_RD
#undef PV_MM
#undef PV_WAIT8
#undef PV_WAIT0
#undef KRD
#undef QK_LD4
#undef QK_LD6
#undef QK_W
#undef QK_WQ
#undef QK_MM
}
template <int SLOT>
__device__ __forceinline__ void fast_tile(f32x16* o, int vb0, int ldsa, int r32, int hi, const bf16x8* qr, int qsa, float& m_reg, float& l_reg, LAS float* al_l, bool diag, int dq) {
#define F_KRD(dst, base, off) asm volatile("ds_read_b128 %0, %1 offset:%2" : "=&v"(dst) : "v"(base), "i"(off) : "memory")
#define F_LDK(B, off) do { F_KRD(kf[B][0], kb[0], off); F_KRD(kf[B][1], kb[1], off); F_KRD(kf[B][2], kb[2], off); F_KRD(kf[B][3], kb[3], off); } while (0)
#define F_LDQ() do { F_KRD(qx[0], qsa, 0); F_KRD(qx[1], qsa, 1024); F_KRD(qx[2], qsa, 2048); F_KRD(qx[3], qsa, 3072); } while (0)
#define F_W4(N, B) asm volatile("s_waitcnt lgkmcnt(" #N ")" : "+v"(kf[B][0]), "+v"(kf[B][1]), "+v"(kf[B][2]), "+v"(kf[B][3]) :: "memory")
#define F_W8(N, B) asm volatile("s_waitcnt lgkmcnt(" #N ")" : "+v"(kf[B][0]), "+v"(kf[B][1]), "+v"(kf[B][2]), "+v"(kf[B][3]), "+v"(qx[0]), "+v"(qx[1]), "+v"(qx[2]), "+v"(qx[3]) :: "memory")
#define F_MF(acc, a, b) acc = __builtin_amdgcn_mfma_f32_32x32x16_bf16(a, b, acc, 0, 0, 0)
#define F_TRRD(dst, off) asm volatile("ds_read_b64_tr_b16 %0, %1 offset:%2" : "=&v"(dst) : "v"(vb0), "i"(off) : "memory")
#define F_VRD(S, d0a, half) do { constexpr int b_ = OFF_V + SLOT * SHM_V + (d0a) * 512 + (half) * 8192; \
        F_TRRD(S[0], b_); F_TRRD(S[1], b_ + 2048); F_TRRD(S[2], b_ + 4096); F_TRRD(S[3], b_ + 6144); F_TRRD(S[4], b_ + 512); F_TRRD(S[5], b_ + 512 + 2048); F_TRRD(S[6], b_ + 512 + 4096); F_TRRD(S[7], b_ + 512 + 6144); } while (0)
#define F_VW(N, S) asm volatile("s_waitcnt lgkmcnt(" #N ")" : "+v"(S[0]), "+v"(S[1]), "+v"(S[2]), "+v"(S[3]), "+v"(S[4]), "+v"(S[5]), "+v"(S[6]), "+v"(S[7]) :: "memory")
#define F_CAT(S, j) ((bf16x8){S[j][0], S[j][1], S[j][2], S[j][3], S[(j) + 1][0], S[(j) + 1][1], S[(j) + 1][2], S[(j) + 1][3]})
#define F_PK4(P, B_, OUT) do { unsigned a0 = cvtpk(P[B_+0], P[B_+1]), a1 = cvtpk(P[B_+2], P[B_+3]); unsigned b0 = cvtpk(P[B_+4], P[B_+5]), b1 = cvtpk(P[B_+6], P[B_+7]); \
        auto r0 = __builtin_amdgcn_permlane32_swap(a0, b0, false, false); auto r1 = __builtin_amdgcn_permlane32_swap(a1, b1, false, false); \
        v4u w = {r0[0], r1[0], r0[1], r1[1]}; OUT = *reinterpret_cast<bf16x8*>(&w); } while (0)
#define F_RESC(a) do { if (hi == 0) al_l[r32] = (a); asm volatile("s_waitcnt lgkmcnt(0)" ::: "memory"); \
        _Pragma("unroll") for (int d_ = 0; d_ < 4; ++d_) _Pragma("unroll") for (int r = 0; r < 16; ++r) o[d_][r] *= al_l[crow(r, hi)]; } while (0)
    constexpr float C2 = 1.4426950408889634f * SCALE;
    bf16x8 kf[2][4], qx[4]; int kb[4];
    { int r32l = r32; asm volatile("" : "+v"(r32l));
#pragma unroll
      for (int dd = 0; dd < 4; ++dd) kb[dd] = ldsa + OFF_K + SLOT * SHM_K + k_off(r32l, dd * 2 + hi); }
    f32x16 p0 = {}, p1;
    F_LDK(0, 0); F_LDK(1, 128);
    F_W4(4, 0); SBAR(); F_MF(p0, kf[0][0], qr[0]); F_MF(p0, kf[0][1], qr[1]); F_MF(p0, kf[0][2], qr[2]); F_MF(p0, kf[0][3], qr[3]); SBAR();
    F_LDK(0, 256); F_LDQ();
    F_W4(8, 1); SBAR(); F_MF(p0, kf[1][0], qr[4]); F_MF(p0, kf[1][1], qr[5]); F_MF(p0, kf[1][2], qr[6]); F_MF(p0, kf[1][3], qr[7]); SBAR();
    F_LDK(1, 12288);
    F_W8(4, 0); SBAR(); F_MF(p0, kf[0][0], qx[0]); F_MF(p0, kf[0][1], qx[1]); F_MF(p0, kf[0][2], qx[2]); F_MF(p0, kf[0][3], qx[3]); SBAR();
    F_LDK(0, 12288 + 128);
    if (diag) {
#pragma unroll
        for (int r = 0; r < 16; ++r) { const int c = (r & 3) + 8 * (r >> 2); if (dq - c < 0) p0[r] = -__builtin_inff(); } }
    float pm0, pm1, pm2, pm3;
    F_W4(4, 1); SBAR();
    p1 = __builtin_amdgcn_mfma_f32_32x32x16_bf16(kf[1][0], qr[0], f32x16{}, 0, 0, 0); SBAR(); pm0 = fmaxf(fmaxf(p0[0], p0[1]), fmaxf(p0[2], p0[3])); SBAR();
    F_MF(p1, kf[1][1], qr[1]); SBAR(); pm1 = fmaxf(fmaxf(p0[4], p0[5]), fmaxf(p0[6], p0[7])); SBAR();
    F_MF(p1, kf[1][2], qr[2]); SBAR(); pm2 = fmaxf(fmaxf(p0[8], p0[9]), fmaxf(p0[10], p0[11])); SBAR();
    F_MF(p1, kf[1][3], qr[3]); SBAR(); pm3 = fmaxf(fmaxf(p0[12], p0[13]), fmaxf(p0[14], p0[15])); SBAR();
    F_LDK(1, 12288 + 256);
    float pmax = fmaxf(fmaxf(pm0, pm1), fmaxf(pm2, pm3));
    { auto rr = __builtin_amdgcn_permlane32_swap(__float_as_uint(pmax), __float_as_uint(pmax), false, false); pmax = fmaxf(__uint_as_float(rr[0]), __uint_as_float(rr[1])); }
    if (!__builtin_expect(__all((pmax - m_reg) * SCALE <= THR), 1)) { const float mn = fmaxf(m_reg, pmax); const float al = __builtin_amdgcn_exp2f((m_reg - mn) * C2); m_reg = mn; l_reg *= al; F_RESC(al); }
    float mnL = -m_reg * C2;
#define F_EX2(P, i_) do { P[2 * (i_)] = __builtin_amdgcn_exp2f(fmaf(P[2 * (i_)], C2, mnL)); P[2 * (i_) + 1] = __builtin_amdgcn_exp2f(fmaf(P[2 * (i_) + 1], C2, mnL)); } while (0)
    F_W4(4, 0); SBAR();
    F_MF(p1, kf[0][0], qr[4]); SBAR(); F_EX2(p0, 0); SBAR();
    F_MF(p1, kf[0][1], qr[5]); SBAR(); F_EX2(p0, 1); SBAR();
    F_MF(p1, kf[0][2], qr[6]); SBAR(); F_EX2(p0, 2); SBAR();
    F_MF(p1, kf[0][3], qr[7]); SBAR(); F_EX2(p0, 3); SBAR();
    F_W4(0, 1); SBAR();
    F_MF(p1, kf[1][0], qx[0]); SBAR(); F_EX2(p0, 4); SBAR();
    F_MF(p1, kf[1][1], qx[1]); SBAR(); F_EX2(p0, 5); SBAR();
    F_MF(p1, kf[1][2], qx[2]); SBAR(); F_EX2(p0, 6); SBAR();
    F_MF(p1, kf[1][3], qx[3]); SBAR(); F_EX2(p0, 7); SBAR();
    s16x4 va[8], vb[8];
    F_VRD(va, 0, 0); F_VRD(vb, 2, 0);
    bf16x8 pa0, pa1, pa2, pa3;
    F_PK4(p0, 0, pa0); F_PK4(p0, 8, pa1);
    if (diag) {
#pragma unroll
        for (int r = 0; r < 16; ++r) { const int c = (r & 3) + 8 * (r >> 2); if (dq - c - 32 < 0) p1[r] = -__builtin_inff(); } }
    pmax = p1[0];
#pragma unroll
    for (int r = 1; r < 16; ++r) pmax = fmaxf(pmax, p1[r]);
    { auto rr = __builtin_amdgcn_permlane32_swap(__float_as_uint(pmax), __float_as_uint(pmax), false, false); pmax = fmaxf(__uint_as_float(rr[0]), __uint_as_float(rr[1])); }
    float al1 = 1.f; bool resc1 = false;
    if (!__builtin_expect(__all((pmax - m_reg) * SCALE <= THR), 1)) { const float mn = fmaxf(m_reg, pmax); al1 = __builtin_amdgcn_exp2f((m_reg - mn) * C2); m_reg = mn; l_reg *= al1; resc1 = true; }
    mnL = -m_reg * C2;
    F_VW(8, va); SBAR();
    F_MF(o[0], pa0, F_CAT(va, 0)); SBAR(); F_EX2(p1, 0); SBAR();
    F_MF(o[0], pa1, F_CAT(va, 2)); SBAR(); F_EX2(p1, 1); SBAR();
    F_MF(o[1], pa0, F_CAT(va, 4)); SBAR(); F_EX2(p1, 2); SBAR();
    F_MF(o[1], pa1, F_CAT(va, 6)); SBAR(); F_EX2(p1, 3); SBAR();
    F_VRD(va, 0, 1);
    F_VW(8, vb); SBAR();
    F_MF(o[2], pa0, F_CAT(vb, 0)); SBAR(); F_EX2(p1, 4); SBAR();
    F_MF(o[2], pa1, F_CAT(vb, 2)); SBAR(); F_EX2(p1, 5); SBAR();
    F_MF(o[3], pa0, F_CAT(vb, 4)); SBAR(); F_EX2(p1, 6); SBAR();
    F_MF(o[3], pa1, F_CAT(vb, 6)); SBAR(); F_EX2(p1, 7); SBAR();
    F_VRD(vb, 2, 1);
    F_PK4(p1, 0, pa2); F_PK4(p1, 8, pa3);
    if (resc1) F_RESC(al1);
    float s0 = 0.f, s1 = 0.f;
    F_VW(8, va); SBAR();
    F_MF(o[0], pa2, F_CAT(va, 0)); SBAR(); s0 += (p0[0] + p0[1]) + (p0[2] + p0[3]); SBAR();
    F_MF(o[0], pa3, F_CAT(va, 2)); SBAR(); s0 += (p0[4] + p0[5]) + (p0[6] + p0[7]); SBAR();
    F_MF(o[1], pa2, F_CAT(va, 4)); SBAR(); s0 += (p0[8] + p0[9]) + (p0[10] + p0[11]); SBAR();
    F_MF(o[1], pa3, F_CAT(va, 6)); SBAR(); s0 += (p0[12] + p0[13]) + (p0[14] + p0[15]); SBAR();
    F_VW(0, vb); SBAR();
    F_MF(o[2], pa2, F_CAT(vb, 0)); SBAR(); s1 += (p1[0] + p1[1]) + (p1[2] + p1[3]); SBAR();
    F_MF(o[2], pa3, F_CAT(vb, 2)); SBAR(); s1 += (p1[4] + p1[5]) + (p1[6] + p1[7]); SBAR();
    F_MF(o[3], pa2, F_CAT(vb, 4)); SBAR(); s1 += (p1[8] + p1[9]) + (p1[10] + p1[11]); SBAR();
    F_MF(o[3], pa3, F_CAT(vb, 6)); SBAR(); s1 += (p1[12] + p1[13]) + (p1[14] + p1[15]); SBAR();
    float ps = s0 * al1 + s1;
    { auto rr = __builtin_amdgcn_permlane32_swap(__float_as_uint(ps), __float_as_uint(ps), false, false); ps = __uint_as_float(rr[0]) + __uint_as_float(rr[1]); }
    l_reg += ps;
#undef F_KRD
#undef F_LDK
#undef F_LDQ
#undef F_W4
#undef F_W8
#undef F_MF
#undef F_TRRD
#undef F_VRD
#undef F_VW
#undef F_CAT
#undef F_PK4
#undef F_RESC
#undef F_EX2
}
__device__ __forceinline__ void attn_block(const bf16* Q, int ldq, const float* qnw, const float* cs, int tok0, const bf16* Kh, const bf16* Vh, bf16* O, int ldo, int P0, int rev, LAS char* lds, int tid_, int wid, int lane_) {
    int tid = tid_, lane = lane_;
    asm volatile("" : "+v"(tid), "+v"(lane));
    const int r32 = lane & 31, hi = lane >> 5;
    const int NTL = (P0 + QB) / KVBLK;
    const int qlo = P0 + wid * QBLK, qm = qlo + r32 - 4 * hi;
    LAS float* ws = (LAS float*)(lds + OFF_WS) + wid * 64; LAS float* li_l = ws; LAS float* al_l = ws + 32;
    unsigned ksrc[3], vsrc[2];
#pragma unroll
    for (int i = 0; i < 3; ++i) { const int p = i * 512 + tid, row = p / 24, pc = p % 24, c = pc ^ ((row >> 1) & 7); ksrc[i] = (unsigned)(row * 384 + c * 16); }
#pragma unroll
    for (int i = 0; i < 2; ++i) { const int p = i * 512 + tid; const int kk = ((p >> 7) << 3) | ((p >> 2) & 7), c = (((p >> 5) & 3) << 5) | ((p & 3) << 3);
        const int k = (kk & ~0xC) | ((kk & 4) << 1) | ((kk & 8) >> 1); vsrc[i] = (unsigned)(k * 256 + c * 2); }
#define ISSUE_TILE(t, slot) do { const char* kg_ = (const char*)Kh + (size_t)(t) * (KVBLK * 384); const char* vg_ = (const char*)Vh + (size_t)(t) * (KVBLK * 256); \
        _Pragma("unroll") for (int i_ = 0; i_ < 3; ++i_) __builtin_amdgcn_global_load_lds((const unsigned*)(kg_ + ksrc[i_]), (LAS unsigned*)(lds + OFF_K + (slot) * SHM_K + i_ * 8192 + wid * 1024), 16, 0, 0); \
        _Pragma("unroll") for (int i_ = 0; i_ < 2; ++i_) __builtin_amdgcn_global_load_lds((const unsigned*)(vg_ + vsrc[i_]), (LAS unsigned*)(lds + OFF_V + (slot) * SHM_V + i_ * 8192 + wid * 1024), 16, 0, 0); } while (0)
#define TIDX(s_) (rev ? NTL - 1 - (s_) : (s_))
    ISSUE_TILE(TIDX(0), 0);
    bf16x8 qr[8];
    LAS char* qs = lds + OFF_Q + wid * 4096 + lane * 16;
    {
        const bf16* qrow = Q + (size_t)(wid * QBLK + r32) * ldq + hi * 8; const float* csr = cs + (size_t)(tok0 + wid * QBLK + r32) * 64 + hi * 8;
        v4u qw[12]; float ss = 0.f;
#pragma unroll
        for (int d0 = 0; d0 < 12; ++d0) qw[d0] = *reinterpret_cast<const v4u*>(qrow + d0 * 16);
#pragma unroll
        for (int d0 = 0; d0 < 12; ++d0) { const v4u w = qw[d0]; const float a0 = bflo(w.x), a1 = bfhi(w.x), a2 = bflo(w.y), a3 = bfhi(w.y), a4 = bflo(w.z), a5 = bfhi(w.z), a6 = bflo(w.w), a7 = bfhi(w.w);
            ss += (a0 * a0 + a1 * a1) + (a2 * a2 + a3 * a3) + (a4 * a4 + a5 * a5) + (a6 * a6 + a7 * a7); }
        ss += shx(ss, 32, lane);
        const float rs = rsqrtf(ss * (1.f / 192.f) + NORM_EPS);
#define QSCALE(X, d0_) do { const v4u w_ = qw[d0_]; const f32x4 g0_ = *(const f32x4*)(qnw + (d0_) * 16 + hi * 8), g1_ = *(const f32x4*)(qnw + (d0_) * 16 + hi * 8 + 4); \
            X[0] = bflo(w_.x) * rs * g0_.x; X[1] = bfhi(w_.x) * rs * g0_.y; X[2] = bflo(w_.y) * rs * g0_.z; X[3] = bfhi(w_.y) * rs * g0_.w; \
            X[4] = bflo(w_.z) * rs * g1_.x; X[5] = bfhi(w_.z) * rs * g1_.y; X[6] = bflo(w_.w) * rs * g1_.z; X[7] = bfhi(w_.w) * rs * g1_.w; } while (0)
#define QPACK(X) ((v4u){cvtpk(X[0], X[1]), cvtpk(X[2], X[3]), cvtpk(X[4], X[5]), cvtpk(X[6], X[7])})
#pragma unroll
        for (int d0 = 0; d0 < 8; ++d0) { float xv[8]; QSCALE(xv, d0); const v4u pk = QPACK(xv); qr[d0] = *reinterpret_cast<const bf16x8*>(&pk); }
#pragma unroll
        for (int d0 = 8; d0 < 10; ++d0) { float x1[8], x2[8], o1[8], o2[8]; QSCALE(x1, d0); QSCALE(x2, d0 + 2);
            const f32x4 c0 = *(const f32x4*)(csr + (d0 - 8) * 16), c1 = *(const f32x4*)(csr + (d0 - 8) * 16 + 4), s0 = *(const f32x4*)(csr + 32 + (d0 - 8) * 16), s1 = *(const f32x4*)(csr + 32 + (d0 - 8) * 16 + 4);
#pragma unroll
            for (int e = 0; e < 8; ++e) { const float c = e < 4 ? c0[e & 3] : c1[e & 3], s = e < 4 ? s0[e & 3] : s1[e & 3]; o1[e] = x1[e] * c - x2[e] * s; o2[e] = x2[e] * c + x1[e] * s; }
            const v4u p1 = QPACK(o1), p2 = QPACK(o2);
            *reinterpret_cast<LAS v4u*>(qs + (d0 - 8) * 1024) = p1; *reinterpret_cast<LAS v4u*>(qs + (d0 - 6) * 1024) = p2; }
#undef QSCALE
#undef QPACK
    }
    float m_reg = -1e30f, l_reg = 0; f32x16 o[4] = {};
    const int vb0 = (int)(uintptr_t)(lds) + v_rd_base(lane);
    VM_WAIT(); __syncthreads();
#define RESC(a) do { if (__any((a) < 1.f)) { if (hi == 0) al_l[r32] = (a); asm volatile("s_waitcnt lgkmcnt(0)" ::: "memory");              \
                     _Pragma("unroll") for (int d_ = 0; d_ < 4; ++d_) _Pragma("unroll") for (int r = 0; r < 16; ++r) o[d_][r] *= al_l[crow(r, hi)]; } } while (0)
#define STEP(t, SLOT) do { \
        if ((t) + 1 < NTL) ISSUE_TILE(TIDX((t) + 1), (SLOT) ^ 1); \
        const int kb_ = TIDX(t) * KVBLK; \
        if (kb_ <= qlo + QBLK - 1)                                            \
            fast_tile<SLOT>(o, vb0, (int)(uintptr_t)lds, r32, hi, qr, (int)(uintptr_t)qs, m_reg, l_reg, al_l, kb_ + KVBLK - 1 > qlo, qm - kb_); \
        VM_WAIT(); __syncthreads(); } while (0)
    for (int t = 0; t < NTL; t += 2) { STEP(t, 0); STEP(t + 1, 1); }
#undef STEP
#undef RESC
#undef ISSUE_TILE
#undef TIDX
    if (hi == 0) li_l[r32] = l_reg; asm volatile("s_waitcnt lgkmcnt(0)" ::: "memory");
    float rli[16];
#pragma unroll
    for (int r = 0; r < 16; ++r) rli[r] = __builtin_amdgcn_rcpf(li_l[crow(r, hi)]);
    int lane2 = lane; asm volatile("" : "+v"(lane2));
    const int r32e = lane2 & 31, hie = lane2 >> 5;
    bf16* Ow = O + (size_t)(wid * QBLK) * ldo;
#pragma unroll
    for (int r = 0; r < 16; ++r) { const int orow = crow(r, hie);
#pragma unroll
        for (int d0 = 0; d0 < 4; ++d0) { const float v = o[d0][r] * rli[r]; const float vn = shx(v, 1, lane);
            if ((r32e & 1) == 0) *(unsigned*)(Ow + (size_t)orow * ldo + d0 * 32 + r32e) = cvtpk(v, vn); } }
    __syncthreads();
}
__device__ __forceinline__ void attn_phase(const bf16* qraw, const float* qnw, const float* cs, const bf16* kf, const bf16* vf, bf16* o, LAS char* lds, int vcu, int G, int tid, int wid, int lane) {
    constexpr int NQB = SEQ / QB, NPAIR = NQB / 2, TOTAL = NB * MLA_H * NPAIR;
    for (int L = vcu; L < TOTAL; L += G) {
        const int bh = L / NPAIR, x = L % NPAIR, b = bh / MLA_H, h = bh % MLA_H;
        const bf16* Kh = kf + (size_t)bh * SEQ * DQK; const bf16* Vh = vf + (size_t)bh * SEQ * DV;
#pragma unroll 1
        for (int pass = 0; pass < 2; ++pass) {
            const int qb = pass ? x : (NQB - 1 - x), P0 = qb * QB, tok0 = b * SEQ + P0;
            attn_block(qraw + (size_t)tok0 * (MLA_H * MLA_QK) + h * MLA_QK, MLA_H * MLA_QK, qnw, cs, tok0, Kh, Vh, o + (size_t)tok0 * (MLA_H * MLA_V) + h * MLA_V, MLA_H * MLA_V, P0, pass, lds, tid, wid, lane);
        }
    }
}
#undef SBAR
}

namespace gdn {
__device__ __forceinline__ int crow(int r, int hi) { return (r & 3) + 8 * (r >> 2) + 4 * hi; }
__device__ __forceinline__ unsigned off_b(unsigned row, unsigned ch) { return 256u * row + 16u * (ch ^ (((row & 3) << 2) | ((row >> 2) & 3))); }
#define MFMA32(a, b, c) __builtin_amdgcn_mfma_f32_32x32x16_bf16((a), (b), (c), 0, 0, 0)
#define MFMA_SETTLE(x) asm volatile("s_nop 7\n\ts_nop 7\n\ts_nop 3" : "+v"(x))
#define BAR_LDS() do { asm volatile("s_waitcnt lgkmcnt(0)" ::: "memory"); __builtin_amdgcn_s_barrier(); asm volatile("" ::: "memory"); } while (0)
#define TR_ISSUE(lo, hi_, a0, a1) asm volatile("ds_read_b64_tr_b16 %0, %2\n\tds_read_b64_tr_b16 %1, %3" : "=&v"(lo), "=&v"(hi_) : "v"(a0), "v"(a1) : "memory")
#define TR_CAT(lo, hi_) ((bf16x8){lo[0], lo[1], lo[2], lo[3], hi_[0], hi_[1], hi_[2], hi_[3]})
__device__ __forceinline__ float softplus_f(float x) { return fmaxf(x, 0.f) + log1pf(__expf(-fabsf(x))); }

__device__ __forceinline__ void phase_halo(const bf16* proj, bf16* halo, int vcu, int G, int tid) {
    for (int u = vcu; u < NB * NCHUNK * 3; u += G) {
        const int j = u % 3, cn = u / 3, n = cn % NCHUNK, b = cn / NCHUNK;
        if (n == 0) continue;
        const v4u* src = (const v4u*)(proj + (size_t)(b * SEQ + 64 * n - 3 + j) * GDN_MAIN); v4u* dst = (v4u*)(halo + (size_t)u * GDN_CONV);
        dst[tid] = src[tid]; dst[512 + tid] = src[512 + tid];
    }
}
constexpr int CV_SLOT = 67 * 256, CONV_LDS = 4 * CV_SLOT;
__device__ __forceinline__ void phase_conv(bf16* proj_, const bf16* halo_, const float* convw, LAS unsigned char* lds, int vcu, int G, int tid, int wid) {
    GAS bf16* proj = (GAS bf16*)proj_; const GAS bf16* halo = (const GAS bf16*)halo_;
    int hg_ = vcu & 63; asm volatile("" : "+s"(hg_));
    const int rg = tid >> 4, cg = tid & 15, hg = hg_, ch0 = hg * 128 + cg * 8, lane = tid & 63;
    constexpr int NU = NB * NCHUNK * 64;
    f32x4 w[4][2];
#pragma unroll
    for (int j = 0; j < 4; ++j) { w[j][0] = *(const f32x4*)(convw + j * GDN_CONV + ch0); w[j][1] = *(const f32x4*)(convw + j * GDN_CONV + ch0 + 4); }
#define CONV_DMA(u_, slot_) do { const int cn_ = (u_) >> 6, n_ = cn_ % NCHUNK, b_ = cn_ / NCHUNK; \
        _Pragma("unroll") for (int i_ = 0; i_ < 3; ++i_) if (i_ < 2 || (wid == 0)) { const int c_ = 512 * i_ + tid; const int ir_ = (c_ < 1072 ? c_ : 1071) >> 4, rr_ = ir_ - 3, cc_ = c_ & 15; \
            const GAS bf16* p_ = (rr_ >= 0 || n_ == 0) ? proj + (size_t)(b_ * SEQ + 64 * n_ + (rr_ >= 0 ? rr_ : 0)) * GDN_MAIN + hg * 128 + cc_ * 8 : halo + (size_t)(cn_ * 3 + ir_) * GDN_CONV + hg * 128 + cc_ * 8; \
            if (i_ < 2 || lane < 48) __builtin_amdgcn_global_load_lds((const GAS unsigned*)p_, (LAS unsigned*)(lds + (slot_) * CV_SLOT + (512 * i_ + wid * 64) * 16), 16, 0, 0); } } while (0)
#define CONV_BODY(u_, slot_) do { const int n_ = ((u_) >> 6) % NCHUNK; \
        v4u X[5]; _Pragma("unroll") for (int j_ = 0; j_ < 5; ++j_) X[j_] = *(const LAS v4u*)(lds + (slot_) * CV_SLOT + (2 * rg + j_) * 256 + cg * 16); \
        if (n_ == 0) { unsigned z_ = 0u; asm volatile("" : "+v"(z_)); _Pragma("unroll") for (int j_ = 0; j_ < 3; ++j_) if (2 * rg + j_ < 3) X[j_] = (v4u){z_, z_, z_, z_}; } \
        float y_[2][8]; float ss_[2]; \
        _Pragma("unroll") for (int o_ = 0; o_ < 2; ++o_) { float a_[8]; _Pragma("unroll") for (int e_ = 0; e_ < 8; ++e_) a_[e_] = 0.f; \
            _Pragma("unroll") for (int j_ = 0; j_ < 4; ++j_) { const v4u xv = X[o_ + j_]; const f32x4 w0 = w[j_][0], w1 = w[j_][1]; \
                a_[0] += w0.x * bflo(xv.x); a_[1] += w0.y * bfhi(xv.x); a_[2] += w0.z * bflo(xv.y); a_[3] += w0.w * bfhi(xv.y); \
                a_[4] += w1.x * bflo(xv.z); a_[5] += w1.y * bfhi(xv.z); a_[6] += w1.z * bflo(xv.w); a_[7] += w1.w * bfhi(xv.w); } \
            float s2_ = 0.f; _Pragma("unroll") for (int e_ = 0; e_ < 8; ++e_) { const float s_ = fsilu(a_[e_]); y_[o_][e_] = s_; s2_ += s_ * s_; } ss_[o_] = s2_; } \
        float sc_[2] = {1.f, 1.f}; \
        if (hg < 32) { _Pragma("unroll") for (int o_ = 0; o_ < 2; ++o_) { float s_ = ss_[o_]; s_ += shx(s_, 1, lane); s_ += shx(s_, 2, lane); s_ += shx(s_, 4, lane); s_ += shx(s_, 8, lane); \
                sc_[o_] = rsqrtf(s_ + NORM_EPS) * (hg < 16 ? 0.08838834764831845f : 1.f); } } \
        const int cn_ = (u_) >> 6, b_ = cn_ / NCHUNK; \
        _Pragma("unroll") for (int o_ = 0; o_ < 2; ++o_) { v4u ov; const float c_ = sc_[o_]; \
            ov.x = pk2(y_[o_][0] * c_, y_[o_][1] * c_); ov.y = pk2(y_[o_][2] * c_, y_[o_][3] * c_); ov.z = pk2(y_[o_][4] * c_, y_[o_][5] * c_); ov.w = pk2(y_[o_][6] * c_, y_[o_][7] * c_); \
            *(GAS v4u*)(proj + (size_t)(b_ * SEQ + 64 * n_ + 2 * rg + o_) * GDN_MAIN + ch0) = ov; } } while (0)
    const int u0 = vcu;
    for (int k = 0; k < 3; ++k) if (u0 + k * G < NU) CONV_DMA(u0 + k * G, k);
    for (int k = 0, u = u0; u < NU; ++k, u += G) {
        const int rem = (NU - 1 - u) / G;
        if (rem >= 2) { if (wid == 0) asm volatile("s_waitcnt vmcnt(6)" ::: "memory"); else asm volatile("s_waitcnt vmcnt(4)" ::: "memory"); }
        else if (rem == 1) { if (wid == 0) asm volatile("s_waitcnt vmcnt(3)" ::: "memory"); else asm volatile("s_waitcnt vmcnt(2)" ::: "memory"); }
        else VM_WAIT();
        BAR_LDS();
        if (rem >= 3) CONV_DMA(u + 3 * G, (k + 3) & 3);
        CONV_BODY(u, k & 3);
    }
#undef CONV_DMA
#undef CONV_BODY
}
constexpr int P_KT = 0, P_QT = 16384, P_L = 32768, P_LSZ = 12288, P_G = P_L + 8 * P_LSZ, P_B = P_G + 2048, PREP_LDS = P_B + 2048;
__device__ __forceinline__ void phase_prep(const bf16* proj_, const float* ba_, const float* a_log, const float* dt_bias, bf16* TB_, bf16* INTRA_, float* gc_,
                                           LAS unsigned char* lds, int vcu, int G, int tid, int wid, int lane) {
    const GAS bf16* proj = (const GAS bf16*)proj_; const GAS float* ba = (const GAS float*)ba_; GAS bf16* TB = (GAS bf16*)TB_; GAS bf16* INTRA = (GAS bf16*)INTRA_; GAS float* gc = (GAS float*)gc_;
    const int r32 = lane & 31, hi = lane >> 5;
    constexpr int NGRP = NB * NCHUNK * GDN_HQK / 4;
    v4u pk[2], pq[2]; float pa = 0.f, pb = 0.f;
#define PREP_LOAD(grp_, s_) do { const int hq_ = ((grp_) & 3) * 4 + (s_), cn_ = (grp_) >> 2; const size_t tk_ = (size_t)(cn_ / NCHUNK) * SEQ + 64 * (cn_ % NCHUNK); \
        _Pragma("unroll") for (int i_ = 0; i_ < 2; ++i_) { const int idx_ = tid + 512 * i_, row_ = idx_ >> 4, ch_ = idx_ & 15; \
            pk[i_] = *(const GAS v4u*)(proj + (tk_ + row_) * GDN_MAIN + GDN_KEY + hq_ * 128 + ch_ * 8); pq[i_] = *(const GAS v4u*)(proj + (tk_ + row_) * GDN_MAIN + hq_ * 128 + ch_ * 8); } \
        if (wid >= 6) { const int h_ = 2 * hq_ + wid - 6; pa = ba[(tk_ + lane) * 64 + 32 + h_]; pb = ba[(tk_ + lane) * 64 + h_]; } } while (0)
    if (vcu < NGRP) PREP_LOAD(vcu, 0);
    for (int grp = vcu; grp < NGRP; grp += G) {
        const int hq0 = (grp & 3) * 4, cn = grp >> 2, n = cn % NCHUNK, b = cn / NCHUNK;
#pragma unroll 1
        for (int s = 0; s < 4; ++s) {
            const int hq = hq0 + s;
#pragma unroll
            for (int i = 0; i < 2; ++i) { const int idx = tid + 512 * i, row = idx >> 4, ch = idx & 15;
                *(LAS v4u*)(lds + P_KT + off_b(row, ch)) = pk[i]; *(LAS v4u*)(lds + P_QT + off_b(row, ch)) = pq[i]; }
            if (wid >= 6) {
                const int vh = wid - 6, h = 2 * hq + vh;
                float gg = -__expf(a_log[h]) * softplus_f(pa + dt_bias[h]);
                int ln = lane; asm volatile("" : "+v"(ln));
#pragma unroll
                for (int o = 1; o < 64; o <<= 1) { const float t = __builtin_bit_cast(float, __builtin_amdgcn_ds_bpermute((ln >= o ? ln - o : ln) << 2, __builtin_bit_cast(int, gg))); if (ln >= o) gg += t; }
                ((LAS float*)(lds + P_G))[(2 * s + vh) * 64 + lane] = gg; ((LAS float*)(lds + P_B))[(2 * s + vh) * 64 + lane] = fsigmoid(pb);
                gc[((size_t)(b * GDN_HV + h)) * SEQ + 64 * n + lane] = gg;
            }
            if (s < 3) PREP_LOAD(grp, s + 1); else if (grp + G < NGRP) PREP_LOAD(grp + G, 0);
            __syncthreads();
            if (wid < 6) {
                const int tw = wid % 3, it = tw > 0 ? 1 : 0, jt = tw > 1 ? 1 : 0; const bool isk = wid < 3;
                const LAS unsigned char* As = lds + (isk ? P_KT : P_QT); const LAS unsigned char* Bs = lds + P_KT;
                f32x16 acc = {};
#pragma unroll
                for (int ks = 0; ks < 8; ++ks) { const bf16x8 a = *(const LAS bf16x8*)(As + off_b(32 * it + r32, 2 * ks + hi)), bb = *(const LAS bf16x8*)(Bs + off_b(32 * jt + r32, 2 * ks + hi));
                    acc = MFMA32(a, bb, acc); }
                const int j = 32 * jt + r32;
#pragma unroll
                for (int vh = 0; vh < 2; ++vh) {
                    const LAS float* Gv = (const LAS float*)(lds + P_G) + (2 * s + vh) * 64; const LAS float* Bv = (const LAS float*)(lds + P_B) + (2 * s + vh) * 64;
                    const float gj = Gv[j];
                    f32x4 gi[4], bi[4];
#pragma unroll
                    for (int g_ = 0; g_ < 4; ++g_) { gi[g_] = *(const LAS f32x4*)(Gv + 32 * it + 8 * g_ + 4 * hi); bi[g_] = *(const LAS f32x4*)(Bv + 32 * it + 8 * g_ + 4 * hi); }
                    __builtin_amdgcn_sched_barrier(0);
                    if (isk) { LAS float* L = (LAS float*)(lds + P_L + (2 * s + vh) * P_LSZ) + (it ? 1024 : 0);
#pragma unroll
                        for (int r = 0; r < 16; ++r) { const int il = crow(r, hi), i = 32 * it + il; const float v = bi[r >> 2][r & 3] * acc[r] * __expf(gi[r >> 2][r & 3] - gj); L[il * (it ? 64 : 32) + j] = (j < i) ? v : 0.f; }
                    } else { GAS bf16* dst = INTRA + ((size_t)(b * GDN_HV + 2 * hq + vh) * NCHUNK + n) * 4096;
#pragma unroll
                        for (int r = 0; r < 16; ++r) { const int i = 32 * it + crow(r, hi); const float v = acc[r] * __expf(gi[r >> 2][r & 3] - gj); dst[i * 64 + j] = (bf16)f2bf((j <= i) ? v : 0.f); }
                    }
                }
            }
            __syncthreads();
        }
        {
            const int hq = hq0 + (wid >> 1), h = 2 * hq + (wid & 1);
            const LAS float* L = (const LAS float*)(lds + P_L + wid * P_LSZ); const float bj = ((const LAS float*)(lds + P_B))[wid * 64 + lane];
            float Tc[64];
            int ln = lane; asm volatile("" : "+v"(ln));
#pragma unroll
            for (int i = 0; i < 64; ++i) Tc[i] = 0.f;
            f32x4 rb[16];
#define INV_LROW(i_) (L + ((i_) < 32 ? (i_) * 32 : 1024 + ((i_) - 32) * 64))
            Tc[0] = (ln == 0) ? 1.f : 0.f;
            rb[0] = *(const LAS f32x4*)(INV_LROW(1));
#pragma unroll
            for (int i = 1; i < 64; ++i) {
                float acc = (ln == i) ? 1.f : 0.f;
#pragma unroll
                for (int c = 0; c < (i + 3) / 4; ++c) { const f32x4 l4 = rb[c];
                    acc -= l4.x * Tc[4 * c]; acc -= l4.y * Tc[4 * c + 1]; acc -= l4.z * Tc[4 * c + 2]; acc -= l4.w * Tc[4 * c + 3];
                    __builtin_amdgcn_sched_barrier(0);
                    if (i + 1 < 64) rb[c] = *(const LAS f32x4*)(INV_LROW(i + 1) + 4 * c);
                    __builtin_amdgcn_sched_barrier(0); }
                if (i + 1 < 64 && (i + 4) / 4 > (i + 3) / 4) rb[(i + 3) / 4] = *(const LAS f32x4*)(INV_LROW(i + 1) + 4 * ((i + 3) / 4));
                Tc[i] = acc;
            }
#undef INV_LROW
            GAS bf16* dst = TB + ((size_t)(b * GDN_HV + h) * NCHUNK + n) * 4096;
#pragma unroll
            for (int i = 0; i < 64; ++i) dst[i * 64 + lane] = (bf16)f2bf(Tc[i] * bj);
        }
        __syncthreads();
    }
#undef PREP_LOAD
}
constexpr int SB_SZ = 55552, S_KT = 0, S_QT = 16384, S_TT = 32768, S_IT = 41984, S_VT = 51200, S_GG = 55296;
constexpr int S_ST = 2 * SB_SZ, ST_P = 272, S_XT = S_ST + 32 * ST_P, XT_P = 144, S_VNT = S_XT + 32 * XT_P, S_VST = S_VNT + 32 * XT_P, S_OT = S_VST + 32 * XT_P, SCAN_LDS = S_OT + 4096;
#define TRW4(a, b, c, d, e, f, g_, h_) asm volatile("s_waitcnt lgkmcnt(0)" : "+v"(a), "+v"(b), "+v"(c), "+v"(d), "+v"(e), "+v"(f), "+v"(g_), "+v"(h_) :: "memory")
struct ScanRegs { v4u k[2], q[2], t, i, v; float g; };
__device__ __forceinline__ void phase_scan(bf16* proj_, const bf16* TB_, const bf16* INTRA_, const float* gc_, LAS unsigned char* lds, int vcu, int G, int tid, int wid, int lane) {
    GAS bf16* proj = (GAS bf16*)proj_; const GAS bf16* TB = (const GAS bf16*)TB_; const GAS bf16* INTRA = (const GAS bf16*)INTRA_; const GAS float* gc = (const GAS float*)gc_;
    const int r32 = lane & 31, hi = lane >> 5, blk = (lane >> 4) & 1, q4 = (lane & 15) >> 2, p4 = lane & 3;
    const unsigned ldsb = (unsigned)(uintptr_t)lds;
    for (int u = vcu; u < NB * GDN_HV * 4; u += G) {
        const int sl = u & 3, bh = u >> 2, h = bh % GDN_HV, b = bh / GDN_HV, hq = h >> 1, e0 = sl * 32;
        ScanRegs RA, RB;
#define SCAN_LOAD(R, n_) do { const int nn_ = (n_) < NCHUNK ? (n_) : NCHUNK - 1; const size_t tok0_ = (size_t)b * SEQ + 64 * nn_; \
            _Pragma("unroll") for (int i_ = 0; i_ < 2; ++i_) { const int idx_ = tid + 512 * i_, row_ = idx_ >> 4, ch_ = idx_ & 15; \
                R.k[i_] = *(const GAS v4u*)(proj + (tok0_ + row_) * GDN_MAIN + GDN_KEY + hq * 128 + ch_ * 8); R.q[i_] = *(const GAS v4u*)(proj + (tok0_ + row_) * GDN_MAIN + hq * 128 + ch_ * 8); } \
            { const size_t mb_ = ((size_t)bh * NCHUNK + nn_) * 4096 + (tid >> 3) * 64 + (tid & 7) * 8; R.t = *(const GAS v4u*)(TB + mb_); R.i = *(const GAS v4u*)(INTRA + mb_); } \
            R.v = *(const GAS v4u*)(proj + (tok0_ + ((tid & 255) >> 2)) * GDN_MAIN + GDN_CONV / 2 + h * 128 + e0 + (tid & 3) * 8); \
            R.g = gc[(size_t)bh * SEQ + 64 * nn_ + (tid & 63)]; } while (0)
#define SCAN_WRITE(R, buf_) do { LAS unsigned char* B_ = lds + (buf_) * SB_SZ; \
            _Pragma("unroll") for (int i_ = 0; i_ < 2; ++i_) { const int idx_ = tid + 512 * i_, row_ = idx_ >> 4, ch_ = idx_ & 15; \
                *(LAS v4u*)(B_ + S_KT + off_b(row_, ch_)) = R.k[i_]; *(LAS v4u*)(B_ + S_QT + off_b(row_, ch_)) = R.q[i_]; } \
            *(LAS v4u*)(B_ + S_TT + (tid >> 3) * 144 + (tid & 7) * 16) = R.t; *(LAS v4u*)(B_ + S_IT + (tid >> 3) * 144 + (tid & 7) * 16) = R.i; \
            if (tid < 256) *(LAS v4u*)(B_ + S_VT + (tid >> 2) * 64 + (tid & 3) * 16) = R.v; \
            if (tid < 64) ((LAS float*)(B_ + S_GG))[tid] = R.g; } while (0)
        SCAN_LOAD(RA, 0);
        { unsigned z = 0u; asm volatile("" : "+v"(z)); for (int i = tid; i < (32 * ST_P) / 16; i += 512) *(LAS v4u*)(lds + S_ST + i * 16) = (v4u){z, z, z, z}; }
        VM_WAIT(); SCAN_WRITE(RA, 0);
        SCAN_LOAD(RB, 1);
        f32x16 Sacc = {};
        __syncthreads();
        const unsigned fx16 = (unsigned)(((((r32 & 3) << 2) | ((r32 >> 2) & 3)) ^ hi) << 4);
        LAS unsigned char* stR = lds + S_ST + r32 * ST_P + 16 * hi;  LAS unsigned char* stW = lds + S_ST + r32 * ST_P + 8 * hi;
        LAS unsigned char* xR = lds + S_XT + r32 * XT_P + 16 * hi;   LAS unsigned char* xW = lds + S_XT + r32 * XT_P + 8 * hi;
#define PK4W(dst, a0_, a1_, a2_, a3_) do { v2u w_; w_.x = pk2(a0_, a1_); w_.y = pk2(a2_, a3_); *(LAS v2u*)(dst) = w_; } while (0)
#define SCAN_STEP(n, RI, RO) do { \
            const int buf = (n) & 1; LAS unsigned char* B = lds + buf * SB_SZ; const LAS float* GG = (const LAS float*)(B + S_GG); \
            if (wid >= 4 && (n) > 0) {                                    \
                const int t_ = tid - 256; const v4u ov = *(const LAS v4u*)(lds + S_OT + t_ * 16); \
                *(GAS v4u*)(proj + ((size_t)b * SEQ + 64 * ((n) - 1) + (t_ >> 2)) * GDN_MAIN + GDN_CONV / 2 + h * 128 + e0 + (t_ & 3) * 8) = ov; } \
            SCAN_LOAD(RI, (n) + 2); \
            f32x16 acc = {}; \
            if (wid < 4) {                                               \
                const LAS unsigned char* Ar = B + (wid < 2 ? S_KT : S_QT) + 256 * (32 * (wid & 1) + r32); \
                bf16x8 af_[8], bf_[8]; \
                _Pragma("unroll") for (int ks = 0; ks < 8; ++ks) { af_[ks] = *(const LAS bf16x8*)(Ar + ((32u * ks) ^ fx16)); bf_[ks] = *(const LAS bf16x8*)(stR + 32 * ks); } \
                __builtin_amdgcn_sched_barrier(0);                       \
                _Pragma("unroll") for (int ks = 0; ks < 8; ++ks) acc = MFMA32(af_[ks], bf_[ks], acc); \
                if (wid < 2) {                                           \
                    f32x4 gg_[4]; unsigned short vv_[16]; \
                    _Pragma("unroll") for (int g_ = 0; g_ < 4; ++g_) { const int c0 = 32 * wid + 8 * g_ + 4 * hi; gg_[g_] = *(const LAS f32x4*)(GG + c0); \
                        _Pragma("unroll") for (int j_ = 0; j_ < 4; ++j_) vv_[4 * g_ + j_] = *(const LAS unsigned short*)(B + S_VT + (c0 + j_) * 64 + r32 * 2); } \
                    __builtin_amdgcn_sched_barrier(0); \
                    _Pragma("unroll") for (int g_ = 0; g_ < 4; ++g_) { float xv[4]; \
                        _Pragma("unroll") for (int j_ = 0; j_ < 4; ++j_) xv[j_] = bf2f(vv_[4 * g_ + j_]) - __expf(gg_[g_][j_]) * acc[4 * g_ + j_]; \
                        PK4W(xW + 64 * wid + 16 * g_, xv[0], xv[1], xv[2], xv[3]); } \
                } \
            } \
            BAR_LDS();                                                      \
            const float gl = GG[63]; \
            if (wid < 2) {                                               \
                f32x16 a3_ = {}; const LAS unsigned char* Ar_ = B + S_TT + (32 * wid + r32) * 144 + 16 * hi; \
                bf16x8 af_[4], bf_[4]; f32x4 gg_[4]; \
                _Pragma("unroll") for (int ks = 0; ks < 4; ++ks) { af_[ks] = *(const LAS bf16x8*)(Ar_ + 32 * ks); bf_[ks] = *(const LAS bf16x8*)(xR + 32 * ks); } \
                _Pragma("unroll") for (int g_ = 0; g_ < 4; ++g_) gg_[g_] = *(const LAS f32x4*)(GG + 32 * wid + 8 * g_ + 4 * hi); \
                __builtin_amdgcn_sched_barrier(0); \
                _Pragma("unroll") for (int ks = 0; ks < 4; ++ks) if (ks < 2 || wid > 0) a3_ = MFMA32(af_[ks], bf_[ks], a3_); \
                MFMA_SETTLE(a3_); \
                _Pragma("unroll") for (int g_ = 0; g_ < 4; ++g_) { const f32x4 gg = gg_[g_]; \
                    PK4W(xW + (S_VNT - S_XT) + 64 * wid + 16 * g_, a3_[4 * g_], a3_[4 * g_ + 1], a3_[4 * g_ + 2], a3_[4 * g_ + 3]); \
                    PK4W(xW + (S_VST - S_XT) + 64 * wid + 16 * g_, a3_[4 * g_] * __expf(gl - gg[0]), a3_[4 * g_ + 1] * __expf(gl - gg[1]), a3_[4 * g_ + 2] * __expf(gl - gg[2]), a3_[4 * g_ + 3] * __expf(gl - gg[3])); } \
            } \
            BAR_LDS();                                                      \
            if (wid == 2 || wid == 3) {                                  \
                const int ct = wid - 2; \
                const LAS unsigned char* Ar_ = B + S_IT + (32 * ct + r32) * 144 + 16 * hi; \
                bf16x8 af_[4], bf_[4]; f32x4 gg_[4]; \
                _Pragma("unroll") for (int g_ = 0; g_ < 4; ++g_) gg_[g_] = *(const LAS f32x4*)(GG + 32 * ct + 8 * g_ + 4 * hi); \
                _Pragma("unroll") for (int ks = 0; ks < 4; ++ks) { af_[ks] = *(const LAS bf16x8*)(Ar_ + 32 * ks); bf_[ks] = *(const LAS bf16x8*)(xR + (S_VNT - S_XT) + 32 * ks); } \
                __builtin_amdgcn_sched_barrier(0); \
                _Pragma("unroll") for (int g_ = 0; g_ < 4; ++g_) _Pragma("unroll") for (int j_ = 0; j_ < 4; ++j_) acc[4 * g_ + j_] *= __expf(gg_[g_][j_]); \
                _Pragma("unroll") for (int ks = 0; ks < 4; ++ks) if (ks < 2 || ct > 0) acc = MFMA32(af_[ks], bf_[ks], acc); \
                MFMA_SETTLE(acc); \
                _Pragma("unroll") for (int r = 0; r < 16; ++r) *(LAS unsigned short*)(lds + S_OT + (32 * ct + crow(r, hi)) * 64 + r32 * 2) = (unsigned short)f2bf(acc[r]); \
            } else if (wid >= 4) {                                       \
                const int dt = wid - 4; const float egl = __expf(gl); \
                _Pragma("unroll") for (int r = 0; r < 16; ++r) Sacc[r] *= egl; \
                  \
                const unsigned chk = (unsigned)(4 * dt + 2 * blk + (p4 >> 1)); \
                const unsigned kb0 = ldsb + buf * SB_SZ + S_KT + 256u * (8 * hi + q4) + 16u * (chk ^ (unsigned)((q4 << 2) | ((2 * hi) & 3))) + 8u * (p4 & 1); \
                const unsigned kb1 = ldsb + buf * SB_SZ + S_KT + 256u * (8 * hi + 4 + q4) + 16u * (chk ^ (unsigned)((q4 << 2) | ((2 * hi + 1) & 3))) + 8u * (p4 & 1); \
                s16x4 al0, ah0, al1, ah1, al2, ah2, al3, ah3; \
                asm volatile("ds_read_b64_tr_b16 %0, %2\n\tds_read_b64_tr_b16 %1, %3" : "=&v"(al0), "=&v"(ah0) : "v"(kb0), "v"(kb1) : "memory"); \
                asm volatile("ds_read_b64_tr_b16 %0, %2 offset:4096\n\tds_read_b64_tr_b16 %1, %3 offset:4096" : "=&v"(al1), "=&v"(ah1) : "v"(kb0), "v"(kb1) : "memory"); \
                asm volatile("ds_read_b64_tr_b16 %0, %2 offset:8192\n\tds_read_b64_tr_b16 %1, %3 offset:8192" : "=&v"(al2), "=&v"(ah2) : "v"(kb0), "v"(kb1) : "memory"); \
                asm volatile("ds_read_b64_tr_b16 %0, %2 offset:12288\n\tds_read_b64_tr_b16 %1, %3 offset:12288" : "=&v"(al3), "=&v"(ah3) : "v"(kb0), "v"(kb1) : "memory"); \
                const bf16x8 b0_ = *(const LAS bf16x8*)(xR + (S_VST - S_XT)), b1_ = *(const LAS bf16x8*)(xR + (S_VST - S_XT) + 32), b2_ = *(const LAS bf16x8*)(xR + (S_VST - S_XT) + 64), b3_ = *(const LAS bf16x8*)(xR + (S_VST - S_XT) + 96); \
                TRW4(al0, ah0, al1, ah1, al2, ah2, al3, ah3); \
                Sacc = MFMA32(TR_CAT(al0, ah0), b0_, Sacc); Sacc = MFMA32(TR_CAT(al1, ah1), b1_, Sacc); Sacc = MFMA32(TR_CAT(al2, ah2), b2_, Sacc); Sacc = MFMA32(TR_CAT(al3, ah3), b3_, Sacc); \
                MFMA_SETTLE(Sacc); \
                _Pragma("unroll") for (int g_ = 0; g_ < 4; ++g_) PK4W(stW + 64 * dt + 16 * g_, Sacc[4 * g_], Sacc[4 * g_ + 1], Sacc[4 * g_ + 2], Sacc[4 * g_ + 3]); \
            } \
            asm volatile("s_waitcnt vmcnt(8)" ::: "memory");              \
            if ((n) + 1 < NCHUNK) SCAN_WRITE(RO, buf ^ 1); \
            BAR_LDS();                                                      \
        } while (0)
        for (int n = 0; n < NCHUNK; n += 2) { SCAN_STEP(n, RA, RB); SCAN_STEP(n + 1, RB, RA); }
        if (wid >= 4) { const int t_ = tid - 256; const v4u ov = *(const LAS v4u*)(lds + S_OT + t_ * 16);
            *(GAS v4u*)(proj + ((size_t)b * SEQ + 64 * (NCHUNK - 1) + (t_ >> 2)) * GDN_MAIN + GDN_CONV / 2 + h * 128 + e0 + (t_ & 3) * 8) = ov; }
        VM_WAIT(); __syncthreads();
#undef SCAN_LOAD
#undef SCAN_WRITE
#undef SCAN_STEP
#undef PK4W
    }
}
#undef TRW4
__device__ __forceinline__ void phase_gate(bf16* proj, const float* out_norm, int gw, int NGW, int lane) {
    const int g = lane >> 4, i = lane & 15; float w[8];
#pragma unroll
    for (int e = 0; e < 8; ++e) w[e] = out_norm[8 * i + e];
    for (int m = gw; m < NT; m += NGW) {
        const bf16* orow = proj + (size_t)m * GDN_MAIN + GDN_CONV / 2; bf16* zrow = proj + (size_t)m * GDN_MAIN + GDN_CONV;
#pragma unroll 4
        for (int it = 0; it < GDN_HV / 4; ++it) {
            const int off = (4 * it + g) * 128 + 8 * i;
            const v4u ov = *(const v4u*)(orow + off), zv = *(const v4u*)(zrow + off);
            float o[8], z[8];
            o[0] = bflo(ov.x); o[1] = bfhi(ov.x); o[2] = bflo(ov.y); o[3] = bfhi(ov.y); o[4] = bflo(ov.z); o[5] = bfhi(ov.z); o[6] = bflo(ov.w); o[7] = bfhi(ov.w);
            z[0] = bflo(zv.x); z[1] = bfhi(zv.x); z[2] = bflo(zv.y); z[3] = bfhi(zv.y); z[4] = bflo(zv.z); z[5] = bfhi(zv.z); z[6] = bflo(zv.w); z[7] = bfhi(zv.w);
            float ss = 0.f;
#pragma unroll
            for (int e = 0; e < 8; ++e) ss += o[e] * o[e];
            ss += shx(ss, 1, lane); ss += shx(ss, 2, lane); ss += shx(ss, 4, lane); ss += shx(ss, 8, lane);
            const float rs = rsqrtf(ss * (1.f / 128.f) + NORM_EPS);
            float r[8];
#pragma unroll
            for (int e = 0; e < 8; ++e) r[e] = o[e] * rs * w[e] * fsilu(z[e]);
            v4u res; res.x = pk2(r[0], r[1]); res.y = pk2(r[2], r[3]); res.z = pk2(r[4], r[5]); res.w = pk2(r[6], r[7]);
            *(v4u*)(zrow + off) = res;
        }
    }
}
#undef MFMA32
#undef BAR_LDS
#undef MFMA_SETTLE
#undef TR_ISSUE
#undef TR_CAT
}

struct Args { const void* in[25]; float* out; unsigned char* ws; };
__device__ __forceinline__ int lane_id_now() { int l; asm volatile("v_mbcnt_lo_u32_b32 %0, -1, 0\n\tv_mbcnt_hi_u32_b32 %0, -1, %0" : "=v"(l)); return l; }
__global__ void __launch_bounds__(NWAVES * 64, 2) mk_fwd(Args a) {
    extern __shared__ __attribute__((aligned(16))) unsigned char lds_raw[];
    LAS unsigned char* lds = (LAS unsigned char*)lds_raw;
    const int tid0 = threadIdx.x; const int wave0 = __builtin_amdgcn_readfirstlane(tid0 >> 6);
    const int G0 = gridDim.x, bx0 = blockIdx.x, vcu0 = (G0 % 8 == 0) ? (bx0 % 8) * (G0 / 8) + bx0 / 8 : bx0;
    volatile LAS unsigned* MISC = (volatile LAS unsigned*)(lds + MISC_OFF);
    if (tid0 < 64) MISC[tid0] = 0u;
    __syncthreads();
    typedef const __attribute__((address_space(4))) unsigned long long* kargp_t;
    const kargp_t kargs0 = (kargp_t)__builtin_amdgcn_kernarg_segment_ptr();
    XcdBarrier bar = xcd_barrier_post((unsigned*)(a.ws + WS_CTL) + CW_BAR, MISC + 8);
#define BTID() (wave0 * 64 + lane_id_now())
#if PROBE_MASK
    if (tid0 == 0) { const unsigned long long t_ = __builtin_amdgcn_s_memrealtime(); MISC[16] = (unsigned)t_; MISC[17] = (unsigned)(t_ >> 32); MISC[18] = 0u; MISC[19] = 0u; }
#define GRID_BAR(cls) do { { XcdBarrier b_ = bar; asm volatile("" : "+s"(b_.bar), "+s"(b_.x)); xcd_barrier(b_, BTID()); } \
        if (BTID() == 0) { const unsigned long long now_ = __builtin_amdgcn_s_memrealtime(); const unsigned long long last_ = ((unsigned long long)MISC[17] << 32) | MISC[16]; \
            if ((cls) & PROBE_MASK) { const unsigned long long a_ = (((unsigned long long)MISC[19] << 32) | MISC[18]) + (now_ - last_); MISC[18] = (unsigned)a_; MISC[19] = (unsigned)(a_ >> 32); } \
            MISC[16] = (unsigned)now_; MISC[17] = (unsigned)(now_ >> 32); } } while (0)
#else
#define GRID_BAR(cls) do { XcdBarrier b_ = bar; asm volatile("" : "+s"(b_.bar), "+s"(b_.x)); xcd_barrier(b_, BTID()); } while (0)
#endif
#define PH() int wave = wave0; asm volatile("" : "+s"(wave)); int tid = wave * 64 + lane_id_now(); const int lane = tid & 63; \
             int G = G0, bx = bx0, vcu = vcu0; asm volatile("" : "+s"(G), "+s"(bx), "+s"(vcu)); const int NGW = G * NWAVES, NGT = G * NWAVES * 64; (void)bx; (void)NGW; (void)NGT; \
             const int gw = vcu * NWAVES + wave, gtid = vcu * (NWAVES * 64) + tid; (void)lane; (void)wave; (void)gw; (void)gtid; \
             kargp_t kp = kargs0; asm volatile("" : "+s"(kp)); unsigned char* ws = (unsigned char*)(GAS unsigned char*)kp[26]; float* out = (float*)(GAS float*)kp[25]; \
             unsigned char* wmix = ws + WS_WMIX; bf16* A0 = (bf16*)(ws + WS_A0); unsigned char* A1 = ws + WS_A1; const float* hin = layer == 0 ? (const float*)(const GAS float*)kp[0] : out; \
             LAS float* scr = (LAS float*)(lds + wave * 16384); \
             (void)out; (void)wmix; (void)A0; (void)A1; (void)hin; (void)scr
#define IN(i) ((const float*)(const GAS float*)kp[i])
#define GEMMX(F16_, EPI, Aptr, Bptr, N_, K_, lda_, ldb_, ...) do { pg8::Gemm g{(const bf16*)(Aptr), (const bf16*)(Bptr), NT, (N_), (K_), (lda_), (ldb_)}; pg8::StaticOrder S; S.init(NT, (N_), G, bx); \
             pg8::EPI E{__VA_ARGS__}; pg8::gemm_phase<pg8::EPI, pg8::StaticOrder, true, true, F16_>(lds, g, S, E, tid); } while (0)
#define GEMM(...) GEMMX(false, __VA_ARGS__)
#define GEMMH(...) GEMMX(true, __VA_ARGS__)
#define COMMA ,
#define SSY ((float*)(ws + WS_SS))
#define SSX1 ((float*)(ws + WS_SS) + 32 * NT)
#define SSX2 ((float*)(ws + WS_SS) + 64 * NT)
#define HBX ((bf16*)(A1 + A1_HBX))
#define HY ((bf16*)out)
    { const int layer = 0; PH(); phase_rope_table((const int*)(const GAS int*)kp[2], (float*)(ws + WS_ROPE), gtid, NGT); }
    { const int layer = 0; PH(); phase_cast_ss(hin, HY, SSY, gw, NGW, lane); }
    for (int layer = 0; layer < DEPTH; ++layer) {
        const int j = layer >> 1; const bool is_mla = (layer & 1) == 0;
        if (is_mla) {
            { PH(); convert_matrix<0, true>(IN(4) + (size_t)j * DM * MLA_IN, IN(3) + layer * DM, DM, MLA_IN, (bf16*)(wmix + WM_MLA_IN), 0, scr, gw, NGW, lane); }
            { PH(); zero_rows((bf16*)(wmix + WM_MLA_IN), DM, MLA_IN, MLA_IN_PAD - MLA_IN, gtid, NGT); }
            { PH(); convert_matrix<0>(IN(7) + (size_t)j * MLA_QL * (MLA_H * MLA_QK), IN(5) + j * MLA_QL, MLA_QL, MLA_H * MLA_QK, (bf16*)(wmix + WM_MLA_UQ), 0, scr, gw, NGW, lane); }
            { PH(); convert_matrix<0>(IN(8) + (size_t)j * MLA_KVL * (MLA_H * 256), IN(6) + j * MLA_KVL, MLA_KVL, MLA_H * 256, (bf16*)(wmix + WM_MLA_UKV), 0, scr, gw, NGW, lane); }
            { PH(); convert_matrix<0>(IN(11) + (size_t)j * DM * DM, nullptr, DM, DM, (bf16*)(wmix + WM_MLA_O), 0, scr, gw, NGW, lane); }
        } else {
            { PH(); convert_matrix<0, true>(IN(12) + (size_t)j * DM * GDN_IN, IN(3) + layer * DM, DM, GDN_IN, (bf16*)(wmix + WM_GDN_IN), 0, scr, gw, NGW, lane); }
            { PH(); zero_rows((bf16*)(wmix + WM_GDN_IN), DM, GDN_IN, GDN_IN_PAD - GDN_IN, gtid, NGT); }
            { PH(); convert_matrix<0>(IN(17) + (size_t)j * GDN_VAL * DM, nullptr, GDN_VAL, DM, (bf16*)(wmix + WM_GDN_OUT), 0, scr, gw, NGW, lane); }
        }
        { PH(); convert_matrix<1, true>(IN(19) + (size_t)layer * DM * (2 * DFF), IN(18) + layer * DM, DM, 2 * DFF, (bf16*)(ws + WS_WGU), 0, scr, gw, NGW, lane); }
        { PH(); convert_matrix<0>(IN(20) + (size_t)layer * DFF * DM, nullptr, DFF, DM, (bf16*)(ws + WS_WDN), 0, scr, gw, NGW, lane); }
        { PH(); convert_matrix<0>(IN(21) + (size_t)layer * PLE_DIM * DM, nullptr, PLE_DIM, DM, (bf16*)(ws + WS_WPP), 0, scr, gw, NGW, lane); }
        { PH(); convert_matrix<0, true>(IN(24) + (size_t)layer * DM * DM, IN(23) + layer * DM, DM, DM, (bf16*)(ws + WS_WPG), 0, scr, gw, NGW, lane); }
        { PH(); phase_cvt_bf16(IN(1) + (size_t)layer * NT * PLE_DIM, (bf16*)(ws + WS_PBF), (size_t)NT * PLE_DIM, gtid, NGT); }
        GRID_BAR(1<<0);
        if (is_mla) {
            { PH(); GEMMH(EpiMlaIn, HY, wmix + WM_MLA_IN, MLA_IN_PAD, DM, DM, DM, (bf16*)(A1 + A1_QKVN), (float*)(A1 + A1_KPE), (float*)(A1 + A1_C), SSY); }
            GRID_BAR(1<<1);
            { PH(); GEMM(EpiBf16Lat, A1 + A1_QKVN, wmix + WM_MLA_UQ, MLA_H * MLA_QK, MLA_QL, 1024, MLA_QL, (bf16*)(A1 + A1_QRAW), MLA_H * MLA_QK, (const float*)(A1 + A1_C), 0); }
            { PH(); GEMM(EpiBf16Lat, (bf16*)(A1 + A1_QKVN) + MLA_QL, wmix + WM_MLA_UKV, MLA_H * 256, MLA_KVL, 1024, MLA_KVL, (bf16*)(A1 + A1_KVRAW), MLA_H * 256, (const float*)(A1 + A1_C), 8); }
            GRID_BAR(1<<1);
            { PH(); phase_mla_finalize_kv((const bf16*)(A1 + A1_KVRAW), (const float*)(A1 + A1_KPE), (const float*)(ws + WS_ROPE), IN(10) + j * MLA_QK, (bf16*)(A1 + A1_KF), (bf16*)(A1 + A1_VF), gw, NGW, lane); }
            GRID_BAR(1<<2);
            { PH(); attn::attn_phase((const bf16*)(A1 + A1_QRAW), IN(9) + j * MLA_QK, (const float*)(ws + WS_ROPE), (const bf16*)(A1 + A1_KF), (const bf16*)(A1 + A1_VF), A0, (LAS char*)lds, vcu, G, tid, wave, lane); }
            GRID_BAR(1<<3);
            { PH(); GEMM(EpiResid, A0, wmix + WM_MLA_O, DM, DM, DM, DM, HY, HBX, DM, SSX1); }
            GRID_BAR(1<<1);
        } else {
            { PH(); GEMMH(EpiGdnProj, HY, wmix + WM_GDN_IN, GDN_IN_PAD, DM, DM, DM, (bf16*)(A1 + A1_PROJ), GDN_MAIN, (float*)(A1 + A1_BA), GDN_MAIN / 256, SSY, (bf16*)(A1 + A1_HALO)); }
            GRID_BAR(1<<4);
            { PH(); gdn::phase_conv((bf16*)(A1 + A1_PROJ), (const bf16*)(A1 + A1_HALO), IN(13) + (size_t)j * 4 * GDN_CONV, lds, vcu, G, tid, wave); }
            GRID_BAR(1<<5);
            { PH(); gdn::phase_prep((const bf16*)(A1 + A1_PROJ), (const float*)(A1 + A1_BA), IN(14) + j * GDN_HV, IN(15) + j * GDN_HV, A0, (bf16*)(A1 + A1_INTRA), (float*)(A1 + A1_GC), lds, vcu, G, tid, wave, lane); }
            GRID_BAR(1<<6);
            { PH(); gdn::phase_scan((bf16*)(A1 + A1_PROJ), A0, (const bf16*)(A1 + A1_INTRA), (const float*)(A1 + A1_GC), lds, vcu, G, tid, wave, lane); }
            GRID_BAR(1<<7);
            { PH(); gdn::phase_gate((bf16*)(A1 + A1_PROJ), IN(16) + j * GDN_DV, gw, NGW, lane); }
            GRID_BAR(1<<8);
            { PH(); GEMM(EpiResid, (bf16*)(A1 + A1_PROJ) + GDN_CONV, wmix + WM_GDN_OUT, DM, GDN_VAL, GDN_MAIN, GDN_VAL, HY, HBX, DM, SSX1); }
            GRID_BAR(1<<9);
        }
        { PH(); GEMMH(EpiSiluMul, HBX, ws + WS_WGU, 2 * DFF, DM, DM, DM, (bf16*)(A1 + A1_ACT), DFF, SSX1); }
        { PH(); GEMM(EpiBf16Plain, ws + WS_PBF, ws + WS_WPP, DM, PLE_DIM, PLE_DIM, PLE_DIM, (bf16*)(A1 + A1_E), DM); }
        GRID_BAR(1<<11);
        { PH(); phase_rstd_e((const bf16*)(A1 + A1_E), (float*)(A1 + A1_RSTDE), gw, NGW, lane); }
        { PH(); GEMM(EpiResid, A1 + A1_ACT, ws + WS_WDN, DM, DFF, DFF, DFF, HBX, HBX, DM, SSX2); }
        GRID_BAR(1<<12);
        if (layer + 1 < DEPTH) { PH(); GEMMH(EpiPleGate<false>, HBX, ws + WS_WPG, DM, DM, DM, DM, HBX, HY, nullptr, DM, (const bf16*)(A1 + A1_E), (const float*)(A1 + A1_RSTDE), IN(22) + layer * DM, SSX2, SSY); }
        else { PH(); GEMMH(EpiPleGate<true>, HBX, ws + WS_WPG, DM, DM, DM, DM, HBX, nullptr, out, DM, (const bf16*)(A1 + A1_E), (const float*)(A1 + A1_RSTDE), IN(22) + layer * DM, SSX2, nullptr); }
        GRID_BAR(1<<14);
    }
#if PROBE_MASK
    if (blockIdx.x == 0 && BTID() == 0) { const unsigned long long acc_ = ((unsigned long long)MISC[19] << 32) | MISC[18]; const unsigned long long t0_ = __builtin_amdgcn_s_memrealtime(); while (__builtin_amdgcn_s_memrealtime() - t0_ < acc_) __builtin_amdgcn_s_sleep(32); }
#endif
}

extern "C" void kernel_launch(void* const* d_in, const int* in_sizes, int n_in, void* d_out, int out_size, void* d_ws, size_t ws_size, hipStream_t stream) {
    static int grid = 0;
    if (grid == 0) {
        if (n_in != 25 || out_size != NT * DM || ws_size < WS_END) { fprintf(stderr, "kernel_launch: unexpected shapes: n_in %d out %d ws %zu (need %zu)\n", n_in, out_size, ws_size, (size_t)WS_END); grid = -1; return; }
        int dev = 0, cus = 0, per_cu = 0;
        if (hipGetDevice(&dev) != hipSuccess || hipDeviceGetAttribute(&cus, hipDeviceAttributeMultiprocessorCount, dev) != hipSuccess) { grid = -1; return; }
        if (hipFuncSetAttribute((const void*)mk_fwd, hipFuncAttributeMaxDynamicSharedMemorySize, LDS_BYTES) != hipSuccess) { fprintf(stderr, "kernel_launch: hipFuncSetAttribute failed\n"); grid = -1; return; }
        if (hipOccupancyMaxActiveBlocksPerMultiprocessor(&per_cu, (const void*)mk_fwd, NWAVES * 64, LDS_BYTES) != hipSuccess || per_cu < 1) { fprintf(stderr, "kernel_launch: occupancy query says %d\n", per_cu); grid = -1; (void)hipGetLastError(); return; }
        grid = cus - cus % 64;
        if (grid < 64) { fprintf(stderr, "kernel_launch: %d CUs: need at least 64\n", cus); grid = -1; return; }
    }
    if (grid < 0) return;
    if (hipMemsetAsync((char*)d_ws + WS_CTL, 0, CTL_ZERO_BYTES, stream) != hipSuccess) return;
    Args a{};
    for (int i = 0; i < 25; ++i) a.in[i] = d_in[i];
    a.out = (float*)d_out; a.ws = (unsigned char*)d_ws;
    hipLaunchKernelGGL(mk_fwd, dim3(grid), dim3(NWAVES * 64), LDS_BYTES, stream, a);
}
```

```cpp
#include <hip/hip_runtime.h>
#include <cstdio>
#include <cstdint>

#ifndef PROBE_SCAN
#define PROBE_SCAN (0)
#endif
#ifndef PROBE_ATTN
#define PROBE_ATTN (0)
#endif
#ifndef PROBE_MASK
#define PROBE_MASK (0)
#endif

#define GAS __attribute__((address_space(1)))
#define LAS __attribute__((address_space(3)))
typedef unsigned short bf16;
typedef unsigned v4u __attribute__((ext_vector_type(4)));
typedef unsigned v2u __attribute__((ext_vector_type(2)));
typedef float f32x4 __attribute__((ext_vector_type(4)));
typedef float f32x16 __attribute__((ext_vector_type(16)));
typedef short bf16x8 __attribute__((ext_vector_type(8)));
typedef short s16x4 __attribute__((ext_vector_type(4)));

constexpr int NB = 2, SEQ = 16384, NT = NB * SEQ, DM = 2048, DEPTH = 4;
constexpr float NORM_EPS = 1e-6f;
constexpr int PLE_DIM = 256;
constexpr int MLA_H = 16, MLA_QL = 512, MLA_KVL = 512, MLA_NOPE = 128, MLA_ROPE = 64, MLA_QK = 192, MLA_V = 128;
constexpr int MLA_IN = MLA_QL + MLA_KVL + MLA_ROPE, MLA_IN_PAD = 1280;
constexpr int GDN_HQK = 16, GDN_HV = 32, GDN_DK = 128, GDN_DV = 128, GDN_KEY = 2048, GDN_VAL = 4096, GDN_CONV = 8192;
constexpr int GDN_MAIN = GDN_CONV + GDN_VAL;
constexpr int GDN_IN = GDN_MAIN + 64, GDN_IN_PAD = GDN_MAIN + 256;
constexpr int NCHUNK = SEQ / 64;
constexpr int DFF = 5632;

constexpr size_t MiB = 1u << 20;
constexpr size_t WS_CTL = 0, CTL_ZERO_BYTES = 64 * 1024;
constexpr size_t WS_WMIX = 1 * MiB, WS_WGU = 66 * MiB, WS_WDN = 110 * MiB, WS_WPP = 132 * MiB, WS_WPG = 133 * MiB, WS_ROPE = 141 * MiB;
constexpr size_t WS_A0 = 149 * MiB, WS_A1 = 277 * MiB, WS_SS = 1277 * MiB, WS_PBF = 1289 * MiB, WS_END = 1305 * MiB;
constexpr size_t A1_HBX = 872 * MiB;
constexpr size_t WM_GDN_IN = 0, WM_GDN_OUT = 49 * MiB;
constexpr size_t WM_MLA_IN = 0, WM_MLA_UQ = 5 * MiB, WM_MLA_UKV = 8 * MiB, WM_MLA_O = 12 * MiB;
constexpr size_t A1_C = 0, A1_QKVN = 160 * MiB, A1_KPE = 224 * MiB, A1_QRAW = 232 * MiB, A1_KVRAW = 424 * MiB, A1_KF = 680 * MiB, A1_VF = 872 * MiB, A1_QF = 0;
constexpr size_t A1_PROJ = 0, A1_BA = 768 * MiB, A1_HALO = 776 * MiB, A1_GC = 800 * MiB, A1_INTRA = 804 * MiB;
constexpr size_t A1_ACT = 0, A1_E = 368 * MiB, A1_RSTDE = 496 * MiB;
constexpr int CW_BAR = 1024;

constexpr int LDS_BYTES = 147456;
constexpr int MISC_OFF = LDS_BYTES - 256;
constexpr int NWAVES = 8;

#define LDS_WAIT() asm volatile("s_waitcnt lgkmcnt(0)" ::: "memory")
#define VM_WAIT() asm volatile("s_waitcnt vmcnt(0)" ::: "memory")
__device__ __forceinline__ unsigned pk2(float lo, float hi) { unsigned r; asm("v_cvt_pk_bf16_f32 %0, %1, %2" : "=v"(r) : "v"(lo), "v"(hi)); return r; }
__device__ __forceinline__ unsigned f2bf(float f) { return pk2(f, f) & 0xffffu; }
typedef _Float16 h16x2 __attribute__((ext_vector_type(2)));
__device__ __forceinline__ unsigned pkh2(float lo, float hi) { const h16x2 v = {(_Float16)lo, (_Float16)hi}; return __builtin_bit_cast(unsigned, v); }
__device__ __forceinline__ float bf2f(unsigned short b) { return __uint_as_float(((unsigned)b) << 16); }
__device__ __forceinline__ float bflo(unsigned w) { return __uint_as_float(w << 16); }
__device__ __forceinline__ float bfhi(unsigned w) { return __uint_as_float(w & 0xffff0000u); }
__device__ __forceinline__ float shx(float v, int mask, int lane) { return __builtin_bit_cast(float, __builtin_amdgcn_ds_bpermute((lane ^ mask) << 2, __builtin_bit_cast(int, v))); }
__device__ __forceinline__ float wave_sum(float v, int lane) {
#pragma unroll
    for (int o = 1; o < 64; o <<= 1) v += shx(v, o, lane);
    return v;
}
__device__ __forceinline__ float fsigmoid(float x) { return __builtin_amdgcn_rcpf(1.0f + __builtin_amdgcn_exp2f(-1.4426950408889634f * x)); }
__device__ __forceinline__ float fsilu(float x) { return x * fsigmoid(x); }

namespace pg8 {
#define PG8_LAS __attribute__((address_space(3)))
typedef unsigned short bf16_t;
typedef short bf16x8 __attribute__((ext_vector_type(8)));
typedef float f32x4 __attribute__((ext_vector_type(4)));
typedef unsigned u32x4 __attribute__((ext_vector_type(4)));
constexpr int BM = 256, BK = 64, HALF = 128, HTB = HALF * BK * 2  , STAGE_BYTES = 8 * HTB, NXCD = 8, WGM = 8;

__host__ __device__ __forceinline__ int lds_byte(int r, int c) { const int st = (r >> 4) * 2 + (c >> 5), rr = r & 15, cc = c & 31, ob = rr * 64 + cc * 2; return st * 1024 + (ob ^ (((ob >> 9) & 1) << 5)); }
__host__ __device__ __forceinline__ void stage_rc(int b, int& R, int& C) { const int st = b / 1024, sb = b % 1024, swz = sb ^ (((sb >> 9) & 1) << 5); R = (st >> 1) * 16 + swz / 64; C = (st & 1) * 32 + (swz % 64) / 2; }
__host__ __device__ __forceinline__ int perm32(int rho) { const int n = rho >> 4, i = rho & 15; return 8 * (i >> 2) + 4 * n + (i & 3); }

struct Unit { int pm, pn; };
struct Gemm { const bf16_t* A; const bf16_t* Bt; int M, N, K, lda, ldb; };

struct StaticOrder {
    int nM, nN, nwg, G, c;
    __host__ __device__ void init(int M, int N, int G_, int c_) { nM = M / BM; nN = N / BM; nwg = nM * nN; G = G_; c = c_; }
    __host__ __device__ bool next(int i, Unit& u) const {
        const long L = (long)i * G + c; if (L >= nwg) return false;
        int wgid = (int)L; { const int q = nwg / NXCD, r = nwg % NXCD, xcd = wgid % NXCD, off = wgid / NXCD; wgid = (xcd < r ? xcd * (q + 1) : r * (q + 1) + (xcd - r) * q) + off; }
        const int nig = WGM * nN, gid = wgid / nig, fm = gid * WGM, gsz = (nM - fm) < WGM ? (nM - fm) : WGM;
        u.pm = fm + ((wgid % nig) % gsz); u.pn = (wgid % nig) / gsz; return true;
    }
    __device__ __forceinline__ void a_ready(const Unit&) const {}
    __device__ __forceinline__ void done(const Unit&) const {}
};

__device__ __forceinline__ unsigned cvt_pk_bf16(float lo, float hi) { unsigned r; asm volatile("v_cvt_pk_bf16_f32 %0, %1, %2" : "=v"(r) : "v"(lo), "v"(hi)); return r; }
typedef float f32x2 __attribute__((ext_vector_type(2)));
__device__ __forceinline__ float fast_sigmoid(float x) { return __builtin_amdgcn_rcpf(1.0f + __builtin_amdgcn_exp2f(-1.4426950408889634f * x)); }

__device__ __forceinline__ float sum_fq(float s) {
    { const auto r = __builtin_amdgcn_permlane16_swap(__float_as_uint(s), __float_as_uint(s), false, false); s = __uint_as_float(r[0]) + __uint_as_float(r[1]); }
    { const auto r = __builtin_amdgcn_permlane32_swap(__float_as_uint(s), __float_as_uint(s), false, false); s = __uint_as_float(r[0]) + __uint_as_float(r[1]); }
    return s;
}
__device__ __forceinline__ float row_rstd(const float* ssp, int row, int fq) {
    const f32x4 a = *(const f32x4*)(ssp + (size_t)row * 32 + fq * 8), b = *(const f32x4*)(ssp + (size_t)row * 32 + fq * 8 + 4);
    float s = ((a[0] + a[1]) + (a[2] + a[3])) + ((b[0] + b[1]) + (b[2] + b[3]));
    s = sum_fq(s);
    return rsqrtf(s * (1.f / 2048.f) + 1e-6f);
}

struct EpiF32Plain {
    static constexpr bool PERM = false, AFTER_DRAIN = false;
    float* C; int ldc; const float* ss;
    __device__ __forceinline__ void operator()(const f32x4 (&acc)[2][2][4][2], const Unit& u, int wr, int wc, int fr, int fq) const {
        const int row0 = u.pm * BM + wr * 64 + fr, col0 = u.pn * BM + wc * 32 + 4 * fq;
#pragma unroll
        for (int ai = 0; ai < 2; ++ai)
#pragma unroll
            for (int m = 0; m < 4; ++m) { const int row = row0 + ai * HALF + m * 16; float* rowp = C + (size_t)row * ldc + col0; const float rs = row_rstd(ss, row, fq);
#pragma unroll
                for (int bj = 0; bj < 2; ++bj)
#pragma unroll
                    for (int n = 0; n < 2; ++n) *(f32x4*)(rowp + bj * HALF + n * 16) = acc[ai][bj][m][n] * rs; }
    }
};
struct EpiMlaIn {
    static constexpr bool PERM = true, AFTER_DRAIN = false;
    bf16_t* O; float* KPE; float* ssl; const float* ss;
    __device__ __forceinline__ void operator()(const f32x4 (&acc)[2][2][4][2], const Unit& u, int wr, int wc, int fr, int fq) const {
        const int row0 = u.pm * BM + wr * 64 + fr;
        if (u.pn < 4) {
            const int col0 = u.pn * BM + wc * 32 + 8 * fq;
#pragma unroll
            for (int ai = 0; ai < 2; ++ai)
#pragma unroll
                for (int m = 0; m < 4; ++m) { const int row = row0 + ai * HALF + m * 16; bf16_t* rowp = O + (size_t)row * 1024 + col0; const float rs = row_rstd(ss, row, fq); float sq = 0.f;
#pragma unroll
                    for (int bj = 0; bj < 2; ++bj) { const f32x4 v0 = acc[ai][bj][m][0] * rs, v1 = acc[ai][bj][m][1] * rs;
                        u32x4 w; w.x = cvt_pk_bf16(v0[0], v0[1]); w.y = cvt_pk_bf16(v0[2], v0[3]); w.z = cvt_pk_bf16(v1[0], v1[1]); w.w = cvt_pk_bf16(v1[2], v1[3]);
                        *(u32x4*)(rowp + bj * HALF) = w;
                        sq += ((v0[0] * v0[0] + v0[1] * v0[1]) + (v0[2] * v0[2] + v0[3] * v0[3])) + ((v1[0] * v1[0] + v1[1] * v1[1]) + (v1[2] * v1[2] + v1[3] * v1[3])); }
                    sq = sum_fq(sq);
                    if (fq == 0) ssl[(size_t)row * 16 + u.pn * 4 + wc] = sq; }
        } else if (wc < 2) {
            const int col0 = wc * 32 + 8 * fq;
#pragma unroll
            for (int ai = 0; ai < 2; ++ai)
#pragma unroll
                for (int m = 0; m < 4; ++m) { const int row = row0 + ai * HALF + m * 16; float* rowp = KPE + (size_t)row * 64 + col0; const float rs = row_rstd(ss, row, fq);
                    *(f32x4*)(rowp) = acc[ai][0][m][0] * rs; *(f32x4*)(rowp + 4) = acc[ai][0][m][1] * rs; }
        }
    }
};
struct EpiBf16Lat {
    static constexpr bool PERM = true, AFTER_DRAIN = false;
    bf16_t* O; int ldc; const float* ssl; int slot0;
    __device__ __forceinline__ void operator()(const f32x4 (&acc)[2][2][4][2], const Unit& u, int wr, int wc, int fr, int fq) const {
        const int row0 = u.pm * BM + wr * 64 + fr, col0 = u.pn * BM + wc * 32 + 8 * fq;
#pragma unroll
        for (int ai = 0; ai < 2; ++ai)
#pragma unroll
            for (int m = 0; m < 4; ++m) { const int row = row0 + ai * HALF + m * 16; bf16_t* rowp = O + (size_t)row * ldc + col0;
                const f32x2 pr = *(const f32x2*)(ssl + (size_t)row * 16 + slot0 + 2 * fq); float s = pr[0] + pr[1]; s = sum_fq(s);
                const float rs = rsqrtf(s * (1.f / 512.f) + 1e-6f);
#pragma unroll
                for (int bj = 0; bj < 2; ++bj) { const f32x4 v0 = acc[ai][bj][m][0] * rs, v1 = acc[ai][bj][m][1] * rs;
                    u32x4 w; w.x = cvt_pk_bf16(v0[0], v0[1]); w.y = cvt_pk_bf16(v0[2], v0[3]); w.z = cvt_pk_bf16(v1[0], v1[1]); w.w = cvt_pk_bf16(v1[2], v1[3]);
                    *(u32x4*)(rowp + bj * HALF) = w; } }
    }
};
struct EpiBf16Plain {
    static constexpr bool PERM = true, AFTER_DRAIN = false;
    bf16_t* O; int ldc;
    __device__ __forceinline__ void operator()(const f32x4 (&acc)[2][2][4][2], const Unit& u, int wr, int wc, int fr, int fq) const {
        const int row0 = u.pm * BM + wr * 64 + fr, col0 = u.pn * BM + wc * 32 + 8 * fq;
#pragma unroll
        for (int ai = 0; ai < 2; ++ai)
#pragma unroll
            for (int m = 0; m < 4; ++m) { bf16_t* rowp = O + (size_t)(row0 + ai * HALF + m * 16) * ldc + col0;
#pragma unroll
                for (int bj = 0; bj < 2; ++bj) { const f32x4 v0 = acc[ai][bj][m][0], v1 = acc[ai][bj][m][1];
                    u32x4 w; w.x = cvt_pk_bf16(v0[0], v0[1]); w.y = cvt_pk_bf16(v0[2], v0[3]); w.z = cvt_pk_bf16(v1[0], v1[1]); w.w = cvt_pk_bf16(v1[2], v1[3]);
                    *(u32x4*)(rowp + bj * HALF) = w; } }
    }
};
struct EpiGdnProj {
    static constexpr bool PERM = true, AFTER_DRAIN = false;
    bf16_t* O; int ldc; float* BA; int ntile_bf; const float* ss; bf16_t* halo;
    __device__ __forceinline__ void operator()(const f32x4 (&acc)[2][2][4][2], const Unit& u, int wr, int wc, int fr, int fq) const {
        const int row0 = u.pm * BM + wr * 64 + fr;
        if (u.pn < ntile_bf) {
            const int col0 = u.pn * BM + wc * 32 + 8 * fq;
#pragma unroll
            for (int ai = 0; ai < 2; ++ai)
#pragma unroll
                for (int m = 0; m < 4; ++m) { const int row = row0 + ai * HALF + m * 16; bf16_t* rowp = O + (size_t)row * ldc + col0; const float rs = row_rstd(ss, row, fq);
#pragma unroll
                    for (int bj = 0; bj < 2; ++bj) { const f32x4 v0 = acc[ai][bj][m][0] * rs, v1 = acc[ai][bj][m][1] * rs;
                        u32x4 w; w.x = cvt_pk_bf16(v0[0], v0[1]); w.y = cvt_pk_bf16(v0[2], v0[3]); w.z = cvt_pk_bf16(v1[0], v1[1]); w.w = cvt_pk_bf16(v1[2], v1[3]);
                        *(u32x4*)(rowp + bj * HALF) = w;
                        if ((row & 63) >= 61 && u.pn < 32 && ((row >> 6) & 255) != 255) *(u32x4*)(halo + ((size_t)((row >> 6) + 1) * 3 + (row & 63) - 61) * 8192 + col0 + bj * HALF) = w; } }
        } else if (wc < 2) {
            const int col0 = wc * 32 + 8 * fq;
#pragma unroll
            for (int ai = 0; ai < 2; ++ai)
#pragma unroll
                for (int m = 0; m < 4; ++m) { const int row = row0 + ai * HALF + m * 16; float* rowp = BA + (size_t)row * 64 + col0; const float rs = row_rstd(ss, row, fq);
                    *(f32x4*)(rowp) = acc[ai][0][m][0] * rs; *(f32x4*)(rowp + 4) = acc[ai][0][m][1] * rs; }
        }
    }
};
struct EpiSiluMul {
    static constexpr bool PERM = true, AFTER_DRAIN = false;
    bf16_t* O; int ldc; const float* ss;
    __device__ __forceinline__ void operator()(const f32x4 (&acc)[2][2][4][2], const Unit& u, int wr, int wc, int fr, int fq) const {
        const int row0 = u.pm * BM + wr * 64 + fr, col0 = u.pn * HALF + wc * 32 + 8 * fq;
#pragma unroll
        for (int ai = 0; ai < 2; ++ai)
#pragma unroll
            for (int m = 0; m < 4; ++m) { const int row = row0 + ai * HALF + m * 16; bf16_t* rowp = O + (size_t)row * ldc + col0; const float rs = row_rstd(ss, row, fq);
                f32x4 r0, r1;
#pragma unroll
                for (int j = 0; j < 4; ++j) { const float g0 = acc[ai][0][m][0][j] * rs, g1 = acc[ai][0][m][1][j] * rs;
                    r0[j] = g0 * fast_sigmoid(g0) * (acc[ai][1][m][0][j] * rs); r1[j] = g1 * fast_sigmoid(g1) * (acc[ai][1][m][1][j] * rs); }
                u32x4 w; w.x = cvt_pk_bf16(r0[0], r0[1]); w.y = cvt_pk_bf16(r0[2], r0[3]); w.z = cvt_pk_bf16(r1[0], r1[1]); w.w = cvt_pk_bf16(r1[2], r1[3]);
                *(u32x4*)(rowp) = w; }
    }
};
typedef _Float16 h2_t __attribute__((ext_vector_type(2)));
__device__ __forceinline__ unsigned pkh(float a, float b) { const h2_t v = {(_Float16)a, (_Float16)b}; return __builtin_bit_cast(unsigned, v); }
__device__ __forceinline__ float hlo(unsigned w) { return (float)__builtin_bit_cast(h2_t, w)[0]; }
__device__ __forceinline__ float hhi(unsigned w) { return (float)__builtin_bit_cast(h2_t, w)[1]; }
struct EpiResid {
    static constexpr bool PERM = true, AFTER_DRAIN = false;
    const bf16_t* base16; bf16_t* out16; int ldc; float* ssout;
    __device__ __forceinline__ void operator()(const f32x4 (&acc)[2][2][4][2], const Unit& u, int wr, int wc, int fr, int fq) const {
        const int row0 = u.pm * BM + wr * 64 + fr, col0 = u.pn * BM + wc * 32 + 8 * fq;
#pragma unroll
        for (int ai = 0; ai < 2; ++ai) {
            u32x4 bs[4][2];
#pragma unroll
            for (int m = 0; m < 4; ++m) { const size_t off = (size_t)(row0 + ai * HALF + m * 16) * ldc + col0; bs[m][0] = *(const u32x4*)(base16 + off); bs[m][1] = *(const u32x4*)(base16 + off + HALF); }
#pragma unroll
            for (int m = 0; m < 4; ++m) { const int row = row0 + ai * HALF + m * 16; const size_t off = (size_t)row * ldc + col0; float sq = 0.f;
#pragma unroll
                for (int bj = 0; bj < 2; ++bj) { const u32x4 b = bs[m][bj]; const f32x4 a0 = acc[ai][bj][m][0], a1 = acc[ai][bj][m][1];
                    const float o0 = hlo(b.x) + a0[0], o1 = hhi(b.x) + a0[1], o2 = hlo(b.y) + a0[2], o3 = hhi(b.y) + a0[3], o4 = hlo(b.z) + a1[0], o5 = hhi(b.z) + a1[1], o6 = hlo(b.w) + a1[2], o7 = hhi(b.w) + a1[3];
                    u32x4 hw; hw.x = pkh(o0, o1); hw.y = pkh(o2, o3); hw.z = pkh(o4, o5); hw.w = pkh(o6, o7); *(u32x4*)(out16 + off + bj * HALF) = hw;
                    sq += ((o0 * o0 + o1 * o1) + (o2 * o2 + o3 * o3)) + ((o4 * o4 + o5 * o5) + (o6 * o6 + o7 * o7)); }
                sq = sum_fq(sq);
                if (fq == 0) ssout[(size_t)row * 32 + u.pn * 4 + wc] = sq; }
            asm volatile("" ::: "memory");
        }
    }
};
template <bool FINAL> struct EpiPleGate {
    static constexpr bool PERM = true, AFTER_DRAIN = false;
    const bf16_t* base16; bf16_t* out16; float* outf; int ldc; const bf16_t* e; const float* rstd; const float* wn; const float* ssin; float* ssout;
    __device__ __forceinline__ void operator()(const f32x4 (&acc)[2][2][4][2], const Unit& u, int wr, int wc, int fr, int fq) const {
        const int row0 = u.pm * BM + wr * 64 + fr, col0 = u.pn * BM + wc * 32 + 8 * fq;
#pragma unroll
        for (int am = 0; am < 4; ++am) { const int ai = am >> 1;
            u32x4 bs[4][2], ev[4][2]; float rs[4], ri[4];
#pragma unroll
            for (int m = 2 * (am & 1); m < 2 * (am & 1) + 2; ++m) { const int row = row0 + ai * HALF + m * 16; const size_t off = (size_t)row * ldc + col0; rs[m] = rstd[row]; ri[m] = row_rstd(ssin, row, fq);
#pragma unroll
                for (int bj = 0; bj < 2; ++bj) { bs[m][bj] = *(const u32x4*)(base16 + off + bj * HALF); ev[m][bj] = *(const u32x4*)(e + off + bj * HALF); } }
#pragma unroll
            for (int m = 2 * (am & 1); m < 2 * (am & 1) + 2; ++m) { const int row = row0 + ai * HALF + m * 16; const size_t off = (size_t)row * ldc + col0; float sq = 0.f;
#pragma unroll
                for (int bj = 0; bj < 2; ++bj) { const f32x4 w0 = *(const f32x4*)(wn + col0 + bj * HALF), w1 = *(const f32x4*)(wn + col0 + bj * HALF + 4); const u32x4 ew = ev[m][bj], b = bs[m][bj];
                    const f32x4 a0 = acc[ai][bj][m][0], a1 = acc[ai][bj][m][1]; const float rsv = rs[m], riv = ri[m];
                    const float o0 = hlo(b.x) + __uint_as_float(ew.x << 16) * rsv * w0[0] * fast_sigmoid(a0[0] * riv), o1 = hhi(b.x) + __uint_as_float(ew.x & 0xffff0000u) * rsv * w0[1] * fast_sigmoid(a0[1] * riv);
                    const float o2 = hlo(b.y) + __uint_as_float(ew.y << 16) * rsv * w0[2] * fast_sigmoid(a0[2] * riv), o3 = hhi(b.y) + __uint_as_float(ew.y & 0xffff0000u) * rsv * w0[3] * fast_sigmoid(a0[3] * riv);
                    const float o4 = hlo(b.z) + __uint_as_float(ew.z << 16) * rsv * w1[0] * fast_sigmoid(a1[0] * riv), o5 = hhi(b.z) + __uint_as_float(ew.z & 0xffff0000u) * rsv * w1[1] * fast_sigmoid(a1[1] * riv);
                    const float o6 = hlo(b.w) + __uint_as_float(ew.w << 16) * rsv * w1[2] * fast_sigmoid(a1[2] * riv), o7 = hhi(b.w) + __uint_as_float(ew.w & 0xffff0000u) * rsv * w1[3] * fast_sigmoid(a1[3] * riv);
                    if constexpr (FINAL) { *(f32x4*)(outf + off + bj * HALF) = (f32x4){o0, o1, o2, o3}; *(f32x4*)(outf + off + bj * HALF + 4) = (f32x4){o4, o5, o6, o7}; }
                    else { u32x4 hw; hw.x = pkh(o0, o1); hw.y = pkh(o2, o3); hw.z = pkh(o4, o5); hw.w = pkh(o6, o7); *(u32x4*)(out16 + off + bj * HALF) = hw;
                        sq += ((o0 * o0 + o1 * o1) + (o2 * o2 + o3 * o3)) + ((o4 * o4 + o5 * o5) + (o6 * o6 + o7 * o7)); } }
                if constexpr (!FINAL) { sq = sum_fq(sq); if (fq == 0) ssout[(size_t)row * 32 + u.pn * 4 + wc] = sq; } }
            asm volatile("" ::: "memory");
        }
    }
};

typedef _Float16 f16x8 __attribute__((ext_vector_type(8)));
template <bool F16> __device__ __forceinline__ f32x4 mma16(bf16x8 b, bf16x8 a, f32x4 c) {
    if constexpr (F16) return __builtin_amdgcn_mfma_f32_16x16x32_f16(__builtin_bit_cast(f16x8, b), __builtin_bit_cast(f16x8, a), c, 0, 0, 0);
    else return __builtin_amdgcn_mfma_f32_16x16x32_bf16(b, a, c, 0, 0, 0);
}
template <class Epi, class Sched, bool ALIGN_EPI = false, bool SP2 = false, bool F16 = false>
__device__ __forceinline__ void gemm_phase(PG8_LAS unsigned char* lds, const Gemm g, const Sched& S, const Epi& E, const int tid_in  ) {
    int tid_ = tid_in; asm volatile("" : "+v"(tid_));
    const int tid = tid_, wid = __builtin_amdgcn_readfirstlane(tid >> 6), lane = tid & 63, wr = wid >> 2, wc = wid & 3, fr = lane & 15, fq = lane >> 4;
    const int K = g.K, nt = K / BK;
    unsigned voffA[2], voffB[2];
#pragma unroll
    for (int i = 0; i < 2; ++i) { int R, C; stage_rc(tid * 16 + i * 8192, R, C); const int Rb = Epi::PERM ? ((R & ~31) + perm32(R & 31)) : R;
        voffA[i] = (unsigned)(R * g.lda + C) * 2u; voffB[i] = (unsigned)(Rb * g.ldb + C) * 2u; }
    const size_t kstep = (size_t)(BK * 2);
    const size_t hstepA = (size_t)HALF * g.lda * 2, hstepB = (size_t)HALF * g.ldb * 2;
    const size_t tstepA = 2 * hstepA, tstepB = 2 * hstepB;
    const unsigned ldsw = (unsigned)wid * 1024u;
    const int aoff = lds_byte(wr * 64 + fr, fq * 8), boff = lds_byte(wc * 32 + fr, fq * 8);
#define PG8_SA(b, h) (((b) * 2 + (h)) * HTB)
#define PG8_SB(b, h) ((4 + (b) * 2 + (h)) * HTB)
#define PG8_STAGE(bufoff, gbase, voff) do { _Pragma("unroll") for (int _i = 0; _i < 2; ++_i) \
        __builtin_amdgcn_global_load_lds((const unsigned*)((const char*)(gbase) + (voff)[_i]), (PG8_LAS unsigned*)(lds + (bufoff) + ldsw + _i * 8192), 16, 0, 0); } while (0)
#define PG8_LDA(dst, b, h) do { _Pragma("unroll") for (int m = 0; m < 4; ++m) _Pragma("unroll") for (int k = 0; k < 2; ++k) dst[m][k] = *(const PG8_LAS bf16x8*)(lds + PG8_SA(b, h) + aoff + m * 2048 + k * 1024); } while (0)
#define PG8_LDB(dst, b, h) do { _Pragma("unroll") for (int n = 0; n < 2; ++n) _Pragma("unroll") for (int k = 0; k < 2; ++k) dst[n][k] = *(const PG8_LAS bf16x8*)(lds + PG8_SB(b, h) + boff + n * 2048 + k * 1024); } while (0)
#define PG8_MMA(ai, bj, At, Bt) do { __builtin_amdgcn_s_setprio(1); _Pragma("unroll") for (int m = 0; m < 4; ++m) _Pragma("unroll") for (int n = 0; n < 2; ++n) _Pragma("unroll") for (int k = 0; k < 2; ++k) \
        acc[ai][bj][m][n] = mma16<F16>(Bt[n][k], At[m][k], acc[ai][bj][m][n]); __builtin_amdgcn_s_setprio(0); } while (0)
#define PG8_WAIT_V(n) asm volatile("s_waitcnt vmcnt(" #n ")" ::: "memory")
#define PG8_WAIT_L(n) asm volatile("s_waitcnt lgkmcnt(" #n ")" ::: "memory")
#define PG8_BAR __builtin_amdgcn_s_barrier()
#define PG8_SCHED __builtin_amdgcn_sched_barrier(0)
    Unit cur, nxt; int ui = 0;
    if (!S.next(0, cur)) return;
    f32x4 acc[2][2][4][2];
#pragma unroll
    for (int a = 0; a < 2; ++a)
#pragma unroll
        for (int b = 0; b < 2; ++b)
#pragma unroll
            for (int m = 0; m < 4; ++m)
#pragma unroll
                for (int n = 0; n < 2; ++n) acc[a][b][m][n] = (f32x4){0.f, 0.f, 0.f, 0.f};
    bf16x8 At[4][2], B0[2][2], B1[2][2];
    const char* cA = (const char*)g.A + (size_t)cur.pm * tstepA; const char* cB = (const char*)g.Bt + (size_t)cur.pn * tstepB;
    S.a_ready(cur);
    if constexpr (SP2) {
        PG8_STAGE(PG8_SB(0, 0), cB, voffB); PG8_STAGE(PG8_SB(0, 1), cB + hstepB, voffB); PG8_STAGE(PG8_SA(0, 0), cA, voffA); PG8_STAGE(PG8_SA(0, 1), cA + hstepA, voffA);
        if (wr == 1) PG8_BAR;
        PG8_WAIT_V(2); PG8_BAR;
        PG8_STAGE(PG8_SB(1, 0), cB + kstep, voffB); PG8_STAGE(PG8_SA(1, 0), cA + kstep, voffA); PG8_STAGE(PG8_SB(1, 1), cB + hstepB + kstep, voffB);
        PG8_WAIT_V(6); PG8_BAR;
    } else {
        PG8_STAGE(PG8_SB(0, 0), cB, voffB); PG8_STAGE(PG8_SA(0, 0), cA, voffA); PG8_STAGE(PG8_SB(0, 1), cB + hstepB, voffB); PG8_STAGE(PG8_SA(0, 1), cA + hstepA, voffA);
        if (wr == 1) PG8_BAR;
        PG8_WAIT_V(4); PG8_BAR;
        PG8_STAGE(PG8_SB(1, 0), cB + kstep, voffB); PG8_STAGE(PG8_SA(1, 0), cA + kstep, voffA); PG8_STAGE(PG8_SB(1, 1), cB + hstepB + kstep, voffB);
        PG8_WAIT_V(6); PG8_BAR;
    }
    for (;;) {
        const bool has_next = S.next(ui + 1, nxt);
        const char* nA = has_next ? (const char*)g.A + (size_t)nxt.pm * tstepA : cA; const char* nB = has_next ? (const char*)g.Bt + (size_t)nxt.pn * tstepB : cB;
        for (int t = 0; t < nt; t += 2) {
            const bool last = (t == nt - 2);
            const char* a1 = cA + (size_t)(t + 1) * kstep;
            const char* a2 = last ? nA : cA + (size_t)(t + 2) * kstep; const char* b2 = last ? nB : cB + (size_t)(t + 2) * kstep;
            const char* a3 = a2 + kstep; const char* b3 = b2 + kstep;
            if (last && has_next) S.a_ready(nxt);
            if constexpr (SP2) {
            PG8_LDB(B0, 0, 0); PG8_LDB(B1, 0, 1); PG8_SCHED; PG8_LDA(At, 0, 0); PG8_STAGE(PG8_SA(1, 1), a1 + hstepA, voffA);
            PG8_WAIT_V(8); PG8_WAIT_L(0); PG8_BAR; PG8_MMA(0, 0, At, B0); PG8_MMA(0, 1, At, B1); PG8_BAR; PG8_SCHED;
            PG8_LDA(At, 0, 1); PG8_STAGE(PG8_SB(0, 0), b2, voffB); PG8_STAGE(PG8_SB(0, 1), b2 + hstepB, voffB); PG8_STAGE(PG8_SA(0, 0), a2, voffA);
            PG8_WAIT_V(8); PG8_WAIT_L(0); PG8_BAR; PG8_MMA(1, 0, At, B0); PG8_MMA(1, 1, At, B1); PG8_BAR; PG8_SCHED;
            PG8_LDB(B0, 1, 0); PG8_LDB(B1, 1, 1); PG8_SCHED; PG8_LDA(At, 1, 0); PG8_STAGE(PG8_SA(0, 1), a2 + hstepA, voffA);
            PG8_WAIT_V(8); PG8_WAIT_L(0); PG8_BAR; PG8_MMA(0, 0, At, B0); PG8_MMA(0, 1, At, B1); PG8_BAR; PG8_SCHED;
            PG8_LDA(At, 1, 1); PG8_STAGE(PG8_SB(1, 0), b3, voffB); PG8_STAGE(PG8_SB(1, 1), b3 + hstepB, voffB); PG8_STAGE(PG8_SA(1, 0), a3, voffA);
            PG8_WAIT_V(8); PG8_WAIT_L(0); PG8_BAR; PG8_MMA(1, 0, At, B0); PG8_MMA(1, 1, At, B1); PG8_BAR; PG8_SCHED;
            } else {
            PG8_LDB(B0, 0, 0); PG8_SCHED; PG8_LDA(At, 0, 0); PG8_STAGE(PG8_SA(1, 1), a1 + hstepA, voffA);
            PG8_WAIT_L(8); PG8_BAR; PG8_WAIT_L(0); PG8_MMA(0, 0, At, B0); PG8_BAR; PG8_SCHED;
            PG8_LDB(B1, 0, 1); PG8_STAGE(PG8_SB(0, 0), b2, voffB);
            PG8_BAR; PG8_WAIT_L(0); PG8_MMA(0, 1, At, B1); PG8_BAR;
            PG8_LDA(At, 0, 1); PG8_STAGE(PG8_SA(0, 0), a2, voffA);
            PG8_BAR; PG8_WAIT_L(0); PG8_MMA(1, 0, At, B0); PG8_BAR; PG8_SCHED;
            PG8_STAGE(PG8_SB(0, 1), b2 + hstepB, voffB);
            PG8_WAIT_V(6); PG8_BAR; PG8_MMA(1, 1, At, B1); PG8_BAR;
            PG8_LDB(B0, 1, 0); PG8_SCHED; PG8_LDA(At, 1, 0); PG8_STAGE(PG8_SA(0, 1), a2 + hstepA, voffA);
            PG8_WAIT_L(8); PG8_BAR; PG8_WAIT_L(0); PG8_MMA(0, 0, At, B0); PG8_BAR; PG8_SCHED;
            PG8_LDB(B1, 1, 1); PG8_STAGE(PG8_SB(1, 0), b3, voffB);
            PG8_BAR; PG8_WAIT_L(0); PG8_MMA(0, 1, At, B1); PG8_BAR;
            PG8_LDA(At, 1, 1); PG8_STAGE(PG8_SA(1, 0), a3, voffA);
            PG8_BAR; PG8_WAIT_L(0); PG8_MMA(1, 0, At, B0); PG8_BAR; PG8_SCHED;
            PG8_STAGE(PG8_SB(1, 1), b3 + hstepB, voffB);
            PG8_WAIT_V(6); PG8_BAR; PG8_MMA(1, 1, At, B1); PG8_BAR;
            }
        }
        if constexpr (ALIGN_EPI) { if (wr == 0) PG8_BAR; }
        if constexpr (!Epi::AFTER_DRAIN) { E(acc, cur, wr, wc, fr, fq); S.done(cur); }
        if (!has_next) break;
#pragma unroll
        for (int a = 0; a < 2; ++a)
#pragma unroll
            for (int b = 0; b < 2; ++b)
#pragma unroll
                for (int m = 0; m < 4; ++m)
#pragma unroll
                    for (int n = 0; n < 2; ++n) acc[a][b][m][n] = (f32x4){0.f, 0.f, 0.f, 0.f};
        cur = nxt; cA = nA; cB = nB; ++ui;
        if constexpr (ALIGN_EPI) { if (wr == 1) PG8_BAR; }
    }
    PG8_WAIT_V(0);
    if constexpr (!ALIGN_EPI) { if (wr == 0) PG8_BAR; }
    PG8_BAR;
    if constexpr (Epi::AFTER_DRAIN) { E.fused(acc, cur, wr, wc, fr, fq, lds, wid, lane); S.done(cur); }
#undef PG8_SA
#undef PG8_SB
#undef PG8_STAGE
#undef PG8_LDA
#undef PG8_LDB
#undef PG8_MMA
#undef PG8_WAIT_V
#undef PG8_WAIT_L
#undef PG8_BAR
#undef PG8_SCHED
}
}
#define XB_TMO      128
#define XB_XCNT(j)  (256  + 64 * (j))
#define XB_XSUB(j)  (1280 + 64 * (j))
#define XB_XGEN(j)  (2304 + 64 * (j))
#define XB_TOP      3328
#define XB_TOPGEN   3392
#define XCD_BAR_WORDS 3456
#define XB_SPIN_CAP (1u << 18)

__device__ __forceinline__ unsigned xb_ld(unsigned* p)              { return __hip_atomic_load(p, __ATOMIC_RELAXED, __HIP_MEMORY_SCOPE_AGENT); }
__device__ __forceinline__ unsigned xb_add(unsigned* p, unsigned v) { return __hip_atomic_fetch_add(p, v, __ATOMIC_RELAXED, __HIP_MEMORY_SCOPE_AGENT); }
__device__ __forceinline__ unsigned xb_xcc_id() { return (unsigned)__builtin_amdgcn_s_getreg((3 << 11) | 20) & 0xFu; }
#define XB_SPIN(cond, bar) do { unsigned _sp = 0; while (cond) { __builtin_amdgcn_s_sleep(1); \
    if ((++_sp & 255u) == 0u) { if (xb_ld(&(bar)[XB_TMO])) break; if (_sp > XB_SPIN_CAP) { atomicAdd(&(bar)[XB_TMO], 1u); break; } } } } while (0)

struct XcdBarrier {
    unsigned* bar; unsigned x;
    volatile LAS unsigned* st;
};

__device__ __forceinline__ XcdBarrier xcd_barrier_post(unsigned* bar, volatile LAS unsigned* st) {
    XcdBarrier b; b.bar = bar; b.x = xb_xcc_id(); b.st = st;
    if (threadIdx.x == 0) (void)xb_add(&bar[XB_XCNT(b.x)], 1u);
    return b;
}
__device__ __forceinline__ void xcd_barrier_complete(unsigned* bar, unsigned x, unsigned& nloc, unsigned& nx) {
    const unsigned G = gridDim.x * gridDim.y * gridDim.z;
    unsigned sum, cnt, mine, sp = 0u;
    for (;;) {
        sum = 0u; cnt = 0u; mine = 0u;
#pragma unroll
        for (unsigned j = 0; j < 16; ++j) { const unsigned c = xb_ld(&bar[XB_XCNT(j)]); sum += c; cnt += (c > 0u) ? 1u : 0u; mine = (j == x) ? c : mine; }
        if (sum == G) break;
        __builtin_amdgcn_s_sleep(1);
        if ((++sp & 255u) == 0u) { if (xb_ld(&bar[XB_TMO])) break; if (sp > XB_SPIN_CAP) { atomicAdd(&bar[XB_TMO], 1u); break; } }
    }
    nloc = mine > 0u ? mine : 1u; nx = cnt > 0u ? cnt : 1u;
}

__device__ __forceinline__ void xcd_barrier(const XcdBarrier& b, const int tid_in  ) {
    asm volatile("s_waitcnt vmcnt(0)" ::: "memory");
    __syncthreads();
    if (tid_in == 0) {
        unsigned* bar = b.bar;
        __builtin_amdgcn_s_waitcnt(0);
        unsigned nloc = b.st[0], nx = b.st[1];
        if (nloc == 0u) { xcd_barrier_complete(bar, b.x, nloc, nx); b.st[0] = nloc; b.st[1] = nx; }
        const unsigned old = xb_add(&bar[XB_XSUB(b.x)], 1u);
        const unsigned gen = old / nloc;
        if (old + 1u == (gen + 1u) * nloc) {
            __builtin_amdgcn_fence(__ATOMIC_RELEASE, "agent");
            asm volatile("s_waitcnt vmcnt(0)" ::: "memory");
            const unsigned og = xb_add(&bar[XB_TOP], 1u);
            const unsigned tg = og / nx;
            if (og + 1u == (tg + 1u) * nx) xb_add(&bar[XB_TOPGEN], 1u);
            else XB_SPIN(xb_ld(&bar[XB_TOPGEN]) == tg, bar);
            __builtin_amdgcn_fence(__ATOMIC_ACQUIRE, "agent");
            xb_add(&bar[XB_XGEN(b.x)], 1u);
            asm volatile("s_waitcnt vmcnt(0)" ::: "memory");
        } else {
            XB_SPIN(xb_ld(&bar[XB_XGEN(b.x)]) == gen, bar);
            __builtin_amdgcn_fence(__ATOMIC_ACQUIRE, "agent");
            asm volatile("s_waitcnt vmcnt(0)" ::: "memory");
        }
    }
    __syncthreads();
}
template <int MODE, bool F16>
__device__ __forceinline__ void transpose_item(const float* W, const float* ksc, int K, int N, bf16* WT, int row_off, LAS float* scr_, int item, int lane) {
    LAS unsigned char* scr = (LAS unsigned char*)scr_;
    const int nblk = N / 64, kb = item / nblk, nb = item % nblk, k0 = 64 * kb, n0 = 64 * nb;
    const int n4 = lane & 15, kq = lane >> 4;
#pragma unroll 4
    for (int i = 0; i < 16; ++i) { const int kk = 4 * i + kq; const f32x4 v = *(const f32x4*)(W + (size_t)(k0 + kk) * N + n0 + 4 * n4); const float sc = ksc ? ksc[k0 + kk] : 1.f;
        const unsigned p01 = F16 ? pkh2(v.x * sc, v.y * sc) : pk2(v.x * sc, v.y * sc), p23 = F16 ? pkh2(v.z * sc, v.w * sc) : pk2(v.z * sc, v.w * sc);
        LAS unsigned char* d = scr + (4 * n4) * 144 + (((kk >> 3) ^ (n4 & 7)) << 4) + (kk & 7) * 2;
        *(LAS unsigned short*)(d) = (unsigned short)p01; *(LAS unsigned short*)(d + 144) = (unsigned short)(p01 >> 16);
        *(LAS unsigned short*)(d + 288) = (unsigned short)p23; *(LAS unsigned short*)(d + 432) = (unsigned short)(p23 >> 16); }
    LDS_WAIT(); asm volatile("" ::: "memory");
    int d0;
    if (MODE == 0) d0 = row_off + n0;
    else { const int half = n0 >= DFF ? 1 : 0, nn = n0 - half * DFF; d0 = (nn >> 7) * 256 + half * 128 + (nn & 127); }
#pragma unroll
    for (int t = 0; t < 8; ++t) { const int idx = lane + 64 * t, n = idx >> 3, c = idx & 7;
        const v4u o = *(const LAS v4u*)(scr + n * 144 + ((c ^ ((n >> 2) & 7)) << 4));
        *(v4u*)(WT + (size_t)(d0 + n) * K + k0 + 8 * c) = o; }
    LDS_WAIT(); asm volatile("" ::: "memory");
}
template <int MODE, bool F16 = false>
__device__ __forceinline__ void convert_matrix(const float* W, const float* ksc, int K, int N, bf16* WT, int row_off, LAS float* scr, int gw, int NGW, int lane) {
    const int nitems = (K / 64) * (N / 64);
    for (int it = gw; it < nitems; it += NGW) transpose_item<MODE, F16>(W, ksc, K, N, WT, row_off, scr, it, lane);
}
__device__ __forceinline__ void zero_rows(bf16* WT, int K, int row0, int nrows, int gtid, int NGT) {
    const size_t n16 = (size_t)nrows * K / 8; v4u* p = (v4u*)(WT + (size_t)row0 * K);
    unsigned z = 0u; asm volatile("" : "+v"(z));
    for (size_t i = gtid; i < n16; i += NGT) p[i] = (v4u){z, z, z, z};
}
__device__ __forceinline__ void phase_cast_ss(const float* h, bf16* hb, float* ss, int gw, int NGW, int lane) {
    for (int m = gw; m < NT; m += NGW) {
        const f32x4* xr = (const f32x4*)(h + (size_t)m * DM) + lane; v2u* o8 = (v2u*)(hb + (size_t)m * DM) + lane; float s = 0.f;
#pragma unroll
        for (int j = 0; j < 8; ++j) { const f32x4 v = xr[64 * j]; s += (v.x * v.x + v.y * v.y) + (v.z * v.z + v.w * v.w); v2u o; o.x = pkh2(v.x, v.y); o.y = pkh2(v.z, v.w); o8[64 * j] = o; }
        s = wave_sum(s, lane);
        if (lane < 32) ss[(size_t)m * 32 + lane] = lane == 0 ? s : 0.f;
    }
}
__device__ __forceinline__ void zero_f32(float* p, int n, int gtid, int NGT) { float z = 0.f; asm volatile("" : "+v"(z)); for (int i = gtid; i < n; i += NGT) p[i] = z; }
__device__ __forceinline__ void phase_rope_table(const int* positions, float* cs, int gtid, int NGT) {
    for (int idx = gtid; idx < NT * 32; idx += NGT) {
        const int t = idx >> 5, i = idx & 31;
        const float inv_freq = __builtin_amdgcn_exp2f(-(float)i * (13.287712379549449f / 32.0f));
        const float ang = (float)positions[t] * inv_freq;
        const double rev = (double)ang * 0.15915494309189535; const double fr = rev - floor(rev);
        const float x = (float)(fr * 6.283185307179586);
        cs[(size_t)t * 64 + i] = cosf(x); cs[(size_t)t * 64 + 32 + i] = sinf(x);
    }
}
__device__ __forceinline__ void phase_mla_latnorm(const float* c, const float* wq, const float* wkv, bf16* qkvn, float* kpe, int gw, int NGW, int lane) {
    for (int m = gw; m < NT; m += NGW) {
        const f32x4* cr = (const f32x4*)(c + (size_t)m * MLA_IN_PAD);
        f32x4 a0 = cr[lane], a1 = cr[64 + lane], b0 = cr[128 + lane], b1 = cr[192 + lane];
        float sa = (a0.x * a0.x + a0.y * a0.y) + (a0.z * a0.z + a0.w * a0.w) + (a1.x * a1.x + a1.y * a1.y) + (a1.z * a1.z + a1.w * a1.w);
        float sb = (b0.x * b0.x + b0.y * b0.y) + (b0.z * b0.z + b0.w * b0.w) + (b1.x * b1.x + b1.y * b1.y) + (b1.z * b1.z + b1.w * b1.w);
        const float ra = rsqrtf(wave_sum(sa, lane) * (1.f / 512.f) + NORM_EPS), rb = rsqrtf(wave_sum(sb, lane) * (1.f / 512.f) + NORM_EPS);
        const f32x4 wa0 = ((const f32x4*)wq)[lane], wa1 = ((const f32x4*)wq)[64 + lane], wb0 = ((const f32x4*)wkv)[lane], wb1 = ((const f32x4*)wkv)[64 + lane];
        v2u* o = (v2u*)(qkvn + (size_t)m * 1024); v2u t;
        t.x = pk2(a0.x * ra * wa0.x, a0.y * ra * wa0.y); t.y = pk2(a0.z * ra * wa0.z, a0.w * ra * wa0.w); o[lane] = t;
        t.x = pk2(a1.x * ra * wa1.x, a1.y * ra * wa1.y); t.y = pk2(a1.z * ra * wa1.z, a1.w * ra * wa1.w); o[64 + lane] = t;
        t.x = pk2(b0.x * rb * wb0.x, b0.y * rb * wb0.y); t.y = pk2(b0.z * rb * wb0.z, b0.w * rb * wb0.w); o[128 + lane] = t;
        t.x = pk2(b1.x * rb * wb1.x, b1.y * rb * wb1.y); t.y = pk2(b1.z * rb * wb1.z, b1.w * rb * wb1.w); o[192 + lane] = t;
        if (lane < 16) ((f32x4*)(kpe + (size_t)m * 64))[lane] = cr[256 + lane];
    }
}
__device__ __forceinline__ void phase_mla_finalize_kv(const bf16* kvraw, const float* kpe, const float* cs, const float* knw, bf16* kf, bf16* vf, int gw, int NGW, int lane) {
    const int g = lane >> 4, i = lane & 15, isv = g & 1;
    float wk[8], wpe[8];
#pragma unroll
    for (int e = 0; e < 8; ++e) { wk[e] = knw[8 * i + e]; wpe[e] = knw[128 + 8 * (i & 7) + e]; }
    for (int m = gw; m < NT; m += NGW) {
        const int b = m / SEQ, s = m % SEQ;
        const float pv = kpe[(size_t)m * 64 + lane]; const float pess = wave_sum(pv * pv, lane);
        float pe[8], cv[8], sv[8];
        { const f32x4 a0 = *(const f32x4*)(kpe + (size_t)m * 64 + 8 * (i & 7)), a1 = *(const f32x4*)(kpe + (size_t)m * 64 + 8 * (i & 7) + 4);
          const f32x4 c0 = *(const f32x4*)(cs + (size_t)m * 64 + 8 * (i & 3)), c1 = *(const f32x4*)(cs + (size_t)m * 64 + 8 * (i & 3) + 4);
          const f32x4 s0 = *(const f32x4*)(cs + (size_t)m * 64 + 32 + 8 * (i & 3)), s1 = *(const f32x4*)(cs + (size_t)m * 64 + 32 + 8 * (i & 3) + 4);
#pragma unroll
          for (int e = 0; e < 4; ++e) { pe[e] = a0[e]; pe[4 + e] = a1[e]; cv[e] = c0[e]; cv[4 + e] = c1[e]; sv[e] = s0[e]; sv[4 + e] = s1[e]; } }
        const bf16* kr = kvraw + (size_t)m * (MLA_H * 256);
#pragma unroll 2
        for (int hp = 0; hp < MLA_H / 2; ++hp) {
            const int h = 2 * hp + (g >> 1); const size_t ob = ((size_t)(b * MLA_H + h) * SEQ + s);
            const v4u raw = *(const v4u*)(kr + h * 256 + isv * 128 + 8 * i);
            float x[8]; x[0] = bflo(raw.x); x[1] = bfhi(raw.x); x[2] = bflo(raw.y); x[3] = bfhi(raw.y); x[4] = bflo(raw.z); x[5] = bfhi(raw.z); x[6] = bflo(raw.w); x[7] = bfhi(raw.w);
            float ss = 0.f;
#pragma unroll
            for (int e = 0; e < 8; ++e) ss += x[e] * x[e];
            ss += shx(ss, 1, lane); ss += shx(ss, 2, lane); ss += shx(ss, 4, lane); ss += shx(ss, 8, lane);
            float rs = rsqrtf((ss + pess) * (1.f / 192.f) + NORM_EPS);
            const float rso = shx(rs, 16, lane); if (isv) rs = rso;
            if (!isv) { v4u o; o.x = pk2(x[0] * rs * wk[0], x[1] * rs * wk[1]); o.y = pk2(x[2] * rs * wk[2], x[3] * rs * wk[3]); o.z = pk2(x[4] * rs * wk[4], x[5] * rs * wk[5]); o.w = pk2(x[6] * rs * wk[6], x[7] * rs * wk[7]);
                *(v4u*)(kf + ob * MLA_QK + 8 * i) = o; }
            else *(v4u*)(vf + ob * MLA_V + 8 * i) = raw;
            float y[8], yp[8];
#pragma unroll
            for (int e = 0; e < 8; ++e) { y[e] = pe[e] * rs * wpe[e]; yp[e] = shx(y[e], 4, lane); }
            if (isv && i < 8) { float r[8];
#pragma unroll
                for (int e = 0; e < 8; ++e) r[e] = (i < 4) ? y[e] * cv[e] - yp[e] * sv[e] : y[e] * cv[e] + yp[e] * sv[e];
                v4u o; o.x = pk2(r[0], r[1]); o.y = pk2(r[2], r[3]); o.z = pk2(r[4], r[5]); o.w = pk2(r[6], r[7]);
                *(v4u*)(kf + ob * MLA_QK + 128 + 8 * i) = o; }
        }
    }
}
__device__ __forceinline__ void phase_cvt_bf16(const float* src, bf16* dst, size_t n, int gtid, int NGT) {
    const size_t n8 = n / 8;
    for (size_t i = gtid; i < n8; i += NGT) { const f32x4 a = ((const f32x4*)src)[2 * i], b = ((const f32x4*)src)[2 * i + 1];
        v4u o; o.x = pk2(a.x, a.y); o.y = pk2(a.z, a.w); o.z = pk2(b.x, b.y); o.w = pk2(b.z, b.w); ((v4u*)dst)[i] = o; }
}
__device__ __forceinline__ void phase_rstd_e(const bf16* e, float* rstd, int gw, int NGW, int lane) {
    for (int m = gw; m < NT; m += NGW) {
        const v4u* er = (const v4u*)(e + (size_t)m * DM) + lane; float s = 0.f;
#pragma unroll
        for (int j = 0; j < 4; ++j) { const v4u w = er[64 * j];
            const float a0 = bflo(w.x), a1 = bfhi(w.x), a2 = bflo(w.y), a3 = bfhi(w.y), a4 = bflo(w.z), a5 = bfhi(w.z), a6 = bflo(w.w), a7 = bfhi(w.w);
            s += (a0 * a0 + a1 * a1) + (a2 * a2 + a3 * a3) + (a4 * a4 + a5 * a5) + (a6 * a6 + a7 * a7); }
        s = wave_sum(s, lane);
        if (lane == 0) rstd[m] = rsqrtf(s * (1.f / 2048.f) + NORM_EPS);
    }
}

namespace attn {
constexpr int DQK = 192, DV = 128, QBLK = 32, KVBLK = 64, QB = 256;
constexpr int SHM_V = KVBLK * DV * 2, SHM_K = KVBLK * DQK * 2;
constexpr int OFF_V = 0, OFF_K = 2 * SHM_V, OFF_WS = OFF_K + 2 * SHM_K;
constexpr int OFF_Q = OFF_WS + NWAVES * 64 * 4;
constexpr int ATTN_LDS = OFF_Q + NWAVES * 4096;
constexpr float SCALE = 0.07216878364870322f;
constexpr float THR = 8.f;
#define SBAR() __builtin_amdgcn_sched_barrier(0)
__device__ __forceinline__ int v_rd_base(int lane) { return ((lane & 3) << 3) | (((lane >> 2) & 3) << 6) | (((lane >> 4) & 1) << 5) | (((lane >> 5) & 1) << 8); }
constexpr int v_rd_off(int d0, int ks, int half) { return d0 * 512 + ks * 4096 + half * 2048; }
__device__ __forceinline__ int crow(int r, int hi) { return (r & 3) + 8 * (r >> 2) + 4 * hi; }
__device__ __forceinline__ unsigned cvtpk(float lo, float hi) { unsigned r; asm volatile("v_cvt_pk_bf16_f32 %0, %1, %2" : "=v"(r) : "v"(lo), "v"(hi)); return r; }
__device__ __forceinline__ void mask_tile(f32x16& p0, f32x16& p1, int dq) {
    const float NEG = -__builtin_inff();
#pragma unroll
    for (int r = 0; r < 16; ++r) { const int c = (r & 3) + 8 * (r >> 2);
        if (dq - c < 0) p0[r] = NEG;
        if (dq - c - 32 < 0) p1[r] = NEG; }
}
__device__ __forceinline__ void partialSM(f32x16& p0, f32x16& p1, float& m_reg, float& mn, float& alpha) {
    float pmax = p0[0];
#pragma unroll
    for (int r = 1; r < 16; ++r) pmax = fmaxf(pmax, p0[r]);
#pragma unroll
    for (int r = 0; r < 16; ++r) pmax = fmaxf(pmax, p1[r]);
    { auto rr = __builtin_amdgcn_permlane32_swap(__float_as_uint(pmax), __float_as_uint(pmax), false, false);
      pmax = fmaxf(__uint_as_float(rr[0]), __uint_as_float(rr[1])); }
    constexpr float C2 = 1.4426950408889634f * SCALE;
    if (__builtin_expect(__all((pmax - m_reg) * SCALE <= THR), 1)) { mn = m_reg; alpha = 1.f; }
    else { mn = fmaxf(m_reg, pmax); alpha = __builtin_amdgcn_exp2f((m_reg - mn) * C2); m_reg = mn; }
    const float mnL = -mn * C2;
#pragma unroll
    for (int r = 0; r < 16; ++r) p0[r] = fmaf(p0[r], C2, mnL);
#pragma unroll
    for (int r = 0; r < 16; ++r) p1[r] = fmaf(p1[r], C2, mnL);
#pragma unroll
    for (int r = 0; r < 16; ++r) p0[r] = __builtin_amdgcn_exp2f(p0[r]);
}
__device__ __forceinline__ void finishSM(f32x16& p0, f32x16& p1, float alpha, float& l_reg, bf16x8& pa0, bf16x8& pa1, bf16x8& pa2, bf16x8& pa3) {
#pragma unroll
    for (int r = 0; r < 16; ++r) p1[r] = __builtin_amdgcn_exp2f(p1[r]);
    float ps = 0;
#pragma unroll
    for (int r = 0; r < 16; ++r) ps += p0[r];
#pragma unroll
    for (int r = 0; r < 16; ++r) ps += p1[r];
    { auto rr = __builtin_amdgcn_permlane32_swap(__float_as_uint(ps), __float_as_uint(ps), false, false);
      ps = __uint_as_float(rr[0]) + __uint_as_float(rr[1]); }
    l_reg = l_reg * alpha + ps;
#define PK4(P, B_, OUT) do { unsigned a0 = cvtpk(P[B_+0], P[B_+1]), a1 = cvtpk(P[B_+2], P[B_+3]);                          \
        unsigned b0 = cvtpk(P[B_+4], P[B_+5]), b1 = cvtpk(P[B_+6], P[B_+7]);                                             \
        auto r0 = __builtin_amdgcn_permlane32_swap(a0, b0, false, false); auto r1 = __builtin_amdgcn_permlane32_swap(a1, b1, false, false); \
        v4u w = {r0[0], r1[0], r0[1], r1[1]}; OUT = *reinterpret_cast<bf16x8*>(&w); } while (0)
    PK4(p0, 0, pa0); PK4(p0, 8, pa1); PK4(p1, 0, pa2); PK4(p1, 8, pa3);
#undef PK4
}
__device__ __forceinline__ int k_off(int row, int ch) { return row * 384 + ((ch ^ ((row >> 1) & 7)) << 4); }
template <int KB>
__device__ __forceinline__ void qkt(f32x16& p0, f32x16& p1, const LAS char* lds, int r32, int hi, const bf16x8* qr, const LAS char* qs) {
    p0 = f32x16{}; p1 = f32x16{};
    const LAS char* kb[4];
#pragma unroll
    for (int dd = 0; dd < 4; ++dd) kb[dd] = lds + OFF_K + KB * SHM_K + k_off(r32, dd * 2 + hi);
#if PROBE_MASK
#pragma unroll
    for (int d0 = 0; d0 < 12; ++d0) { const LAS char* a = kb[d0 & 3] + (d0 >> 2) * 128;
        bf16x8 b0 = *reinterpret_cast<const LAS bf16x8*>(a);
        bf16x8 b1 = *reinterpret_cast<const LAS bf16x8*>(a + 32 * 384);
        const bf16x8 qv = d0 < 8 ? qr[d0 < 8 ? d0 : 0] : *reinterpret_cast<const LAS bf16x8*>(qs + (d0 - 8) * 1024);
        p0 = __builtin_amdgcn_mfma_f32_32x32x16_bf16(b0, qv, p0, 0, 0, 0);
        p1 = __builtin_amdgcn_mfma_f32_32x32x16_bf16(b1, qv, p1, 0, 0, 0); }
#else
    bf16x8 kf[2][4], qx[2][2];
#define QKT_LOAD(i_, buf_) do { _Pragma("unroll") for (int e_ = 0; e_ < 2; ++e_) { const int d0_ = 2 * (i_) + e_; const LAS char* a_ = kb[d0_ & 3] + (d0_ >> 2) * 128; \
        kf[buf_][2 * e_] = *reinterpret_cast<const LAS bf16x8*>(a_); kf[buf_][2 * e_ + 1] = *reinterpret_cast<const LAS bf16x8*>(a_ + 32 * 384); \
        if (d0_ >= 8) qx[buf_][e_] = *reinterpret_cast<const LAS bf16x8*>(qs + (d0_ - 8) * 1024); } } while (0)
    QKT_LOAD(0, 0);
#pragma unroll
    for (int i = 0; i < 6; ++i) {
        if (i < 5) QKT_LOAD(i + 1, (i + 1) & 1);
        __builtin_amdgcn_sched_barrier(0);
#pragma unroll
        for (int e = 0; e < 2; ++e) { const int d0 = 2 * i + e; const bf16x8 qv = d0 < 8 ? qr[d0 < 8 ? d0 : 0] : qx[i & 1][e];
            p0 = __builtin_amdgcn_mfma_f32_32x32x16_bf16(kf[i & 1][2 * e], qv, p0, 0, 0, 0);
            p1 = __builtin_amdgcn_mfma_f32_32x32x16_bf16(kf[i & 1][2 * e + 1], qv, p1, 0, 0, 0); }
        __builtin_amdgcn_sched_barrier(0);
    }
#undef QKT_LOAD
#endif
}
template <int VB>
__device__ __forceinline__ void pv_tile(f32x16* o, int vb0, bf16x8 pa0, bf16x8 pa1, bf16x8 pa2, bf16x8 pa3) {
#define TRRD(dst, off) asm volatile("ds_read_b64_tr_b16 %0, %1 offset:%2" : "=&v"(dst) : "v"(vb0), "i"(off) : "memory")
#define PV_RD(S, d0) do { constexpr int b_ = OFF_V + VB * SHM_V + v_rd_off(d0, 0, 0); \
        TRRD(S[0], b_); TRRD(S[1], b_ + 2048); TRRD(S[2], b_ + 4096); TRRD(S[3], b_ + 6144); TRRD(S[4], b_ + 8192); TRRD(S[5], b_ + 10240); TRRD(S[6], b_ + 12288); TRRD(S[7], b_ + 14336); } while (0)
#define PV_MM(S, d0) do { \
        o[d0] = __builtin_amdgcn_mfma_f32_32x32x16_bf16(pa0, (bf16x8){S[0][0], S[0][1], S[0][2], S[0][3], S[1][0], S[1][1], S[1][2], S[1][3]}, o[d0], 0, 0, 0);   \
        o[d0] = __builtin_amdgcn_mfma_f32_32x32x16_bf16(pa1, (bf16x8){S[2][0], S[2][1], S[2][2], S[2][3], S[3][0], S[3][1], S[3][2], S[3][3]}, o[d0], 0, 0, 0);   \
        o[d0] = __builtin_amdgcn_mfma_f32_32x32x16_bf16(pa2, (bf16x8){S[4][0], S[4][1], S[4][2], S[4][3], S[5][0], S[5][1], S[5][2], S[5][3]}, o[d0], 0, 0, 0);   \
        o[d0] = __builtin_amdgcn_mfma_f32_32x32x16_bf16(pa3, (bf16x8){S[6][0], S[6][1], S[6][2], S[6][3], S[7][0], S[7][1], S[7][2], S[7][3]}, o[d0], 0, 0, 0); } while (0)
#define PV_WAIT8(S) asm volatile("s_waitcnt lgkmcnt(8)" : "+v"(S[0]), "+v"(S[1]), "+v"(S[2]), "+v"(S[3]), "+v"(S[4]), "+v"(S[5]), "+v"(S[6]), "+v"(S[7]) :: "memory")
#define PV_WAIT0(S) asm volatile("s_waitcnt lgkmcnt(0)" : "+v"(S[0]), "+v"(S[1]), "+v"(S[2]), "+v"(S[3]), "+v"(S[4]), "+v"(S[5]), "+v"(S[6]), "+v"(S[7]) :: "memory")
    s16x4 sa[8], sb[8];
    PV_RD(sa, 0);
    PV_RD(sb, 1); PV_WAIT8(sa); SBAR(); PV_MM(sa, 0); SBAR();
    PV_RD(sa, 2); PV_WAIT8(sb); SBAR(); PV_MM(sb, 1); SBAR();
    PV_RD(sb, 3); PV_WAIT8(sa); SBAR(); PV_MM(sa, 2); SBAR();
    PV_WAIT0(sb); SBAR(); PV_MM(sb, 3);
#undef PV_RD
#undef PV_MM
#undef PV_WAIT8
#undef PV_WAIT0
#undef TRRD
}
template <int VB, int KB, bool DO_PV, bool DO_QK>
__device__ __forceinline__ void mseg(f32x16* o, int vb0, bf16x8 pa0, bf16x8 pa1, bf16x8 pa2, bf16x8 pa3, f32x16& p0, f32x16& p1, int ldsa, int r32, int hi, const bf16x8* qr, int qsa) {
#define TRRD(dst, off) asm volatile("ds_read_b64_tr_b16 %0, %1 offset:%2" : "=&v"(dst) : "v"(vb0), "i"(off) : "memory")
#define PV_RD(S, d0) do { constexpr int b_ = OFF_V + VB * SHM_V + v_rd_off(d0, 0, 0); \
        TRRD(S[0], b_); TRRD(S[1], b_ + 2048); TRRD(S[2], b_ + 4096); TRRD(S[3], b_ + 6144); TRRD(S[4], b_ + 8192); TRRD(S[5], b_ + 10240); TRRD(S[6], b_ + 12288); TRRD(S[7], b_ + 14336); } while (0)
#define PV_MM(S, d0) do { \
        o[d0] = __builtin_amdgcn_mfma_f32_32x32x16_bf16(pa0, (bf16x8){S[0][0], S[0][1], S[0][2], S[0][3], S[1][0], S[1][1], S[1][2], S[1][3]}, o[d0], 0, 0, 0);   \
        o[d0] = __builtin_amdgcn_mfma_f32_32x32x16_bf16(pa1, (bf16x8){S[2][0], S[2][1], S[2][2], S[2][3], S[3][0], S[3][1], S[3][2], S[3][3]}, o[d0], 0, 0, 0);   \
        o[d0] = __builtin_amdgcn_mfma_f32_32x32x16_bf16(pa2, (bf16x8){S[4][0], S[4][1], S[4][2], S[4][3], S[5][0], S[5][1], S[5][2], S[5][3]}, o[d0], 0, 0, 0);   \
        o[d0] = __builtin_amdgcn_mfma_f32_32x32x16_bf16(pa3, (bf16x8){S[6][0], S[6][1], S[6][2], S[6][3], S[7][0], S[7][1], S[7][2], S[7][3]}, o[d0], 0, 0, 0); } while (0)
#define PV_WAIT8(S) asm volatile("s_waitcnt lgkmcnt(8)" : "+v"(S[0]), "+v"(S[1]), "+v"(S[2]), "+v"(S[3]), "+v"(S[4]), "+v"(S[5]), "+v"(S[6]), "+v"(S[7]) :: "memory")
#define PV_WAIT0(S) asm volatile("s_waitcnt lgkmcnt(0)" : "+v"(S[0]), "+v"(S[1]), "+v"(S[2]), "+v"(S[3]), "+v"(S[4]), "+v"(S[5]), "+v"(S[6]), "+v"(S[7]) :: "memory")
#define KRD(dst, base, off) asm volatile("ds_read_b128 %0, %1 offset:%2" : "=&v"(dst) : "v"(base), "i"(off) : "memory")
#define QK_LD4(B, da, db) do { KRD(kf[B][0], kb[(da) & 3], ((da) >> 2) * 128); KRD(kf[B][1], kb[(da) & 3], ((da) >> 2) * 128 + 12288); \
                               KRD(kf[B][2], kb[(db) & 3], ((db) >> 2) * 128); KRD(kf[B][3], kb[(db) & 3], ((db) >> 2) * 128 + 12288); } while (0)
#define QK_LD6(B, da, db) do { QK_LD4(B, da, db); KRD(qx[B][0], qsa, ((da) - 8) * 1024); KRD(qx[B][1], qsa, ((db) - 8) * 1024); } while (0)
#define QK_W(N, B)  asm volatile("s_waitcnt lgkmcnt(" #N ")" : "+v"(kf[B][0]), "+v"(kf[B][1]), "+v"(kf[B][2]), "+v"(kf[B][3]) :: "memory")
#define QK_WQ(N, B) asm volatile("s_waitcnt lgkmcnt(" #N ")" : "+v"(kf[B][0]), "+v"(kf[B][1]), "+v"(kf[B][2]), "+v"(kf[B][3]), "+v"(qx[B][0]), "+v"(qx[B][1]) :: "memory")
#define QK_MM(B, qa, qb) do { p0 = __builtin_amdgcn_mfma_f32_32x32x16_bf16(kf[B][0], qa, p0, 0, 0, 0); p1 = __builtin_amdgcn_mfma_f32_32x32x16_bf16(kf[B][1], qa, p1, 0, 0, 0); \
                              p0 = __builtin_amdgcn_mfma_f32_32x32x16_bf16(kf[B][2], qb, p0, 0, 0, 0); p1 = __builtin_amdgcn_mfma_f32_32x32x16_bf16(kf[B][3], qb, p1, 0, 0, 0); } while (0)
    s16x4 sa[8], sb[8]; bf16x8 kf[2][4]; int kb[4];
    if (DO_QK) {
#pragma unroll
        for (int dd = 0; dd < 4; ++dd) kb[dd] = ldsa + OFF_K + KB * SHM_K + k_off(r32, dd * 2 + hi);
    }
    if (DO_PV) {
        PV_RD(sa, 0);
        PV_RD(sb, 1); PV_WAIT8(sa); SBAR(); PV_MM(sa, 0); SBAR();
        PV_RD(sa, 2); PV_WAIT8(sb); SBAR(); PV_MM(sb, 1); SBAR();
        PV_RD(sb, 3); PV_WAIT8(sa); SBAR(); PV_MM(sa, 2); SBAR();
        if (DO_QK) { QK_LD4(0, 0, 1); QK_LD4(1, 2, 3); PV_WAIT8(sb); } else PV_WAIT0(sb);
        SBAR(); PV_MM(sb, 3); SBAR();
    } else if (DO_QK) { QK_LD4(0, 0, 1); QK_LD4(1, 2, 3); }
    if (DO_QK) {
        p0 = f32x16{}; p1 = f32x16{};
        QK_W(4, 0); SBAR(); QK_MM(0, qr[0], qr[1]); SBAR(); QK_LD4(0, 4, 5);
        QK_W(4, 1); SBAR(); QK_MM(1, qr[2], qr[3]); SBAR(); QK_LD4(1, 6, 7);
        QK_W(4, 0); SBAR(); QK_MM(0, qr[4], qr[5]); SBAR(); QK_LD4(0, 8, 9);
        QK_W(4, 1); SBAR(); QK_MM(1, qr[6], qr[7]); SBAR(); QK_LD4(1, 10, 11);
        QK_W(4, 0); SBAR(); QK_MM(0, qr[8], qr[9]); SBAR();
        QK_W(0, 1); SBAR(); QK_MM(1, qr[10], qr[11]); SBAR();
    }
#undef TRRD
#undef PV_RD
#undef PV_MM
#undef PV_WAIT8
#undef PV_WAIT0
#undef KRD
#undef QK_LD4
#undef QK_LD6
#undef QK_W
#undef QK_WQ
#undef QK_MM
}
__device__ __forceinline__ void attn_block(const bf16* Q, int ldq, const float* qnw, const float* cs, int tok0, const bf16* Kh, const bf16* Vh, bf16* O, int ldo, int P0, int rev, LAS char* lds, int tid_, int wid, int lane_) {
    int tid = tid_, lane = lane_;
    asm volatile("" : "+v"(tid), "+v"(lane));
    const int r32 = lane & 31, hi = lane >> 5;
    const int NTL = (P0 + QB) / KVBLK;
    const int qlo = P0 + wid * QBLK, qm = qlo + r32 - 4 * hi;
    LAS float* ws = (LAS float*)(lds + OFF_WS) + wid * 64; LAS float* li_l = ws; LAS float* al_l = ws + 32;
    unsigned ksrc[3], vsrc[2];
#pragma unroll
    for (int i = 0; i < 3; ++i) { const int p = i * 512 + tid, row = p / 24, pc = p % 24, c = pc ^ ((row >> 1) & 7); ksrc[i] = (unsigned)(row * 384 + c * 16); }
#pragma unroll
    for (int i = 0; i < 2; ++i) { const int p = i * 512 + tid; const int kk = ((p >> 7) << 3) | ((p >> 2) & 7), c = (((p >> 5) & 3) << 5) | ((p & 3) << 3);
        const int k = (kk & ~0xC) | ((kk & 4) << 1) | ((kk & 8) >> 1); vsrc[i] = (unsigned)(k * 256 + c * 2); }
#define ISSUE_TILE(t, slot) do { const char* kg_ = (const char*)Kh + (size_t)(t) * (KVBLK * 384); const char* vg_ = (const char*)Vh + (size_t)(t) * (KVBLK * 256); \
        _Pragma("unroll") for (int i_ = 0; i_ < 3; ++i_) __builtin_amdgcn_global_load_lds((const unsigned*)(kg_ + ksrc[i_]), (LAS unsigned*)(lds + OFF_K + (slot) * SHM_K + i_ * 8192 + wid * 1024), 16, 0, 0); \
        _Pragma("unroll") for (int i_ = 0; i_ < 2; ++i_) __builtin_amdgcn_global_load_lds((const unsigned*)(vg_ + vsrc[i_]), (LAS unsigned*)(lds + OFF_V + (slot) * SHM_V + i_ * 8192 + wid * 1024), 16, 0, 0); } while (0)
#define TIDX(s_) (rev ? NTL - 1 - (s_) : (s_))
    ISSUE_TILE(TIDX(0), 0);
    bf16x8 qr[12];
    LAS char* qs = lds + OFF_Q + wid * 4096 + lane * 16;
    {
        const bf16* qrow = Q + (size_t)(wid * QBLK + r32) * ldq + hi * 8; const float* csr = cs + (size_t)(tok0 + wid * QBLK + r32) * 64 + hi * 8;
        v4u qw[12]; float ss = 0.f;
#pragma unroll
        for (int d0 = 0; d0 < 12; ++d0) qw[d0] = *reinterpret_cast<const v4u*>(qrow + d0 * 16);
#pragma unroll
        for (int d0 = 0; d0 < 12; ++d0) { const v4u w = qw[d0]; const float a0 = bflo(w.x), a1 = bfhi(w.x), a2 = bflo(w.y), a3 = bfhi(w.y), a4 = bflo(w.z), a5 = bfhi(w.z), a6 = bflo(w.w), a7 = bfhi(w.w);
            ss += (a0 * a0 + a1 * a1) + (a2 * a2 + a3 * a3) + (a4 * a4 + a5 * a5) + (a6 * a6 + a7 * a7); }
        ss += shx(ss, 32, lane);
        const float rs = rsqrtf(ss * (1.f / 192.f) + NORM_EPS);
#define QSCALE(X, d0_) do { const v4u w_ = qw[d0_]; const f32x4 g0_ = *(const f32x4*)(qnw + (d0_) * 16 + hi * 8), g1_ = *(const f32x4*)(qnw + (d0_) * 16 + hi * 8 + 4); \
            X[0] = bflo(w_.x) * rs * g0_.x; X[1] = bfhi(w_.x) * rs * g0_.y; X[2] = bflo(w_.y) * rs * g0_.z; X[3] = bfhi(w_.y) * rs * g0_.w; \
            X[4] = bflo(w_.z) * rs * g1_.x; X[5] = bfhi(w_.z) * rs * g1_.y; X[6] = bflo(w_.w) * rs * g1_.z; X[7] = bfhi(w_.w) * rs * g1_.w; } while (0)
#define QPACK(X) ((v4u){cvtpk(X[0], X[1]), cvtpk(X[2], X[3]), cvtpk(X[4], X[5]), cvtpk(X[6], X[7])})
#pragma unroll
        for (int d0 = 0; d0 < 8; ++d0) { float xv[8]; QSCALE(xv, d0); const v4u pk = QPACK(xv); qr[d0] = *reinterpret_cast<const bf16x8*>(&pk); }
#pragma unroll
        for (int d0 = 8; d0 < 10; ++d0) { float x1[8], x2[8], o1[8], o2[8]; QSCALE(x1, d0); QSCALE(x2, d0 + 2);
            const f32x4 c0 = *(const f32x4*)(csr + (d0 - 8) * 16), c1 = *(const f32x4*)(csr + (d0 - 8) * 16 + 4), s0 = *(const f32x4*)(csr + 32 + (d0 - 8) * 16), s1 = *(const f32x4*)(csr + 32 + (d0 - 8) * 16 + 4);
#pragma unroll
            for (int e = 0; e < 8; ++e) { const float c = e < 4 ? c0[e & 3] : c1[e & 3], s = e < 4 ? s0[e & 3] : s1[e & 3]; o1[e] = x1[e] * c - x2[e] * s; o2[e] = x2[e] * c + x1[e] * s; }
            const v4u p1 = QPACK(o1), p2 = QPACK(o2);
            qr[d0] = *reinterpret_cast<const bf16x8*>(&p1); qr[d0 + 2] = *reinterpret_cast<const bf16x8*>(&p2); }
#undef QSCALE
#undef QPACK
    }
    float m_reg = -1e30f, l_reg = 0; f32x16 o[4] = {};
    const int vb0 = (int)(uintptr_t)(lds) + v_rd_base(lane);
    VM_WAIT(); __syncthreads();
#define RESC(a) do { if (__any((a) < 1.f)) { if (hi == 0) al_l[r32] = (a); asm volatile("s_waitcnt lgkmcnt(0)" ::: "memory");              \
                     _Pragma("unroll") for (int d_ = 0; d_ < 4; ++d_) _Pragma("unroll") for (int r = 0; r < 16; ++r) o[d_][r] *= al_l[crow(r, hi)]; } } while (0)
#define STEP(t, SLOT) do { \
        if ((t) + 1 < NTL) ISSUE_TILE(TIDX((t) + 1), (SLOT) ^ 1); \
        const int kb_ = TIDX(t) * KVBLK; \
        if (kb_ <= qlo + QBLK - 1) {                                          \
            f32x16 p0, p1; float mn, al; bf16x8 pa0, pa1, pa2, pa3; \
            mseg<SLOT, SLOT, false, true>(o, vb0, pa0, pa1, pa2, pa3, p0, p1, (int)(uintptr_t)lds, r32, hi, qr, (int)(uintptr_t)qs); \
            if (kb_ + KVBLK - 1 > qlo) mask_tile(p0, p1, qm - kb_); \
            partialSM(p0, p1, m_reg, mn, al); RESC(al); \
            finishSM(p0, p1, al, l_reg, pa0, pa1, pa2, pa3); SBAR(); \
            pv_tile<SLOT>(o, vb0, pa0, pa1, pa2, pa3); } \
        VM_WAIT(); __syncthreads(); } while (0)
    for (int t = 0; t < NTL; t += 2) { STEP(t, 0); STEP(t + 1, 1); }
#undef STEP
#undef RESC
#undef ISSUE_TILE
#undef TIDX
    if (hi == 0) li_l[r32] = l_reg; asm volatile("s_waitcnt lgkmcnt(0)" ::: "memory");
    float rli[16];
#pragma unroll
    for (int r = 0; r < 16; ++r) rli[r] = __builtin_amdgcn_rcpf(li_l[crow(r, hi)]);
    int lane2 = lane; asm volatile("" : "+v"(lane2));
    const int r32e = lane2 & 31, hie = lane2 >> 5;
    bf16* Ow = O + (size_t)(wid * QBLK) * ldo;
#pragma unroll
    for (int r = 0; r < 16; ++r) { const int orow = crow(r, hie);
#pragma unroll
        for (int d0 = 0; d0 < 4; ++d0) { const float v = o[d0][r] * rli[r]; const float vn = shx(v, 1, lane);
            if ((r32e & 1) == 0) *(unsigned*)(Ow + (size_t)orow * ldo + d0 * 32 + r32e) = cvtpk(v, vn); } }
    __syncthreads();
}
__device__ __forceinline__ void attn_phase(const bf16* qraw, const float* qnw, const float* cs, const bf16* kf, const bf16* vf, bf16* o, LAS char* lds, int vcu, int G, int tid, int wid, int lane) {
    constexpr int NQB = SEQ / QB, NPAIR = NQB / 2, TOTAL = NB * MLA_H * NPAIR;
    for (int L = vcu; L < TOTAL; L += G) {
        const int bh = L / NPAIR, x = L % NPAIR, b = bh / MLA_H, h = bh % MLA_H;
        const bf16* Kh = kf + (size_t)bh * SEQ * DQK; const bf16* Vh = vf + (size_t)bh * SEQ * DV;
#pragma unroll 1
        for (int pass = 0; pass < 2; ++pass) {
            const int qb = pass ? x : (NQB - 1 - x), P0 = qb * QB, tok0 = b * SEQ + P0;
            attn_block(qraw + (size_t)tok0 * (MLA_H * MLA_QK) + h * MLA_QK, MLA_H * MLA_QK, qnw, cs, tok0, Kh, Vh, o + (size_t)tok0 * (MLA_H * MLA_V) + h * MLA_V, MLA_H * MLA_V, P0, pass, lds, tid, wid, lane);
        }
    }
}
#undef SBAR
}

namespace gdn {
__device__ __forceinline__ int crow(int r, int hi) { return (r & 3) + 8 * (r >> 2) + 4 * hi; }
__device__ __forceinline__ unsigned off_b(unsigned row, unsigned ch) { return 256u * row + 16u * (ch ^ (((row & 3) << 2) | ((row >> 2) & 3))); }
#define MFMA32(a, b, c) __builtin_amdgcn_mfma_f32_32x32x16_bf16((a), (b), (c), 0, 0, 0)
#define MFMA_SETTLE(x) asm volatile("s_nop 7\n\ts_nop 7\n\ts_nop 3" : "+v"(x))
#define BAR_LDS() do { asm volatile("s_waitcnt lgkmcnt(0)" ::: "memory"); __builtin_amdgcn_s_barrier(); asm volatile("" ::: "memory"); } while (0)
#define TR_ISSUE(lo, hi_, a0, a1) asm volatile("ds_read_b64_tr_b16 %0, %2\n\tds_read_b64_tr_b16 %1, %3" : "=&v"(lo), "=&v"(hi_) : "v"(a0), "v"(a1) : "memory")
#define TR_CAT(lo, hi_) ((bf16x8){lo[0], lo[1], lo[2], lo[3], hi_[0], hi_[1], hi_[2], hi_[3]})
__device__ __forceinline__ float softplus_f(float x) { return fmaxf(x, 0.f) + log1pf(__expf(-fabsf(x))); }

__device__ __forceinline__ void phase_halo(const bf16* proj, bf16* halo, int vcu, int G, int tid) {
    for (int u = vcu; u < NB * NCHUNK * 3; u += G) {
        const int j = u % 3, cn = u / 3, n = cn % NCHUNK, b = cn / NCHUNK;
        if (n == 0) continue;
        const v4u* src = (const v4u*)(proj + (size_t)(b * SEQ + 64 * n - 3 + j) * GDN_MAIN); v4u* dst = (v4u*)(halo + (size_t)u * GDN_CONV);
        dst[tid] = src[tid]; dst[512 + tid] = src[512 + tid];
    }
}
constexpr int CV_SLOT = 67 * 256, CONV_LDS = 4 * CV_SLOT;
__device__ __forceinline__ void phase_conv(bf16* proj_, const bf16* halo_, const float* convw, LAS unsigned char* lds, int vcu, int G, int tid, int wid) {
    GAS bf16* proj = (GAS bf16*)proj_; const GAS bf16* halo = (const GAS bf16*)halo_;
    int hg_ = vcu & 63; asm volatile("" : "+s"(hg_));
    const int rg = tid >> 4, cg = tid & 15, hg = hg_, ch0 = hg * 128 + cg * 8, lane = tid & 63;
    constexpr int NU = NB * NCHUNK * 64;
    f32x4 w[4][2];
#pragma unroll
    for (int j = 0; j < 4; ++j) { w[j][0] = *(const f32x4*)(convw + j * GDN_CONV + ch0); w[j][1] = *(const f32x4*)(convw + j * GDN_CONV + ch0 + 4); }
#define CONV_DMA(u_, slot_) do { const int cn_ = (u_) >> 6, n_ = cn_ % NCHUNK, b_ = cn_ / NCHUNK; \
        _Pragma("unroll") for (int i_ = 0; i_ < 3; ++i_) if (i_ < 2 || (wid == 0)) { const int c_ = 512 * i_ + tid; const int ir_ = (c_ < 1072 ? c_ : 1071) >> 4, rr_ = ir_ - 3, cc_ = c_ & 15; \
            const GAS bf16* p_ = (rr_ >= 0 || n_ == 0) ? proj + (size_t)(b_ * SEQ + 64 * n_ + (rr_ >= 0 ? rr_ : 0)) * GDN_MAIN + hg * 128 + cc_ * 8 : halo + (size_t)(cn_ * 3 + ir_) * GDN_CONV + hg * 128 + cc_ * 8; \
            if (i_ < 2 || lane < 48) __builtin_amdgcn_global_load_lds((const GAS unsigned*)p_, (LAS unsigned*)(lds + (slot_) * CV_SLOT + (512 * i_ + wid * 64) * 16), 16, 0, 0); } } while (0)
#define CONV_BODY(u_, slot_) do { const int n_ = ((u_) >> 6) % NCHUNK; \
        v4u X[5]; _Pragma("unroll") for (int j_ = 0; j_ < 5; ++j_) X[j_] = *(const LAS v4u*)(lds + (slot_) * CV_SLOT + (2 * rg + j_) * 256 + cg * 16); \
        if (n_ == 0) { unsigned z_ = 0u; asm volatile("" : "+v"(z_)); _Pragma("unroll") for (int j_ = 0; j_ < 3; ++j_) if (2 * rg + j_ < 3) X[j_] = (v4u){z_, z_, z_, z_}; } \
        float y_[2][8]; float ss_[2]; \
        _Pragma("unroll") for (int o_ = 0; o_ < 2; ++o_) { float a_[8]; _Pragma("unroll") for (int e_ = 0; e_ < 8; ++e_) a_[e_] = 0.f; \
            _Pragma("unroll") for (int j_ = 0; j_ < 4; ++j_) { const v4u xv = X[o_ + j_]; const f32x4 w0 = w[j_][0], w1 = w[j_][1]; \
                a_[0] += w0.x * bflo(xv.x); a_[1] += w0.y * bfhi(xv.x); a_[2] += w0.z * bflo(xv.y); a_[3] += w0.w * bfhi(xv.y); \
                a_[4] += w1.x * bflo(xv.z); a_[5] += w1.y * bfhi(xv.z); a_[6] += w1.z * bflo(xv.w); a_[7] += w1.w * bfhi(xv.w); } \
            float s2_ = 0.f; _Pragma("unroll") for (int e_ = 0; e_ < 8; ++e_) { const float s_ = fsilu(a_[e_]); y_[o_][e_] = s_; s2_ += s_ * s_; } ss_[o_] = s2_; } \
        float sc_[2] = {1.f, 1.f}; \
        if (hg < 32) { _Pragma("unroll") for (int o_ = 0; o_ < 2; ++o_) { float s_ = ss_[o_]; s_ += shx(s_, 1, lane); s_ += shx(s_, 2, lane); s_ += shx(s_, 4, lane); s_ += shx(s_, 8, lane); \
                sc_[o_] = rsqrtf(s_ + NORM_EPS) * (hg < 16 ? 0.08838834764831845f : 1.f); } } \
        const int cn_ = (u_) >> 6, b_ = cn_ / NCHUNK; \
        _Pragma("unroll") for (int o_ = 0; o_ < 2; ++o_) { v4u ov; const float c_ = sc_[o_]; \
            ov.x = pk2(y_[o_][0] * c_, y_[o_][1] * c_); ov.y = pk2(y_[o_][2] * c_, y_[o_][3] * c_); ov.z = pk2(y_[o_][4] * c_, y_[o_][5] * c_); ov.w = pk2(y_[o_][6] * c_, y_[o_][7] * c_); \
            *(GAS v4u*)(proj + (size_t)(b_ * SEQ + 64 * n_ + 2 * rg + o_) * GDN_MAIN + ch0) = ov; } } while (0)
    const int u0 = vcu;
    for (int k = 0; k < 3; ++k) if (u0 + k * G < NU) CONV_DMA(u0 + k * G, k);
    for (int k = 0, u = u0; u < NU; ++k, u += G) {
        const int rem = (NU - 1 - u) / G;
        if (rem >= 2) { if (wid == 0) asm volatile("s_waitcnt vmcnt(6)" ::: "memory"); else asm volatile("s_waitcnt vmcnt(4)" ::: "memory"); }
        else if (rem == 1) { if (wid == 0) asm volatile("s_waitcnt vmcnt(3)" ::: "memory"); else asm volatile("s_waitcnt vmcnt(2)" ::: "memory"); }
        else VM_WAIT();
        BAR_LDS();
        if (rem >= 3) CONV_DMA(u + 3 * G, (k + 3) & 3);
        CONV_BODY(u, k & 3);
    }
#undef CONV_DMA
#undef CONV_BODY
}
constexpr int P_KT = 0, P_QT = 16384, P_L = 32768, P_LSZ = 12288, P_G = P_L + 8 * P_LSZ, P_B = P_G + 2048, PREP_LDS = P_B + 2048;
__device__ __forceinline__ void phase_prep(const bf16* proj_, const float* ba_, const float* a_log, const float* dt_bias, bf16* TB_, bf16* INTRA_, float* gc_,
                                           LAS unsigned char* lds, int vcu, int G, int tid, int wid, int lane) {
    const GAS bf16* proj = (const GAS bf16*)proj_; const GAS float* ba = (const GAS float*)ba_; GAS bf16* TB = (GAS bf16*)TB_; GAS bf16* INTRA = (GAS bf16*)INTRA_; GAS float* gc = (GAS float*)gc_;
    const int r32 = lane & 31, hi = lane >> 5;
    constexpr int NGRP = NB * NCHUNK * GDN_HQK / 4;
    v4u pk[2], pq[2]; float pa = 0.f, pb = 0.f;
#define PREP_LOAD(grp_, s_) do { const int hq_ = ((grp_) & 3) * 4 + (s_), cn_ = (grp_) >> 2; const size_t tk_ = (size_t)(cn_ / NCHUNK) * SEQ + 64 * (cn_ % NCHUNK); \
        _Pragma("unroll") for (int i_ = 0; i_ < 2; ++i_) { const int idx_ = tid + 512 * i_, row_ = idx_ >> 4, ch_ = idx_ & 15; \
            pk[i_] = *(const GAS v4u*)(proj + (tk_ + row_) * GDN_MAIN + GDN_KEY + hq_ * 128 + ch_ * 8); pq[i_] = *(const GAS v4u*)(proj + (tk_ + row_) * GDN_MAIN + hq_ * 128 + ch_ * 8); } \
        if (wid >= 6) { const int h_ = 2 * hq_ + wid - 6; pa = ba[(tk_ + lane) * 64 + 32 + h_]; pb = ba[(tk_ + lane) * 64 + h_]; } } while (0)
    if (vcu < NGRP) PREP_LOAD(vcu, 0);
    for (int grp = vcu; grp < NGRP; grp += G) {
        const int hq0 = (grp & 3) * 4, cn = grp >> 2, n = cn % NCHUNK, b = cn / NCHUNK;
#pragma unroll 1
        for (int s = 0; s < 4; ++s) {
            const int hq = hq0 + s;
#pragma unroll
            for (int i = 0; i < 2; ++i) { const int idx = tid + 512 * i, row = idx >> 4, ch = idx & 15;
                *(LAS v4u*)(lds + P_KT + off_b(row, ch)) = pk[i]; *(LAS v4u*)(lds + P_QT + off_b(row, ch)) = pq[i]; }
            if (wid >= 6) {
                const int vh = wid - 6, h = 2 * hq + vh;
                float gg = -__expf(a_log[h]) * softplus_f(pa + dt_bias[h]);
                int ln = lane; asm volatile("" : "+v"(ln));
#pragma unroll
                for (int o = 1; o < 64; o <<= 1) { const float t = __builtin_bit_cast(float, __builtin_amdgcn_ds_bpermute((ln >= o ? ln - o : ln) << 2, __builtin_bit_cast(int, gg))); if (ln >= o) gg += t; }
                ((LAS float*)(lds + P_G))[(2 * s + vh) * 64 + lane] = gg; ((LAS float*)(lds + P_B))[(2 * s + vh) * 64 + lane] = fsigmoid(pb);
                gc[((size_t)(b * GDN_HV + h)) * SEQ + 64 * n + lane] = gg;
            }
            if (s < 3) PREP_LOAD(grp, s + 1); else if (grp + G < NGRP) PREP_LOAD(grp + G, 0);
            __syncthreads();
            if (wid < 6) {
                const int tw = wid % 3, it = tw > 0 ? 1 : 0, jt = tw > 1 ? 1 : 0; const bool isk = wid < 3;
                const LAS unsigned char* As = lds + (isk ? P_KT : P_QT); const LAS unsigned char* Bs = lds + P_KT;
                f32x16 acc = {};
#pragma unroll
                for (int ks = 0; ks < 8; ++ks) { const bf16x8 a = *(const LAS bf16x8*)(As + off_b(32 * it + r32, 2 * ks + hi)), bb = *(const LAS bf16x8*)(Bs + off_b(32 * jt + r32, 2 * ks + hi));
                    acc = MFMA32(a, bb, acc); }
                const int j = 32 * jt + r32;
#pragma unroll
                for (int vh = 0; vh < 2; ++vh) {
                    const LAS float* Gv = (const LAS float*)(lds + P_G) + (2 * s + vh) * 64; const LAS float* Bv = (const LAS float*)(lds + P_B) + (2 * s + vh) * 64;
                    const float gj = Gv[j];
                    f32x4 gi[4], bi[4];
#pragma unroll
                    for (int g_ = 0; g_ < 4; ++g_) { gi[g_] = *(const LAS f32x4*)(Gv + 32 * it + 8 * g_ + 4 * hi); bi[g_] = *(const LAS f32x4*)(Bv + 32 * it + 8 * g_ + 4 * hi); }
                    __builtin_amdgcn_sched_barrier(0);
                    if (isk) { LAS float* L = (LAS float*)(lds + P_L + (2 * s + vh) * P_LSZ) + (it ? 1024 : 0);
#pragma unroll
                        for (int r = 0; r < 16; ++r) { const int il = crow(r, hi), i = 32 * it + il; const float v = bi[r >> 2][r & 3] * acc[r] * __expf(gi[r >> 2][r & 3] - gj); L[il * (it ? 64 : 32) + j] = (j < i) ? v : 0.f; }
                    } else { GAS bf16* dst = INTRA + ((size_t)(b * GDN_HV + 2 * hq + vh) * NCHUNK + n) * 4096;
#pragma unroll
                        for (int r = 0; r < 16; ++r) { const int i = 32 * it + crow(r, hi); const float v = acc[r] * __expf(gi[r >> 2][r & 3] - gj); dst[i * 64 + j] = (bf16)f2bf((j <= i) ? v : 0.f); }
                    }
                }
            }
            __syncthreads();
        }
        {
            const int hq = hq0 + (wid >> 1), h = 2 * hq + (wid & 1);
            const LAS float* L = (const LAS float*)(lds + P_L + wid * P_LSZ); const float bj = ((const LAS float*)(lds + P_B))[wid * 64 + lane];
            float Tc[64];
            int ln = lane; asm volatile("" : "+v"(ln));
#pragma unroll
            for (int i = 0; i < 64; ++i) Tc[i] = 0.f;
            f32x4 rb[16];
#define INV_LROW(i_) (L + ((i_) < 32 ? (i_) * 32 : 1024 + ((i_) - 32) * 64))
            Tc[0] = (ln == 0) ? 1.f : 0.f;
            rb[0] = *(const LAS f32x4*)(INV_LROW(1));
#pragma unroll
            for (int i = 1; i < 64; ++i) {
                float acc = (ln == i) ? 1.f : 0.f;
#pragma unroll
                for (int c = 0; c < (i + 3) / 4; ++c) { const f32x4 l4 = rb[c];
                    acc -= l4.x * Tc[4 * c]; acc -= l4.y * Tc[4 * c + 1]; acc -= l4.z * Tc[4 * c + 2]; acc -= l4.w * Tc[4 * c + 3];
                    __builtin_amdgcn_sched_barrier(0);
                    if (i + 1 < 64) rb[c] = *(const LAS f32x4*)(INV_LROW(i + 1) + 4 * c);
                    __builtin_amdgcn_sched_barrier(0); }
                if (i + 1 < 64 && (i + 4) / 4 > (i + 3) / 4) rb[(i + 3) / 4] = *(const LAS f32x4*)(INV_LROW(i + 1) + 4 * ((i + 3) / 4));
                Tc[i] = acc;
            }
#undef INV_LROW
            GAS bf16* dst = TB + ((size_t)(b * GDN_HV + h) * NCHUNK + n) * 4096;
#pragma unroll
            for (int i = 0; i < 64; ++i) dst[i * 64 + lane] = (bf16)f2bf(Tc[i] * bj);
        }
        __syncthreads();
    }
#undef PREP_LOAD
}
constexpr int SB_SZ = 55552, S_KT = 0, S_QT = 16384, S_TT = 32768, S_IT = 41984, S_VT = 51200, S_GG = 55296;
constexpr int S_ST = 2 * SB_SZ, ST_P = 272, S_XT = S_ST + 32 * ST_P, XT_P = 144, S_VNT = S_XT + 32 * XT_P, S_VST = S_VNT + 32 * XT_P, S_OT = S_VST + 32 * XT_P, SCAN_LDS = S_OT + 4096;
#define TRW4(a, b, c, d, e, f, g_, h_) asm volatile("s_waitcnt lgkmcnt(0)" : "+v"(a), "+v"(b), "+v"(c), "+v"(d), "+v"(e), "+v"(f), "+v"(g_), "+v"(h_) :: "memory")
struct ScanRegs { v4u k[2], q[2], t, i, v; float g; };
__device__ __forceinline__ void phase_scan(bf16* proj_, const bf16* TB_, const bf16* INTRA_, const float* gc_, LAS unsigned char* lds, int vcu, int G, int tid, int wid, int lane) {
    GAS bf16* proj = (GAS bf16*)proj_; const GAS bf16* TB = (const GAS bf16*)TB_; const GAS bf16* INTRA = (const GAS bf16*)INTRA_; const GAS float* gc = (const GAS float*)gc_;
    const int r32 = lane & 31, hi = lane >> 5, blk = (lane >> 4) & 1, q4 = (lane & 15) >> 2, p4 = lane & 3;
    const unsigned ldsb = (unsigned)(uintptr_t)lds;
    for (int u = vcu; u < NB * GDN_HV * 4; u += G) {
        const int sl = u & 3, bh = u >> 2, h = bh % GDN_HV, b = bh / GDN_HV, hq = h >> 1, e0 = sl * 32;
        ScanRegs RA, RB;
#define SCAN_LOAD(R, n_) do { const int nn_ = (n_) < NCHUNK ? (n_) : NCHUNK - 1; const size_t tok0_ = (size_t)b * SEQ + 64 * nn_; \
            _Pragma("unroll") for (int i_ = 0; i_ < 2; ++i_) { const int idx_ = tid + 512 * i_, row_ = idx_ >> 4, ch_ = idx_ & 15; \
                R.k[i_] = *(const GAS v4u*)(proj + (tok0_ + row_) * GDN_MAIN + GDN_KEY + hq * 128 + ch_ * 8); R.q[i_] = *(const GAS v4u*)(proj + (tok0_ + row_) * GDN_MAIN + hq * 128 + ch_ * 8); } \
            { const size_t mb_ = ((size_t)bh * NCHUNK + nn_) * 4096 + (tid >> 3) * 64 + (tid & 7) * 8; R.t = *(const GAS v4u*)(TB + mb_); R.i = *(const GAS v4u*)(INTRA + mb_); } \
            R.v = *(const GAS v4u*)(proj + (tok0_ + ((tid & 255) >> 2)) * GDN_MAIN + GDN_CONV / 2 + h * 128 + e0 + (tid & 3) * 8); \
            R.g = gc[(size_t)bh * SEQ + 64 * nn_ + (tid & 63)]; } while (0)
#define SCAN_WRITE(R, buf_) do { LAS unsigned char* B_ = lds + (buf_) * SB_SZ; \
            _Pragma("unroll") for (int i_ = 0; i_ < 2; ++i_) { const int idx_ = tid + 512 * i_, row_ = idx_ >> 4, ch_ = idx_ & 15; \
                *(LAS v4u*)(B_ + S_KT + off_b(row_, ch_)) = R.k[i_]; *(LAS v4u*)(B_ + S_QT + off_b(row_, ch_)) = R.q[i_]; } \
            *(LAS v4u*)(B_ + S_TT + (tid >> 3) * 144 + (tid & 7) * 16) = R.t; *(LAS v4u*)(B_ + S_IT + (tid >> 3) * 144 + (tid & 7) * 16) = R.i; \
            if (tid < 256) *(LAS v4u*)(B_ + S_VT + (tid >> 2) * 64 + (tid & 3) * 16) = R.v; \
            if (tid < 64) ((LAS float*)(B_ + S_GG))[tid] = R.g; } while (0)
        SCAN_LOAD(RA, 0);
        { unsigned z = 0u; asm volatile("" : "+v"(z)); for (int i = tid; i < (32 * ST_P) / 16; i += 512) *(LAS v4u*)(lds + S_ST + i * 16) = (v4u){z, z, z, z}; }
        VM_WAIT(); SCAN_WRITE(RA, 0);
        SCAN_LOAD(RB, 1);
        f32x16 Sacc = {};
        __syncthreads();
        const unsigned fx16 = (unsigned)(((((r32 & 3) << 2) | ((r32 >> 2) & 3)) ^ hi) << 4);
        LAS unsigned char* stR = lds + S_ST + r32 * ST_P + 16 * hi;  LAS unsigned char* stW = lds + S_ST + r32 * ST_P + 8 * hi;
        LAS unsigned char* xR = lds + S_XT + r32 * XT_P + 16 * hi;   LAS unsigned char* xW = lds + S_XT + r32 * XT_P + 8 * hi;
#define PK4W(dst, a0_, a1_, a2_, a3_) do { v2u w_; w_.x = pk2(a0_, a1_); w_.y = pk2(a2_, a3_); *(LAS v2u*)(dst) = w_; } while (0)
#define SCAN_STEP(n, RI, RO) do { \
            const int buf = (n) & 1; LAS unsigned char* B = lds + buf * SB_SZ; const LAS float* GG = (const LAS float*)(B + S_GG); \
            if (wid >= 4 && (n) > 0) {                                    \
                const int t_ = tid - 256; const v4u ov = *(const LAS v4u*)(lds + S_OT + t_ * 16); \
                *(GAS v4u*)(proj + ((size_t)b * SEQ + 64 * ((n) - 1) + (t_ >> 2)) * GDN_MAIN + GDN_CONV / 2 + h * 128 + e0 + (t_ & 3) * 8) = ov; } \
            SCAN_LOAD(RI, (n) + 2); \
            f32x16 acc = {}; \
            if (wid < 4) {                                               \
                const LAS unsigned char* Ar = B + (wid < 2 ? S_KT : S_QT) + 256 * (32 * (wid & 1) + r32); \
                bf16x8 af_[8], bf_[8]; \
                _Pragma("unroll") for (int ks = 0; ks < 8; ++ks) { af_[ks] = *(const LAS bf16x8*)(Ar + ((32u * ks) ^ fx16)); bf_[ks] = *(const LAS bf16x8*)(stR + 32 * ks); } \
                __builtin_amdgcn_sched_barrier(0);                       \
                _Pragma("unroll") for (int ks = 0; ks < 8; ++ks) acc = MFMA32(af_[ks], bf_[ks], acc); \
                if (wid < 2) {                                           \
                    f32x4 gg_[4]; unsigned short vv_[16]; \
                    _Pragma("unroll") for (int g_ = 0; g_ < 4; ++g_) { const int c0 = 32 * wid + 8 * g_ + 4 * hi; gg_[g_] = *(const LAS f32x4*)(GG + c0); \
                        _Pragma("unroll") for (int j_ = 0; j_ < 4; ++j_) vv_[4 * g_ + j_] = *(const LAS unsigned short*)(B + S_VT + (c0 + j_) * 64 + r32 * 2); } \
                    __builtin_amdgcn_sched_barrier(0); \
                    _Pragma("unroll") for (int g_ = 0; g_ < 4; ++g_) { float xv[4]; \
                        _Pragma("unroll") for (int j_ = 0; j_ < 4; ++j_) xv[j_] = bf2f(vv_[4 * g_ + j_]) - __expf(gg_[g_][j_]) * acc[4 * g_ + j_]; \
                        PK4W(xW + 64 * wid + 16 * g_, xv[0], xv[1], xv[2], xv[3]); } \
                } \
            } \
            BAR_LDS();                                                      \
            const float gl = GG[63]; \
            if (wid < 2) {                                               \
                f32x16 a3_ = {}; const LAS unsigned char* Ar_ = B + S_TT + (32 * wid + r32) * 144 + 16 * hi; \
                bf16x8 af_[4], bf_[4]; f32x4 gg_[4]; \
                _Pragma("unroll") for (int ks = 0; ks < 4; ++ks) { af_[ks] = *(const LAS bf16x8*)(Ar_ + 32 * ks); bf_[ks] = *(const LAS bf16x8*)(xR + 32 * ks); } \
                _Pragma("unroll") for (int g_ = 0; g_ < 4; ++g_) gg_[g_] = *(const LAS f32x4*)(GG + 32 * wid + 8 * g_ + 4 * hi); \
                __builtin_amdgcn_sched_barrier(0); \
                _Pragma("unroll") for (int ks = 0; ks < 4; ++ks) if (ks < 2 || wid > 0) a3_ = MFMA32(af_[ks], bf_[ks], a3_); \
                MFMA_SETTLE(a3_); \
                _Pragma("unroll") for (int g_ = 0; g_ < 4; ++g_) { const f32x4 gg = gg_[g_]; \
                    PK4W(xW + (S_VNT - S_XT) + 64 * wid + 16 * g_, a3_[4 * g_], a3_[4 * g_ + 1], a3_[4 * g_ + 2], a3_[4 * g_ + 3]); \
                    PK4W(xW + (S_VST - S_XT) + 64 * wid + 16 * g_, a3_[4 * g_] * __expf(gl - gg[0]), a3_[4 * g_ + 1] * __expf(gl - gg[1]), a3_[4 * g_ + 2] * __expf(gl - gg[2]), a3_[4 * g_ + 3] * __expf(gl - gg[3])); } \
            } \
            BAR_LDS();                                                      \
            if (wid == 2 || wid == 3) {                                  \
                const int ct = wid - 2; \
                const LAS unsigned char* Ar_ = B + S_IT + (32 * ct + r32) * 144 + 16 * hi; \
                bf16x8 af_[4], bf_[4]; f32x4 gg_[4]; \
                _Pragma("unroll") for (int g_ = 0; g_ < 4; ++g_) gg_[g_] = *(const LAS f32x4*)(GG + 32 * ct + 8 * g_ + 4 * hi); \
                _Pragma("unroll") for (int ks = 0; ks < 4; ++ks) { af_[ks] = *(const LAS bf16x8*)(Ar_ + 32 * ks); bf_[ks] = *(const LAS bf16x8*)(xR + (S_VNT - S_XT) + 32 * ks); } \
                __builtin_amdgcn_sched_barrier(0); \
                _Pragma("unroll") for (int g_ = 0; g_ < 4; ++g_) _Pragma("unroll") for (int j_ = 0; j_ < 4; ++j_) acc[4 * g_ + j_] *= __expf(gg_[g_][j_]); \
                _Pragma("unroll") for (int ks = 0; ks < 4; ++ks) if (ks < 2 || ct > 0) acc = MFMA32(af_[ks], bf_[ks], acc); \
                MFMA_SETTLE(acc); \
                _Pragma("unroll") for (int r = 0; r < 16; ++r) *(LAS unsigned short*)(lds + S_OT + (32 * ct + crow(r, hi)) * 64 + r32 * 2) = (unsigned short)f2bf(acc[r]); \
            } else if (wid >= 4) {                                       \
                const int dt = wid - 4; const float egl = __expf(gl); \
                _Pragma("unroll") for (int r = 0; r < 16; ++r) Sacc[r] *= egl; \
                  \
                const unsigned chk = (unsigned)(4 * dt + 2 * blk + (p4 >> 1)); \
                const unsigned kb0 = ldsb + buf * SB_SZ + S_KT + 256u * (8 * hi + q4) + 16u * (chk ^ (unsigned)((q4 << 2) | ((2 * hi) & 3))) + 8u * (p4 & 1); \
                const unsigned kb1 = ldsb + buf * SB_SZ + S_KT + 256u * (8 * hi + 4 + q4) + 16u * (chk ^ (unsigned)((q4 << 2) | ((2 * hi + 1) & 3))) + 8u * (p4 & 1); \
                s16x4 al0, ah0, al1, ah1, al2, ah2, al3, ah3; \
                asm volatile("ds_read_b64_tr_b16 %0, %2\n\tds_read_b64_tr_b16 %1, %3" : "=&v"(al0), "=&v"(ah0) : "v"(kb0), "v"(kb1) : "memory"); \
                asm volatile("ds_read_b64_tr_b16 %0, %2 offset:4096\n\tds_read_b64_tr_b16 %1, %3 offset:4096" : "=&v"(al1), "=&v"(ah1) : "v"(kb0), "v"(kb1) : "memory"); \
                asm volatile("ds_read_b64_tr_b16 %0, %2 offset:8192\n\tds_read_b64_tr_b16 %1, %3 offset:8192" : "=&v"(al2), "=&v"(ah2) : "v"(kb0), "v"(kb1) : "memory"); \
                asm volatile("ds_read_b64_tr_b16 %0, %2 offset:12288\n\tds_read_b64_tr_b16 %1, %3 offset:12288" : "=&v"(al3), "=&v"(ah3) : "v"(kb0), "v"(kb1) : "memory"); \
                const bf16x8 b0_ = *(const LAS bf16x8*)(xR + (S_VST - S_XT)), b1_ = *(const LAS bf16x8*)(xR + (S_VST - S_XT) + 32), b2_ = *(const LAS bf16x8*)(xR + (S_VST - S_XT) + 64), b3_ = *(const LAS bf16x8*)(xR + (S_VST - S_XT) + 96); \
                TRW4(al0, ah0, al1, ah1, al2, ah2, al3, ah3); \
                Sacc = MFMA32(TR_CAT(al0, ah0), b0_, Sacc); Sacc = MFMA32(TR_CAT(al1, ah1), b1_, Sacc); Sacc = MFMA32(TR_CAT(al2, ah2), b2_, Sacc); Sacc = MFMA32(TR_CAT(al3, ah3), b3_, Sacc); \
                MFMA_SETTLE(Sacc); \
                _Pragma("unroll") for (int g_ = 0; g_ < 4; ++g_) PK4W(stW + 64 * dt + 16 * g_, Sacc[4 * g_], Sacc[4 * g_ + 1], Sacc[4 * g_ + 2], Sacc[4 * g_ + 3]); \
            } \
            asm volatile("s_waitcnt vmcnt(8)" ::: "memory");              \
            if ((n) + 1 < NCHUNK) SCAN_WRITE(RO, buf ^ 1); \
            BAR_LDS();                                                      \
        } while (0)
        for (int n = 0; n < NCHUNK; n += 2) { SCAN_STEP(n, RA, RB); SCAN_STEP(n + 1, RB, RA); }
        if (wid >= 4) { const int t_ = tid - 256; const v4u ov = *(const LAS v4u*)(lds + S_OT + t_ * 16);
            *(GAS v4u*)(proj + ((size_t)b * SEQ + 64 * (NCHUNK - 1) + (t_ >> 2)) * GDN_MAIN + GDN_CONV / 2 + h * 128 + e0 + (t_ & 3) * 8) = ov; }
        VM_WAIT(); __syncthreads();
#undef SCAN_LOAD
#undef SCAN_WRITE
#undef SCAN_STEP
#undef PK4W
    }
}
#undef TRW4
__device__ __forceinline__ void phase_gate(bf16* proj, const float* out_norm, int gw, int NGW, int lane) {
    const int g = lane >> 4, i = lane & 15; float w[8];
#pragma unroll
    for (int e = 0; e < 8; ++e) w[e] = out_norm[8 * i + e];
    for (int m = gw; m < NT; m += NGW) {
        const bf16* orow = proj + (size_t)m * GDN_MAIN + GDN_CONV / 2; bf16* zrow = proj + (size_t)m * GDN_MAIN + GDN_CONV;
#pragma unroll 4
        for (int it = 0; it < GDN_HV / 4; ++it) {
            const int off = (4 * it + g) * 128 + 8 * i;
            const v4u ov = *(const v4u*)(orow + off), zv = *(const v4u*)(zrow + off);
            float o[8], z[8];
            o[0] = bflo(ov.x); o[1] = bfhi(ov.x); o[2] = bflo(ov.y); o[3] = bfhi(ov.y); o[4] = bflo(ov.z); o[5] = bfhi(ov.z); o[6] = bflo(ov.w); o[7] = bfhi(ov.w);
            z[0] = bflo(zv.x); z[1] = bfhi(zv.x); z[2] = bflo(zv.y); z[3] = bfhi(zv.y); z[4] = bflo(zv.z); z[5] = bfhi(zv.z); z[6] = bflo(zv.w); z[7] = bfhi(zv.w);
            float ss = 0.f;
#pragma unroll
            for (int e = 0; e < 8; ++e) ss += o[e] * o[e];
            ss += shx(ss, 1, lane); ss += shx(ss, 2, lane); ss += shx(ss, 4, lane); ss += shx(ss, 8, lane);
            const float rs = rsqrtf(ss * (1.f / 128.f) + NORM_EPS);
            float r[8];
#pragma unroll
            for (int e = 0; e < 8; ++e) r[e] = o[e] * rs * w[e] * fsilu(z[e]);
            v4u res; res.x = pk2(r[0], r[1]); res.y = pk2(r[2], r[3]); res.z = pk2(r[4], r[5]); res.w = pk2(r[6], r[7]);
            *(v4u*)(zrow + off) = res;
        }
    }
}
#undef MFMA32
#undef BAR_LDS
#undef MFMA_SETTLE
#undef TR_ISSUE
#undef TR_CAT
}

struct Args { const void* in[25]; float* out; unsigned char* ws; };
__device__ __forceinline__ int lane_id_now() { int l; asm volatile("v_mbcnt_lo_u32_b32 %0, -1, 0\n\tv_mbcnt_hi_u32_b32 %0, -1, %0" : "=v"(l)); return l; }
__global__ void __launch_bounds__(NWAVES * 64, 2) mk_fwd(Args a) {
    extern __shared__ __attribute__((aligned(16))) unsigned char lds_raw[];
    LAS unsigned char* lds = (LAS unsigned char*)lds_raw;
    const int tid0 = threadIdx.x; const int wave0 = __builtin_amdgcn_readfirstlane(tid0 >> 6);
    const int G0 = gridDim.x, bx0 = blockIdx.x, vcu0 = (G0 % 8 == 0) ? (bx0 % 8) * (G0 / 8) + bx0 / 8 : bx0;
    volatile LAS unsigned* MISC = (volatile LAS unsigned*)(lds + MISC_OFF);
    if (tid0 < 64) MISC[tid0] = 0u;
    __syncthreads();
    typedef const __attribute__((address_space(4))) unsigned long long* kargp_t;
    const kargp_t kargs0 = (kargp_t)__builtin_amdgcn_kernarg_segment_ptr();
    XcdBarrier bar = xcd_barrier_post((unsigned*)(a.ws + WS_CTL) + CW_BAR, MISC + 8);
#define BTID() (wave0 * 64 + lane_id_now())
#if PROBE_MASK
    if (tid0 == 0) { const unsigned long long t_ = __builtin_amdgcn_s_memrealtime(); MISC[16] = (unsigned)t_; MISC[17] = (unsigned)(t_ >> 32); MISC[18] = 0u; MISC[19] = 0u; }
#define GRID_BAR(cls) do { { XcdBarrier b_ = bar; asm volatile("" : "+s"(b_.bar), "+s"(b_.x)); xcd_barrier(b_, BTID()); } \
        if (BTID() == 0) { const unsigned long long now_ = __builtin_amdgcn_s_memrealtime(); const unsigned long long last_ = ((unsigned long long)MISC[17] << 32) | MISC[16]; \
            if ((cls) & PROBE_MASK) { const unsigned long long a_ = (((unsigned long long)MISC[19] << 32) | MISC[18]) + (now_ - last_); MISC[18] = (unsigned)a_; MISC[19] = (unsigned)(a_ >> 32); } \
            MISC[16] = (unsigned)now_; MISC[17] = (unsigned)(now_ >> 32); } } while (0)
#else
#define GRID_BAR(cls) do { XcdBarrier b_ = bar; asm volatile("" : "+s"(b_.bar), "+s"(b_.x)); xcd_barrier(b_, BTID()); } while (0)
#endif
#define PH() int wave = wave0; asm volatile("" : "+s"(wave)); int tid = wave * 64 + lane_id_now(); const int lane = tid & 63; \
             int G = G0, bx = bx0, vcu = vcu0; asm volatile("" : "+s"(G), "+s"(bx), "+s"(vcu)); const int NGW = G * NWAVES, NGT = G * NWAVES * 64; (void)bx; (void)NGW; (void)NGT; \
             const int gw = vcu * NWAVES + wave, gtid = vcu * (NWAVES * 64) + tid; (void)lane; (void)wave; (void)gw; (void)gtid; \
             kargp_t kp = kargs0; asm volatile("" : "+s"(kp)); unsigned char* ws = (unsigned char*)(GAS unsigned char*)kp[26]; float* out = (float*)(GAS float*)kp[25]; \
             unsigned char* wmix = ws + WS_WMIX; bf16* A0 = (bf16*)(ws + WS_A0); unsigned char* A1 = ws + WS_A1; const float* hin = layer == 0 ? (const float*)(const GAS float*)kp[0] : out; \
             LAS float* scr = (LAS float*)(lds + wave * 16384); \
             (void)out; (void)wmix; (void)A0; (void)A1; (void)hin; (void)scr
#define IN(i) ((const float*)(const GAS float*)kp[i])
#define GEMMX(F16_, EPI, Aptr, Bptr, N_, K_, lda_, ldb_, ...) do { pg8::Gemm g{(const bf16*)(Aptr), (const bf16*)(Bptr), NT, (N_), (K_), (lda_), (ldb_)}; pg8::StaticOrder S; S.init(NT, (N_), G, bx); \
             pg8::EPI E{__VA_ARGS__}; pg8::gemm_phase<pg8::EPI, pg8::StaticOrder, true, true, F16_>(lds, g, S, E, tid); } while (0)
#define GEMM(...) GEMMX(false, __VA_ARGS__)
#define GEMMH(...) GEMMX(true, __VA_ARGS__)
#define COMMA ,
#define SSY ((float*)(ws + WS_SS))
#define SSX1 ((float*)(ws + WS_SS) + 32 * NT)
#define SSX2 ((float*)(ws + WS_SS) + 64 * NT)
#define HBX ((bf16*)(A1 + A1_HBX))
#define HY ((bf16*)out)
    { const int layer = 0; PH(); phase_rope_table((const int*)(const GAS int*)kp[2], (float*)(ws + WS_ROPE), gtid, NGT); }
    { const int layer = 0; PH(); phase_cast_ss(hin, HY, SSY, gw, NGW, lane); }
    for (int layer = 0; layer < DEPTH; ++layer) {
        const int j = layer >> 1; const bool is_mla = (layer & 1) == 0;
        if (is_mla) {
            { PH(); convert_matrix<0, true>(IN(4) + (size_t)j * DM * MLA_IN, IN(3) + layer * DM, DM, MLA_IN, (bf16*)(wmix + WM_MLA_IN), 0, scr, gw, NGW, lane); }
            { PH(); zero_rows((bf16*)(wmix + WM_MLA_IN), DM, MLA_IN, MLA_IN_PAD - MLA_IN, gtid, NGT); }
            { PH(); convert_matrix<0>(IN(7) + (size_t)j * MLA_QL * (MLA_H * MLA_QK), IN(5) + j * MLA_QL, MLA_QL, MLA_H * MLA_QK, (bf16*)(wmix + WM_MLA_UQ), 0, scr, gw, NGW, lane); }
            { PH(); convert_matrix<0>(IN(8) + (size_t)j * MLA_KVL * (MLA_H * 256), IN(6) + j * MLA_KVL, MLA_KVL, MLA_H * 256, (bf16*)(wmix + WM_MLA_UKV), 0, scr, gw, NGW, lane); }
            { PH(); convert_matrix<0>(IN(11) + (size_t)j * DM * DM, nullptr, DM, DM, (bf16*)(wmix + WM_MLA_O), 0, scr, gw, NGW, lane); }
        } else {
            { PH(); convert_matrix<0, true>(IN(12) + (size_t)j * DM * GDN_IN, IN(3) + layer * DM, DM, GDN_IN, (bf16*)(wmix + WM_GDN_IN), 0, scr, gw, NGW, lane); }
            { PH(); zero_rows((bf16*)(wmix + WM_GDN_IN), DM, GDN_IN, GDN_IN_PAD - GDN_IN, gtid, NGT); }
            { PH(); convert_matrix<0>(IN(17) + (size_t)j * GDN_VAL * DM, nullptr, GDN_VAL, DM, (bf16*)(wmix + WM_GDN_OUT), 0, scr, gw, NGW, lane); }
        }
        { PH(); convert_matrix<1, true>(IN(19) + (size_t)layer * DM * (2 * DFF), IN(18) + layer * DM, DM, 2 * DFF, (bf16*)(ws + WS_WGU), 0, scr, gw, NGW, lane); }
        { PH(); convert_matrix<0>(IN(20) + (size_t)layer * DFF * DM, nullptr, DFF, DM, (bf16*)(ws + WS_WDN), 0, scr, gw, NGW, lane); }
        { PH(); convert_matrix<0>(IN(21) + (size_t)layer * PLE_DIM * DM, nullptr, PLE_DIM, DM, (bf16*)(ws + WS_WPP), 0, scr, gw, NGW, lane); }
        { PH(); convert_matrix<0, true>(IN(24) + (size_t)layer * DM * DM, IN(23) + layer * DM, DM, DM, (bf16*)(ws + WS_WPG), 0, scr, gw, NGW, lane); }
        { PH(); phase_cvt_bf16(IN(1) + (size_t)layer * NT * PLE_DIM, (bf16*)(ws + WS_PBF), (size_t)NT * PLE_DIM, gtid, NGT); }
        GRID_BAR(1<<0);
        if (is_mla) {
            { PH(); GEMMH(EpiMlaIn, HY, wmix + WM_MLA_IN, MLA_IN_PAD, DM, DM, DM, (bf16*)(A1 + A1_QKVN), (float*)(A1 + A1_KPE), (float*)(A1 + A1_C), SSY); }
            GRID_BAR(1<<1);
            { PH(); GEMM(EpiBf16Lat, A1 + A1_QKVN, wmix + WM_MLA_UQ, MLA_H * MLA_QK, MLA_QL, 1024, MLA_QL, (bf16*)(A1 + A1_QRAW), MLA_H * MLA_QK, (const float*)(A1 + A1_C), 0); }
            { PH(); GEMM(EpiBf16Lat, (bf16*)(A1 + A1_QKVN) + MLA_QL, wmix + WM_MLA_UKV, MLA_H * 256, MLA_KVL, 1024, MLA_KVL, (bf16*)(A1 + A1_KVRAW), MLA_H * 256, (const float*)(A1 + A1_C), 8); }
            GRID_BAR(1<<1);
            { PH(); phase_mla_finalize_kv((const bf16*)(A1 + A1_KVRAW), (const float*)(A1 + A1_KPE), (const float*)(ws + WS_ROPE), IN(10) + j * MLA_QK, (bf16*)(A1 + A1_KF), (bf16*)(A1 + A1_VF), gw, NGW, lane); }
            GRID_BAR(1<<2);
            { PH(); attn::attn_phase((const bf16*)(A1 + A1_QRAW), IN(9) + j * MLA_QK, (const float*)(ws + WS_ROPE), (const bf16*)(A1 + A1_KF), (const bf16*)(A1 + A1_VF), A0, (LAS char*)lds, vcu, G, tid, wave, lane); }
            GRID_BAR(1<<3);
            { PH(); GEMM(EpiResid, A0, wmix + WM_MLA_O, DM, DM, DM, DM, HY, HBX, DM, SSX1); }
            GRID_BAR(1<<1);
        } else {
            { PH(); GEMMH(EpiGdnProj, HY, wmix + WM_GDN_IN, GDN_IN_PAD, DM, DM, DM, (bf16*)(A1 + A1_PROJ), GDN_MAIN, (float*)(A1 + A1_BA), GDN_MAIN / 256, SSY, (bf16*)(A1 + A1_HALO)); }
            GRID_BAR(1<<4);
            { PH(); gdn::phase_conv((bf16*)(A1 + A1_PROJ), (const bf16*)(A1 + A1_HALO), IN(13) + (size_t)j * 4 * GDN_CONV, lds, vcu, G, tid, wave); }
            GRID_BAR(1<<5);
            { PH(); gdn::phase_prep((const bf16*)(A1 + A1_PROJ), (const float*)(A1 + A1_BA), IN(14) + j * GDN_HV, IN(15) + j * GDN_HV, A0, (bf16*)(A1 + A1_INTRA), (float*)(A1 + A1_GC), lds, vcu, G, tid, wave, lane); }
            GRID_BAR(1<<6);
            { PH(); gdn::phase_scan((bf16*)(A1 + A1_PROJ), A0, (const bf16*)(A1 + A1_INTRA), (const float*)(A1 + A1_GC), lds, vcu, G, tid, wave, lane); }
            GRID_BAR(1<<7);
            { PH(); gdn::phase_gate((bf16*)(A1 + A1_PROJ), IN(16) + j * GDN_DV, gw, NGW, lane); }
            GRID_BAR(1<<8);
            { PH(); GEMM(EpiResid, (bf16*)(A1 + A1_PROJ) + GDN_CONV, wmix + WM_GDN_OUT, DM, GDN_VAL, GDN_MAIN, GDN_VAL, HY, HBX, DM, SSX1); }
            GRID_BAR(1<<9);
        }
        { PH(); GEMMH(EpiSiluMul, HBX, ws + WS_WGU, 2 * DFF, DM, DM, DM, (bf16*)(A1 + A1_ACT), DFF, SSX1); }
        { PH(); GEMM(EpiBf16Plain, ws + WS_PBF, ws + WS_WPP, DM, PLE_DIM, PLE_DIM, PLE_DIM, (bf16*)(A1 + A1_E), DM); }
        GRID_BAR(1<<11);
        { PH(); phase_rstd_e((const bf16*)(A1 + A1_E), (float*)(A1 + A1_RSTDE), gw, NGW, lane); }
        { PH(); GEMM(EpiResid, A1 + A1_ACT, ws + WS_WDN, DM, DFF, DFF, DFF, HBX, HBX, DM, SSX2); }
        GRID_BAR(1<<12);
        if (layer + 1 < DEPTH) { PH(); GEMMH(EpiPleGate<false>, HBX, ws + WS_WPG, DM, DM, DM, DM, HBX, HY, nullptr, DM, (const bf16*)(A1 + A1_E), (const float*)(A1 + A1_RSTDE), IN(22) + layer * DM, SSX2, SSY); }
        else { PH(); GEMMH(EpiPleGate<true>, HBX, ws + WS_WPG, DM, DM, DM, DM, HBX, nullptr, out, DM, (const bf16*)(A1 + A1_E), (const float*)(A1 + A1_RSTDE), IN(22) + layer * DM, SSX2, nullptr); }
        GRID_BAR(1<<14);
    }
#if PROBE_MASK
    if (blockIdx.x == 0 && BTID() == 0) { const unsigned long long acc_ = ((unsigned long long)MISC[19] << 32) | MISC[18]; const unsigned long long t0_ = __builtin_amdgcn_s_memrealtime(); while (__builtin_amdgcn_s_memrealtime() - t0_ < acc_) __builtin_amdgcn_s_sleep(32); }
#endif
}

extern "C" void kernel_launch(void* const* d_in, const int* in_sizes, int n_in, void* d_out, int out_size, void* d_ws, size_t ws_size, hipStream_t stream) {
    static int grid = 0;
    if (grid == 0) {
        if (n_in != 25 || out_size != NT * DM || ws_size < WS_END) { fprintf(stderr, "kernel_launch: unexpected shapes: n_in %d out %d ws %zu (need %zu)\n", n_in, out_size, ws_size, (size_t)WS_END); grid = -1; return; }
        int dev = 0, cus = 0, per_cu = 0;
        if (hipGetDevice(&dev) != hipSuccess || hipDeviceGetAttribute(&cus, hipDeviceAttributeMultiprocessorCount, dev) != hipSuccess) { grid = -1; return; }
        if (hipFuncSetAttribute((const void*)mk_fwd, hipFuncAttributeMaxDynamicSharedMemorySize, LDS_BYTES) != hipSuccess) { fprintf(stderr, "kernel_launch: hipFuncSetAttribute failed\n"); grid = -1; return; }
        if (hipOccupancyMaxActiveBlocksPerMultiprocessor(&per_cu, (const void*)mk_fwd, NWAVES * 64, LDS_BYTES) != hipSuccess || per_cu < 1) { fprintf(stderr, "kernel_launch: occupancy query says %d\n", per_cu); grid = -1; (void)hipGetLastError(); return; }
        grid = cus - cus % 64;
        if (grid < 64) { fprintf(stderr, "kernel_launch: %d CUs: need at least 64\n", cus); grid = -1; return; }
    }
    if (grid < 0) return;
    if (hipMemsetAsync((char*)d_ws + WS_CTL, 0, CTL_ZERO_BYTES, stream) != hipSuccess) return;
    Args a{};
    for (int i = 0; i < 25; ++i) a.in[i] = d_in[i];
    a.out = (float*)d_out; a.ws = (unsigned char*)d_ws;
    hipLaunchKernelGGL(mk_fwd, dim3(grid), dim3(NWAVES * 64), LDS_BYTES, stream, a);
}
```

```cpp
#include <hip/hip_runtime.h>
#include <cstdio>
#include <cstdint>

#ifndef PROBE_SCAN
#define PROBE_SCAN (0)
#endif
#ifndef PROBE_ATTN
#define PROBE_ATTN (0)
#endif
#ifndef PROBE_MASK
#define PROBE_MASK (0)
#endif

#define GAS __attribute__((address_space(1)))
#define LAS __attribute__((address_space(3)))
typedef unsigned short bf16;
typedef unsigned v4u __attribute__((ext_vector_type(4)));
typedef unsigned v2u __attribute__((ext_vector_type(2)));
typedef float f32x4 __attribute__((ext_vector_type(4)));
typedef float f32x16 __attribute__((ext_vector_type(16)));
typedef short bf16x8 __attribute__((ext_vector_type(8)));
typedef short s16x4 __attribute__((ext_vector_type(4)));

constexpr int NB = 2, SEQ = 16384, NT = NB * SEQ, DM = 2048, DEPTH = 4;
constexpr float NORM_EPS = 1e-6f;
constexpr int PLE_DIM = 256;
constexpr int MLA_H = 16, MLA_QL = 512, MLA_KVL = 512, MLA_NOPE = 128, MLA_ROPE = 64, MLA_QK = 192, MLA_V = 128;
constexpr int MLA_IN = MLA_QL + MLA_KVL + MLA_ROPE, MLA_IN_PAD = 1280;
constexpr int GDN_HQK = 16, GDN_HV = 32, GDN_DK = 128, GDN_DV = 128, GDN_KEY = 2048, GDN_VAL = 4096, GDN_CONV = 8192;
constexpr int GDN_MAIN = GDN_CONV + GDN_VAL;
constexpr int GDN_IN = GDN_MAIN + 64, GDN_IN_PAD = GDN_MAIN + 256;
constexpr int NCHUNK = SEQ / 64;
constexpr int DFF = 5632;

constexpr size_t MiB = 1u << 20;
constexpr size_t WS_CTL = 0, CTL_ZERO_BYTES = 64 * 1024;
constexpr size_t WS_WMIX = 1 * MiB, WS_WGU = 66 * MiB, WS_WDN = 110 * MiB, WS_WPP = 132 * MiB, WS_WPG = 133 * MiB, WS_ROPE = 141 * MiB;
constexpr size_t WS_A0 = 149 * MiB, WS_A1 = 277 * MiB, WS_SS = 1277 * MiB, WS_PBF = 1289 * MiB, WS_END = 1305 * MiB;
constexpr size_t A1_HBX = 872 * MiB;
constexpr size_t WM_GDN_IN = 0, WM_GDN_OUT = 49 * MiB;
constexpr size_t WM_MLA_IN = 0, WM_MLA_UQ = 5 * MiB, WM_MLA_UKV = 8 * MiB, WM_MLA_O = 12 * MiB;
constexpr size_t A1_C = 0, A1_QKVN = 160 * MiB, A1_KPE = 224 * MiB, A1_QRAW = 232 * MiB, A1_KVRAW = 424 * MiB, A1_KF = 680 * MiB, A1_VF = 872 * MiB, A1_QF = 0;
constexpr size_t A1_PROJ = 0, A1_BA = 768 * MiB, A1_HALO = 776 * MiB, A1_GC = 800 * MiB, A1_INTRA = 804 * MiB;
constexpr size_t A1_ACT = 0, A1_E = 368 * MiB, A1_RSTDE = 496 * MiB;
constexpr int CW_BAR = 1024;

constexpr int LDS_BYTES = 147456;
constexpr int MISC_OFF = LDS_BYTES - 256;
constexpr int NWAVES = 8;

#define LDS_WAIT() asm volatile("s_waitcnt lgkmcnt(0)" ::: "memory")
#define VM_WAIT() asm volatile("s_waitcnt vmcnt(0)" ::: "memory")
__device__ __forceinline__ unsigned pk2(float lo, float hi) { unsigned r; asm("v_cvt_pk_bf16_f32 %0, %1, %2" : "=v"(r) : "v"(lo), "v"(hi)); return r; }
__device__ __forceinline__ unsigned f2bf(float f) { return pk2(f, f) & 0xffffu; }
typedef _Float16 h16x2 __attribute__((ext_vector_type(2)));
__device__ __forceinline__ unsigned pkh2(float lo, float hi) { const h16x2 v = {(_Float16)lo, (_Float16)hi}; return __builtin_bit_cast(unsigned, v); }
__device__ __forceinline__ float bf2f(unsigned short b) { return __uint_as_float(((unsigned)b) << 16); }
__device__ __forceinline__ float bflo(unsigned w) { return __uint_as_float(w << 16); }
__device__ __forceinline__ float bfhi(unsigned w) { return __uint_as_float(w & 0xffff0000u); }
__device__ __forceinline__ float shx(float v, int mask, int lane) { return __builtin_bit_cast(float, __builtin_amdgcn_ds_bpermute((lane ^ mask) << 2, __builtin_bit_cast(int, v))); }
__device__ __forceinline__ float wave_sum(float v, int lane) {
#pragma unroll
    for (int o = 1; o < 64; o <<= 1) v += shx(v, o, lane);
    return v;
}
__device__ __forceinline__ float fsigmoid(float x) { return __builtin_amdgcn_rcpf(1.0f + __builtin_amdgcn_exp2f(-1.4426950408889634f * x)); }
__device__ __forceinline__ float fsilu(float x) { return x * fsigmoid(x); }

namespace pg8 {
#define PG8_LAS __attribute__((address_space(3)))
typedef unsigned short bf16_t;
typedef short bf16x8 __attribute__((ext_vector_type(8)));
typedef float f32x4 __attribute__((ext_vector_type(4)));
typedef unsigned u32x4 __attribute__((ext_vector_type(4)));
constexpr int BM = 256, BK = 64, HALF = 128, HTB = HALF * BK * 2  , STAGE_BYTES = 8 * HTB, NXCD = 8, WGM = 8;

__host__ __device__ __forceinline__ int lds_byte(int r, int c) { const int st = (r >> 4) * 2 + (c >> 5), rr = r & 15, cc = c & 31, ob = rr * 64 + cc * 2; return st * 1024 + (ob ^ (((ob >> 9) & 1) << 5)); }
__host__ __device__ __forceinline__ void stage_rc(int b, int& R, int& C) { const int st = b / 1024, sb = b % 1024, swz = sb ^ (((sb >> 9) & 1) << 5); R = (st >> 1) * 16 + swz / 64; C = (st & 1) * 32 + (swz % 64) / 2; }
__host__ __device__ __forceinline__ int perm32(int rho) { const int n = rho >> 4, i = rho & 15; return 8 * (i >> 2) + 4 * n + (i & 3); }

struct Unit { int pm, pn; };
struct Gemm { const bf16_t* A; const bf16_t* Bt; int M, N, K, lda, ldb; };

struct StaticOrder {
    int nM, nN, nwg, G, c;
    __host__ __device__ void init(int M, int N, int G_, int c_) { nM = M / BM; nN = N / BM; nwg = nM * nN; G = G_; c = c_; }
    __host__ __device__ bool next(int i, Unit& u) const {
        const long L = (long)i * G + c; if (L >= nwg) return false;
        int wgid = (int)L; { const int q = nwg / NXCD, r = nwg % NXCD, xcd = wgid % NXCD, off = wgid / NXCD; wgid = (xcd < r ? xcd * (q + 1) : r * (q + 1) + (xcd - r) * q) + off; }
        const int nig = WGM * nN, gid = wgid / nig, fm = gid * WGM, gsz = (nM - fm) < WGM ? (nM - fm) : WGM;
        u.pm = fm + ((wgid % nig) % gsz); u.pn = (wgid % nig) / gsz; return true;
    }
    __device__ __forceinline__ void a_ready(const Unit&) const {}
    __device__ __forceinline__ void done(const Unit&) const {}
};

__device__ __forceinline__ unsigned cvt_pk_bf16(float lo, float hi) { unsigned r; asm volatile("v_cvt_pk_bf16_f32 %0, %1, %2" : "=v"(r) : "v"(lo), "v"(hi)); return r; }
typedef float f32x2 __attribute__((ext_vector_type(2)));
__device__ __forceinline__ float fast_sigmoid(float x) { return __builtin_amdgcn_rcpf(1.0f + __builtin_amdgcn_exp2f(-1.4426950408889634f * x)); }

__device__ __forceinline__ float sum_fq(float s) {
    { const auto r = __builtin_amdgcn_permlane16_swap(__float_as_uint(s), __float_as_uint(s), false, false); s = __uint_as_float(r[0]) + __uint_as_float(r[1]); }
    { const auto r = __builtin_amdgcn_permlane32_swap(__float_as_uint(s), __float_as_uint(s), false, false); s = __uint_as_float(r[0]) + __uint_as_float(r[1]); }
    return s;
}
__device__ __forceinline__ float row_rstd(const float* ssp, int row, int fq) {
    const f32x4 a = *(const f32x4*)(ssp + (size_t)row * 32 + fq * 8), b = *(const f32x4*)(ssp + (size_t)row * 32 + fq * 8 + 4);
    float s = ((a[0] + a[1]) + (a[2] + a[3])) + ((b[0] + b[1]) + (b[2] + b[3]));
    s = sum_fq(s);
    return rsqrtf(s * (1.f / 2048.f) + 1e-6f);
}

struct EpiF32Plain {
    static constexpr bool PERM = false, AFTER_DRAIN = false;
    float* C; int ldc; const float* ss;
    __device__ __forceinline__ void operator()(const f32x4 (&acc)[2][2][4][2], const Unit& u, int wr, int wc, int fr, int fq) const {
        const int row0 = u.pm * BM + wr * 64 + fr, col0 = u.pn * BM + wc * 32 + 4 * fq;
#pragma unroll
        for (int ai = 0; ai < 2; ++ai)
#pragma unroll
            for (int m = 0; m < 4; ++m) { const int row = row0 + ai * HALF + m * 16; float* rowp = C + (size_t)row * ldc + col0; const float rs = row_rstd(ss, row, fq);
#pragma unroll
                for (int bj = 0; bj < 2; ++bj)
#pragma unroll
                    for (int n = 0; n < 2; ++n) *(f32x4*)(rowp + bj * HALF + n * 16) = acc[ai][bj][m][n] * rs; }
    }
};
struct EpiMlaIn {
    static constexpr bool PERM = true, AFTER_DRAIN = false;
    bf16_t* O; float* KPE; float* ssl; const float* ss;
    __device__ __forceinline__ void operator()(const f32x4 (&acc)[2][2][4][2], const Unit& u, int wr, int wc, int fr, int fq) const {
        const int row0 = u.pm * BM + wr * 64 + fr;
        if (u.pn < 4) {
            const int col0 = u.pn * BM + wc * 32 + 8 * fq;
#pragma unroll
            for (int ai = 0; ai < 2; ++ai)
#pragma unroll
                for (int m = 0; m < 4; ++m) { const int row = row0 + ai * HALF + m * 16; bf16_t* rowp = O + (size_t)row * 1024 + col0; const float rs = row_rstd(ss, row, fq); float sq = 0.f;
#pragma unroll
                    for (int bj = 0; bj < 2; ++bj) { const f32x4 v0 = acc[ai][bj][m][0] * rs, v1 = acc[ai][bj][m][1] * rs;
                        u32x4 w; w.x = cvt_pk_bf16(v0[0], v0[1]); w.y = cvt_pk_bf16(v0[2], v0[3]); w.z = cvt_pk_bf16(v1[0], v1[1]); w.w = cvt_pk_bf16(v1[2], v1[3]);
                        *(u32x4*)(rowp + bj * HALF) = w;
                        sq += ((v0[0] * v0[0] + v0[1] * v0[1]) + (v0[2] * v0[2] + v0[3] * v0[3])) + ((v1[0] * v1[0] + v1[1] * v1[1]) + (v1[2] * v1[2] + v1[3] * v1[3])); }
                    sq = sum_fq(sq);
                    if (fq == 0) ssl[(size_t)row * 16 + u.pn * 4 + wc] = sq; }
        } else if (wc < 2) {
            const int col0 = wc * 32 + 8 * fq;
#pragma unroll
            for (int ai = 0; ai < 2; ++ai)
#pragma unroll
                for (int m = 0; m < 4; ++m) { const int row = row0 + ai * HALF + m * 16; float* rowp = KPE + (size_t)row * 64 + col0; const float rs = row_rstd(ss, row, fq);
                    *(f32x4*)(rowp) = acc[ai][0][m][0] * rs; *(f32x4*)(rowp + 4) = acc[ai][0][m][1] * rs; }
        }
    }
};
struct EpiBf16Lat {
    static constexpr bool PERM = true, AFTER_DRAIN = false;
    bf16_t* O; int ldc; const float* ssl; int slot0;
    __device__ __forceinline__ void operator()(const f32x4 (&acc)[2][2][4][2], const Unit& u, int wr, int wc, int fr, int fq) const {
        const int row0 = u.pm * BM + wr * 64 + fr, col0 = u.pn * BM + wc * 32 + 8 * fq;
#pragma unroll
        for (int ai = 0; ai < 2; ++ai)
#pragma unroll
            for (int m = 0; m < 4; ++m) { const int row = row0 + ai * HALF + m * 16; bf16_t* rowp = O + (size_t)row * ldc + col0;
                const f32x2 pr = *(const f32x2*)(ssl + (size_t)row * 16 + slot0 + 2 * fq); float s = pr[0] + pr[1]; s = sum_fq(s);
                const float rs = rsqrtf(s * (1.f / 512.f) + 1e-6f);
#pragma unroll
                for (int bj = 0; bj < 2; ++bj) { const f32x4 v0 = acc[ai][bj][m][0] * rs, v1 = acc[ai][bj][m][1] * rs;
                    u32x4 w; w.x = cvt_pk_bf16(v0[0], v0[1]); w.y = cvt_pk_bf16(v0[2], v0[3]); w.z = cvt_pk_bf16(v1[0], v1[1]); w.w = cvt_pk_bf16(v1[2], v1[3]);
                    *(u32x4*)(rowp + bj * HALF) = w; } }
    }
};
struct EpiBf16Plain {
    static constexpr bool PERM = true, AFTER_DRAIN = false;
    bf16_t* O; int ldc;
    __device__ __forceinline__ void operator()(const f32x4 (&acc)[2][2][4][2], const Unit& u, int wr, int wc, int fr, int fq) const {
        const int row0 = u.pm * BM + wr * 64 + fr, col0 = u.pn * BM + wc * 32 + 8 * fq;
#pragma unroll
        for (int ai = 0; ai < 2; ++ai)
#pragma unroll
            for (int m = 0; m < 4; ++m) { bf16_t* rowp = O + (size_t)(row0 + ai * HALF + m * 16) * ldc + col0;
#pragma unroll
                for (int bj = 0; bj < 2; ++bj) { const f32x4 v0 = acc[ai][bj][m][0], v1 = acc[ai][bj][m][1];
                    u32x4 w; w.x = cvt_pk_bf16(v0[0], v0[1]); w.y = cvt_pk_bf16(v0[2], v0[3]); w.z = cvt_pk_bf16(v1[0], v1[1]); w.w = cvt_pk_bf16(v1[2], v1[3]);
                    *(u32x4*)(rowp + bj * HALF) = w; } }
    }
};
struct EpiGdnProj {
    static constexpr bool PERM = true, AFTER_DRAIN = false;
    bf16_t* O; int ldc; float* BA; int ntile_bf; const float* ss; bf16_t* halo;
    __device__ __forceinline__ void operator()(const f32x4 (&acc)[2][2][4][2], const Unit& u, int wr, int wc, int fr, int fq) const {
        const int row0 = u.pm * BM + wr * 64 + fr;
        if (u.pn < ntile_bf) {
            const int col0 = u.pn * BM + wc * 32 + 8 * fq;
#pragma unroll
            for (int ai = 0; ai < 2; ++ai)
#pragma unroll
                for (int m = 0; m < 4; ++m) { const int row = row0 + ai * HALF + m * 16; bf16_t* rowp = O + (size_t)row * ldc + col0; const float rs = row_rstd(ss, row, fq);
#pragma unroll
                    for (int bj = 0; bj < 2; ++bj) { const f32x4 v0 = acc[ai][bj][m][0] * rs, v1 = acc[ai][bj][m][1] * rs;
                        u32x4 w; w.x = cvt_pk_bf16(v0[0], v0[1]); w.y = cvt_pk_bf16(v0[2], v0[3]); w.z = cvt_pk_bf16(v1[0], v1[1]); w.w = cvt_pk_bf16(v1[2], v1[3]);
                        *(u32x4*)(rowp + bj * HALF) = w;
                        if ((row & 63) >= 61 && u.pn < 32 && ((row >> 6) & 255) != 255) *(u32x4*)(halo + ((size_t)((row >> 6) + 1) * 3 + (row & 63) - 61) * 8192 + col0 + bj * HALF) = w; } }
        } else if (wc < 2) {
            const int col0 = wc * 32 + 8 * fq;
#pragma unroll
            for (int ai = 0; ai < 2; ++ai)
#pragma unroll
                for (int m = 0; m < 4; ++m) { const int row = row0 + ai * HALF + m * 16; float* rowp = BA + (size_t)row * 64 + col0; const float rs = row_rstd(ss, row, fq);
                    *(f32x4*)(rowp) = acc[ai][0][m][0] * rs; *(f32x4*)(rowp + 4) = acc[ai][0][m][1] * rs; }
        }
    }
};
struct EpiSiluMul {
    static constexpr bool PERM = true, AFTER_DRAIN = false;
    bf16_t* O; int ldc; const float* ss;
    __device__ __forceinline__ void operator()(const f32x4 (&acc)[2][2][4][2], const Unit& u, int wr, int wc, int fr, int fq) const {
        const int row0 = u.pm * BM + wr * 64 + fr, col0 = u.pn * HALF + wc * 32 + 8 * fq;
#pragma unroll
        for (int ai = 0; ai < 2; ++ai)
#pragma unroll
            for (int m = 0; m < 4; ++m) { const int row = row0 + ai * HALF + m * 16; bf16_t* rowp = O + (size_t)row * ldc + col0; const float rs = row_rstd(ss, row, fq);
                f32x4 r0, r1;
#pragma unroll
                for (int j = 0; j < 4; ++j) { const float g0 = acc[ai][0][m][0][j] * rs, g1 = acc[ai][0][m][1][j] * rs;
                    r0[j] = g0 * fast_sigmoid(g0) * (acc[ai][1][m][0][j] * rs); r1[j] = g1 * fast_sigmoid(g1) * (acc[ai][1][m][1][j] * rs); }
                u32x4 w; w.x = cvt_pk_bf16(r0[0], r0[1]); w.y = cvt_pk_bf16(r0[2], r0[3]); w.z = cvt_pk_bf16(r1[0], r1[1]); w.w = cvt_pk_bf16(r1[2], r1[3]);
                *(u32x4*)(rowp) = w; }
    }
};
typedef _Float16 h2_t __attribute__((ext_vector_type(2)));
__device__ __forceinline__ unsigned pkh(float a, float b) { const h2_t v = {(_Float16)a, (_Float16)b}; return __builtin_bit_cast(unsigned, v); }
__device__ __forceinline__ float hlo(unsigned w) { return (float)__builtin_bit_cast(h2_t, w)[0]; }
__device__ __forceinline__ float hhi(unsigned w) { return (float)__builtin_bit_cast(h2_t, w)[1]; }
struct EpiResid {
    static constexpr bool PERM = true, AFTER_DRAIN = false;
    const bf16_t* base16; bf16_t* out16; int ldc; float* ssout;
    __device__ __forceinline__ void operator()(const f32x4 (&acc)[2][2][4][2], const Unit& u, int wr, int wc, int fr, int fq) const {
        const int row0 = u.pm * BM + wr * 64 + fr, col0 = u.pn * BM + wc * 32 + 8 * fq;
#pragma unroll
        for (int ai = 0; ai < 2; ++ai) {
            u32x4 bs[4][2];
#pragma unroll
            for (int m = 0; m < 4; ++m) { const size_t off = (size_t)(row0 + ai * HALF + m * 16) * ldc + col0; bs[m][0] = *(const u32x4*)(base16 + off); bs[m][1] = *(const u32x4*)(base16 + off + HALF); }
#pragma unroll
            for (int m = 0; m < 4; ++m) { const int row = row0 + ai * HALF + m * 16; const size_t off = (size_t)row * ldc + col0; float sq = 0.f;
#pragma unroll
                for (int bj = 0; bj < 2; ++bj) { const u32x4 b = bs[m][bj]; const f32x4 a0 = acc[ai][bj][m][0], a1 = acc[ai][bj][m][1];
                    const float o0 = hlo(b.x) + a0[0], o1 = hhi(b.x) + a0[1], o2 = hlo(b.y) + a0[2], o3 = hhi(b.y) + a0[3], o4 = hlo(b.z) + a1[0], o5 = hhi(b.z) + a1[1], o6 = hlo(b.w) + a1[2], o7 = hhi(b.w) + a1[3];
                    u32x4 hw; hw.x = pkh(o0, o1); hw.y = pkh(o2, o3); hw.z = pkh(o4, o5); hw.w = pkh(o6, o7); *(u32x4*)(out16 + off + bj * HALF) = hw;
                    sq += ((o0 * o0 + o1 * o1) + (o2 * o2 + o3 * o3)) + ((o4 * o4 + o5 * o5) + (o6 * o6 + o7 * o7)); }
                sq = sum_fq(sq);
                if (fq == 0) ssout[(size_t)row * 32 + u.pn * 4 + wc] = sq; }
            asm volatile("" ::: "memory");
        }
    }
};
template <bool FINAL> struct EpiPleGate {
    static constexpr bool PERM = true, AFTER_DRAIN = false;
    const bf16_t* base16; bf16_t* out16; float* outf; int ldc; const bf16_t* e; const float* rstd; const float* wn; const float* ssin; float* ssout;
    __device__ __forceinline__ void operator()(const f32x4 (&acc)[2][2][4][2], const Unit& u, int wr, int wc, int fr, int fq) const {
        const int row0 = u.pm * BM + wr * 64 + fr, col0 = u.pn * BM + wc * 32 + 8 * fq;
#pragma unroll
        for (int am = 0; am < 4; ++am) { const int ai = am >> 1;
            u32x4 bs[4][2], ev[4][2]; float rs[4], ri[4];
#pragma unroll
            for (int m = 2 * (am & 1); m < 2 * (am & 1) + 2; ++m) { const int row = row0 + ai * HALF + m * 16; const size_t off = (size_t)row * ldc + col0; rs[m] = rstd[row]; ri[m] = row_rstd(ssin, row, fq);
#pragma unroll
                for (int bj = 0; bj < 2; ++bj) { bs[m][bj] = *(const u32x4*)(base16 + off + bj * HALF); ev[m][bj] = *(const u32x4*)(e + off + bj * HALF); } }
#pragma unroll
            for (int m = 2 * (am & 1); m < 2 * (am & 1) + 2; ++m) { const int row = row0 + ai * HALF + m * 16; const size_t off = (size_t)row * ldc + col0; float sq = 0.f;
#pragma unroll
                for (int bj = 0; bj < 2; ++bj) { const f32x4 w0 = *(const f32x4*)(wn + col0 + bj * HALF), w1 = *(const f32x4*)(wn + col0 + bj * HALF + 4); const u32x4 ew = ev[m][bj], b = bs[m][bj];
                    const f32x4 a0 = acc[ai][bj][m][0], a1 = acc[ai][bj][m][1]; const float rsv = rs[m], riv = ri[m];
                    const float o0 = hlo(b.x) + __uint_as_float(ew.x << 16) * rsv * w0[0] * fast_sigmoid(a0[0] * riv), o1 = hhi(b.x) + __uint_as_float(ew.x & 0xffff0000u) * rsv * w0[1] * fast_sigmoid(a0[1] * riv);
                    const float o2 = hlo(b.y) + __uint_as_float(ew.y << 16) * rsv * w0[2] * fast_sigmoid(a0[2] * riv), o3 = hhi(b.y) + __uint_as_float(ew.y & 0xffff0000u) * rsv * w0[3] * fast_sigmoid(a0[3] * riv);
                    const float o4 = hlo(b.z) + __uint_as_float(ew.z << 16) * rsv * w1[0] * fast_sigmoid(a1[0] * riv), o5 = hhi(b.z) + __uint_as_float(ew.z & 0xffff0000u) * rsv * w1[1] * fast_sigmoid(a1[1] * riv);
                    const float o6 = hlo(b.w) + __uint_as_float(ew.w << 16) * rsv * w1[2] * fast_sigmoid(a1[2] * riv), o7 = hhi(b.w) + __uint_as_float(ew.w & 0xffff0000u) * rsv * w1[3] * fast_sigmoid(a1[3] * riv);
                    if constexpr (FINAL) { *(f32x4*)(outf + off + bj * HALF) = (f32x4){o0, o1, o2, o3}; *(f32x4*)(outf + off + bj * HALF + 4) = (f32x4){o4, o5, o6, o7}; }
                    else { u32x4 hw; hw.x = pkh(o0, o1); hw.y = pkh(o2, o3); hw.z = pkh(o4, o5); hw.w = pkh(o6, o7); *(u32x4*)(out16 + off + bj * HALF) = hw;
                        sq += ((o0 * o0 + o1 * o1) + (o2 * o2 + o3 * o3)) + ((o4 * o4 + o5 * o5) + (o6 * o6 + o7 * o7)); } }
                if constexpr (!FINAL) { sq = sum_fq(sq); if (fq == 0) ssout[(size_t)row * 32 + u.pn * 4 + wc] = sq; } }
            asm volatile("" ::: "memory");
        }
    }
};

typedef _Float16 f16x8 __attribute__((ext_vector_type(8)));
template <bool F16> __device__ __forceinline__ f32x4 mma16(bf16x8 b, bf16x8 a, f32x4 c) {
    if constexpr (F16) return __builtin_amdgcn_mfma_f32_16x16x32_f16(__builtin_bit_cast(f16x8, b), __builtin_bit_cast(f16x8, a), c, 0, 0, 0);
    else return __builtin_amdgcn_mfma_f32_16x16x32_bf16(b, a, c, 0, 0, 0);
}
template <class Epi, class Sched, bool ALIGN_EPI = false, bool SP2 = false, bool F16 = false>
__device__ __forceinline__ void gemm_phase(PG8_LAS unsigned char* lds, const Gemm g, const Sched& S, const Epi& E, const int tid_in  ) {
    int tid_ = tid_in; asm volatile("" : "+v"(tid_));
    const int tid = tid_, wid = __builtin_amdgcn_readfirstlane(tid >> 6), lane = tid & 63, wr = wid >> 2, wc = wid & 3, fr = lane & 15, fq = lane >> 4;
    const int K = g.K, nt = K / BK;
    unsigned voffA[2], voffB[2];
#pragma unroll
    for (int i = 0; i < 2; ++i) { int R, C; stage_rc(tid * 16 + i * 8192, R, C); const int Rb = Epi::PERM ? ((R & ~31) + perm32(R & 31)) : R;
        voffA[i] = (unsigned)(R * g.lda + C) * 2u; voffB[i] = (unsigned)(Rb * g.ldb + C) * 2u; }
    const size_t kstep = (size_t)(BK * 2);
    const size_t hstepA = (size_t)HALF * g.lda * 2, hstepB = (size_t)HALF * g.ldb * 2;
    const size_t tstepA = 2 * hstepA, tstepB = 2 * hstepB;
    const unsigned ldsw = (unsigned)wid * 1024u;
    const int aoff = lds_byte(wr * 64 + fr, fq * 8), boff = lds_byte(wc * 32 + fr, fq * 8);
#define PG8_SA(b, h) (((b) * 2 + (h)) * HTB)
#define PG8_SB(b, h) ((4 + (b) * 2 + (h)) * HTB)
#define PG8_STAGE(bufoff, gbase, voff) do { _Pragma("unroll") for (int _i = 0; _i < 2; ++_i) \
        __builtin_amdgcn_global_load_lds((const unsigned*)((const char*)(gbase) + (voff)[_i]), (PG8_LAS unsigned*)(lds + (bufoff) + ldsw + _i * 8192), 16, 0, 0); } while (0)
#define PG8_LDA(dst, b, h) do { _Pragma("unroll") for (int m = 0; m < 4; ++m) _Pragma("unroll") for (int k = 0; k < 2; ++k) dst[m][k] = *(const PG8_LAS bf16x8*)(lds + PG8_SA(b, h) + aoff + m * 2048 + k * 1024); } while (0)
#define PG8_LDB(dst, b, h) do { _Pragma("unroll") for (int n = 0; n < 2; ++n) _Pragma("unroll") for (int k = 0; k < 2; ++k) dst[n][k] = *(const PG8_LAS bf16x8*)(lds + PG8_SB(b, h) + boff + n * 2048 + k * 1024); } while (0)
#define PG8_MMA(ai, bj, At, Bt) do { __builtin_amdgcn_s_setprio(1); _Pragma("unroll") for (int m = 0; m < 4; ++m) _Pragma("unroll") for (int n = 0; n < 2; ++n) _Pragma("unroll") for (int k = 0; k < 2; ++k) \
        acc[ai][bj][m][n] = mma16<F16>(Bt[n][k], At[m][k], acc[ai][bj][m][n]); __builtin_amdgcn_s_setprio(0); } while (0)
#define PG8_WAIT_V(n) asm volatile("s_waitcnt vmcnt(" #n ")" ::: "memory")
#define PG8_WAIT_L(n) asm volatile("s_waitcnt lgkmcnt(" #n ")" ::: "memory")
#define PG8_BAR __builtin_amdgcn_s_barrier()
#define PG8_SCHED __builtin_amdgcn_sched_barrier(0)
    Unit cur, nxt; int ui = 0;
    if (!S.next(0, cur)) return;
    f32x4 acc[2][2][4][2];
#pragma unroll
    for (int a = 0; a < 2; ++a)
#pragma unroll
        for (int b = 0; b < 2; ++b)
#pragma unroll
            for (int m = 0; m < 4; ++m)
#pragma unroll
                for (int n = 0; n < 2; ++n) acc[a][b][m][n] = (f32x4){0.f, 0.f, 0.f, 0.f};
    bf16x8 At[4][2], B0[2][2], B1[2][2];
    const char* cA = (const char*)g.A + (size_t)cur.pm * tstepA; const char* cB = (const char*)g.Bt + (size_t)cur.pn * tstepB;
    S.a_ready(cur);
    if constexpr (SP2) {
        PG8_STAGE(PG8_SB(0, 0), cB, voffB); PG8_STAGE(PG8_SB(0, 1), cB + hstepB, voffB); PG8_STAGE(PG8_SA(0, 0), cA, voffA); PG8_STAGE(PG8_SA(0, 1), cA + hstepA, voffA);
        if (wr == 1) PG8_BAR;
        PG8_WAIT_V(2); PG8_BAR;
        PG8_STAGE(PG8_SB(1, 0), cB + kstep, voffB); PG8_STAGE(PG8_SA(1, 0), cA + kstep, voffA); PG8_STAGE(PG8_SB(1, 1), cB + hstepB + kstep, voffB);
        PG8_WAIT_V(6); PG8_BAR;
    } else {
        PG8_STAGE(PG8_SB(0, 0), cB, voffB); PG8_STAGE(PG8_SA(0, 0), cA, voffA); PG8_STAGE(PG8_SB(0, 1), cB + hstepB, voffB); PG8_STAGE(PG8_SA(0, 1), cA + hstepA, voffA);
        if (wr == 1) PG8_BAR;
        PG8_WAIT_V(4); PG8_BAR;
        PG8_STAGE(PG8_SB(1, 0), cB + kstep, voffB); PG8_STAGE(PG8_SA(1, 0), cA + kstep, voffA); PG8_STAGE(PG8_SB(1, 1), cB + hstepB + kstep, voffB);
        PG8_WAIT_V(6); PG8_BAR;
    }
    for (;;) {
        const bool has_next = S.next(ui + 1, nxt);
        const char* nA = has_next ? (const char*)g.A + (size_t)nxt.pm * tstepA : cA; const char* nB = has_next ? (const char*)g.Bt + (size_t)nxt.pn * tstepB : cB;
        for (int t = 0; t < nt; t += 2) {
            const bool last = (t == nt - 2);
            const char* a1 = cA + (size_t)(t + 1) * kstep;
            const char* a2 = last ? nA : cA + (size_t)(t + 2) * kstep; const char* b2 = last ? nB : cB + (size_t)(t + 2) * kstep;
            const char* a3 = a2 + kstep; const char* b3 = b2 + kstep;
            if (last && has_next) S.a_ready(nxt);
            if constexpr (SP2) {
            PG8_LDB(B0, 0, 0); PG8_LDB(B1, 0, 1); PG8_SCHED; PG8_LDA(At, 0, 0); PG8_STAGE(PG8_SA(1, 1), a1 + hstepA, voffA);
            PG8_WAIT_V(8); PG8_WAIT_L(0); PG8_BAR; PG8_MMA(0, 0, At, B0); PG8_MMA(0, 1, At, B1); PG8_BAR; PG8_SCHED;
            PG8_LDA(At, 0, 1); PG8_STAGE(PG8_SB(0, 0), b2, voffB); PG8_STAGE(PG8_SB(0, 1), b2 + hstepB, voffB); PG8_STAGE(PG8_SA(0, 0), a2, voffA);
            PG8_WAIT_V(8); PG8_WAIT_L(0); PG8_BAR; PG8_MMA(1, 0, At, B0); PG8_MMA(1, 1, At, B1); PG8_BAR; PG8_SCHED;
            PG8_LDB(B0, 1, 0); PG8_LDB(B1, 1, 1); PG8_SCHED; PG8_LDA(At, 1, 0); PG8_STAGE(PG8_SA(0, 1), a2 + hstepA, voffA);
            PG8_WAIT_V(8); PG8_WAIT_L(0); PG8_BAR; PG8_MMA(0, 0, At, B0); PG8_MMA(0, 1, At, B1); PG8_BAR; PG8_SCHED;
            PG8_LDA(At, 1, 1); PG8_STAGE(PG8_SB(1, 0), b3, voffB); PG8_STAGE(PG8_SB(1, 1), b3 + hstepB, voffB); PG8_STAGE(PG8_SA(1, 0), a3, voffA);
            PG8_WAIT_V(8); PG8_WAIT_L(0); PG8_BAR; PG8_MMA(1, 0, At, B0); PG8_MMA(1, 1, At, B1); PG8_BAR; PG8_SCHED;
            } else {
            PG8_LDB(B0, 0, 0); PG8_SCHED; PG8_LDA(At, 0, 0); PG8_STAGE(PG8_SA(1, 1), a1 + hstepA, voffA);
            PG8_WAIT_L(8); PG8_BAR; PG8_WAIT_L(0); PG8_MMA(0, 0, At, B0); PG8_BAR; PG8_SCHED;
            PG8_LDB(B1, 0, 1); PG8_STAGE(PG8_SB(0, 0), b2, voffB);
            PG8_BAR; PG8_WAIT_L(0); PG8_MMA(0, 1, At, B1); PG8_BAR;
            PG8_LDA(At, 0, 1); PG8_STAGE(PG8_SA(0, 0), a2, voffA);
            PG8_BAR; PG8_WAIT_L(0); PG8_MMA(1, 0, At, B0); PG8_BAR; PG8_SCHED;
            PG8_STAGE(PG8_SB(0, 1), b2 + hstepB, voffB);
            PG8_WAIT_V(6); PG8_BAR; PG8_MMA(1, 1, At, B1); PG8_BAR;
            PG8_LDB(B0, 1, 0); PG8_SCHED; PG8_LDA(At, 1, 0); PG8_STAGE(PG8_SA(0, 1), a2 + hstepA, voffA);
            PG8_WAIT_L(8); PG8_BAR; PG8_WAIT_L(0); PG8_MMA(0, 0, At, B0); PG8_BAR; PG8_SCHED;
            PG8_LDB(B1, 1, 1); PG8_STAGE(PG8_SB(1, 0), b3, voffB);
            PG8_BAR; PG8_WAIT_L(0); PG8_MMA(0, 1, At, B1); PG8_BAR;
            PG8_LDA(At, 1, 1); PG8_STAGE(PG8_SA(1, 0), a3, voffA);
            PG8_BAR; PG8_WAIT_L(0); PG8_MMA(1, 0, At, B0); PG8_BAR; PG8_SCHED;
            PG8_STAGE(PG8_SB(1, 1), b3 + hstepB, voffB);
            PG8_WAIT_V(6); PG8_BAR; PG8_MMA(1, 1, At, B1); PG8_BAR;
            }
        }
        if constexpr (ALIGN_EPI) { if (wr == 0) PG8_BAR; }
        if constexpr (!Epi::AFTER_DRAIN) { E(acc, cur, wr, wc, fr, fq); S.done(cur); }
        if (!has_next) break;
#pragma unroll
        for (int a = 0; a < 2; ++a)
#pragma unroll
            for (int b = 0; b < 2; ++b)
#pragma unroll
                for (int m = 0; m < 4; ++m)
#pragma unroll
                    for (int n = 0; n < 2; ++n) acc[a][b][m][n] = (f32x4){0.f, 0.f, 0.f, 0.f};
        cur = nxt; cA = nA; cB = nB; ++ui;
        if constexpr (ALIGN_EPI) { if (wr == 1) PG8_BAR; }
    }
    PG8_WAIT_V(0);
    if constexpr (!ALIGN_EPI) { if (wr == 0) PG8_BAR; }
    PG8_BAR;
    if constexpr (Epi::AFTER_DRAIN) { E.fused(acc, cur, wr, wc, fr, fq, lds, wid, lane); S.done(cur); }
#undef PG8_SA
#undef PG8_SB
#undef PG8_STAGE
#undef PG8_LDA
#undef PG8_LDB
#undef PG8_MMA
#undef PG8_WAIT_V
#undef PG8_WAIT_L
#undef PG8_BAR
#undef PG8_SCHED
}
}
#define XB_TMO      128
#define XB_XCNT(j)  (256  + 64 * (j))
#define XB_XSUB(j)  (1280 + 64 * (j))
#define XB_XGEN(j)  (2304 + 64 * (j))
#define XB_TOP      3328
#define XB_TOPGEN   3392
#define XCD_BAR_WORDS 3456
#define XB_SPIN_CAP (1u << 18)

__device__ __forceinline__ unsigned xb_ld(unsigned* p)              { return __hip_atomic_load(p, __ATOMIC_RELAXED, __HIP_MEMORY_SCOPE_AGENT); }
__device__ __forceinline__ unsigned xb_add(unsigned* p, unsigned v) { return __hip_atomic_fetch_add(p, v, __ATOMIC_RELAXED, __HIP_MEMORY_SCOPE_AGENT); }
__device__ __forceinline__ unsigned xb_xcc_id() { return (unsigned)__builtin_amdgcn_s_getreg((3 << 11) | 20) & 0xFu; }
#define XB_SPIN(cond, bar) do { unsigned _sp = 0; while (cond) { __builtin_amdgcn_s_sleep(1); \
    if ((++_sp & 255u) == 0u) { if (xb_ld(&(bar)[XB_TMO])) break; if (_sp > XB_SPIN_CAP) { atomicAdd(&(bar)[XB_TMO], 1u); break; } } } } while (0)

struct XcdBarrier {
    unsigned* bar; unsigned x;
    volatile LAS unsigned* st;
};

__device__ __forceinline__ XcdBarrier xcd_barrier_post(unsigned* bar, volatile LAS unsigned* st) {
    XcdBarrier b; b.bar = bar; b.x = xb_xcc_id(); b.st = st;
    if (threadIdx.x == 0) (void)xb_add(&bar[XB_XCNT(b.x)], 1u);
    return b;
}
__device__ __forceinline__ void xcd_barrier_complete(unsigned* bar, unsigned x, unsigned& nloc, unsigned& nx) {
    const unsigned G = gridDim.x * gridDim.y * gridDim.z;
    unsigned sum, cnt, mine, sp = 0u;
    for (;;) {
        sum = 0u; cnt = 0u; mine = 0u;
#pragma unroll
        for (unsigned j = 0; j < 16; ++j) { const unsigned c = xb_ld(&bar[XB_XCNT(j)]); sum += c; cnt += (c > 0u) ? 1u : 0u; mine = (j == x) ? c : mine; }
        if (sum == G) break;
        __builtin_amdgcn_s_sleep(1);
        if ((++sp & 255u) == 0u) { if (xb_ld(&bar[XB_TMO])) break; if (sp > XB_SPIN_CAP) { atomicAdd(&bar[XB_TMO], 1u); break; } }
    }
    nloc = mine > 0u ? mine : 1u; nx = cnt > 0u ? cnt : 1u;
}

__device__ __forceinline__ void xcd_barrier(const XcdBarrier& b, const int tid_in  ) {
    asm volatile("s_waitcnt vmcnt(0)" ::: "memory");
    __syncthreads();
    if (tid_in == 0) {
        unsigned* bar = b.bar;
        __builtin_amdgcn_s_waitcnt(0);
        unsigned nloc = b.st[0], nx = b.st[1];
        if (nloc == 0u) { xcd_barrier_complete(bar, b.x, nloc, nx); b.st[0] = nloc; b.st[1] = nx; }
        const unsigned old = xb_add(&bar[XB_XSUB(b.x)], 1u);
        const unsigned gen = old / nloc;
        if (old + 1u == (gen + 1u) * nloc) {
            __builtin_amdgcn_fence(__ATOMIC_RELEASE, "agent");
            asm volatile("s_waitcnt vmcnt(0)" ::: "memory");
            const unsigned og = xb_add(&bar[XB_TOP], 1u);
            const unsigned tg = og / nx;
            if (og + 1u == (tg + 1u) * nx) xb_add(&bar[XB_TOPGEN], 1u);
            else XB_SPIN(xb_ld(&bar[XB_TOPGEN]) == tg, bar);
            __builtin_amdgcn_fence(__ATOMIC_ACQUIRE, "agent");
            xb_add(&bar[XB_XGEN(b.x)], 1u);
            asm volatile("s_waitcnt vmcnt(0)" ::: "memory");
        } else {
            XB_SPIN(xb_ld(&bar[XB_XGEN(b.x)]) == gen, bar);
            __builtin_amdgcn_fence(__ATOMIC_ACQUIRE, "agent");
            asm volatile("s_waitcnt vmcnt(0)" ::: "memory");
        }
    }
    __syncthreads();
}
template <int MODE, bool F16>
__device__ __forceinline__ void transpose_item(const float* W, const float* ksc, int K, int N, bf16* WT, int row_off, LAS float* scr_, int item, int lane) {
    LAS unsigned char* scr = (LAS unsigned char*)scr_;
    const int nblk = N / 64, kb = item / nblk, nb = item % nblk, k0 = 64 * kb, n0 = 64 * nb;
    const int n4 = lane & 15, kq = lane >> 4;
#pragma unroll 4
    for (int i = 0; i < 16; ++i) { const int kk = 4 * i + kq; const f32x4 v = *(const f32x4*)(W + (size_t)(k0 + kk) * N + n0 + 4 * n4); const float sc = ksc ? ksc[k0 + kk] : 1.f;
        const unsigned p01 = F16 ? pkh2(v.x * sc, v.y * sc) : pk2(v.x * sc, v.y * sc), p23 = F16 ? pkh2(v.z * sc, v.w * sc) : pk2(v.z * sc, v.w * sc);
        LAS unsigned char* d = scr + (4 * n4) * 144 + (((kk >> 3) ^ (n4 & 7)) << 4) + (kk & 7) * 2;
        *(LAS unsigned short*)(d) = (unsigned short)p01; *(LAS unsigned short*)(d + 144) = (unsigned short)(p01 >> 16);
        *(LAS unsigned short*)(d + 288) = (unsigned short)p23; *(LAS unsigned short*)(d + 432) = (unsigned short)(p23 >> 16); }
    LDS_WAIT(); asm volatile("" ::: "memory");
    int d0;
    if (MODE == 0) d0 = row_off + n0;
    else { const int half = n0 >= DFF ? 1 : 0, nn = n0 - half * DFF; d0 = (nn >> 7) * 256 + half * 128 + (nn & 127); }
#pragma unroll
    for (int t = 0; t < 8; ++t) { const int idx = lane + 64 * t, n = idx >> 3, c = idx & 7;
        const v4u o = *(const LAS v4u*)(scr + n * 144 + ((c ^ ((n >> 2) & 7)) << 4));
        *(v4u*)(WT + (size_t)(d0 + n) * K + k0 + 8 * c) = o; }
    LDS_WAIT(); asm volatile("" ::: "memory");
}
template <int MODE, bool F16 = false>
__device__ __forceinline__ void convert_matrix(const float* W, const float* ksc, int K, int N, bf16* WT, int row_off, LAS float* scr, int gw, int NGW, int lane) {
    const int nitems = (K / 64) * (N / 64);
    for (int it = gw; it < nitems; it += NGW) transpose_item<MODE, F16>(W, ksc, K, N, WT, row_off, scr, it, lane);
}
__device__ __forceinline__ void zero_rows(bf16* WT, int K, int row0, int nrows, int gtid, int NGT) {
    const size_t n16 = (size_t)nrows * K / 8; v4u* p = (v4u*)(WT + (size_t)row0 * K);
    unsigned z = 0u; asm volatile("" : "+v"(z));
    for (size_t i = gtid; i < n16; i += NGT) p[i] = (v4u){z, z, z, z};
}
__device__ __forceinline__ void phase_cast_ss(const float* h, bf16* hb, float* ss, int gw, int NGW, int lane) {
    for (int m = gw; m < NT; m += NGW) {
        const f32x4* xr = (const f32x4*)(h + (size_t)m * DM) + lane; v2u* o8 = (v2u*)(hb + (size_t)m * DM) + lane; float s = 0.f;
#pragma unroll
        for (int j = 0; j < 8; ++j) { const f32x4 v = xr[64 * j]; s += (v.x * v.x + v.y * v.y) + (v.z * v.z + v.w * v.w); v2u o; o.x = pkh2(v.x, v.y); o.y = pkh2(v.z, v.w); o8[64 * j] = o; }
        s = wave_sum(s, lane);
        if (lane < 32) ss[(size_t)m * 32 + lane] = lane == 0 ? s : 0.f;
    }
}
__device__ __forceinline__ void zero_f32(float* p, int n, int gtid, int NGT) { float z = 0.f; asm volatile("" : "+v"(z)); for (int i = gtid; i < n; i += NGT) p[i] = z; }
__device__ __forceinline__ void phase_rope_table(const int* positions, float* cs, int gtid, int NGT) {
    for (int idx = gtid; idx < NT * 32; idx += NGT) {
        const int t = idx >> 5, i = idx & 31;
        const float inv_freq = __builtin_amdgcn_exp2f(-(float)i * (13.287712379549449f / 32.0f));
        const float ang = (float)positions[t] * inv_freq;
        const double rev = (double)ang * 0.15915494309189535; const double fr = rev - floor(rev);
        const float x = (float)(fr * 6.283185307179586);
        cs[(size_t)t * 64 + i] = cosf(x); cs[(size_t)t * 64 + 32 + i] = sinf(x);
    }
}
__device__ __forceinline__ void phase_mla_latnorm(const float* c, const float* wq, const float* wkv, bf16* qkvn, float* kpe, int gw, int NGW, int lane) {
    for (int m = gw; m < NT; m += NGW) {
        const f32x4* cr = (const f32x4*)(c + (size_t)m * MLA_IN_PAD);
        f32x4 a0 = cr[lane], a1 = cr[64 + lane], b0 = cr[128 + lane], b1 = cr[192 + lane];
        float sa = (a0.x * a0.x + a0.y * a0.y) + (a0.z * a0.z + a0.w * a0.w) + (a1.x * a1.x + a1.y * a1.y) + (a1.z * a1.z + a1.w * a1.w);
        float sb = (b0.x * b0.x + b0.y * b0.y) + (b0.z * b0.z + b0.w * b0.w) + (b1.x * b1.x + b1.y * b1.y) + (b1.z * b1.z + b1.w * b1.w);
        const float ra = rsqrtf(wave_sum(sa, lane) * (1.f / 512.f) + NORM_EPS), rb = rsqrtf(wave_sum(sb, lane) * (1.f / 512.f) + NORM_EPS);
        const f32x4 wa0 = ((const f32x4*)wq)[lane], wa1 = ((const f32x4*)wq)[64 + lane], wb0 = ((const f32x4*)wkv)[lane], wb1 = ((const f32x4*)wkv)[64 + lane];
        v2u* o = (v2u*)(qkvn + (size_t)m * 1024); v2u t;
        t.x = pk2(a0.x * ra * wa0.x, a0.y * ra * wa0.y); t.y = pk2(a0.z * ra * wa0.z, a0.w * ra * wa0.w); o[lane] = t;
        t.x = pk2(a1.x * ra * wa1.x, a1.y * ra * wa1.y); t.y = pk2(a1.z * ra * wa1.z, a1.w * ra * wa1.w); o[64 + lane] = t;
        t.x = pk2(b0.x * rb * wb0.x, b0.y * rb * wb0.y); t.y = pk2(b0.z * rb * wb0.z, b0.w * rb * wb0.w); o[128 + lane] = t;
        t.x = pk2(b1.x * rb * wb1.x, b1.y * rb * wb1.y); t.y = pk2(b1.z * rb * wb1.z, b1.w * rb * wb1.w); o[192 + lane] = t;
        if (lane < 16) ((f32x4*)(kpe + (size_t)m * 64))[lane] = cr[256 + lane];
    }
}
__device__ __forceinline__ void phase_mla_finalize_kv(const bf16* kvraw, const float* kpe, const float* cs, const float* knw, bf16* kf, bf16* vf, int gw, int NGW, int lane) {
    const int g = lane >> 4, i = lane & 15, isv = g & 1;
    float wk[8], wpe[8];
#pragma unroll
    for (int e = 0; e < 8; ++e) { wk[e] = knw[8 * i + e]; wpe[e] = knw[128 + 8 * (i & 7) + e]; }
    for (int m = gw; m < NT; m += NGW) {
        const int b = m / SEQ, s = m % SEQ;
        const float pv = kpe[(size_t)m * 64 + lane]; const float pess = wave_sum(pv * pv, lane);
        float pe[8], cv[8], sv[8];
        { const f32x4 a0 = *(const f32x4*)(kpe + (size_t)m * 64 + 8 * (i & 7)), a1 = *(const f32x4*)(kpe + (size_t)m * 64 + 8 * (i & 7) + 4);
          const f32x4 c0 = *(const f32x4*)(cs + (size_t)m * 64 + 8 * (i & 3)), c1 = *(const f32x4*)(cs + (size_t)m * 64 + 8 * (i & 3) + 4);
          const f32x4 s0 = *(const f32x4*)(cs + (size_t)m * 64 + 32 + 8 * (i & 3)), s1 = *(const f32x4*)(cs + (size_t)m * 64 + 32 + 8 * (i & 3) + 4);
#pragma unroll
          for (int e = 0; e < 4; ++e) { pe[e] = a0[e]; pe[4 + e] = a1[e]; cv[e] = c0[e]; cv[4 + e] = c1[e]; sv[e] = s0[e]; sv[4 + e] = s1[e]; } }
        const bf16* kr = kvraw + (size_t)m * (MLA_H * 256);
#pragma unroll 2
        for (int hp = 0; hp < MLA_H / 2; ++hp) {
            const int h = 2 * hp + (g >> 1); const size_t ob = ((size_t)(b * MLA_H + h) * SEQ + s);
            const v4u raw = *(const v4u*)(kr + h * 256 + isv * 128 + 8 * i);
            float x[8]; x[0] = bflo(raw.x); x[1] = bfhi(raw.x); x[2] = bflo(raw.y); x[3] = bfhi(raw.y); x[4] = bflo(raw.z); x[5] = bfhi(raw.z); x[6] = bflo(raw.w); x[7] = bfhi(raw.w);
            float ss = 0.f;
#pragma unroll
            for (int e = 0; e < 8; ++e) ss += x[e] * x[e];
            ss += shx(ss, 1, lane); ss += shx(ss, 2, lane); ss += shx(ss, 4, lane); ss += shx(ss, 8, lane);
            float rs = rsqrtf((ss + pess) * (1.f / 192.f) + NORM_EPS);
            const float rso = shx(rs, 16, lane); if (isv) rs = rso;
            if (!isv) { v4u o; o.x = pk2(x[0] * rs * wk[0], x[1] * rs * wk[1]); o.y = pk2(x[2] * rs * wk[2], x[3] * rs * wk[3]); o.z = pk2(x[4] * rs * wk[4], x[5] * rs * wk[5]); o.w = pk2(x[6] * rs * wk[6], x[7] * rs * wk[7]);
                *(v4u*)(kf + ob * MLA_QK + 8 * i) = o; }
            else *(v4u*)(vf + ob * MLA_V + 8 * i) = raw;
            float y[8], yp[8];
#pragma unroll
            for (int e = 0; e < 8; ++e) { y[e] = pe[e] * rs * wpe[e]; yp[e] = shx(y[e], 4, lane); }
            if (isv && i < 8) { float r[8];
#pragma unroll
                for (int e = 0; e < 8; ++e) r[e] = (i < 4) ? y[e] * cv[e] - yp[e] * sv[e] : y[e] * cv[e] + yp[e] * sv[e];
                v4u o; o.x = pk2(r[0], r[1]); o.y = pk2(r[2], r[3]); o.z = pk2(r[4], r[5]); o.w = pk2(r[6], r[7]);
                *(v4u*)(kf + ob * MLA_QK + 128 + 8 * i) = o; }
        }
    }
}
__device__ __forceinline__ void phase_cvt_bf16(const float* src, bf16* dst, size_t n, int gtid, int NGT) {
    const size_t n8 = n / 8;
    for (size_t i = gtid; i < n8; i += NGT) { const f32x4 a = ((const f32x4*)src)[2 * i], b = ((const f32x4*)src)[2 * i + 1];
        v4u o; o.x = pk2(a.x, a.y); o.y = pk2(a.z, a.w); o.z = pk2(b.x, b.y); o.w = pk2(b.z, b.w); ((v4u*)dst)[i] = o; }
}
__device__ __forceinline__ void phase_rstd_e(const bf16* e, float* rstd, int gw, int NGW, int lane) {
    for (int m = gw; m < NT; m += NGW) {
        const v4u* er = (const v4u*)(e + (size_t)m * DM) + lane; float s = 0.f;
#pragma unroll
        for (int j = 0; j < 4; ++j) { const v4u w = er[64 * j];
            const float a0 = bflo(w.x), a1 = bfhi(w.x), a2 = bflo(w.y), a3 = bfhi(w.y), a4 = bflo(w.z), a5 = bfhi(w.z), a6 = bflo(w.w), a7 = bfhi(w.w);
            s += (a0 * a0 + a1 * a1) + (a2 * a2 + a3 * a3) + (a4 * a4 + a5 * a5) + (a6 * a6 + a7 * a7); }
        s = wave_sum(s, lane);
        if (lane == 0) rstd[m] = rsqrtf(s * (1.f / 2048.f) + NORM_EPS);
    }
}

namespace attn {
constexpr int DQK = 192, DV = 128, QBLK = 32, KVBLK = 64, QB = 256;
constexpr int SHM_V = KVBLK * DV * 2, SHM_K = KVBLK * DQK * 2;
constexpr int OFF_V = 0, OFF_K = 2 * SHM_V, OFF_WS = OFF_K + 2 * SHM_K;
constexpr int OFF_Q = OFF_WS + NWAVES * 64 * 4;
constexpr int ATTN_LDS = OFF_Q + NWAVES * 4096;
constexpr float SCALE = 0.07216878364870322f;
constexpr float THR = 8.f;
#define SBAR() __builtin_amdgcn_sched_barrier(0)
__device__ __forceinline__ int v_rd_base(int lane) { return ((lane & 3) << 3) | (((lane >> 2) & 3) << 6) | (((lane >> 4) & 1) << 5) | (((lane >> 5) & 1) << 8); }
constexpr int v_rd_off(int d0, int ks, int half) { return d0 * 512 + ks * 4096 + half * 2048; }
__device__ __forceinline__ int crow(int r, int hi) { return (r & 3) + 8 * (r >> 2) + 4 * hi; }
__device__ __forceinline__ unsigned cvtpk(float lo, float hi) { unsigned r; asm volatile("v_cvt_pk_bf16_f32 %0, %1, %2" : "=v"(r) : "v"(lo), "v"(hi)); return r; }
__device__ __forceinline__ void mask_tile(f32x16& p0, f32x16& p1, int dq) {
    const float NEG = -__builtin_inff();
#pragma unroll
    for (int r = 0; r < 16; ++r) { const int c = (r & 3) + 8 * (r >> 2);
        if (dq - c < 0) p0[r] = NEG;
        if (dq - c - 32 < 0) p1[r] = NEG; }
}
__device__ __forceinline__ void partialSM(f32x16& p0, f32x16& p1, float& m_reg, float& mn, float& alpha) {
    float pmax = p0[0];
#pragma unroll
    for (int r = 1; r < 16; ++r) pmax = fmaxf(pmax, p0[r]);
#pragma unroll
    for (int r = 0; r < 16; ++r) pmax = fmaxf(pmax, p1[r]);
    { auto rr = __builtin_amdgcn_permlane32_swap(__float_as_uint(pmax), __float_as_uint(pmax), false, false);
      pmax = fmaxf(__uint_as_float(rr[0]), __uint_as_float(rr[1])); }
    constexpr float C2 = 1.4426950408889634f * SCALE;
    if (__builtin_expect(__all((pmax - m_reg) * SCALE <= THR), 1)) { mn = m_reg; alpha = 1.f; }
    else { mn = fmaxf(m_reg, pmax); alpha = __builtin_amdgcn_exp2f((m_reg - mn) * C2); m_reg = mn; }
    const float mnL = -mn * C2;
#pragma unroll
    for (int r = 0; r < 16; ++r) p0[r] = fmaf(p0[r], C2, mnL);
#pragma unroll
    for (int r = 0; r < 16; ++r) p1[r] = fmaf(p1[r], C2, mnL);
#pragma unroll
    for (int r = 0; r < 16; ++r) p0[r] = __builtin_amdgcn_exp2f(p0[r]);
}
__device__ __forceinline__ void finishSM(f32x16& p0, f32x16& p1, float alpha, float& l_reg, bf16x8& pa0, bf16x8& pa1, bf16x8& pa2, bf16x8& pa3) {
#pragma unroll
    for (int r = 0; r < 16; ++r) p1[r] = __builtin_amdgcn_exp2f(p1[r]);
    float ps = 0;
#pragma unroll
    for (int r = 0; r < 16; ++r) ps += p0[r];
#pragma unroll
    for (int r = 0; r < 16; ++r) ps += p1[r];
    { auto rr = __builtin_amdgcn_permlane32_swap(__float_as_uint(ps), __float_as_uint(ps), false, false);
      ps = __uint_as_float(rr[0]) + __uint_as_float(rr[1]); }
    l_reg = l_reg * alpha + ps;
#define PK4(P, B_, OUT) do { unsigned a0 = cvtpk(P[B_+0], P[B_+1]), a1 = cvtpk(P[B_+2], P[B_+3]);                          \
        unsigned b0 = cvtpk(P[B_+4], P[B_+5]), b1 = cvtpk(P[B_+6], P[B_+7]);                                             \
        auto r0 = __builtin_amdgcn_permlane32_swap(a0, b0, false, false); auto r1 = __builtin_amdgcn_permlane32_swap(a1, b1, false, false); \
        v4u w = {r0[0], r1[0], r0[1], r1[1]}; OUT = *reinterpret_cast<bf16x8*>(&w); } while (0)
    PK4(p0, 0, pa0); PK4(p0, 8, pa1); PK4(p1, 0, pa2); PK4(p1, 8, pa3);
#undef PK4
}
__device__ __forceinline__ int k_off(int row, int ch) { return row * 384 + ((ch ^ ((row >> 1) & 7)) << 4); }
template <int KB>
__device__ __forceinline__ void qkt(f32x16& p0, f32x16& p1, const LAS char* lds, int r32, int hi, const bf16x8* qr, const LAS char* qs) {
    p0 = f32x16{}; p1 = f32x16{};
    const LAS char* kb[4];
#pragma unroll
    for (int dd = 0; dd < 4; ++dd) kb[dd] = lds + OFF_K + KB * SHM_K + k_off(r32, dd * 2 + hi);
#if PROBE_MASK
#pragma unroll
    for (int d0 = 0; d0 < 12; ++d0) { const LAS char* a = kb[d0 & 3] + (d0 >> 2) * 128;
        bf16x8 b0 = *reinterpret_cast<const LAS bf16x8*>(a);
        bf16x8 b1 = *reinterpret_cast<const LAS bf16x8*>(a + 32 * 384);
        const bf16x8 qv = d0 < 8 ? qr[d0 < 8 ? d0 : 0] : *reinterpret_cast<const LAS bf16x8*>(qs + (d0 - 8) * 1024);
        p0 = __builtin_amdgcn_mfma_f32_32x32x16_bf16(b0, qv, p0, 0, 0, 0);
        p1 = __builtin_amdgcn_mfma_f32_32x32x16_bf16(b1, qv, p1, 0, 0, 0); }
#else
    bf16x8 kf[2][4], qx[2][2];
#define QKT_LOAD(i_, buf_) do { _Pragma("unroll") for (int e_ = 0; e_ < 2; ++e_) { const int d0_ = 2 * (i_) + e_; const LAS char* a_ = kb[d0_ & 3] + (d0_ >> 2) * 128; \
        kf[buf_][2 * e_] = *reinterpret_cast<const LAS bf16x8*>(a_); kf[buf_][2 * e_ + 1] = *reinterpret_cast<const LAS bf16x8*>(a_ + 32 * 384); \
        if (d0_ >= 8) qx[buf_][e_] = *reinterpret_cast<const LAS bf16x8*>(qs + (d0_ - 8) * 1024); } } while (0)
    QKT_LOAD(0, 0);
#pragma unroll
    for (int i = 0; i < 6; ++i) {
        if (i < 5) QKT_LOAD(i + 1, (i + 1) & 1);
        __builtin_amdgcn_sched_barrier(0);
#pragma unroll
        for (int e = 0; e < 2; ++e) { const int d0 = 2 * i + e; const bf16x8 qv = d0 < 8 ? qr[d0 < 8 ? d0 : 0] : qx[i & 1][e];
            p0 = __builtin_amdgcn_mfma_f32_32x32x16_bf16(kf[i & 1][2 * e], qv, p0, 0, 0, 0);
            p1 = __builtin_amdgcn_mfma_f32_32x32x16_bf16(kf[i & 1][2 * e + 1], qv, p1, 0, 0, 0); }
        __builtin_amdgcn_sched_barrier(0);
    }
#undef QKT_LOAD
#endif
}
template <int VB>
__device__ __forceinline__ void pv_tile(f32x16* o, int vb0, bf16x8 pa0, bf16x8 pa1, bf16x8 pa2, bf16x8 pa3) {
#define TRRD(dst, off) asm volatile("ds_read_b64_tr_b16 %0, %1 offset:%2" : "=&v"(dst) : "v"(vb0), "i"(off) : "memory")
#define PV_RD(S, d0) do { constexpr int b_ = OFF_V + VB * SHM_V + v_rd_off(d0, 0, 0); \
        TRRD(S[0], b_); TRRD(S[1], b_ + 2048); TRRD(S[2], b_ + 4096); TRRD(S[3], b_ + 6144); TRRD(S[4], b_ + 8192); TRRD(S[5], b_ + 10240); TRRD(S[6], b_ + 12288); TRRD(S[7], b_ + 14336); } while (0)
#define PV_MM(S, d0) do { \
        o[d0] = __builtin_amdgcn_mfma_f32_32x32x16_bf16(pa0, (bf16x8){S[0][0], S[0][1], S[0][2], S[0][3], S[1][0], S[1][1], S[1][2], S[1][3]}, o[d0], 0, 0, 0);   \
        o[d0] = __builtin_amdgcn_mfma_f32_32x32x16_bf16(pa1, (bf16x8){S[2][0], S[2][1], S[2][2], S[2][3], S[3][0], S[3][1], S[3][2], S[3][3]}, o[d0], 0, 0, 0);   \
        o[d0] = __builtin_amdgcn_mfma_f32_32x32x16_bf16(pa2, (bf16x8){S[4][0], S[4][1], S[4][2], S[4][3], S[5][0], S[5][1], S[5][2], S[5][3]}, o[d0], 0, 0, 0);   \
        o[d0] = __builtin_amdgcn_mfma_f32_32x32x16_bf16(pa3, (bf16x8){S[6][0], S[6][1], S[6][2], S[6][3], S[7][0], S[7][1], S[7][2], S[7][3]}, o[d0], 0, 0, 0); } while (0)
#define PV_WAIT8(S) asm volatile("s_waitcnt lgkmcnt(8)" : "+v"(S[0]), "+v"(S[1]), "+v"(S[2]), "+v"(S[3]), "+v"(S[4]), "+v"(S[5]), "+v"(S[6]), "+v"(S[7]) :: "memory")
#define PV_WAIT0(S) asm volatile("s_waitcnt lgkmcnt(0)" : "+v"(S[0]), "+v"(S[1]), "+v"(S[2]), "+v"(S[3]), "+v"(S[4]), "+v"(S[5]), "+v"(S[6]), "+v"(S[7]) :: "memory")
    s16x4 sa[8], sb[8];
    PV_RD(sa, 0);
    PV_RD(sb, 1); PV_WAIT8(sa); SBAR(); PV_MM(sa, 0); SBAR();
    PV_RD(sa, 2); PV_WAIT8(sb); SBAR(); PV_MM(sb, 1); SBAR();
    PV_RD(sb, 3); PV_WAIT8(sa); SBAR(); PV_MM(sa, 2); SBAR();
    PV_WAIT0(sb); SBAR(); PV_MM(sb, 3);
#undef PV_RD
#undef PV_MM
#undef PV_WAIT8
#undef PV_WAIT0
#undef TRRD
}
template <int VB, int KB, bool DO_PV, bool DO_QK>
__device__ __forceinline__ void mseg(f32x16* o, int vb0, bf16x8 pa0, bf16x8 pa1, bf16x8 pa2, bf16x8 pa3, f32x16& p0, f32x16& p1, int ldsa, int r32, int hi, const bf16x8* qr, int qsa) {
#define TRRD(dst, off) asm volatile("ds_read_b64_tr_b16 %0, %1 offset:%2" : "=&v"(dst) : "v"(vb0), "i"(off) : "memory")
#define PV_RD(S, d0) do { constexpr int b_ = OFF_V + VB * SHM_V + v_rd_off(d0, 0, 0); \
        TRRD(S[0], b_); TRRD(S[1], b_ + 2048); TRRD(S[2], b_ + 4096); TRRD(S[3], b_ + 6144); TRRD(S[4], b_ + 8192); TRRD(S[5], b_ + 10240); TRRD(S[6], b_ + 12288); TRRD(S[7], b_ + 14336); } while (0)
#define PV_MM(S, d0) do { \
        o[d0] = __builtin_amdgcn_mfma_f32_32x32x16_bf16(pa0, (bf16x8){S[0][0], S[0][1], S[0][2], S[0][3], S[1][0], S[1][1], S[1][2], S[1][3]}, o[d0], 0, 0, 0);   \
        o[d0] = __builtin_amdgcn_mfma_f32_32x32x16_bf16(pa1, (bf16x8){S[2][0], S[2][1], S[2][2], S[2][3], S[3][0], S[3][1], S[3][2], S[3][3]}, o[d0], 0, 0, 0);   \
        o[d0] = __builtin_amdgcn_mfma_f32_32x32x16_bf16(pa2, (bf16x8){S[4][0], S[4][1], S[4][2], S[4][3], S[5][0], S[5][1], S[5][2], S[5][3]}, o[d0], 0, 0, 0);   \
        o[d0] = __builtin_amdgcn_mfma_f32_32x32x16_bf16(pa3, (bf16x8){S[6][0], S[6][1], S[6][2], S[6][3], S[7][0], S[7][1], S[7][2], S[7][3]}, o[d0], 0, 0, 0); } while (0)
#define PV_WAIT8(S) asm volatile("s_waitcnt lgkmcnt(8)" : "+v"(S[0]), "+v"(S[1]), "+v"(S[2]), "+v"(S[3]), "+v"(S[4]), "+v"(S[5]), "+v"(S[6]), "+v"(S[7]) :: "memory")
#define PV_WAIT0(S) asm volatile("s_waitcnt lgkmcnt(0)" : "+v"(S[0]), "+v"(S[1]), "+v"(S[2]), "+v"(S[3]), "+v"(S[4]), "+v"(S[5]), "+v"(S[6]), "+v"(S[7]) :: "memory")
#define KRD(dst, base, off) asm volatile("ds_read_b128 %0, %1 offset:%2" : "=&v"(dst) : "v"(base), "i"(off) : "memory")
#define QK_LD4(B, da, db) do { KRD(kf[B][0], kb[(da) & 3], ((da) >> 2) * 128); KRD(kf[B][1], kb[(da) & 3], ((da) >> 2) * 128 + 12288); \
                               KRD(kf[B][2], kb[(db) & 3], ((db) >> 2) * 128); KRD(kf[B][3], kb[(db) & 3], ((db) >> 2) * 128 + 12288); } while (0)
#define QK_LD6(B, da, db) do { QK_LD4(B, da, db); KRD(qx[B][0], qsa, ((da) - 8) * 1024); KRD(qx[B][1], qsa, ((db) - 8) * 1024); } while (0)
#define QK_W(N, B)  asm volatile("s_waitcnt lgkmcnt(" #N ")" : "+v"(kf[B][0]), "+v"(kf[B][1]), "+v"(kf[B][2]), "+v"(kf[B][3]) :: "memory")
#define QK_WQ(N, B) asm volatile("s_waitcnt lgkmcnt(" #N ")" : "+v"(kf[B][0]), "+v"(kf[B][1]), "+v"(kf[B][2]), "+v"(kf[B][3]), "+v"(qx[B][0]), "+v"(qx[B][1]) :: "memory")
#define QK_MM(B, qa, qb) do { p0 = __builtin_amdgcn_mfma_f32_32x32x16_bf16(kf[B][0], qa, p0, 0, 0, 0); p1 = __builtin_amdgcn_mfma_f32_32x32x16_bf16(kf[B][1], qa, p1, 0, 0, 0); \
                              p0 = __builtin_amdgcn_mfma_f32_32x32x16_bf16(kf[B][2], qb, p0, 0, 0, 0); p1 = __builtin_amdgcn_mfma_f32_32x32x16_bf16(kf[B][3], qb, p1, 0, 0, 0); } while (0)
    s16x4 sa[8], sb[8]; bf16x8 kf[2][4]; int kb[4];
    if (DO_QK) {
#pragma unroll
        for (int dd = 0; dd < 4; ++dd) kb[dd] = ldsa + OFF_K + KB * SHM_K + k_off(r32, dd * 2 + hi);
    }
    if (DO_PV) {
        PV_RD(sa, 0);
        PV_RD(sb, 1); PV_WAIT8(sa); SBAR(); PV_MM(sa, 0); SBAR();
        PV_RD(sa, 2); PV_WAIT8(sb); SBAR(); PV_MM(sb, 1); SBAR();
        PV_RD(sb, 3); PV_WAIT8(sa); SBAR(); PV_MM(sa, 2); SBAR();
        if (DO_QK) { QK_LD4(0, 0, 1); QK_LD4(1, 2, 3); PV_WAIT8(sb); } else PV_WAIT0(sb);
        SBAR(); PV_MM(sb, 3); SBAR();
    } else if (DO_QK) { QK_LD4(0, 0, 1); QK_LD4(1, 2, 3); }
    if (DO_QK) {
        p0 = f32x16{}; p1 = f32x16{};
        QK_W(4, 0); SBAR(); QK_MM(0, qr[0], qr[1]); SBAR(); QK_LD4(0, 4, 5);
        QK_W(4, 1); SBAR(); QK_MM(1, qr[2], qr[3]); SBAR(); QK_LD4(1, 6, 7);
        QK_W(4, 0); SBAR(); QK_MM(0, qr[4], qr[5]); SBAR(); QK_LD4(0, 8, 9);
        QK_W(4, 1); SBAR(); QK_MM(1, qr[6], qr[7]); SBAR(); QK_LD4(1, 10, 11);
        QK_W(4, 0); SBAR(); QK_MM(0, qr[8], qr[9]); SBAR();
        QK_W(0, 1); SBAR(); QK_MM(1, qr[10], qr[11]); SBAR();
    }
#undef TRRD
#undef PV_RD
#undef PV_MM
#undef PV_WAIT8
#undef PV_WAIT0
#undef KRD
#undef QK_LD4
#undef QK_LD6
#undef QK_W
#undef QK_WQ
#undef QK_MM
}
__device__ __forceinline__ void attn_block(const bf16* Q, int ldq, const float* qnw, const float* cs, int tok0, const bf16* Kh, const bf16* Vh, bf16* O, int ldo, int P0, int rev, LAS char* lds, int tid_, int wid, int lane_) {
    int tid = tid_, lane = lane_;
    asm volatile("" : "+v"(tid), "+v"(lane));
    const int r32 = lane & 31, hi = lane >> 5;
    const int NTL = (P0 + QB) / KVBLK;
    const int qlo = P0 + wid * QBLK, qm = qlo + r32 - 4 * hi;
    LAS float* ws = (LAS float*)(lds + OFF_WS) + wid * 64; LAS float* li_l = ws; LAS float* al_l = ws + 32;
    unsigned ksrc[3], vsrc[2];
#pragma unroll
    for (int i = 0; i < 3; ++i) { const int p = i * 512 + tid, row = p / 24, pc = p % 24, c = pc ^ ((row >> 1) & 7); ksrc[i] = (unsigned)(row * 384 + c * 16); }
#pragma unroll
    for (int i = 0; i < 2; ++i) { const int p = i * 512 + tid; const int kk = ((p >> 7) << 3) | ((p >> 2) & 7), c = (((p >> 5) & 3) << 5) | ((p & 3) << 3);
        const int k = (kk & ~0xC) | ((kk & 4) << 1) | ((kk & 8) >> 1); vsrc[i] = (unsigned)(k * 256 + c * 2); }
#define DMA16(voff_, base_, ldsdst_) asm volatile("s_mov_b32 m0, %2\n\ts_nop 0\n\tglobal_load_lds_dwordx4 %0, %1" :: "v"(voff_), "s"(base_), "s"(ldsdst_) : "memory", "m0")
#define ISSUE_TILE(t, slot) do { const unsigned long long kg_ = (unsigned long long)(uintptr_t)Kh + (unsigned long long)(t) * (KVBLK * 384), vg_ = (unsigned long long)(uintptr_t)Vh + (unsigned long long)(t) * (KVBLK * 256); \
        const int kd_ = __builtin_amdgcn_readfirstlane((int)(uintptr_t)(lds + OFF_K + (slot) * SHM_K + wid * 1024)), vd_ = __builtin_amdgcn_readfirstlane((int)(uintptr_t)(lds + OFF_V + (slot) * SHM_V + wid * 1024)); \
        _Pragma("unroll") for (int i_ = 0; i_ < 3; ++i_) DMA16(ksrc[i_], kg_, kd_ + i_ * 8192); \
        _Pragma("unroll") for (int i_ = 0; i_ < 2; ++i_) DMA16(vsrc[i_], vg_, vd_ + i_ * 8192); } while (0)
#define TIDX(s_) (rev ? NTL - 1 - (s_) : (s_))
    ISSUE_TILE(TIDX(0), 0);
    bf16x8 qr[12];
    LAS char* qs = lds + OFF_Q + wid * 4096 + lane * 16;
    {
        const bf16* qrow = Q + (size_t)(wid * QBLK + r32) * ldq + hi * 8; const float* csr = cs + (size_t)(tok0 + wid * QBLK + r32) * 64 + hi * 8;
        v4u qw[12]; float ss = 0.f;
#pragma unroll
        for (int d0 = 0; d0 < 12; ++d0) qw[d0] = *reinterpret_cast<const v4u*>(qrow + d0 * 16);
#pragma unroll
        for (int d0 = 0; d0 < 12; ++d0) { const v4u w = qw[d0]; const float a0 = bflo(w.x), a1 = bfhi(w.x), a2 = bflo(w.y), a3 = bfhi(w.y), a4 = bflo(w.z), a5 = bfhi(w.z), a6 = bflo(w.w), a7 = bfhi(w.w);
            ss += (a0 * a0 + a1 * a1) + (a2 * a2 + a3 * a3) + (a4 * a4 + a5 * a5) + (a6 * a6 + a7 * a7); }
        ss += shx(ss, 32, lane);
        const float rs = rsqrtf(ss * (1.f / 192.f) + NORM_EPS);
#define QSCALE(X, d0_) do { const v4u w_ = qw[d0_]; const f32x4 g0_ = *(const f32x4*)(qnw + (d0_) * 16 + hi * 8), g1_ = *(const f32x4*)(qnw + (d0_) * 16 + hi * 8 + 4); \
            X[0] = bflo(w_.x) * rs * g0_.x; X[1] = bfhi(w_.x) * rs * g0_.y; X[2] = bflo(w_.y) * rs * g0_.z; X[3] = bfhi(w_.y) * rs * g0_.w; \
            X[4] = bflo(w_.z) * rs * g1_.x; X[5] = bfhi(w_.z) * rs * g1_.y; X[6] = bflo(w_.w) * rs * g1_.z; X[7] = bfhi(w_.w) * rs * g1_.w; } while (0)
#define QPACK(X) ((v4u){cvtpk(X[0], X[1]), cvtpk(X[2], X[3]), cvtpk(X[4], X[5]), cvtpk(X[6], X[7])})
#pragma unroll
        for (int d0 = 0; d0 < 8; ++d0) { float xv[8]; QSCALE(xv, d0); const v4u pk = QPACK(xv); qr[d0] = *reinterpret_cast<const bf16x8*>(&pk); }
#pragma unroll
        for (int d0 = 8; d0 < 10; ++d0) { float x1[8], x2[8], o1[8], o2[8]; QSCALE(x1, d0); QSCALE(x2, d0 + 2);
            const f32x4 c0 = *(const f32x4*)(csr + (d0 - 8) * 16), c1 = *(const f32x4*)(csr + (d0 - 8) * 16 + 4), s0 = *(const f32x4*)(csr + 32 + (d0 - 8) * 16), s1 = *(const f32x4*)(csr + 32 + (d0 - 8) * 16 + 4);
#pragma unroll
            for (int e = 0; e < 8; ++e) { const float c = e < 4 ? c0[e & 3] : c1[e & 3], s = e < 4 ? s0[e & 3] : s1[e & 3]; o1[e] = x1[e] * c - x2[e] * s; o2[e] = x2[e] * c + x1[e] * s; }
            const v4u p1 = QPACK(o1), p2 = QPACK(o2);
            qr[d0] = *reinterpret_cast<const bf16x8*>(&p1); qr[d0 + 2] = *reinterpret_cast<const bf16x8*>(&p2); }
#undef QSCALE
#undef QPACK
    }
    float m_reg = -1e30f, l_reg = 0; f32x16 o[4] = {};
    const int vb0 = (int)(uintptr_t)(lds) + v_rd_base(lane);
    VM_WAIT(); __syncthreads();
#define RESC(a) do { if (__any((a) < 1.f)) { if (hi == 0) al_l[r32] = (a); asm volatile("s_waitcnt lgkmcnt(0)" ::: "memory");              \
                     _Pragma("unroll") for (int d_ = 0; d_ < 4; ++d_) _Pragma("unroll") for (int r = 0; r < 16; ++r) o[d_][r] *= al_l[crow(r, hi)]; } } while (0)
#define STEP(t, SLOT) do { \
        if ((t) + 1 < NTL) ISSUE_TILE(TIDX((t) + 1), (SLOT) ^ 1); \
        const int kb_ = TIDX(t) * KVBLK; \
        if (kb_ <= qlo + QBLK - 1) {                                          \
            f32x16 p0, p1; float mn, al; bf16x8 pa0, pa1, pa2, pa3; \
            mseg<SLOT, SLOT, false, true>(o, vb0, pa0, pa1, pa2, pa3, p0, p1, (int)(uintptr_t)lds, r32, hi, qr, (int)(uintptr_t)qs); \
            if (kb_ + KVBLK - 1 > qlo) mask_tile(p0, p1, qm - kb_); \
            partialSM(p0, p1, m_reg, mn, al); RESC(al); \
            finishSM(p0, p1, al, l_reg, pa0, pa1, pa2, pa3); SBAR(); \
            pv_tile<SLOT>(o, vb0, pa0, pa1, pa2, pa3); } \
        VM_WAIT(); __syncthreads(); } while (0)
    for (int t = 0; t < NTL; t += 2) { STEP(t, 0); STEP(t + 1, 1); }
#undef STEP
#undef RESC
#undef ISSUE_TILE
#undef DMA16
#undef TIDX
    if (hi == 0) li_l[r32] = l_reg; asm volatile("s_waitcnt lgkmcnt(0)" ::: "memory");
    float rli[16];
#pragma unroll
    for (int r = 0; r < 16; ++r) rli[r] = __builtin_amdgcn_rcpf(li_l[crow(r, hi)]);
    int lane2 = lane; asm volatile("" : "+v"(lane2));
    const int r32e = lane2 & 31, hie = lane2 >> 5;
    bf16* Ow = O + (size_t)(wid * QBLK) * ldo;
#pragma unroll
    for (int r = 0; r < 16; ++r) { const int orow = crow(r, hie);
#pragma unroll
        for (int d0 = 0; d0 < 4; ++d0) { const float v = o[d0][r] * rli[r]; const float vn = shx(v, 1, lane);
            if ((r32e & 1) == 0) *(unsigned*)(Ow + (size_t)orow * ldo + d0 * 32 + r32e) = cvtpk(v, vn); } }
    __syncthreads();
}
__device__ __forceinline__ void attn_phase(const bf16* qraw, const float* qnw, const float* cs, const bf16* kf, const bf16* vf, bf16* o, LAS char* lds, int vcu, int G, int tid, int wid, int lane) {
    constexpr int NQB = SEQ / QB, NPAIR = NQB / 2, TOTAL = NB * MLA_H * NPAIR;
    for (int L = vcu; L < TOTAL; L += G) {
        const int bh = L / NPAIR, x = L % NPAIR, b = bh / MLA_H, h = bh % MLA_H;
        const bf16* Kh = kf + (size_t)bh * SEQ * DQK; const bf16* Vh = vf + (size_t)bh * SEQ * DV;
#pragma unroll 1
        for (int pass = 0; pass < 2; ++pass) {
            const int qb = pass ? x : (NQB - 1 - x), P0 = qb * QB, tok0 = b * SEQ + P0;
            attn_block(qraw + (size_t)tok0 * (MLA_H * MLA_QK) + h * MLA_QK, MLA_H * MLA_QK, qnw, cs, tok0, Kh, Vh, o + (size_t)tok0 * (MLA_H * MLA_V) + h * MLA_V, MLA_H * MLA_V, P0, pass, lds, tid, wid, lane);
        }
    }
}
#undef SBAR
}

namespace gdn {
__device__ __forceinline__ int crow(int r, int hi) { return (r & 3) + 8 * (r >> 2) + 4 * hi; }
__device__ __forceinline__ unsigned off_b(unsigned row, unsigned ch) { return 256u * row + 16u * (ch ^ (((row & 3) << 2) | ((row >> 2) & 3))); }
#define MFMA32(a, b, c) __builtin_amdgcn_mfma_f32_32x32x16_bf16((a), (b), (c), 0, 0, 0)
#define MFMA_SETTLE(x) asm volatile("s_nop 7\n\ts_nop 7\n\ts_nop 3" : "+v"(x))
#define BAR_LDS() do { asm volatile("s_waitcnt lgkmcnt(0)" ::: "memory"); __builtin_amdgcn_s_barrier(); asm volatile("" ::: "memory"); } while (0)
#define TR_ISSUE(lo, hi_, a0, a1) asm volatile("ds_read_b64_tr_b16 %0, %2\n\tds_read_b64_tr_b16 %1, %3" : "=&v"(lo), "=&v"(hi_) : "v"(a0), "v"(a1) : "memory")
#define TR_CAT(lo, hi_) ((bf16x8){lo[0], lo[1], lo[2], lo[3], hi_[0], hi_[1], hi_[2], hi_[3]})
__device__ __forceinline__ float softplus_f(float x) { return fmaxf(x, 0.f) + log1pf(__expf(-fabsf(x))); }

__device__ __forceinline__ void phase_halo(const bf16* proj, bf16* halo, int vcu, int G, int tid) {
    for (int u = vcu; u < NB * NCHUNK * 3; u += G) {
        const int j = u % 3, cn = u / 3, n = cn % NCHUNK, b = cn / NCHUNK;
        if (n == 0) continue;
        const v4u* src = (const v4u*)(proj + (size_t)(b * SEQ + 64 * n - 3 + j) * GDN_MAIN); v4u* dst = (v4u*)(halo + (size_t)u * GDN_CONV);
        dst[tid] = src[tid]; dst[512 + tid] = src[512 + tid];
    }
}
constexpr int CV_SLOT = 67 * 256, CONV_LDS = 4 * CV_SLOT;
__device__ __forceinline__ void phase_conv(bf16* proj_, const bf16* halo_, const float* convw, LAS unsigned char* lds, int vcu, int G, int tid, int wid) {
    GAS bf16* proj = (GAS bf16*)proj_; const GAS bf16* halo = (const GAS bf16*)halo_;
    int hg_ = vcu & 63; asm volatile("" : "+s"(hg_));
    const int rg = tid >> 4, cg = tid & 15, hg = hg_, ch0 = hg * 128 + cg * 8, lane = tid & 63;
    constexpr int NU = NB * NCHUNK * 64;
    f32x4 w[4][2];
#pragma unroll
    for (int j = 0; j < 4; ++j) { w[j][0] = *(const f32x4*)(convw + j * GDN_CONV + ch0); w[j][1] = *(const f32x4*)(convw + j * GDN_CONV + ch0 + 4); }
#define CONV_DMA(u_, slot_) do { const int cn_ = (u_) >> 6, n_ = cn_ % NCHUNK, b_ = cn_ / NCHUNK; \
        _Pragma("unroll") for (int i_ = 0; i_ < 3; ++i_) if (i_ < 2 || (wid == 0)) { const int c_ = 512 * i_ + tid; const int ir_ = (c_ < 1072 ? c_ : 1071) >> 4, rr_ = ir_ - 3, cc_ = c_ & 15; \
            const GAS bf16* p_ = (rr_ >= 0 || n_ == 0) ? proj + (size_t)(b_ * SEQ + 64 * n_ + (rr_ >= 0 ? rr_ : 0)) * GDN_MAIN + hg * 128 + cc_ * 8 : halo + (size_t)(cn_ * 3 + ir_) * GDN_CONV + hg * 128 + cc_ * 8; \
            if (i_ < 2 || lane < 48) __builtin_amdgcn_global_load_lds((const GAS unsigned*)p_, (LAS unsigned*)(lds + (slot_) * CV_SLOT + (512 * i_ + wid * 64) * 16), 16, 0, 0); } } while (0)
#define CONV_BODY(u_, slot_) do { const int n_ = ((u_) >> 6) % NCHUNK; \
        v4u X[5]; _Pragma("unroll") for (int j_ = 0; j_ < 5; ++j_) X[j_] = *(const LAS v4u*)(lds + (slot_) * CV_SLOT + (2 * rg + j_) * 256 + cg * 16); \
        if (n_ == 0) { unsigned z_ = 0u; asm volatile("" : "+v"(z_)); _Pragma("unroll") for (int j_ = 0; j_ < 3; ++j_) if (2 * rg + j_ < 3) X[j_] = (v4u){z_, z_, z_, z_}; } \
        float y_[2][8]; float ss_[2]; \
        _Pragma("unroll") for (int o_ = 0; o_ < 2; ++o_) { float a_[8]; _Pragma("unroll") for (int e_ = 0; e_ < 8; ++e_) a_[e_] = 0.f; \
            _Pragma("unroll") for (int j_ = 0; j_ < 4; ++j_) { const v4u xv = X[o_ + j_]; const f32x4 w0 = w[j_][0], w1 = w[j_][1]; \
                a_[0] += w0.x * bflo(xv.x); a_[1] += w0.y * bfhi(xv.x); a_[2] += w0.z * bflo(xv.y); a_[3] += w0.w * bfhi(xv.y); \
                a_[4] += w1.x * bflo(xv.z); a_[5] += w1.y * bfhi(xv.z); a_[6] += w1.z * bflo(xv.w); a_[7] += w1.w * bfhi(xv.w); } \
            float s2_ = 0.f; _Pragma("unroll") for (int e_ = 0; e_ < 8; ++e_) { const float s_ = fsilu(a_[e_]); y_[o_][e_] = s_; s2_ += s_ * s_; } ss_[o_] = s2_; } \
        float sc_[2] = {1.f, 1.f}; \
        if (hg < 32) { _Pragma("unroll") for (int o_ = 0; o_ < 2; ++o_) { float s_ = ss_[o_]; s_ += shx(s_, 1, lane); s_ += shx(s_, 2, lane); s_ += shx(s_, 4, lane); s_ += shx(s_, 8, lane); \
                sc_[o_] = rsqrtf(s_ + NORM_EPS) * (hg < 16 ? 0.08838834764831845f : 1.f); } } \
        const int cn_ = (u_) >> 6, b_ = cn_ / NCHUNK; \
        _Pragma("unroll") for (int o_ = 0; o_ < 2; ++o_) { v4u ov; const float c_ = sc_[o_]; \
            ov.x = pk2(y_[o_][0] * c_, y_[o_][1] * c_); ov.y = pk2(y_[o_][2] * c_, y_[o_][3] * c_); ov.z = pk2(y_[o_][4] * c_, y_[o_][5] * c_); ov.w = pk2(y_[o_][6] * c_, y_[o_][7] * c_); \
            *(GAS v4u*)(proj + (size_t)(b_ * SEQ + 64 * n_ + 2 * rg + o_) * GDN_MAIN + ch0) = ov; } } while (0)
    const int u0 = vcu;
    for (int k = 0; k < 3; ++k) if (u0 + k * G < NU) CONV_DMA(u0 + k * G, k);
    for (int k = 0, u = u0; u < NU; ++k, u += G) {
        const int rem = (NU - 1 - u) / G;
        if (rem >= 2) { if (wid == 0) asm volatile("s_waitcnt vmcnt(6)" ::: "memory"); else asm volatile("s_waitcnt vmcnt(4)" ::: "memory"); }
        else if (rem == 1) { if (wid == 0) asm volatile("s_waitcnt vmcnt(3)" ::: "memory"); else asm volatile("s_waitcnt vmcnt(2)" ::: "memory"); }
        else VM_WAIT();
        BAR_LDS();
        if (rem >= 3) CONV_DMA(u + 3 * G, (k + 3) & 3);
        CONV_BODY(u, k & 3);
    }
#undef CONV_DMA
#undef CONV_BODY
}
constexpr int P_KT = 0, P_QT = 16384, P_L = 32768, P_LSZ = 12288, P_G = P_L + 8 * P_LSZ, P_B = P_G + 2048, PREP_LDS = P_B + 2048;
__device__ __forceinline__ void phase_prep(const bf16* proj_, const float* ba_, const float* a_log, const float* dt_bias, bf16* TB_, bf16* INTRA_, float* gc_,
                                           LAS unsigned char* lds, int vcu, int G, int tid, int wid, int lane) {
    const GAS bf16* proj = (const GAS bf16*)proj_; const GAS float* ba = (const GAS float*)ba_; GAS bf16* TB = (GAS bf16*)TB_; GAS bf16* INTRA = (GAS bf16*)INTRA_; GAS float* gc = (GAS float*)gc_;
    const int r32 = lane & 31, hi = lane >> 5;
    constexpr int NGRP = NB * NCHUNK * GDN_HQK / 4;
    v4u pk[2], pq[2]; float pa = 0.f, pb = 0.f;
#define PREP_LOAD(grp_, s_) do { const int hq_ = ((grp_) & 3) * 4 + (s_), cn_ = (grp_) >> 2; const size_t tk_ = (size_t)(cn_ / NCHUNK) * SEQ + 64 * (cn_ % NCHUNK); \
        _Pragma("unroll") for (int i_ = 0; i_ < 2; ++i_) { const int idx_ = tid + 512 * i_, row_ = idx_ >> 4, ch_ = idx_ & 15; \
            pk[i_] = *(const GAS v4u*)(proj + (tk_ + row_) * GDN_MAIN + GDN_KEY + hq_ * 128 + ch_ * 8); pq[i_] = *(const GAS v4u*)(proj + (tk_ + row_) * GDN_MAIN + hq_ * 128 + ch_ * 8); } \
        if (wid >= 6) { const int h_ = 2 * hq_ + wid - 6; pa = ba[(tk_ + lane) * 64 + 32 + h_]; pb = ba[(tk_ + lane) * 64 + h_]; } } while (0)
    if (vcu < NGRP) PREP_LOAD(vcu, 0);
    for (int grp = vcu; grp < NGRP; grp += G) {
        const int hq0 = (grp & 3) * 4, cn = grp >> 2, n = cn % NCHUNK, b = cn / NCHUNK;
#pragma unroll 1
        for (int s = 0; s < 4; ++s) {
            const int hq = hq0 + s;
#pragma unroll
            for (int i = 0; i < 2; ++i) { const int idx = tid + 512 * i, row = idx >> 4, ch = idx & 15;
                *(LAS v4u*)(lds + P_KT + off_b(row, ch)) = pk[i]; *(LAS v4u*)(lds + P_QT + off_b(row, ch)) = pq[i]; }
            if (wid >= 6) {
                const int vh = wid - 6, h = 2 * hq + vh;
                float gg = -__expf(a_log[h]) * softplus_f(pa + dt_bias[h]);
                int ln = lane; asm volatile("" : "+v"(ln));
#pragma unroll
                for (int o = 1; o < 64; o <<= 1) { const float t = __builtin_bit_cast(float, __builtin_amdgcn_ds_bpermute((ln >= o ? ln - o : ln) << 2, __builtin_bit_cast(int, gg))); if (ln >= o) gg += t; }
                ((LAS float*)(lds + P_G))[(2 * s + vh) * 64 + lane] = gg; ((LAS float*)(lds + P_B))[(2 * s + vh) * 64 + lane] = fsigmoid(pb);
                gc[((size_t)(b * GDN_HV + h)) * SEQ + 64 * n + lane] = gg;
            }
            if (s < 3) PREP_LOAD(grp, s + 1); else if (grp + G < NGRP) PREP_LOAD(grp + G, 0);
            __syncthreads();
            if (wid < 6) {
                const int tw = wid % 3, it = tw > 0 ? 1 : 0, jt = tw > 1 ? 1 : 0; const bool isk = wid < 3;
                const LAS unsigned char* As = lds + (isk ? P_KT : P_QT); const LAS unsigned char* Bs = lds + P_KT;
                f32x16 acc = {};
#pragma unroll
                for (int ks = 0; ks < 8; ++ks) { const bf16x8 a = *(const LAS bf16x8*)(As + off_b(32 * it + r32, 2 * ks + hi)), bb = *(const LAS bf16x8*)(Bs + off_b(32 * jt + r32, 2 * ks + hi));
                    acc = MFMA32(a, bb, acc); }
                const int j = 32 * jt + r32;
#pragma unroll
                for (int vh = 0; vh < 2; ++vh) {
                    const LAS float* Gv = (const LAS float*)(lds + P_G) + (2 * s + vh) * 64; const LAS float* Bv = (const LAS float*)(lds + P_B) + (2 * s + vh) * 64;
                    const float gj = Gv[j];
                    f32x4 gi[4], bi[4];
#pragma unroll
                    for (int g_ = 0; g_ < 4; ++g_) { gi[g_] = *(const LAS f32x4*)(Gv + 32 * it + 8 * g_ + 4 * hi); bi[g_] = *(const LAS f32x4*)(Bv + 32 * it + 8 * g_ + 4 * hi); }
                    __builtin_amdgcn_sched_barrier(0);
                    if (isk) { LAS float* L = (LAS float*)(lds + P_L + (2 * s + vh) * P_LSZ) + (it ? 1024 : 0);
#pragma unroll
                        for (int r = 0; r < 16; ++r) { const int il = crow(r, hi), i = 32 * it + il; const float v = bi[r >> 2][r & 3] * acc[r] * __expf(gi[r >> 2][r & 3] - gj); L[il * (it ? 64 : 32) + j] = (j < i) ? v : 0.f; }
                    } else { GAS bf16* dst = INTRA + ((size_t)(b * GDN_HV + 2 * hq + vh) * NCHUNK + n) * 4096;
#pragma unroll
                        for (int r = 0; r < 16; ++r) { const int i = 32 * it + crow(r, hi); const float v = acc[r] * __expf(gi[r >> 2][r & 3] - gj); dst[i * 64 + j] = (bf16)f2bf((j <= i) ? v : 0.f); }
                    }
                }
            }
            __syncthreads();
        }
        {
            const int hq = hq0 + (wid >> 1), h = 2 * hq + (wid & 1);
            const LAS float* L = (const LAS float*)(lds + P_L + wid * P_LSZ); const float bj = ((const LAS float*)(lds + P_B))[wid * 64 + lane];
            float Tc[64];
            int ln = lane; asm volatile("" : "+v"(ln));
#pragma unroll
            for (int i = 0; i < 64; ++i) Tc[i] = 0.f;
            f32x4 rb[16];
#define INV_LROW(i_) (L + ((i_) < 32 ? (i_) * 32 : 1024 + ((i_) - 32) * 64))
            Tc[0] = (ln == 0) ? 1.f : 0.f;
            rb[0] = *(const LAS f32x4*)(INV_LROW(1));
#pragma unroll
            for (int i = 1; i < 64; ++i) {
                float acc = (ln == i) ? 1.f : 0.f;
#pragma unroll
                for (int c = 0; c < (i + 3) / 4; ++c) { const f32x4 l4 = rb[c];
                    acc -= l4.x * Tc[4 * c]; acc -= l4.y * Tc[4 * c + 1]; acc -= l4.z * Tc[4 * c + 2]; acc -= l4.w * Tc[4 * c + 3];
                    __builtin_amdgcn_sched_barrier(0);
                    if (i + 1 < 64) rb[c] = *(const LAS f32x4*)(INV_LROW(i + 1) + 4 * c);
                    __builtin_amdgcn_sched_barrier(0); }
                if (i + 1 < 64 && (i + 4) / 4 > (i + 3) / 4) rb[(i + 3) / 4] = *(const LAS f32x4*)(INV_LROW(i + 1) + 4 * ((i + 3) / 4));
                Tc[i] = acc;
            }
#undef INV_LROW
            GAS bf16* dst = TB + ((size_t)(b * GDN_HV + h) * NCHUNK + n) * 4096;
#pragma unroll
            for (int i = 0; i < 64; ++i) dst[i * 64 + lane] = (bf16)f2bf(Tc[i] * bj);
        }
        __syncthreads();
    }
#undef PREP_LOAD
}
constexpr int SB_SZ = 55552, S_KT = 0, S_QT = 16384, S_TT = 32768, S_IT = 41984, S_VT = 51200, S_GG = 55296;
constexpr int S_ST = 2 * SB_SZ, ST_P = 272, S_XT = S_ST + 32 * ST_P, XT_P = 144, S_VNT = S_XT + 32 * XT_P, S_VST = S_VNT + 32 * XT_P, S_OT = S_VST + 32 * XT_P, SCAN_LDS = S_OT + 4096;
#define TRW4(a, b, c, d, e, f, g_, h_) asm volatile("s_waitcnt lgkmcnt(0)" : "+v"(a), "+v"(b), "+v"(c), "+v"(d), "+v"(e), "+v"(f), "+v"(g_), "+v"(h_) :: "memory")
struct ScanRegs { v4u k[2], q[2], t, i, v; float g; };
__device__ __forceinline__ void phase_scan(bf16* proj_, const bf16* TB_, const bf16* INTRA_, const float* gc_, LAS unsigned char* lds, int vcu, int G, int tid, int wid, int lane) {
    GAS bf16* proj = (GAS bf16*)proj_; const GAS bf16* TB = (const GAS bf16*)TB_; const GAS bf16* INTRA = (const GAS bf16*)INTRA_; const GAS float* gc = (const GAS float*)gc_;
    const int r32 = lane & 31, hi = lane >> 5, blk = (lane >> 4) & 1, q4 = (lane & 15) >> 2, p4 = lane & 3;
    const unsigned ldsb = (unsigned)(uintptr_t)lds;
    for (int u = vcu; u < NB * GDN_HV * 4; u += G) {
        const int sl = u & 3, bh = u >> 2, h = bh % GDN_HV, b = bh / GDN_HV, hq = h >> 1, e0 = sl * 32;
        ScanRegs RA, RB;
#define SCAN_LOAD(R, n_) do { const int nn_ = (n_) < NCHUNK ? (n_) : NCHUNK - 1; const size_t tok0_ = (size_t)b * SEQ + 64 * nn_; \
            _Pragma("unroll") for (int i_ = 0; i_ < 2; ++i_) { const int idx_ = tid + 512 * i_, row_ = idx_ >> 4, ch_ = idx_ & 15; \
                R.k[i_] = *(const GAS v4u*)(proj + (tok0_ + row_) * GDN_MAIN + GDN_KEY + hq * 128 + ch_ * 8); R.q[i_] = *(const GAS v4u*)(proj + (tok0_ + row_) * GDN_MAIN + hq * 128 + ch_ * 8); } \
            { const size_t mb_ = ((size_t)bh * NCHUNK + nn_) * 4096 + (tid >> 3) * 64 + (tid & 7) * 8; R.t = *(const GAS v4u*)(TB + mb_); R.i = *(const GAS v4u*)(INTRA + mb_); } \
            R.v = *(const GAS v4u*)(proj + (tok0_ + ((tid & 255) >> 2)) * GDN_MAIN + GDN_CONV / 2 + h * 128 + e0 + (tid & 3) * 8); \
            R.g = gc[(size_t)bh * SEQ + 64 * nn_ + (tid & 63)]; } while (0)
#define SCAN_WRITE(R, buf_) do { LAS unsigned char* B_ = lds + (buf_) * SB_SZ; \
            _Pragma("unroll") for (int i_ = 0; i_ < 2; ++i_) { const int idx_ = tid + 512 * i_, row_ = idx_ >> 4, ch_ = idx_ & 15; \
                *(LAS v4u*)(B_ + S_KT + off_b(row_, ch_)) = R.k[i_]; *(LAS v4u*)(B_ + S_QT + off_b(row_, ch_)) = R.q[i_]; } \
            *(LAS v4u*)(B_ + S_TT + (tid >> 3) * 144 + (tid & 7) * 16) = R.t; *(LAS v4u*)(B_ + S_IT + (tid >> 3) * 144 + (tid & 7) * 16) = R.i; \
            if (tid < 256) *(LAS v4u*)(B_ + S_VT + (tid >> 2) * 64 + (tid & 3) * 16) = R.v; \
            if (tid < 64) ((LAS float*)(B_ + S_GG))[tid] = R.g; } while (0)
        SCAN_LOAD(RA, 0);
        { unsigned z = 0u; asm volatile("" : "+v"(z)); for (int i = tid; i < (32 * ST_P) / 16; i += 512) *(LAS v4u*)(lds + S_ST + i * 16) = (v4u){z, z, z, z}; }
        VM_WAIT(); SCAN_WRITE(RA, 0);
        SCAN_LOAD(RB, 1);
        f32x16 Sacc = {};
        __syncthreads();
        const unsigned fx16 = (unsigned)(((((r32 & 3) << 2) | ((r32 >> 2) & 3)) ^ hi) << 4);
        LAS unsigned char* stR = lds + S_ST + r32 * ST_P + 16 * hi;  LAS unsigned char* stW = lds + S_ST + r32 * ST_P + 8 * hi;
        LAS unsigned char* xR = lds + S_XT + r32 * XT_P + 16 * hi;   LAS unsigned char* xW = lds + S_XT + r32 * XT_P + 8 * hi;
#define PK4W(dst, a0_, a1_, a2_, a3_) do { v2u w_; w_.x = pk2(a0_, a1_); w_.y = pk2(a2_, a3_); *(LAS v2u*)(dst) = w_; } while (0)
#define SCAN_STEP(n, RI, RO) do { \
            const int buf = (n) & 1; LAS unsigned char* B = lds + buf * SB_SZ; const LAS float* GG = (const LAS float*)(B + S_GG); \
            if (wid >= 4 && (n) > 0) {                                    \
                const int t_ = tid - 256; const v4u ov = *(const LAS v4u*)(lds + S_OT + t_ * 16); \
                *(GAS v4u*)(proj + ((size_t)b * SEQ + 64 * ((n) - 1) + (t_ >> 2)) * GDN_MAIN + GDN_CONV / 2 + h * 128 + e0 + (t_ & 3) * 8) = ov; } \
            SCAN_LOAD(RI, (n) + 2); \
            f32x16 acc = {}; \
            if (wid < 4) {                                               \
                const LAS unsigned char* Ar = B + (wid < 2 ? S_KT : S_QT) + 256 * (32 * (wid & 1) + r32); \
                bf16x8 af_[8], bf_[8]; \
                _Pragma("unroll") for (int ks = 0; ks < 8; ++ks) { af_[ks] = *(const LAS bf16x8*)(Ar + ((32u * ks) ^ fx16)); bf_[ks] = *(const LAS bf16x8*)(stR + 32 * ks); } \
                __builtin_amdgcn_sched_barrier(0);                       \
                _Pragma("unroll") for (int ks = 0; ks < 8; ++ks) acc = MFMA32(af_[ks], bf_[ks], acc); \
                if (wid < 2) {                                           \
                    f32x4 gg_[4]; unsigned short vv_[16]; \
                    _Pragma("unroll") for (int g_ = 0; g_ < 4; ++g_) { const int c0 = 32 * wid + 8 * g_ + 4 * hi; gg_[g_] = *(const LAS f32x4*)(GG + c0); \
                        _Pragma("unroll") for (int j_ = 0; j_ < 4; ++j_) vv_[4 * g_ + j_] = *(const LAS unsigned short*)(B + S_VT + (c0 + j_) * 64 + r32 * 2); } \
                    __builtin_amdgcn_sched_barrier(0); \
                    _Pragma("unroll") for (int g_ = 0; g_ < 4; ++g_) { float xv[4]; \
                        _Pragma("unroll") for (int j_ = 0; j_ < 4; ++j_) xv[j_] = bf2f(vv_[4 * g_ + j_]) - __expf(gg_[g_][j_]) * acc[4 * g_ + j_]; \
                        PK4W(xW + 64 * wid + 16 * g_, xv[0], xv[1], xv[2], xv[3]); } \
                } \
            } \
            BAR_LDS();                                                      \
            const float gl = GG[63]; \
            if (wid < 2) {                                               \
                f32x16 a3_ = {}; const LAS unsigned char* Ar_ = B + S_TT + (32 * wid + r32) * 144 + 16 * hi; \
                bf16x8 af_[4], bf_[4]; f32x4 gg_[4]; \
                _Pragma("unroll") for (int ks = 0; ks < 4; ++ks) { af_[ks] = *(const LAS bf16x8*)(Ar_ + 32 * ks); bf_[ks] = *(const LAS bf16x8*)(xR + 32 * ks); } \
                _Pragma("unroll") for (int g_ = 0; g_ < 4; ++g_) gg_[g_] = *(const LAS f32x4*)(GG + 32 * wid + 8 * g_ + 4 * hi); \
                __builtin_amdgcn_sched_barrier(0); \
                _Pragma("unroll") for (int ks = 0; ks < 4; ++ks) if (ks < 2 || wid > 0) a3_ = MFMA32(af_[ks], bf_[ks], a3_); \
                MFMA_SETTLE(a3_); \
                _Pragma("unroll") for (int g_ = 0; g_ < 4; ++g_) { const f32x4 gg = gg_[g_]; \
                    PK4W(xW + (S_VNT - S_XT) + 64 * wid + 16 * g_, a3_[4 * g_], a3_[4 * g_ + 1], a3_[4 * g_ + 2], a3_[4 * g_ + 3]); \
                    PK4W(xW + (S_VST - S_XT) + 64 * wid + 16 * g_, a3_[4 * g_] * __expf(gl - gg[0]), a3_[4 * g_ + 1] * __expf(gl - gg[1]), a3_[4 * g_ + 2] * __expf(gl - gg[2]), a3_[4 * g_ + 3] * __expf(gl - gg[3])); } \
            } \
            BAR_LDS();                                                      \
            if (wid == 2 || wid == 3) {                                  \
                const int ct = wid - 2; \
                const LAS unsigned char* Ar_ = B + S_IT + (32 * ct + r32) * 144 + 16 * hi; \
                bf16x8 af_[4], bf_[4]; f32x4 gg_[4]; \
                _Pragma("unroll") for (int g_ = 0; g_ < 4; ++g_) gg_[g_] = *(const LAS f32x4*)(GG + 32 * ct + 8 * g_ + 4 * hi); \
                _Pragma("unroll") for (int ks = 0; ks < 4; ++ks) { af_[ks] = *(const LAS bf16x8*)(Ar_ + 32 * ks); bf_[ks] = *(const LAS bf16x8*)(xR + (S_VNT - S_XT) + 32 * ks); } \
                __builtin_amdgcn_sched_barrier(0); \
                _Pragma("unroll") for (int g_ = 0; g_ < 4; ++g_) _Pragma("unroll") for (int j_ = 0; j_ < 4; ++j_) acc[4 * g_ + j_] *= __expf(gg_[g_][j_]); \
                _Pragma("unroll") for (int ks = 0; ks < 4; ++ks) if (ks < 2 || ct > 0) acc = MFMA32(af_[ks], bf_[ks], acc); \
                MFMA_SETTLE(acc); \
                _Pragma("unroll") for (int r = 0; r < 16; ++r) *(LAS unsigned short*)(lds + S_OT + (32 * ct + crow(r, hi)) * 64 + r32 * 2) = (unsigned short)f2bf(acc[r]); \
            } else if (wid >= 4) {                                       \
                const int dt = wid - 4; const float egl = __expf(gl); \
                _Pragma("unroll") for (int r = 0; r < 16; ++r) Sacc[r] *= egl; \
                  \
                const unsigned chk = (unsigned)(4 * dt + 2 * blk + (p4 >> 1)); \
                const unsigned kb0 = ldsb + buf * SB_SZ + S_KT + 256u * (8 * hi + q4) + 16u * (chk ^ (unsigned)((q4 << 2) | ((2 * hi) & 3))) + 8u * (p4 & 1); \
                const unsigned kb1 = ldsb + buf * SB_SZ + S_KT + 256u * (8 * hi + 4 + q4) + 16u * (chk ^ (unsigned)((q4 << 2) | ((2 * hi + 1) & 3))) + 8u * (p4 & 1); \
                s16x4 al0, ah0, al1, ah1, al2, ah2, al3, ah3; \
                asm volatile("ds_read_b64_tr_b16 %0, %2\n\tds_read_b64_tr_b16 %1, %3" : "=&v"(al0), "=&v"(ah0) : "v"(kb0), "v"(kb1) : "memory"); \
                asm volatile("ds_read_b64_tr_b16 %0, %2 offset:4096\n\tds_read_b64_tr_b16 %1, %3 offset:4096" : "=&v"(al1), "=&v"(ah1) : "v"(kb0), "v"(kb1) : "memory"); \
                asm volatile("ds_read_b64_tr_b16 %0, %2 offset:8192\n\tds_read_b64_tr_b16 %1, %3 offset:8192" : "=&v"(al2), "=&v"(ah2) : "v"(kb0), "v"(kb1) : "memory"); \
                asm volatile("ds_read_b64_tr_b16 %0, %2 offset:12288\n\tds_read_b64_tr_b16 %1, %3 offset:12288" : "=&v"(al3), "=&v"(ah3) : "v"(kb0), "v"(kb1) : "memory"); \
                const bf16x8 b0_ = *(const LAS bf16x8*)(xR + (S_VST - S_XT)), b1_ = *(const LAS bf16x8*)(xR + (S_VST - S_XT) + 32), b2_ = *(const LAS bf16x8*)(xR + (S_VST - S_XT) + 64), b3_ = *(const LAS bf16x8*)(xR + (S_VST - S_XT) + 96); \
                TRW4(al0, ah0, al1, ah1, al2, ah2, al3, ah3); \
                Sacc = MFMA32(TR_CAT(al0, ah0), b0_, Sacc); Sacc = MFMA32(TR_CAT(al1, ah1), b1_, Sacc); Sacc = MFMA32(TR_CAT(al2, ah2), b2_, Sacc); Sacc = MFMA32(TR_CAT(al3, ah3), b3_, Sacc); \
                MFMA_SETTLE(Sacc); \
                _Pragma("unroll") for (int g_ = 0; g_ < 4; ++g_) PK4W(stW + 64 * dt + 16 * g_, Sacc[4 * g_], Sacc[4 * g_ + 1], Sacc[4 * g_ + 2], Sacc[4 * g_ + 3]); \
            } \
            asm volatile("s_waitcnt vmcnt(8)" ::: "memory");              \
            if ((n) + 1 < NCHUNK) SCAN_WRITE(RO, buf ^ 1); \
            BAR_LDS();                                                      \
        } while (0)
        for (int n = 0; n < NCHUNK; n += 2) { SCAN_STEP(n, RA, RB); SCAN_STEP(n + 1, RB, RA); }
        if (wid >= 4) { const int t_ = tid - 256; const v4u ov = *(const LAS v4u*)(lds + S_OT + t_ * 16);
            *(GAS v4u*)(proj + ((size_t)b * SEQ + 64 * (NCHUNK - 1) + (t_ >> 2)) * GDN_MAIN + GDN_CONV / 2 + h * 128 + e0 + (t_ & 3) * 8) = ov; }
        VM_WAIT(); __syncthreads();
#undef SCAN_LOAD
#undef SCAN_WRITE
#undef SCAN_STEP
#undef PK4W
    }
}
#undef TRW4
__device__ __forceinline__ void phase_gate(bf16* proj, const float* out_norm, int gw, int NGW, int lane) {
    const int g = lane >> 4, i = lane & 15; float w[8];
#pragma unroll
    for (int e = 0; e < 8; ++e) w[e] = out_norm[8 * i + e];
    for (int m = gw; m < NT; m += NGW) {
        const bf16* orow = proj + (size_t)m * GDN_MAIN + GDN_CONV / 2; bf16* zrow = proj + (size_t)m * GDN_MAIN + GDN_CONV;
#pragma unroll 4
        for (int it = 0; it < GDN_HV / 4; ++it) {
            const int off = (4 * it + g) * 128 + 8 * i;
            const v4u ov = *(const v4u*)(orow + off), zv = *(const v4u*)(zrow + off);
            float o[8], z[8];
            o[0] = bflo(ov.x); o[1] = bfhi(ov.x); o[2] = bflo(ov.y); o[3] = bfhi(ov.y); o[4] = bflo(ov.z); o[5] = bfhi(ov.z); o[6] = bflo(ov.w); o[7] = bfhi(ov.w);
            z[0] = bflo(zv.x); z[1] = bfhi(zv.x); z[2] = bflo(zv.y); z[3] = bfhi(zv.y); z[4] = bflo(zv.z); z[5] = bfhi(zv.z); z[6] = bflo(zv.w); z[7] = bfhi(zv.w);
            float ss = 0.f;
#pragma unroll
            for (int e = 0; e < 8; ++e) ss += o[e] * o[e];
            ss += shx(ss, 1, lane); ss += shx(ss, 2, lane); ss += shx(ss, 4, lane); ss += shx(ss, 8, lane);
            const float rs = rsqrtf(ss * (1.f / 128.f) + NORM_EPS);
            float r[8];
#pragma unroll
            for (int e = 0; e < 8; ++e) r[e] = o[e] * rs * w[e] * fsilu(z[e]);
            v4u res; res.x = pk2(r[0], r[1]); res.y = pk2(r[2], r[3]); res.z = pk2(r[4], r[5]); res.w = pk2(r[6], r[7]);
            *(v4u*)(zrow + off) = res;
        }
    }
}
#undef MFMA32
#undef BAR_LDS
#undef MFMA_SETTLE
#undef TR_ISSUE
#undef TR_CAT
}

struct Args { const void* in[25]; float* out; unsigned char* ws; };
__device__ __forceinline__ int lane_id_now() { int l; asm volatile("v_mbcnt_lo_u32_b32 %0, -1, 0\n\tv_mbcnt_hi_u32_b32 %0, -1, %0" : "=v"(l)); return l; }
__global__ void __launch_bounds__(NWAVES * 64, 2) mk_fwd(Args a) {
    extern __shared__ __attribute__((aligned(16))) unsigned char lds_raw[];
    LAS unsigned char* lds = (LAS unsigned char*)lds_raw;
    const int tid0 = threadIdx.x; const int wave0 = __builtin_amdgcn_readfirstlane(tid0 >> 6);
    const int G0 = gridDim.x, bx0 = blockIdx.x, vcu0 = (G0 % 8 == 0) ? (bx0 % 8) * (G0 / 8) + bx0 / 8 : bx0;
    volatile LAS unsigned* MISC = (volatile LAS unsigned*)(lds + MISC_OFF);
    if (tid0 < 64) MISC[tid0] = 0u;
    __syncthreads();
    typedef const __attribute__((address_space(4))) unsigned long long* kargp_t;
    const kargp_t kargs0 = (kargp_t)__builtin_amdgcn_kernarg_segment_ptr();
    XcdBarrier bar = xcd_barrier_post((unsigned*)(a.ws + WS_CTL) + CW_BAR, MISC + 8);
#define BTID() (wave0 * 64 + lane_id_now())
#if PROBE_MASK
    if (tid0 == 0) { const unsigned long long t_ = __builtin_amdgcn_s_memrealtime(); MISC[16] = (unsigned)t_; MISC[17] = (unsigned)(t_ >> 32); MISC[18] = 0u; MISC[19] = 0u; }
#define GRID_BAR(cls) do { { XcdBarrier b_ = bar; asm volatile("" : "+s"(b_.bar), "+s"(b_.x)); xcd_barrier(b_, BTID()); } \
        if (BTID() == 0) { const unsigned long long now_ = __builtin_amdgcn_s_memrealtime(); const unsigned long long last_ = ((unsigned long long)MISC[17] << 32) | MISC[16]; \
            if ((cls) & PROBE_MASK) { const unsigned long long a_ = (((unsigned long long)MISC[19] << 32) | MISC[18]) + (now_ - last_); MISC[18] = (unsigned)a_; MISC[19] = (unsigned)(a_ >> 32); } \
            MISC[16] = (unsigned)now_; MISC[17] = (unsigned)(now_ >> 32); } } while (0)
#else
#define GRID_BAR(cls) do { XcdBarrier b_ = bar; asm volatile("" : "+s"(b_.bar), "+s"(b_.x)); xcd_barrier(b_, BTID()); } while (0)
#endif
#define PH() int wave = wave0; asm volatile("" : "+s"(wave)); int tid = wave * 64 + lane_id_now(); const int lane = tid & 63; \
             int G = G0, bx = bx0, vcu = vcu0; asm volatile("" : "+s"(G), "+s"(bx), "+s"(vcu)); const int NGW = G * NWAVES, NGT = G * NWAVES * 64; (void)bx; (void)NGW; (void)NGT; \
             const int gw = vcu * NWAVES + wave, gtid = vcu * (NWAVES * 64) + tid; (void)lane; (void)wave; (void)gw; (void)gtid; \
             kargp_t kp = kargs0; asm volatile("" : "+s"(kp)); unsigned char* ws = (unsigned char*)(GAS unsigned char*)kp[26]; float* out = (float*)(GAS float*)kp[25]; \
             unsigned char* wmix = ws + WS_WMIX; bf16* A0 = (bf16*)(ws + WS_A0); unsigned char* A1 = ws + WS_A1; const float* hin = layer == 0 ? (const float*)(const GAS float*)kp[0] : out; \
             LAS float* scr = (LAS float*)(lds + wave * 16384); \
             (void)out; (void)wmix; (void)A0; (void)A1; (void)hin; (void)scr
#define IN(i) ((const float*)(const GAS float*)kp[i])
#define GEMMX(F16_, EPI, Aptr, Bptr, N_, K_, lda_, ldb_, ...) do { pg8::Gemm g{(const bf16*)(Aptr), (const bf16*)(Bptr), NT, (N_), (K_), (lda_), (ldb_)}; pg8::StaticOrder S; S.init(NT, (N_), G, bx); \
             pg8::EPI E{__VA_ARGS__}; pg8::gemm_phase<pg8::EPI, pg8::StaticOrder, true, true, F16_>(lds, g, S, E, tid); } while (0)
#define GEMM(...) GEMMX(false, __VA_ARGS__)
#define GEMMH(...) GEMMX(true, __VA_ARGS__)
#define COMMA ,
#define SSY ((float*)(ws + WS_SS))
#define SSX1 ((float*)(ws + WS_SS) + 32 * NT)
#define SSX2 ((float*)(ws + WS_SS) + 64 * NT)
#define HBX ((bf16*)(A1 + A1_HBX))
#define HY ((bf16*)out)
    { const int layer = 0; PH(); phase_rope_table((const int*)(const GAS int*)kp[2], (float*)(ws + WS_ROPE), gtid, NGT); }
    { const int layer = 0; PH(); phase_cast_ss(hin, HY, SSY, gw, NGW, lane); }
    for (int layer = 0; layer < DEPTH; ++layer) {
        const int j = layer >> 1; const bool is_mla = (layer & 1) == 0;
        if (is_mla) {
            { PH(); convert_matrix<0, true>(IN(4) + (size_t)j * DM * MLA_IN, IN(3) + layer * DM, DM, MLA_IN, (bf16*)(wmix + WM_MLA_IN), 0, scr, gw, NGW, lane); }
            { PH(); zero_rows((bf16*)(wmix + WM_MLA_IN), DM, MLA_IN, MLA_IN_PAD - MLA_IN, gtid, NGT); }
            { PH(); convert_matrix<0>(IN(7) + (size_t)j * MLA_QL * (MLA_H * MLA_QK), IN(5) + j * MLA_QL, MLA_QL, MLA_H * MLA_QK, (bf16*)(wmix + WM_MLA_UQ), 0, scr, gw, NGW, lane); }
            { PH(); convert_matrix<0>(IN(8) + (size_t)j * MLA_KVL * (MLA_H * 256), IN(6) + j * MLA_KVL, MLA_KVL, MLA_H * 256, (bf16*)(wmix + WM_MLA_UKV), 0, scr, gw, NGW, lane); }
            { PH(); convert_matrix<0>(IN(11) + (size_t)j * DM * DM, nullptr, DM, DM, (bf16*)(wmix + WM_MLA_O), 0, scr, gw, NGW, lane); }
        } else {
            { PH(); convert_matrix<0, true>(IN(12) + (size_t)j * DM * GDN_IN, IN(3) + layer * DM, DM, GDN_IN, (bf16*)(wmix + WM_GDN_IN), 0, scr, gw, NGW, lane); }
            { PH(); zero_rows((bf16*)(wmix + WM_GDN_IN), DM, GDN_IN, GDN_IN_PAD - GDN_IN, gtid, NGT); }
            { PH(); convert_matrix<0>(IN(17) + (size_t)j * GDN_VAL * DM, nullptr, GDN_VAL, DM, (bf16*)(wmix + WM_GDN_OUT), 0, scr, gw, NGW, lane); }
        }
        { PH(); convert_matrix<1, true>(IN(19) + (size_t)layer * DM * (2 * DFF), IN(18) + layer * DM, DM, 2 * DFF, (bf16*)(ws + WS_WGU), 0, scr, gw, NGW, lane); }
        { PH(); convert_matrix<0>(IN(20) + (size_t)layer * DFF * DM, nullptr, DFF, DM, (bf16*)(ws + WS_WDN), 0, scr, gw, NGW, lane); }
        { PH(); convert_matrix<0>(IN(21) + (size_t)layer * PLE_DIM * DM, nullptr, PLE_DIM, DM, (bf16*)(ws + WS_WPP), 0, scr, gw, NGW, lane); }
        { PH(); convert_matrix<0, true>(IN(24) + (size_t)layer * DM * DM, IN(23) + layer * DM, DM, DM, (bf16*)(ws + WS_WPG), 0, scr, gw, NGW, lane); }
        { PH(); phase_cvt_bf16(IN(1) + (size_t)layer * NT * PLE_DIM, (bf16*)(ws + WS_PBF), (size_t)NT * PLE_DIM, gtid, NGT); }
        GRID_BAR(1<<0);
        if (is_mla) {
            { PH(); GEMMH(EpiMlaIn, HY, wmix + WM_MLA_IN, MLA_IN_PAD, DM, DM, DM, (bf16*)(A1 + A1_QKVN), (float*)(A1 + A1_KPE), (float*)(A1 + A1_C), SSY); }
            GRID_BAR(1<<1);
            { PH(); GEMM(EpiBf16Lat, A1 + A1_QKVN, wmix + WM_MLA_UQ, MLA_H * MLA_QK, MLA_QL, 1024, MLA_QL, (bf16*)(A1 + A1_QRAW), MLA_H * MLA_QK, (const float*)(A1 + A1_C), 0); }
            { PH(); GEMM(EpiBf16Lat, (bf16*)(A1 + A1_QKVN) + MLA_QL, wmix + WM_MLA_UKV, MLA_H * 256, MLA_KVL, 1024, MLA_KVL, (bf16*)(A1 + A1_KVRAW), MLA_H * 256, (const float*)(A1 + A1_C), 8); }
            GRID_BAR(1<<1);
            { PH(); phase_mla_finalize_kv((const bf16*)(A1 + A1_KVRAW), (const float*)(A1 + A1_KPE), (const float*)(ws + WS_ROPE), IN(10) + j * MLA_QK, (bf16*)(A1 + A1_KF), (bf16*)(A1 + A1_VF), gw, NGW, lane); }
            GRID_BAR(1<<2);
            { PH(); attn::attn_phase((const bf16*)(A1 + A1_QRAW), IN(9) + j * MLA_QK, (const float*)(ws + WS_ROPE), (const bf16*)(A1 + A1_KF), (const bf16*)(A1 + A1_VF), A0, (LAS char*)lds, vcu, G, tid, wave, lane); }
            GRID_BAR(1<<3);
            { PH(); GEMM(EpiResid, A0, wmix + WM_MLA_O, DM, DM, DM, DM, HY, HBX, DM, SSX1); }
            GRID_BAR(1<<1);
        } else {
            { PH(); GEMMH(EpiGdnProj, HY, wmix + WM_GDN_IN, GDN_IN_PAD, DM, DM, DM, (bf16*)(A1 + A1_PROJ), GDN_MAIN, (float*)(A1 + A1_BA), GDN_MAIN / 256, SSY, (bf16*)(A1 + A1_HALO)); }
            GRID_BAR(1<<4);
            { PH(); gdn::phase_conv((bf16*)(A1 + A1_PROJ), (const bf16*)(A1 + A1_HALO), IN(13) + (size_t)j * 4 * GDN_CONV, lds, vcu, G, tid, wave); }
            GRID_BAR(1<<5);
            { PH(); gdn::phase_prep((const bf16*)(A1 + A1_PROJ), (const float*)(A1 + A1_BA), IN(14) + j * GDN_HV, IN(15) + j * GDN_HV, A0, (bf16*)(A1 + A1_INTRA), (float*)(A1 + A1_GC), lds, vcu, G, tid, wave, lane); }
            GRID_BAR(1<<6);
            { PH(); gdn::phase_scan((bf16*)(A1 + A1_PROJ), A0, (const bf16*)(A1 + A1_INTRA), (const float*)(A1 + A1_GC), lds, vcu, G, tid, wave, lane); }
            GRID_BAR(1<<7);
            { PH(); gdn::phase_gate((bf16*)(A1 + A1_PROJ), IN(16) + j * GDN_DV, gw, NGW, lane); }
            GRID_BAR(1<<8);
            { PH(); GEMM(EpiResid, (bf16*)(A1 + A1_PROJ) + GDN_CONV, wmix + WM_GDN_OUT, DM, GDN_VAL, GDN_MAIN, GDN_VAL, HY, HBX, DM, SSX1); }
            GRID_BAR(1<<9);
        }
        { PH(); GEMMH(EpiSiluMul, HBX, ws + WS_WGU, 2 * DFF, DM, DM, DM, (bf16*)(A1 + A1_ACT), DFF, SSX1); }
        { PH(); GEMM(EpiBf16Plain, ws + WS_PBF, ws + WS_WPP, DM, PLE_DIM, PLE_DIM, PLE_DIM, (bf16*)(A1 + A1_E), DM); }
        GRID_BAR(1<<11);
        { PH(); phase_rstd_e((const bf16*)(A1 + A1_E), (float*)(A1 + A1_RSTDE), gw, NGW, lane); }
        { PH(); GEMM(EpiResid, A1 + A1_ACT, ws + WS_WDN, DM, DFF, DFF, DFF, HBX, HBX, DM, SSX2); }
        GRID_BAR(1<<12);
        if (layer + 1 < DEPTH) { PH(); GEMMH(EpiPleGate<false>, HBX, ws + WS_WPG, DM, DM, DM, DM, HBX, HY, nullptr, DM, (const bf16*)(A1 + A1_E), (const float*)(A1 + A1_RSTDE), IN(22) + layer * DM, SSX2, SSY); }
        else { PH(); GEMMH(EpiPleGate<true>, HBX, ws + WS_WPG, DM, DM, DM, DM, HBX, nullptr, out, DM, (const bf16*)(A1 + A1_E), (const float*)(A1 + A1_RSTDE), IN(22) + layer * DM, SSX2, nullptr); }
        GRID_BAR(1<<14);
    }
#if PROBE_MASK
    if (blockIdx.x == 0 && BTID() == 0) { const unsigned long long acc_ = ((unsigned long long)MISC[19] << 32) | MISC[18]; const unsigned long long t0_ = __builtin_amdgcn_s_memrealtime(); while (__builtin_amdgcn_s_memrealtime() - t0_ < acc_) __builtin_amdgcn_s_sleep(32); }
#endif
}

extern "C" void kernel_launch(void* const* d_in, const int* in_sizes, int n_in, void* d_out, int out_size, void* d_ws, size_t ws_size, hipStream_t stream) {
    static int grid = 0;
    if (grid == 0) {
        if (n_in != 25 || out_size != NT * DM || ws_size < WS_END) { fprintf(stderr, "kernel_launch: unexpected shapes: n_in %d out %d ws %zu (need %zu)\n", n_in, out_size, ws_size, (size_t)WS_END); grid = -1; return; }
        int dev = 0, cus = 0, per_cu = 0;
        if (hipGetDevice(&dev) != hipSuccess || hipDeviceGetAttribute(&cus, hipDeviceAttributeMultiprocessorCount, dev) != hipSuccess) { grid = -1; return; }
        if (hipFuncSetAttribute((const void*)mk_fwd, hipFuncAttributeMaxDynamicSharedMemorySize, LDS_BYTES) != hipSuccess) { fprintf(stderr, "kernel_launch: hipFuncSetAttribute failed\n"); grid = -1; return; }
        if (hipOccupancyMaxActiveBlocksPerMultiprocessor(&per_cu, (const void*)mk_fwd, NWAVES * 64, LDS_BYTES) != hipSuccess || per_cu < 1) { fprintf(stderr, "kernel_launch: occupancy query says %d\n", per_cu); grid = -1; (void)hipGetLastError(); return; }
        grid = cus - cus % 64;
        if (grid < 64) { fprintf(stderr, "kernel_launch: %d CUs: need at least 64\n", cus); grid = -1; return; }
    }
    if (grid < 0) return;
    if (hipMemsetAsync((char*)d_ws + WS_CTL, 0, CTL_ZERO_BYTES, stream) != hipSuccess) return;
    Args a{};
    for (int i = 0; i < 25; ++i) a.in[i] = d_in[i];
    a.out = (float*)d_out; a.ws = (unsigned char*)d_ws;
    hipLaunchKernelGGL(mk_fwd, dim3(grid), dim3(NWAVES * 64), LDS_BYTES, stream, a);
}
```

```cpp
#include <hip/hip_runtime.h>
#include <cstdio>
#include <cstdint>

#ifndef PROBE_SCAN
#define PROBE_SCAN (0)
#endif
#ifndef PROBE_ATTN
#define PROBE_ATTN (0)
#endif
#ifndef PROBE_MASK
#define PROBE_MASK (0)
#endif

#define GAS __attribute__((address_space(1)))
#define LAS __attribute__((address_space(3)))
typedef unsigned short bf16;
typedef unsigned v4u __attribute__((ext_vector_type(4)));
typedef unsigned v2u __attribute__((ext_vector_type(2)));
typedef float f32x4 __attribute__((ext_vector_type(4)));
typedef float f32x16 __attribute__((ext_vector_type(16)));
typedef short bf16x8 __attribute__((ext_vector_type(8)));
typedef short s16x4 __attribute__((ext_vector_type(4)));

constexpr int NB = 2, SEQ = 16384, NT = NB * SEQ, DM = 2048, DEPTH = 4;
constexpr float NORM_EPS = 1e-6f;
constexpr int PLE_DIM = 256;
constexpr int MLA_H = 16, MLA_QL = 512, MLA_KVL = 512, MLA_NOPE = 128, MLA_ROPE = 64, MLA_QK = 192, MLA_V = 128;
constexpr int MLA_IN = MLA_QL + MLA_KVL + MLA_ROPE, MLA_IN_PAD = 1280;
constexpr int GDN_HQK = 16, GDN_HV = 32, GDN_DK = 128, GDN_DV = 128, GDN_KEY = 2048, GDN_VAL = 4096, GDN_CONV = 8192;
constexpr int GDN_MAIN = GDN_CONV + GDN_VAL;
constexpr int GDN_IN = GDN_MAIN + 64, GDN_IN_PAD = GDN_MAIN + 256;
constexpr int NCHUNK = SEQ / 64;
constexpr int DFF = 5632;

constexpr size_t MiB = 1u << 20;
constexpr size_t WS_CTL = 0, CTL_ZERO_BYTES = 64 * 1024;
constexpr size_t WS_WMIX = 1 * MiB, WS_WGU = 66 * MiB, WS_WDN = 110 * MiB, WS_WPP = 132 * MiB, WS_WPG = 133 * MiB, WS_ROPE = 141 * MiB;
constexpr size_t WS_A0 = 149 * MiB, WS_A1 = 277 * MiB, WS_SS = 1277 * MiB, WS_PBF = 1289 * MiB, WS_END = 1305 * MiB;
constexpr size_t A1_HBX = 872 * MiB;
constexpr size_t WM_GDN_IN = 0, WM_GDN_OUT = 49 * MiB;
constexpr size_t WM_MLA_IN = 0, WM_MLA_UQ = 5 * MiB, WM_MLA_UKV = 8 * MiB, WM_MLA_O = 12 * MiB;
constexpr size_t A1_C = 0, A1_QKVN = 160 * MiB, A1_KPE = 224 * MiB, A1_QRAW = 232 * MiB, A1_KVRAW = 424 * MiB, A1_KF = 680 * MiB, A1_VF = 872 * MiB, A1_QF = 0;
constexpr size_t A1_PROJ = 0, A1_BA = 768 * MiB, A1_HALO = 776 * MiB, A1_GC = 800 * MiB, A1_INTRA = 804 * MiB;
constexpr size_t A1_ACT = 0, A1_E = 368 * MiB, A1_RSTDE = 496 * MiB;
constexpr int CW_BAR = 1024;

constexpr int LDS_BYTES = 147456;
constexpr int MISC_OFF = LDS_BYTES - 256;
constexpr int NWAVES = 8;

#define LDS_WAIT() asm volatile("s_waitcnt lgkmcnt(0)" ::: "memory")
#define VM_WAIT() asm volatile("s_waitcnt vmcnt(0)" ::: "memory")
__device__ __forceinline__ unsigned pk2(float lo, float hi) { unsigned r; asm("v_cvt_pk_bf16_f32 %0, %1, %2" : "=v"(r) : "v"(lo), "v"(hi)); return r; }
__device__ __forceinline__ unsigned f2bf(float f) { return pk2(f, f) & 0xffffu; }
typedef _Float16 h16x2 __attribute__((ext_vector_type(2)));
__device__ __forceinline__ unsigned pkh2(float lo, float hi) { const h16x2 v = {(_Float16)lo, (_Float16)hi}; return __builtin_bit_cast(unsigned, v); }
__device__ __forceinline__ float bf2f(unsigned short b) { return __uint_as_float(((unsigned)b) << 16); }
__device__ __forceinline__ float bflo(unsigned w) { return __uint_as_float(w << 16); }
__device__ __forceinline__ float bfhi(unsigned w) { return __uint_as_float(w & 0xffff0000u); }
__device__ __forceinline__ float shx(float v, int mask, int lane) { return __builtin_bit_cast(float, __builtin_amdgcn_ds_bpermute((lane ^ mask) << 2, __builtin_bit_cast(int, v))); }
__device__ __forceinline__ float wave_sum(float v, int lane) {
#pragma unroll
    for (int o = 1; o < 64; o <<= 1) v += shx(v, o, lane);
    return v;
}
__device__ __forceinline__ float fsigmoid(float x) { return __builtin_amdgcn_rcpf(1.0f + __builtin_amdgcn_exp2f(-1.4426950408889634f * x)); }
__device__ __forceinline__ float fsilu(float x) { return x * fsigmoid(x); }

namespace pg8 {
#define PG8_LAS __attribute__((address_space(3)))
typedef unsigned short bf16_t;
typedef short bf16x8 __attribute__((ext_vector_type(8)));
typedef float f32x4 __attribute__((ext_vector_type(4)));
typedef unsigned u32x4 __attribute__((ext_vector_type(4)));
constexpr int BM = 256, BK = 64, HALF = 128, HTB = HALF * BK * 2  , STAGE_BYTES = 8 * HTB, NXCD = 8, WGM = 8;

__host__ __device__ __forceinline__ int lds_byte(int r, int c) { const int st = (r >> 4) * 2 + (c >> 5), rr = r & 15, cc = c & 31, ob = rr * 64 + cc * 2; return st * 1024 + (ob ^ (((ob >> 9) & 1) << 5)); }
__host__ __device__ __forceinline__ void stage_rc(int b, int& R, int& C) { const int st = b / 1024, sb = b % 1024, swz = sb ^ (((sb >> 9) & 1) << 5); R = (st >> 1) * 16 + swz / 64; C = (st & 1) * 32 + (swz % 64) / 2; }
__host__ __device__ __forceinline__ int perm32(int rho) { const int n = rho >> 4, i = rho & 15; return 8 * (i >> 2) + 4 * n + (i & 3); }

struct Unit { int pm, pn; };
struct Gemm { const bf16_t* A; const bf16_t* Bt; int M, N, K, lda, ldb; };

struct StaticOrder {
    int nM, nN, nwg, G, c;
    __host__ __device__ void init(int M, int N, int G_, int c_) { nM = M / BM; nN = N / BM; nwg = nM * nN; G = G_; c = c_; }
    __host__ __device__ bool next(int i, Unit& u) const {
        const long L = (long)i * G + c; if (L >= nwg) return false;
        int wgid = (int)L; { const int q = nwg / NXCD, r = nwg % NXCD, xcd = wgid % NXCD, off = wgid / NXCD; wgid = (xcd < r ? xcd * (q + 1) : r * (q + 1) + (xcd - r) * q) + off; }
        const int nig = WGM * nN, gid = wgid / nig, fm = gid * WGM, gsz = (nM - fm) < WGM ? (nM - fm) : WGM;
        u.pm = fm + ((wgid % nig) % gsz); u.pn = (wgid % nig) / gsz; return true;
    }
    __device__ __forceinline__ void a_ready(const Unit&) const {}
    __device__ __forceinline__ void done(const Unit&) const {}
};

__device__ __forceinline__ unsigned cvt_pk_bf16(float lo, float hi) { unsigned r; asm volatile("v_cvt_pk_bf16_f32 %0, %1, %2" : "=v"(r) : "v"(lo), "v"(hi)); return r; }
typedef float f32x2 __attribute__((ext_vector_type(2)));
__device__ __forceinline__ float fast_sigmoid(float x) { return __builtin_amdgcn_rcpf(1.0f + __builtin_amdgcn_exp2f(-1.4426950408889634f * x)); }

__device__ __forceinline__ float sum_fq(float s) {
    { const auto r = __builtin_amdgcn_permlane16_swap(__float_as_uint(s), __float_as_uint(s), false, false); s = __uint_as_float(r[0]) + __uint_as_float(r[1]); }
    { const auto r = __builtin_amdgcn_permlane32_swap(__float_as_uint(s), __float_as_uint(s), false, false); s = __uint_as_float(r[0]) + __uint_as_float(r[1]); }
    return s;
}
__device__ __forceinline__ float row_rstd(const float* ssp, int row, int fq) {
    const f32x4 a = *(const f32x4*)(ssp + (size_t)row * 32 + fq * 8), b = *(const f32x4*)(ssp + (size_t)row * 32 + fq * 8 + 4);
    float s = ((a[0] + a[1]) + (a[2] + a[3])) + ((b[0] + b[1]) + (b[2] + b[3]));
    s = sum_fq(s);
    return rsqrtf(s * (1.f / 2048.f) + 1e-6f);
}

struct EpiF32Plain {
    static constexpr bool PERM = false, AFTER_DRAIN = false;
    float* C; int ldc; const float* ss;
    __device__ __forceinline__ void operator()(const f32x4 (&acc)[2][2][4][2], const Unit& u, int wr, int wc, int fr, int fq) const {
        const int row0 = u.pm * BM + wr * 64 + fr, col0 = u.pn * BM + wc * 32 + 4 * fq;
#pragma unroll
        for (int ai = 0; ai < 2; ++ai)
#pragma unroll
            for (int m = 0; m < 4; ++m) { const int row = row0 + ai * HALF + m * 16; float* rowp = C + (size_t)row * ldc + col0; const float rs = row_rstd(ss, row, fq);
#pragma unroll
                for (int bj = 0; bj < 2; ++bj)
#pragma unroll
                    for (int n = 0; n < 2; ++n) *(f32x4*)(rowp + bj * HALF + n * 16) = acc[ai][bj][m][n] * rs; }
    }
};
struct EpiMlaIn {
    static constexpr bool PERM = true, AFTER_DRAIN = false;
    bf16_t* O; float* KPE; float* ssl; const float* ss;
    __device__ __forceinline__ void operator()(const f32x4 (&acc)[2][2][4][2], const Unit& u, int wr, int wc, int fr, int fq) const {
        const int row0 = u.pm * BM + wr * 64 + fr;
        if (u.pn < 4) {
            const int col0 = u.pn * BM + wc * 32 + 8 * fq;
#pragma unroll
            for (int ai = 0; ai < 2; ++ai)
#pragma unroll
                for (int m = 0; m < 4; ++m) { const int row = row0 + ai * HALF + m * 16; bf16_t* rowp = O + (size_t)row * 1024 + col0; const float rs = row_rstd(ss, row, fq); float sq = 0.f;
#pragma unroll
                    for (int bj = 0; bj < 2; ++bj) { const f32x4 v0 = acc[ai][bj][m][0] * rs, v1 = acc[ai][bj][m][1] * rs;
                        u32x4 w; w.x = cvt_pk_bf16(v0[0], v0[1]); w.y = cvt_pk_bf16(v0[2], v0[3]); w.z = cvt_pk_bf16(v1[0], v1[1]); w.w = cvt_pk_bf16(v1[2], v1[3]);
                        *(u32x4*)(rowp + bj * HALF) = w;
                        sq += ((v0[0] * v0[0] + v0[1] * v0[1]) + (v0[2] * v0[2] + v0[3] * v0[3])) + ((v1[0] * v1[0] + v1[1] * v1[1]) + (v1[2] * v1[2] + v1[3] * v1[3])); }
                    sq = sum_fq(sq);
                    if (fq == 0) ssl[(size_t)row * 16 + u.pn * 4 + wc] = sq; }
        } else if (wc < 2) {
            const int col0 = wc * 32 + 8 * fq;
#pragma unroll
            for (int ai = 0; ai < 2; ++ai)
#pragma unroll
                for (int m = 0; m < 4; ++m) { const int row = row0 + ai * HALF + m * 16; float* rowp = KPE + (size_t)row * 64 + col0; const float rs = row_rstd(ss, row, fq);
                    *(f32x4*)(rowp) = acc[ai][0][m][0] * rs; *(f32x4*)(rowp + 4) = acc[ai][0][m][1] * rs; }
        }
    }
};
struct EpiBf16Lat {
    static constexpr bool PERM = true, AFTER_DRAIN = false;
    bf16_t* O; int ldc; const float* ssl; int slot0;
    __device__ __forceinline__ void operator()(const f32x4 (&acc)[2][2][4][2], const Unit& u, int wr, int wc, int fr, int fq) const {
        const int row0 = u.pm * BM + wr * 64 + fr, col0 = u.pn * BM + wc * 32 + 8 * fq;
#pragma unroll
        for (int ai = 0; ai < 2; ++ai)
#pragma unroll
            for (int m = 0; m < 4; ++m) { const int row = row0 + ai * HALF + m * 16; bf16_t* rowp = O + (size_t)row * ldc + col0;
                const f32x2 pr = *(const f32x2*)(ssl + (size_t)row * 16 + slot0 + 2 * fq); float s = pr[0] + pr[1]; s = sum_fq(s);
                const float rs = rsqrtf(s * (1.f / 512.f) + 1e-6f);
#pragma unroll
                for (int bj = 0; bj < 2; ++bj) { const f32x4 v0 = acc[ai][bj][m][0] * rs, v1 = acc[ai][bj][m][1] * rs;
                    u32x4 w; w.x = cvt_pk_bf16(v0[0], v0[1]); w.y = cvt_pk_bf16(v0[2], v0[3]); w.z = cvt_pk_bf16(v1[0], v1[1]); w.w = cvt_pk_bf16(v1[2], v1[3]);
                    *(u32x4*)(rowp + bj * HALF) = w; } }
    }
};
struct EpiBf16Plain {
    static constexpr bool PERM = true, AFTER_DRAIN = false;
    bf16_t* O; int ldc;
    __device__ __forceinline__ void operator()(const f32x4 (&acc)[2][2][4][2], const Unit& u, int wr, int wc, int fr, int fq) const {
        const int row0 = u.pm * BM + wr * 64 + fr, col0 = u.pn * BM + wc * 32 + 8 * fq;
#pragma unroll
        for (int ai = 0; ai < 2; ++ai)
#pragma unroll
            for (int m = 0; m < 4; ++m) { bf16_t* rowp = O + (size_t)(row0 + ai * HALF + m * 16) * ldc + col0;
#pragma unroll
                for (int bj = 0; bj < 2; ++bj) { const f32x4 v0 = acc[ai][bj][m][0], v1 = acc[ai][bj][m][1];
                    u32x4 w; w.x = cvt_pk_bf16(v0[0], v0[1]); w.y = cvt_pk_bf16(v0[2], v0[3]); w.z = cvt_pk_bf16(v1[0], v1[1]); w.w = cvt_pk_bf16(v1[2], v1[3]);
                    *(u32x4*)(rowp + bj * HALF) = w; } }
    }
};
struct EpiGdnProj {
    static constexpr bool PERM = true, AFTER_DRAIN = false;
    bf16_t* O; int ldc; float* BA; int ntile_bf; const float* ss; bf16_t* halo;
    __device__ __forceinline__ void operator()(const f32x4 (&acc)[2][2][4][2], const Unit& u, int wr, int wc, int fr, int fq) const {
        const int row0 = u.pm * BM + wr * 64 + fr;
        if (u.pn < ntile_bf) {
            const int col0 = u.pn * BM + wc * 32 + 8 * fq;
#pragma unroll
            for (int ai = 0; ai < 2; ++ai)
#pragma unroll
                for (int m = 0; m < 4; ++m) { const int row = row0 + ai * HALF + m * 16; bf16_t* rowp = O + (size_t)row * ldc + col0; const float rs = row_rstd(ss, row, fq);
#pragma unroll
                    for (int bj = 0; bj < 2; ++bj) { const f32x4 v0 = acc[ai][bj][m][0] * rs, v1 = acc[ai][bj][m][1] * rs;
                        u32x4 w; w.x = cvt_pk_bf16(v0[0], v0[1]); w.y = cvt_pk_bf16(v0[2], v0[3]); w.z = cvt_pk_bf16(v1[0], v1[1]); w.w = cvt_pk_bf16(v1[2], v1[3]);
                        *(u32x4*)(rowp + bj * HALF) = w;
                        if ((row & 63) >= 61 && u.pn < 32 && ((row >> 6) & 255) != 255) *(u32x4*)(halo + ((size_t)((row >> 6) + 1) * 3 + (row & 63) - 61) * 8192 + col0 + bj * HALF) = w; } }
        } else if (wc < 2) {
            const int col0 = wc * 32 + 8 * fq;
#pragma unroll
            for (int ai = 0; ai < 2; ++ai)
#pragma unroll
                for (int m = 0; m < 4; ++m) { const int row = row0 + ai * HALF + m * 16; float* rowp = BA + (size_t)row * 64 + col0; const float rs = row_rstd(ss, row, fq);
                    *(f32x4*)(rowp) = acc[ai][0][m][0] * rs; *(f32x4*)(rowp + 4) = acc[ai][0][m][1] * rs; }
        }
    }
};
struct EpiSiluMul {
    static constexpr bool PERM = true, AFTER_DRAIN = false;
    bf16_t* O; int ldc; const float* ss;
    __device__ __forceinline__ void operator()(const f32x4 (&acc)[2][2][4][2], const Unit& u, int wr, int wc, int fr, int fq) const {
        const int row0 = u.pm * BM + wr * 64 + fr, col0 = u.pn * HALF + wc * 32 + 8 * fq;
#pragma unroll
        for (int ai = 0; ai < 2; ++ai)
#pragma unroll
            for (int m = 0; m < 4; ++m) { const int row = row0 + ai * HALF + m * 16; bf16_t* rowp = O + (size_t)row * ldc + col0; const float rs = row_rstd(ss, row, fq);
                f32x4 r0, r1;
#pragma unroll
                for (int j = 0; j < 4; ++j) { const float g0 = acc[ai][0][m][0][j] * rs, g1 = acc[ai][0][m][1][j] * rs;
                    r0[j] = g0 * fast_sigmoid(g0) * (acc[ai][1][m][0][j] * rs); r1[j] = g1 * fast_sigmoid(g1) * (acc[ai][1][m][1][j] * rs); }
                u32x4 w; w.x = cvt_pk_bf16(r0[0], r0[1]); w.y = cvt_pk_bf16(r0[2], r0[3]); w.z = cvt_pk_bf16(r1[0], r1[1]); w.w = cvt_pk_bf16(r1[2], r1[3]);
                *(u32x4*)(rowp) = w; }
    }
};
typedef _Float16 h2_t __attribute__((ext_vector_type(2)));
__device__ __forceinline__ unsigned pkh(float a, float b) { const h2_t v = {(_Float16)a, (_Float16)b}; return __builtin_bit_cast(unsigned, v); }
__device__ __forceinline__ float hlo(unsigned w) { return (float)__builtin_bit_cast(h2_t, w)[0]; }
__device__ __forceinline__ float hhi(unsigned w) { return (float)__builtin_bit_cast(h2_t, w)[1]; }
struct EpiResid {
    static constexpr bool PERM = true, AFTER_DRAIN = false;
    const bf16_t* base16; bf16_t* out16; int ldc; float* ssout;
    __device__ __forceinline__ void operator()(const f32x4 (&acc)[2][2][4][2], const Unit& u, int wr, int wc, int fr, int fq) const {
        const int row0 = u.pm * BM + wr * 64 + fr, col0 = u.pn * BM + wc * 32 + 8 * fq;
#pragma unroll
        for (int ai = 0; ai < 2; ++ai) {
            u32x4 bs[4][2];
#pragma unroll
            for (int m = 0; m < 4; ++m) { const size_t off = (size_t)(row0 + ai * HALF + m * 16) * ldc + col0; bs[m][0] = *(const u32x4*)(base16 + off); bs[m][1] = *(const u32x4*)(base16 + off + HALF); }
#pragma unroll
            for (int m = 0; m < 4; ++m) { const int row = row0 + ai * HALF + m * 16; const size_t off = (size_t)row * ldc + col0; float sq = 0.f;
#pragma unroll
                for (int bj = 0; bj < 2; ++bj) { const u32x4 b = bs[m][bj]; const f32x4 a0 = acc[ai][bj][m][0], a1 = acc[ai][bj][m][1];
                    const float o0 = hlo(b.x) + a0[0], o1 = hhi(b.x) + a0[1], o2 = hlo(b.y) + a0[2], o3 = hhi(b.y) + a0[3], o4 = hlo(b.z) + a1[0], o5 = hhi(b.z) + a1[1], o6 = hlo(b.w) + a1[2], o7 = hhi(b.w) + a1[3];
                    u32x4 hw; hw.x = pkh(o0, o1); hw.y = pkh(o2, o3); hw.z = pkh(o4, o5); hw.w = pkh(o6, o7); *(u32x4*)(out16 + off + bj * HALF) = hw;
                    sq += ((o0 * o0 + o1 * o1) + (o2 * o2 + o3 * o3)) + ((o4 * o4 + o5 * o5) + (o6 * o6 + o7 * o7)); }
                sq = sum_fq(sq);
                if (fq == 0) ssout[(size_t)row * 32 + u.pn * 4 + wc] = sq; }
            asm volatile("" ::: "memory");
        }
    }
};
template <bool FINAL> struct EpiPleGate {
    static constexpr bool PERM = true, AFTER_DRAIN = false;
    const bf16_t* base16; bf16_t* out16; float* outf; int ldc; const bf16_t* e; const float* rstd; const float* wn; const float* ssin; float* ssout;
    __device__ __forceinline__ void operator()(const f32x4 (&acc)[2][2][4][2], const Unit& u, int wr, int wc, int fr, int fq) const {
        const int row0 = u.pm * BM + wr * 64 + fr, col0 = u.pn * BM + wc * 32 + 8 * fq;
#pragma unroll
        for (int am = 0; am < 4; ++am) { const int ai = am >> 1;
            u32x4 bs[4][2], ev[4][2]; float rs[4], ri[4];
#pragma unroll
            for (int m = 2 * (am & 1); m < 2 * (am & 1) + 2; ++m) { const int row = row0 + ai * HALF + m * 16; const size_t off = (size_t)row * ldc + col0; rs[m] = rstd[row]; ri[m] = row_rstd(ssin, row, fq);
#pragma unroll
                for (int bj = 0; bj < 2; ++bj) { bs[m][bj] = *(const u32x4*)(base16 + off + bj * HALF); ev[m][bj] = *(const u32x4*)(e + off + bj * HALF); } }
#pragma unroll
            for (int m = 2 * (am & 1); m < 2 * (am & 1) + 2; ++m) { const int row = row0 + ai * HALF + m * 16; const size_t off = (size_t)row * ldc + col0; float sq = 0.f;
#pragma unroll
                for (int bj = 0; bj < 2; ++bj) { const f32x4 w0 = *(const f32x4*)(wn + col0 + bj * HALF), w1 = *(const f32x4*)(wn + col0 + bj * HALF + 4); const u32x4 ew = ev[m][bj], b = bs[m][bj];
                    const f32x4 a0 = acc[ai][bj][m][0], a1 = acc[ai][bj][m][1]; const float rsv = rs[m], riv = ri[m];
                    const float o0 = hlo(b.x) + __uint_as_float(ew.x << 16) * rsv * w0[0] * fast_sigmoid(a0[0] * riv), o1 = hhi(b.x) + __uint_as_float(ew.x & 0xffff0000u) * rsv * w0[1] * fast_sigmoid(a0[1] * riv);
                    const float o2 = hlo(b.y) + __uint_as_float(ew.y << 16) * rsv * w0[2] * fast_sigmoid(a0[2] * riv), o3 = hhi(b.y) + __uint_as_float(ew.y & 0xffff0000u) * rsv * w0[3] * fast_sigmoid(a0[3] * riv);
                    const float o4 = hlo(b.z) + __uint_as_float(ew.z << 16) * rsv * w1[0] * fast_sigmoid(a1[0] * riv), o5 = hhi(b.z) + __uint_as_float(ew.z & 0xffff0000u) * rsv * w1[1] * fast_sigmoid(a1[1] * riv);
                    const float o6 = hlo(b.w) + __uint_as_float(ew.w << 16) * rsv * w1[2] * fast_sigmoid(a1[2] * riv), o7 = hhi(b.w) + __uint_as_float(ew.w & 0xffff0000u) * rsv * w1[3] * fast_sigmoid(a1[3] * riv);
                    if constexpr (FINAL) { *(f32x4*)(outf + off + bj * HALF) = (f32x4){o0, o1, o2, o3}; *(f32x4*)(outf + off + bj * HALF + 4) = (f32x4){o4, o5, o6, o7}; }
                    else { u32x4 hw; hw.x = pkh(o0, o1); hw.y = pkh(o2, o3); hw.z = pkh(o4, o5); hw.w = pkh(o6, o7); *(u32x4*)(out16 + off + bj * HALF) = hw;
                        sq += ((o0 * o0 + o1 * o1) + (o2 * o2 + o3 * o3)) + ((o4 * o4 + o5 * o5) + (o6 * o6 + o7 * o7)); } }
                if constexpr (!FINAL) { sq = sum_fq(sq); if (fq == 0) ssout[(size_t)row * 32 + u.pn * 4 + wc] = sq; } }
            asm volatile("" ::: "memory");
        }
    }
};

typedef _Float16 f16x8 __attribute__((ext_vector_type(8)));
template <bool F16> __device__ __forceinline__ f32x4 mma16(bf16x8 b, bf16x8 a, f32x4 c) {
    if constexpr (F16) return __builtin_amdgcn_mfma_f32_16x16x32_f16(__builtin_bit_cast(f16x8, b), __builtin_bit_cast(f16x8, a), c, 0, 0, 0);
    else return __builtin_amdgcn_mfma_f32_16x16x32_bf16(b, a, c, 0, 0, 0);
}
template <class Epi, class Sched, bool ALIGN_EPI = false, bool SP2 = false, bool F16 = false>
__device__ __forceinline__ void gemm_phase(PG8_LAS unsigned char* lds, const Gemm g, const Sched& S, const Epi& E, const int tid_in  ) {
    int tid_ = tid_in; asm volatile("" : "+v"(tid_));
    const int tid = tid_, wid = __builtin_amdgcn_readfirstlane(tid >> 6), lane = tid & 63, wr = wid >> 2, wc = wid & 3, fr = lane & 15, fq = lane >> 4;
    const int K = g.K, nt = K / BK;
    unsigned voffA[2], voffB[2];
#pragma unroll
    for (int i = 0; i < 2; ++i) { int R, C; stage_rc(tid * 16 + i * 8192, R, C); const int Rb = Epi::PERM ? ((R & ~31) + perm32(R & 31)) : R;
        voffA[i] = (unsigned)(R * g.lda + C) * 2u; voffB[i] = (unsigned)(Rb * g.ldb + C) * 2u; }
    const size_t kstep = (size_t)(BK * 2);
    const size_t hstepA = (size_t)HALF * g.lda * 2, hstepB = (size_t)HALF * g.ldb * 2;
    const size_t tstepA = 2 * hstepA, tstepB = 2 * hstepB;
    const unsigned ldsw = (unsigned)wid * 1024u;
    const int aoff = lds_byte(wr * 64 + fr, fq * 8), boff = lds_byte(wc * 32 + fr, fq * 8);
#define PG8_SA(b, h) (((b) * 2 + (h)) * HTB)
#define PG8_SB(b, h) ((4 + (b) * 2 + (h)) * HTB)
#define PG8_STAGE(bufoff, gbase, voff) do { const unsigned long long gb_ = (unsigned long long)(uintptr_t)(gbase); const int ld_ = __builtin_amdgcn_readfirstlane((int)(uintptr_t)(lds + (bufoff) + ldsw)); \
        _Pragma("unroll") for (int _i = 0; _i < 2; ++_i) asm volatile("s_mov_b32 m0, %2\n\ts_nop 0\n\tglobal_load_lds_dwordx4 %0, %1" :: "v"((voff)[_i]), "s"(gb_), "s"(ld_ + _i * 8192) : "memory", "m0"); } while (0)
#define PG8_LDA(dst, b, h) do { _Pragma("unroll") for (int m = 0; m < 4; ++m) _Pragma("unroll") for (int k = 0; k < 2; ++k) dst[m][k] = *(const PG8_LAS bf16x8*)(lds + PG8_SA(b, h) + aoff + m * 2048 + k * 1024); } while (0)
#define PG8_LDB(dst, b, h) do { _Pragma("unroll") for (int n = 0; n < 2; ++n) _Pragma("unroll") for (int k = 0; k < 2; ++k) dst[n][k] = *(const PG8_LAS bf16x8*)(lds + PG8_SB(b, h) + boff + n * 2048 + k * 1024); } while (0)
#define PG8_MMA(ai, bj, At, Bt) do { __builtin_amdgcn_s_setprio(1); _Pragma("unroll") for (int m = 0; m < 4; ++m) _Pragma("unroll") for (int n = 0; n < 2; ++n) _Pragma("unroll") for (int k = 0; k < 2; ++k) \
        acc[ai][bj][m][n] = mma16<F16>(Bt[n][k], At[m][k], acc[ai][bj][m][n]); __builtin_amdgcn_s_setprio(0); } while (0)
#define PG8_WAIT_V(n) asm volatile("s_waitcnt vmcnt(" #n ")" ::: "memory")
#define PG8_WAIT_L(n) asm volatile("s_waitcnt lgkmcnt(" #n ")" ::: "memory")
#define PG8_BAR __builtin_amdgcn_s_barrier()
#define PG8_SCHED __builtin_amdgcn_sched_barrier(0)
    Unit cur, nxt; int ui = 0;
    if (!S.next(0, cur)) return;
    f32x4 acc[2][2][4][2];
#pragma unroll
    for (int a = 0; a < 2; ++a)
#pragma unroll
        for (int b = 0; b < 2; ++b)
#pragma unroll
            for (int m = 0; m < 4; ++m)
#pragma unroll
                for (int n = 0; n < 2; ++n) acc[a][b][m][n] = (f32x4){0.f, 0.f, 0.f, 0.f};
    bf16x8 At[4][2], B0[2][2], B1[2][2];
    const char* cA = (const char*)g.A + (size_t)cur.pm * tstepA; const char* cB = (const char*)g.Bt + (size_t)cur.pn * tstepB;
    S.a_ready(cur);
    if constexpr (SP2) {
        PG8_STAGE(PG8_SB(0, 0), cB, voffB); PG8_STAGE(PG8_SB(0, 1), cB + hstepB, voffB); PG8_STAGE(PG8_SA(0, 0), cA, voffA); PG8_STAGE(PG8_SA(0, 1), cA + hstepA, voffA);
        if (wr == 1) PG8_BAR;
        PG8_WAIT_V(2); PG8_BAR;
        PG8_STAGE(PG8_SB(1, 0), cB + kstep, voffB); PG8_STAGE(PG8_SA(1, 0), cA + kstep, voffA); PG8_STAGE(PG8_SB(1, 1), cB + hstepB + kstep, voffB);
        PG8_WAIT_V(6); PG8_BAR;
    } else {
        PG8_STAGE(PG8_SB(0, 0), cB, voffB); PG8_STAGE(PG8_SA(0, 0), cA, voffA); PG8_STAGE(PG8_SB(0, 1), cB + hstepB, voffB); PG8_STAGE(PG8_SA(0, 1), cA + hstepA, voffA);
        if (wr == 1) PG8_BAR;
        PG8_WAIT_V(4); PG8_BAR;
        PG8_STAGE(PG8_SB(1, 0), cB + kstep, voffB); PG8_STAGE(PG8_SA(1, 0), cA + kstep, voffA); PG8_STAGE(PG8_SB(1, 1), cB + hstepB + kstep, voffB);
        PG8_WAIT_V(6); PG8_BAR;
    }
    for (;;) {
        const bool has_next = S.next(ui + 1, nxt);
        const char* nA = has_next ? (const char*)g.A + (size_t)nxt.pm * tstepA : cA; const char* nB = has_next ? (const char*)g.Bt + (size_t)nxt.pn * tstepB : cB;
        for (int t = 0; t < nt; t += 2) {
            const bool last = (t == nt - 2);
            const char* a1 = cA + (size_t)(t + 1) * kstep;
            const char* a2 = last ? nA : cA + (size_t)(t + 2) * kstep; const char* b2 = last ? nB : cB + (size_t)(t + 2) * kstep;
            const char* a3 = a2 + kstep; const char* b3 = b2 + kstep;
            if (last && has_next) S.a_ready(nxt);
            if constexpr (SP2) {
            PG8_LDB(B0, 0, 0); PG8_LDB(B1, 0, 1); PG8_SCHED; PG8_LDA(At, 0, 0); PG8_STAGE(PG8_SA(1, 1), a1 + hstepA, voffA);
            PG8_WAIT_V(8); PG8_WAIT_L(0); PG8_BAR; PG8_MMA(0, 0, At, B0); PG8_MMA(0, 1, At, B1); PG8_BAR; PG8_SCHED;
            PG8_LDA(At, 0, 1); PG8_STAGE(PG8_SB(0, 0), b2, voffB); PG8_STAGE(PG8_SB(0, 1), b2 + hstepB, voffB); PG8_STAGE(PG8_SA(0, 0), a2, voffA);
            PG8_WAIT_V(8); PG8_WAIT_L(0); PG8_BAR; PG8_MMA(1, 0, At, B0); PG8_MMA(1, 1, At, B1); PG8_BAR; PG8_SCHED;
            PG8_LDB(B0, 1, 0); PG8_LDB(B1, 1, 1); PG8_SCHED; PG8_LDA(At, 1, 0); PG8_STAGE(PG8_SA(0, 1), a2 + hstepA, voffA);
            PG8_WAIT_V(8); PG8_WAIT_L(0); PG8_BAR; PG8_MMA(0, 0, At, B0); PG8_MMA(0, 1, At, B1); PG8_BAR; PG8_SCHED;
            PG8_LDA(At, 1, 1); PG8_STAGE(PG8_SB(1, 0), b3, voffB); PG8_STAGE(PG8_SB(1, 1), b3 + hstepB, voffB); PG8_STAGE(PG8_SA(1, 0), a3, voffA);
            PG8_WAIT_V(8); PG8_WAIT_L(0); PG8_BAR; PG8_MMA(1, 0, At, B0); PG8_MMA(1, 1, At, B1); PG8_BAR; PG8_SCHED;
            } else {
            PG8_LDB(B0, 0, 0); PG8_SCHED; PG8_LDA(At, 0, 0); PG8_STAGE(PG8_SA(1, 1), a1 + hstepA, voffA);
            PG8_WAIT_L(8); PG8_BAR; PG8_WAIT_L(0); PG8_MMA(0, 0, At, B0); PG8_BAR; PG8_SCHED;
            PG8_LDB(B1, 0, 1); PG8_STAGE(PG8_SB(0, 0), b2, voffB);
            PG8_BAR; PG8_WAIT_L(0); PG8_MMA(0, 1, At, B1); PG8_BAR;
            PG8_LDA(At, 0, 1); PG8_STAGE(PG8_SA(0, 0), a2, voffA);
            PG8_BAR; PG8_WAIT_L(0); PG8_MMA(1, 0, At, B0); PG8_BAR; PG8_SCHED;
            PG8_STAGE(PG8_SB(0, 1), b2 + hstepB, voffB);
            PG8_WAIT_V(6); PG8_BAR; PG8_MMA(1, 1, At, B1); PG8_BAR;
            PG8_LDB(B0, 1, 0); PG8_SCHED; PG8_LDA(At, 1, 0); PG8_STAGE(PG8_SA(0, 1), a2 + hstepA, voffA);
            PG8_WAIT_L(8); PG8_BAR; PG8_WAIT_L(0); PG8_MMA(0, 0, At, B0); PG8_BAR; PG8_SCHED;
            PG8_LDB(B1, 1, 1); PG8_STAGE(PG8_SB(1, 0), b3, voffB);
            PG8_BAR; PG8_WAIT_L(0); PG8_MMA(0, 1, At, B1); PG8_BAR;
            PG8_LDA(At, 1, 1); PG8_STAGE(PG8_SA(1, 0), a3, voffA);
            PG8_BAR; PG8_WAIT_L(0); PG8_MMA(1, 0, At, B0); PG8_BAR; PG8_SCHED;
            PG8_STAGE(PG8_SB(1, 1), b3 + hstepB, voffB);
            PG8_WAIT_V(6); PG8_BAR; PG8_MMA(1, 1, At, B1); PG8_BAR;
            }
        }
        if constexpr (ALIGN_EPI) { if (wr == 0) PG8_BAR; }
        if constexpr (!Epi::AFTER_DRAIN) { E(acc, cur, wr, wc, fr, fq); S.done(cur); }
        if (!has_next) break;
#pragma unroll
        for (int a = 0; a < 2; ++a)
#pragma unroll
            for (int b = 0; b < 2; ++b)
#pragma unroll
                for (int m = 0; m < 4; ++m)
#pragma unroll
                    for (int n = 0; n < 2; ++n) acc[a][b][m][n] = (f32x4){0.f, 0.f, 0.f, 0.f};
        cur = nxt; cA = nA; cB = nB; ++ui;
        if constexpr (ALIGN_EPI) { if (wr == 1) PG8_BAR; }
    }
    PG8_WAIT_V(0);
    if constexpr (!ALIGN_EPI) { if (wr == 0) PG8_BAR; }
    PG8_BAR;
    if constexpr (Epi::AFTER_DRAIN) { E.fused(acc, cur, wr, wc, fr, fq, lds, wid, lane); S.done(cur); }
#undef PG8_SA
#undef PG8_SB
#undef PG8_STAGE
#undef PG8_LDA
#undef PG8_LDB
#undef PG8_MMA
#undef PG8_WAIT_V
#undef PG8_WAIT_L
#undef PG8_BAR
#undef PG8_SCHED
}
}
#define XB_TMO      128
#define XB_XCNT(j)  (256  + 64 * (j))
#define XB_XSUB(j)  (1280 + 64 * (j))
#define XB_XGEN(j)  (2304 + 64 * (j))
#define XB_TOP      3328
#define XB_TOPGEN   3392
#define XCD_BAR_WORDS 3456
#define XB_SPIN_CAP (1u << 18)

__device__ __forceinline__ unsigned xb_ld(unsigned* p)              { return __hip_atomic_load(p, __ATOMIC_RELAXED, __HIP_MEMORY_SCOPE_AGENT); }
__device__ __forceinline__ unsigned xb_add(unsigned* p, unsigned v) { return __hip_atomic_fetch_add(p, v, __ATOMIC_RELAXED, __HIP_MEMORY_SCOPE_AGENT); }
__device__ __forceinline__ unsigned xb_xcc_id() { return (unsigned)__builtin_amdgcn_s_getreg((3 << 11) | 20) & 0xFu; }
#define XB_SPIN(cond, bar) do { unsigned _sp = 0; while (cond) { __builtin_amdgcn_s_sleep(1); \
    if ((++_sp & 255u) == 0u) { if (xb_ld(&(bar)[XB_TMO])) break; if (_sp > XB_SPIN_CAP) { atomicAdd(&(bar)[XB_TMO], 1u); break; } } } } while (0)

struct XcdBarrier {
    unsigned* bar; unsigned x;
    volatile LAS unsigned* st;
};

__device__ __forceinline__ XcdBarrier xcd_barrier_post(unsigned* bar, volatile LAS unsigned* st) {
    XcdBarrier b; b.bar = bar; b.x = xb_xcc_id(); b.st = st;
    if (threadIdx.x == 0) (void)xb_add(&bar[XB_XCNT(b.x)], 1u);
    return b;
}
__device__ __forceinline__ void xcd_barrier_complete(unsigned* bar, unsigned x, unsigned& nloc, unsigned& nx) {
    const unsigned G = gridDim.x * gridDim.y * gridDim.z;
    unsigned sum, cnt, mine, sp = 0u;
    for (;;) {
        sum = 0u; cnt = 0u; mine = 0u;
#pragma unroll
        for (unsigned j = 0; j < 16; ++j) { const unsigned c = xb_ld(&bar[XB_XCNT(j)]); sum += c; cnt += (c > 0u) ? 1u : 0u; mine = (j == x) ? c : mine; }
        if (sum == G) break;
        __builtin_amdgcn_s_sleep(1);
        if ((++sp & 255u) == 0u) { if (xb_ld(&bar[XB_TMO])) break; if (sp > XB_SPIN_CAP) { atomicAdd(&bar[XB_TMO], 1u); break; } }
    }
    nloc = mine > 0u ? mine : 1u; nx = cnt > 0u ? cnt : 1u;
}

__device__ __forceinline__ void xcd_barrier(const XcdBarrier& b, const int tid_in  ) {
    asm volatile("s_waitcnt vmcnt(0)" ::: "memory");
    __syncthreads();
    if (tid_in == 0) {
        unsigned* bar = b.bar;
        __builtin_amdgcn_s_waitcnt(0);
        unsigned nloc = b.st[0], nx = b.st[1];
        if (nloc == 0u) { xcd_barrier_complete(bar, b.x, nloc, nx); b.st[0] = nloc; b.st[1] = nx; }
        const unsigned old = xb_add(&bar[XB_XSUB(b.x)], 1u);
        const unsigned gen = old / nloc;
        if (old + 1u == (gen + 1u) * nloc) {
            __builtin_amdgcn_fence(__ATOMIC_RELEASE, "agent");
            asm volatile("s_waitcnt vmcnt(0)" ::: "memory");
            const unsigned og = xb_add(&bar[XB_TOP], 1u);
            const unsigned tg = og / nx;
            if (og + 1u == (tg + 1u) * nx) xb_add(&bar[XB_TOPGEN], 1u);
            else XB_SPIN(xb_ld(&bar[XB_TOPGEN]) == tg, bar);
            __builtin_amdgcn_fence(__ATOMIC_ACQUIRE, "agent");
            xb_add(&bar[XB_XGEN(b.x)], 1u);
            asm volatile("s_waitcnt vmcnt(0)" ::: "memory");
        } else {
            XB_SPIN(xb_ld(&bar[XB_XGEN(b.x)]) == gen, bar);
            __builtin_amdgcn_fence(__ATOMIC_ACQUIRE, "agent");
            asm volatile("s_waitcnt vmcnt(0)" ::: "memory");
        }
    }
    __syncthreads();
}
template <int MODE, bool F16>
__device__ __forceinline__ void transpose_item(const float* W, const float* ksc, int K, int N, bf16* WT, int row_off, LAS float* scr_, int item, int lane) {
    LAS unsigned char* scr = (LAS unsigned char*)scr_;
    const int nblk = N / 64, kb = item / nblk, nb = item % nblk, k0 = 64 * kb, n0 = 64 * nb;
    const int n4 = lane & 15, kq = lane >> 4;
#pragma unroll 4
    for (int i = 0; i < 16; ++i) { const int kk = 4 * i + kq; const f32x4 v = *(const f32x4*)(W + (size_t)(k0 + kk) * N + n0 + 4 * n4); const float sc = ksc ? ksc[k0 + kk] : 1.f;
        const unsigned p01 = F16 ? pkh2(v.x * sc, v.y * sc) : pk2(v.x * sc, v.y * sc), p23 = F16 ? pkh2(v.z * sc, v.w * sc) : pk2(v.z * sc, v.w * sc);
        LAS unsigned char* d = scr + (4 * n4) * 144 + (((kk >> 3) ^ (n4 & 7)) << 4) + (kk & 7) * 2;
        *(LAS unsigned short*)(d) = (unsigned short)p01; *(LAS unsigned short*)(d + 144) = (unsigned short)(p01 >> 16);
        *(LAS unsigned short*)(d + 288) = (unsigned short)p23; *(LAS unsigned short*)(d + 432) = (unsigned short)(p23 >> 16); }
    LDS_WAIT(); asm volatile("" ::: "memory");
    int d0;
    if (MODE == 0) d0 = row_off + n0;
    else { const int half = n0 >= DFF ? 1 : 0, nn = n0 - half * DFF; d0 = (nn >> 7) * 256 + half * 128 + (nn & 127); }
#pragma unroll
    for (int t = 0; t < 8; ++t) { const int idx = lane + 64 * t, n = idx >> 3, c = idx & 7;
        const v4u o = *(const LAS v4u*)(scr + n * 144 + ((c ^ ((n >> 2) & 7)) << 4));
        *(v4u*)(WT + (size_t)(d0 + n) * K + k0 + 8 * c) = o; }
    LDS_WAIT(); asm volatile("" ::: "memory");
}
template <int MODE, bool F16 = false>
__device__ __forceinline__ void convert_matrix(const float* W, const float* ksc, int K, int N, bf16* WT, int row_off, LAS float* scr, int gw, int NGW, int lane) {
    const int nitems = (K / 64) * (N / 64);
    for (int it = gw; it < nitems; it += NGW) transpose_item<MODE, F16>(W, ksc, K, N, WT, row_off, scr, it, lane);
}
__device__ __forceinline__ void zero_rows(bf16* WT, int K, int row0, int nrows, int gtid, int NGT) {
    const size_t n16 = (size_t)nrows * K / 8; v4u* p = (v4u*)(WT + (size_t)row0 * K);
    unsigned z = 0u; asm volatile("" : "+v"(z));
    for (size_t i = gtid; i < n16; i += NGT) p[i] = (v4u){z, z, z, z};
}
__device__ __forceinline__ void phase_cast_ss(const float* h, bf16* hb, float* ss, int gw, int NGW, int lane) {
    for (int m = gw; m < NT; m += NGW) {
        const f32x4* xr = (const f32x4*)(h + (size_t)m * DM) + lane; v2u* o8 = (v2u*)(hb + (size_t)m * DM) + lane; float s = 0.f;
#pragma unroll
        for (int j = 0; j < 8; ++j) { const f32x4 v = xr[64 * j]; s += (v.x * v.x + v.y * v.y) + (v.z * v.z + v.w * v.w); v2u o; o.x = pkh2(v.x, v.y); o.y = pkh2(v.z, v.w); o8[64 * j] = o; }
        s = wave_sum(s, lane);
        if (lane < 32) ss[(size_t)m * 32 + lane] = lane == 0 ? s : 0.f;
    }
}
__device__ __forceinline__ void zero_f32(float* p, int n, int gtid, int NGT) { float z = 0.f; asm volatile("" : "+v"(z)); for (int i = gtid; i < n; i += NGT) p[i] = z; }
__device__ __forceinline__ void phase_rope_table(const int* positions, float* cs, int gtid, int NGT) {
    for (int idx = gtid; idx < NT * 32; idx += NGT) {
        const int t = idx >> 5, i = idx & 31;
        const float inv_freq = __builtin_amdgcn_exp2f(-(float)i * (13.287712379549449f / 32.0f));
        const float ang = (float)positions[t] * inv_freq;
        const double rev = (double)ang * 0.15915494309189535; const double fr = rev - floor(rev);
        const float x = (float)(fr * 6.283185307179586);
        cs[(size_t)t * 64 + i] = cosf(x); cs[(size_t)t * 64 + 32 + i] = sinf(x);
    }
}
__device__ __forceinline__ void phase_mla_latnorm(const float* c, const float* wq, const float* wkv, bf16* qkvn, float* kpe, int gw, int NGW, int lane) {
    for (int m = gw; m < NT; m += NGW) {
        const f32x4* cr = (const f32x4*)(c + (size_t)m * MLA_IN_PAD);
        f32x4 a0 = cr[lane], a1 = cr[64 + lane], b0 = cr[128 + lane], b1 = cr[192 + lane];
        float sa = (a0.x * a0.x + a0.y * a0.y) + (a0.z * a0.z + a0.w * a0.w) + (a1.x * a1.x + a1.y * a1.y) + (a1.z * a1.z + a1.w * a1.w);
        float sb = (b0.x * b0.x + b0.y * b0.y) + (b0.z * b0.z + b0.w * b0.w) + (b1.x * b1.x + b1.y * b1.y) + (b1.z * b1.z + b1.w * b1.w);
        const float ra = rsqrtf(wave_sum(sa, lane) * (1.f / 512.f) + NORM_EPS), rb = rsqrtf(wave_sum(sb, lane) * (1.f / 512.f) + NORM_EPS);
        const f32x4 wa0 = ((const f32x4*)wq)[lane], wa1 = ((const f32x4*)wq)[64 + lane], wb0 = ((const f32x4*)wkv)[lane], wb1 = ((const f32x4*)wkv)[64 + lane];
        v2u* o = (v2u*)(qkvn + (size_t)m * 1024); v2u t;
        t.x = pk2(a0.x * ra * wa0.x, a0.y * ra * wa0.y); t.y = pk2(a0.z * ra * wa0.z, a0.w * ra * wa0.w); o[lane] = t;
        t.x = pk2(a1.x * ra * wa1.x, a1.y * ra * wa1.y); t.y = pk2(a1.z * ra * wa1.z, a1.w * ra * wa1.w); o[64 + lane] = t;
        t.x = pk2(b0.x * rb * wb0.x, b0.y * rb * wb0.y); t.y = pk2(b0.z * rb * wb0.z, b0.w * rb * wb0.w); o[128 + lane] = t;
        t.x = pk2(b1.x * rb * wb1.x, b1.y * rb * wb1.y); t.y = pk2(b1.z * rb * wb1.z, b1.w * rb * wb1.w); o[192 + lane] = t;
        if (lane < 16) ((f32x4*)(kpe + (size_t)m * 64))[lane] = cr[256 + lane];
    }
}
__device__ __forceinline__ void phase_mla_finalize_kv(const bf16* kvraw, const float* kpe, const float* cs, const float* knw, bf16* kf, bf16* vf, int gw, int NGW, int lane) {
    const int g = lane >> 4, i = lane & 15, isv = g & 1;
    float wk[8], wpe[8];
#pragma unroll
    for (int e = 0; e < 8; ++e) { wk[e] = knw[8 * i + e]; wpe[e] = knw[128 + 8 * (i & 7) + e]; }
    for (int m = gw; m < NT; m += NGW) {
        const int b = m / SEQ, s = m % SEQ;
        const float pv = kpe[(size_t)m * 64 + lane]; const float pess = wave_sum(pv * pv, lane);
        float pe[8], cv[8], sv[8];
        { const f32x4 a0 = *(const f32x4*)(kpe + (size_t)m * 64 + 8 * (i & 7)), a1 = *(const f32x4*)(kpe + (size_t)m * 64 + 8 * (i & 7) + 4);
          const f32x4 c0 = *(const f32x4*)(cs + (size_t)m * 64 + 8 * (i & 3)), c1 = *(const f32x4*)(cs + (size_t)m * 64 + 8 * (i & 3) + 4);
          const f32x4 s0 = *(const f32x4*)(cs + (size_t)m * 64 + 32 + 8 * (i & 3)), s1 = *(const f32x4*)(cs + (size_t)m * 64 + 32 + 8 * (i & 3) + 4);
#pragma unroll
          for (int e = 0; e < 4; ++e) { pe[e] = a0[e]; pe[4 + e] = a1[e]; cv[e] = c0[e]; cv[4 + e] = c1[e]; sv[e] = s0[e]; sv[4 + e] = s1[e]; } }
        const bf16* kr = kvraw + (size_t)m * (MLA_H * 256);
#pragma unroll 2
        for (int hp = 0; hp < MLA_H / 2; ++hp) {
            const int h = 2 * hp + (g >> 1); const size_t ob = ((size_t)(b * MLA_H + h) * SEQ + s);
            const v4u raw = *(const v4u*)(kr + h * 256 + isv * 128 + 8 * i);
            float x[8]; x[0] = bflo(raw.x); x[1] = bfhi(raw.x); x[2] = bflo(raw.y); x[3] = bfhi(raw.y); x[4] = bflo(raw.z); x[5] = bfhi(raw.z); x[6] = bflo(raw.w); x[7] = bfhi(raw.w);
            float ss = 0.f;
#pragma unroll
            for (int e = 0; e < 8; ++e) ss += x[e] * x[e];
            ss += shx(ss, 1, lane); ss += shx(ss, 2, lane); ss += shx(ss, 4, lane); ss += shx(ss, 8, lane);
            float rs = rsqrtf((ss + pess) * (1.f / 192.f) + NORM_EPS);
            const float rso = shx(rs, 16, lane); if (isv) rs = rso;
            if (!isv) { v4u o; o.x = pk2(x[0] * rs * wk[0], x[1] * rs * wk[1]); o.y = pk2(x[2] * rs * wk[2], x[3] * rs * wk[3]); o.z = pk2(x[4] * rs * wk[4], x[5] * rs * wk[5]); o.w = pk2(x[6] * rs * wk[6], x[7] * rs * wk[7]);
                *(v4u*)(kf + ob * MLA_QK + 8 * i) = o; }
            else *(v4u*)(vf + ob * MLA_V + 8 * i) = raw;
            float y[8], yp[8];
#pragma unroll
            for (int e = 0; e < 8; ++e) { y[e] = pe[e] * rs * wpe[e]; yp[e] = shx(y[e], 4, lane); }
            if (isv && i < 8) { float r[8];
#pragma unroll
                for (int e = 0; e < 8; ++e) r[e] = (i < 4) ? y[e] * cv[e] - yp[e] * sv[e] : y[e] * cv[e] + yp[e] * sv[e];
                v4u o; o.x = pk2(r[0], r[1]); o.y = pk2(r[2], r[3]); o.z = pk2(r[4], r[5]); o.w = pk2(r[6], r[7]);
                *(v4u*)(kf + ob * MLA_QK + 128 + 8 * i) = o; }
        }
    }
}
__device__ __forceinline__ void phase_cvt_bf16(const float* src, bf16* dst, size_t n, int gtid, int NGT) {
    const size_t n8 = n / 8;
    for (size_t i = gtid; i < n8; i += NGT) { const f32x4 a = ((const f32x4*)src)[2 * i], b = ((const f32x4*)src)[2 * i + 1];
        v4u o; o.x = pk2(a.x, a.y); o.y = pk2(a.z, a.w); o.z = pk2(b.x, b.y); o.w = pk2(b.z, b.w); ((v4u*)dst)[i] = o; }
}
__device__ __forceinline__ void phase_rstd_e(const bf16* e, float* rstd, int gw, int NGW, int lane) {
    for (int m = gw; m < NT; m += NGW) {
        const v4u* er = (const v4u*)(e + (size_t)m * DM) + lane; float s = 0.f;
#pragma unroll
        for (int j = 0; j < 4; ++j) { const v4u w = er[64 * j];
            const float a0 = bflo(w.x), a1 = bfhi(w.x), a2 = bflo(w.y), a3 = bfhi(w.y), a4 = bflo(w.z), a5 = bfhi(w.z), a6 = bflo(w.w), a7 = bfhi(w.w);
            s += (a0 * a0 + a1 * a1) + (a2 * a2 + a3 * a3) + (a4 * a4 + a5 * a5) + (a6 * a6 + a7 * a7); }
        s = wave_sum(s, lane);
        if (lane == 0) rstd[m] = rsqrtf(s * (1.f / 2048.f) + NORM_EPS);
    }
}

namespace attn {
constexpr int DQK = 192, DV = 128, QBLK = 32, KVBLK = 64, QB = 256;
constexpr int SHM_V = KVBLK * DV * 2, SHM_K = KVBLK * DQK * 2;
constexpr int OFF_V = 0, OFF_K = 2 * SHM_V, OFF_WS = OFF_K + 2 * SHM_K;
constexpr int OFF_Q = OFF_WS + NWAVES * 64 * 4;
constexpr int ATTN_LDS = OFF_Q + NWAVES * 4096;
constexpr float SCALE = 0.07216878364870322f;
constexpr float THR = 8.f;
#define SBAR() __builtin_amdgcn_sched_barrier(0)
__device__ __forceinline__ int v_rd_base(int lane) { return ((lane & 3) << 3) | (((lane >> 2) & 3) << 6) | (((lane >> 4) & 1) << 5) | (((lane >> 5) & 1) << 8); }
constexpr int v_rd_off(int d0, int ks, int half) { return d0 * 512 + ks * 4096 + half * 2048; }
__device__ __forceinline__ int crow(int r, int hi) { return (r & 3) + 8 * (r >> 2) + 4 * hi; }
__device__ __forceinline__ unsigned cvtpk(float lo, float hi) { unsigned r; asm volatile("v_cvt_pk_bf16_f32 %0, %1, %2" : "=v"(r) : "v"(lo), "v"(hi)); return r; }
__device__ __forceinline__ void mask_tile(f32x16& p0, f32x16& p1, int dq) {
    const float NEG = -__builtin_inff();
#pragma unroll
    for (int r = 0; r < 16; ++r) { const int c = (r & 3) + 8 * (r >> 2);
        if (dq - c < 0) p0[r] = NEG;
        if (dq - c - 32 < 0) p1[r] = NEG; }
}
__device__ __forceinline__ void partialSM(f32x16& p0, f32x16& p1, float& m_reg, float& mn, float& alpha) {
    float pmax = p0[0];
#pragma unroll
    for (int r = 1; r < 16; ++r) pmax = fmaxf(pmax, p0[r]);
#pragma unroll
    for (int r = 0; r < 16; ++r) pmax = fmaxf(pmax, p1[r]);
    { auto rr = __builtin_amdgcn_permlane32_swap(__float_as_uint(pmax), __float_as_uint(pmax), false, false);
      pmax = fmaxf(__uint_as_float(rr[0]), __uint_as_float(rr[1])); }
    constexpr float C2 = 1.4426950408889634f * SCALE;
    if (__builtin_expect(__all((pmax - m_reg) * SCALE <= THR), 1)) { mn = m_reg; alpha = 1.f; }
    else { mn = fmaxf(m_reg, pmax); alpha = __builtin_amdgcn_exp2f((m_reg - mn) * C2); m_reg = mn; }
    const float mnL = -mn * C2;
#pragma unroll
    for (int r = 0; r < 16; ++r) p0[r] = fmaf(p0[r], C2, mnL);
#pragma unroll
    for (int r = 0; r < 16; ++r) p1[r] = fmaf(p1[r], C2, mnL);
#pragma unroll
    for (int r = 0; r < 16; ++r) p0[r] = __builtin_amdgcn_exp2f(p0[r]);
}
__device__ __forceinline__ void finishSM(f32x16& p0, f32x16& p1, float alpha, float& l_reg, bf16x8& pa0, bf16x8& pa1, bf16x8& pa2, bf16x8& pa3) {
#pragma unroll
    for (int r = 0; r < 16; ++r) p1[r] = __builtin_amdgcn_exp2f(p1[r]);
    float ps = 0;
#pragma unroll
    for (int r = 0; r < 16; ++r) ps += p0[r];
#pragma unroll
    for (int r = 0; r < 16; ++r) ps += p1[r];
    { auto rr = __builtin_amdgcn_permlane32_swap(__float_as_uint(ps), __float_as_uint(ps), false, false);
      ps = __uint_as_float(rr[0]) + __uint_as_float(rr[1]); }
    l_reg = l_reg * alpha + ps;
#define PK4(P, B_, OUT) do { unsigned a0 = cvtpk(P[B_+0], P[B_+1]), a1 = cvtpk(P[B_+2], P[B_+3]);                          \
        unsigned b0 = cvtpk(P[B_+4], P[B_+5]), b1 = cvtpk(P[B_+6], P[B_+7]);                                             \
        auto r0 = __builtin_amdgcn_permlane32_swap(a0, b0, false, false); auto r1 = __builtin_amdgcn_permlane32_swap(a1, b1, false, false); \
        v4u w = {r0[0], r1[0], r0[1], r1[1]}; OUT = *reinterpret_cast<bf16x8*>(&w); } while (0)
    PK4(p0, 0, pa0); PK4(p0, 8, pa1); PK4(p1, 0, pa2); PK4(p1, 8, pa3);
#undef PK4
}
__device__ __forceinline__ int k_off(int row, int ch) { return row * 384 + ((ch ^ ((row >> 1) & 7)) << 4); }
template <int KB>
__device__ __forceinline__ void qkt(f32x16& p0, f32x16& p1, const LAS char* lds, int r32, int hi, const bf16x8* qr, const LAS char* qs) {
    p0 = f32x16{}; p1 = f32x16{};
    const LAS char* kb[4];
#pragma unroll
    for (int dd = 0; dd < 4; ++dd) kb[dd] = lds + OFF_K + KB * SHM_K + k_off(r32, dd * 2 + hi);
#if PROBE_MASK
#pragma unroll
    for (int d0 = 0; d0 < 12; ++d0) { const LAS char* a = kb[d0 & 3] + (d0 >> 2) * 128;
        bf16x8 b0 = *reinterpret_cast<const LAS bf16x8*>(a);
        bf16x8 b1 = *reinterpret_cast<const LAS bf16x8*>(a + 32 * 384);
        const bf16x8 qv = d0 < 8 ? qr[d0 < 8 ? d0 : 0] : *reinterpret_cast<const LAS bf16x8*>(qs + (d0 - 8) * 1024);
        p0 = __builtin_amdgcn_mfma_f32_32x32x16_bf16(b0, qv, p0, 0, 0, 0);
        p1 = __builtin_amdgcn_mfma_f32_32x32x16_bf16(b1, qv, p1, 0, 0, 0); }
#else
    bf16x8 kf[2][4], qx[2][2];
#define QKT_LOAD(i_, buf_) do { _Pragma("unroll") for (int e_ = 0; e_ < 2; ++e_) { const int d0_ = 2 * (i_) + e_; const LAS char* a_ = kb[d0_ & 3] + (d0_ >> 2) * 128; \
        kf[buf_][2 * e_] = *reinterpret_cast<const LAS bf16x8*>(a_); kf[buf_][2 * e_ + 1] = *reinterpret_cast<const LAS bf16x8*>(a_ + 32 * 384); \
        if (d0_ >= 8) qx[buf_][e_] = *reinterpret_cast<const LAS bf16x8*>(qs + (d0_ - 8) * 1024); } } while (0)
    QKT_LOAD(0, 0);
#pragma unroll
    for (int i = 0; i < 6; ++i) {
        if (i < 5) QKT_LOAD(i + 1, (i + 1) & 1);
        __builtin_amdgcn_sched_barrier(0);
#pragma unroll
        for (int e = 0; e < 2; ++e) { const int d0 = 2 * i + e; const bf16x8 qv = d0 < 8 ? qr[d0 < 8 ? d0 : 0] : qx[i & 1][e];
            p0 = __builtin_amdgcn_mfma_f32_32x32x16_bf16(kf[i & 1][2 * e], qv, p0, 0, 0, 0);
            p1 = __builtin_amdgcn_mfma_f32_32x32x16_bf16(kf[i & 1][2 * e + 1], qv, p1, 0, 0, 0); }
        __builtin_amdgcn_sched_barrier(0);
    }
#undef QKT_LOAD
#endif
}
template <int VB>
__device__ __forceinline__ void pv_tile(f32x16* o, int vb0, bf16x8 pa0, bf16x8 pa1, bf16x8 pa2, bf16x8 pa3) {
#define TRRD(dst, off) asm volatile("ds_read_b64_tr_b16 %0, %1 offset:%2" : "=&v"(dst) : "v"(vb0), "i"(off) : "memory")
#define PV_RD(S, d0) do { constexpr int b_ = OFF_V + VB * SHM_V + v_rd_off(d0, 0, 0); \
        TRRD(S[0], b_); TRRD(S[1], b_ + 2048); TRRD(S[2], b_ + 4096); TRRD(S[3], b_ + 6144); TRRD(S[4], b_ + 8192); TRRD(S[5], b_ + 10240); TRRD(S[6], b_ + 12288); TRRD(S[7], b_ + 14336); } while (0)
#define PV_MM(S, d0) do { \
        o[d0] = __builtin_amdgcn_mfma_f32_32x32x16_bf16(pa0, (bf16x8){S[0][0], S[0][1], S[0][2], S[0][3], S[1][0], S[1][1], S[1][2], S[1][3]}, o[d0], 0, 0, 0);   \
        o[d0] = __builtin_amdgcn_mfma_f32_32x32x16_bf16(pa1, (bf16x8){S[2][0], S[2][1], S[2][2], S[2][3], S[3][0], S[3][1], S[3][2], S[3][3]}, o[d0], 0, 0, 0);   \
        o[d0] = __builtin_amdgcn_mfma_f32_32x32x16_bf16(pa2, (bf16x8){S[4][0], S[4][1], S[4][2], S[4][3], S[5][0], S[5][1], S[5][2], S[5][3]}, o[d0], 0, 0, 0);   \
        o[d0] = __builtin_amdgcn_mfma_f32_32x32x16_bf16(pa3, (bf16x8){S[6][0], S[6][1], S[6][2], S[6][3], S[7][0], S[7][1], S[7][2], S[7][3]}, o[d0], 0, 0, 0); } while (0)
#define PV_WAIT8(S) asm volatile("s_waitcnt lgkmcnt(8)" : "+v"(S[0]), "+v"(S[1]), "+v"(S[2]), "+v"(S[3]), "+v"(S[4]), "+v"(S[5]), "+v"(S[6]), "+v"(S[7]) :: "memory")
#define PV_WAIT0(S) asm volatile("s_waitcnt lgkmcnt(0)" : "+v"(S[0]), "+v"(S[1]), "+v"(S[2]), "+v"(S[3]), "+v"(S[4]), "+v"(S[5]), "+v"(S[6]), "+v"(S[7]) :: "memory")
    s16x4 sa[8], sb[8];
    PV_RD(sa, 0);
    PV_RD(sb, 1); PV_WAIT8(sa); SBAR(); PV_MM(sa, 0); SBAR();
    PV_RD(sa, 2); PV_WAIT8(sb); SBAR(); PV_MM(sb, 1); SBAR();
    PV_RD(sb, 3); PV_WAIT8(sa); SBAR(); PV_MM(sa, 2); SBAR();
    PV_WAIT0(sb); SBAR(); PV_MM(sb, 3);
#undef PV_RD
#undef PV_MM
#undef PV_WAIT8
#undef PV_WAIT0
#undef TRRD
}
template <int VB, int KB, bool DO_PV, bool DO_QK>
__device__ __forceinline__ void mseg(f32x16* o, int vb0, bf16x8 pa0, bf16x8 pa1, bf16x8 pa2, bf16x8 pa3, f32x16& p0, f32x16& p1, int ldsa, int r32, int hi, const bf16x8* qr, int qsa) {
#define TRRD(dst, off) asm volatile("ds_read_b64_tr_b16 %0, %1 offset:%2" : "=&v"(dst) : "v"(vb0), "i"(off) : "memory")
#define PV_RD(S, d0) do { constexpr int b_ = OFF_V + VB * SHM_V + v_rd_off(d0, 0, 0); \
        TRRD(S[0], b_); TRRD(S[1], b_ + 2048); TRRD(S[2], b_ + 4096); TRRD(S[3], b_ + 6144); TRRD(S[4], b_ + 8192); TRRD(S[5], b_ + 10240); TRRD(S[6], b_ + 12288); TRRD(S[7], b_ + 14336); } while (0)
#define PV_MM(S, d0) do { \
        o[d0] = __builtin_amdgcn_mfma_f32_32x32x16_bf16(pa0, (bf16x8){S[0][0], S[0][1], S[0][2], S[0][3], S[1][0], S[1][1], S[1][2], S[1][3]}, o[d0], 0, 0, 0);   \
        o[d0] = __builtin_amdgcn_mfma_f32_32x32x16_bf16(pa1, (bf16x8){S[2][0], S[2][1], S[2][2], S[2][3], S[3][0], S[3][1], S[3][2], S[3][3]}, o[d0], 0, 0, 0);   \
        o[d0] = __builtin_amdgcn_mfma_f32_32x32x16_bf16(pa2, (bf16x8){S[4][0], S[4][1], S[4][2], S[4][3], S[5][0], S[5][1], S[5][2], S[5][3]}, o[d0], 0, 0, 0);   \
        o[d0] = __builtin_amdgcn_mfma_f32_32x32x16_bf16(pa3, (bf16x8){S[6][0], S[6][1], S[6][2], S[6][3], S[7][0], S[7][1], S[7][2], S[7][3]}, o[d0], 0, 0, 0); } while (0)
#define PV_WAIT8(S) asm volatile("s_waitcnt lgkmcnt(8)" : "+v"(S[0]), "+v"(S[1]), "+v"(S[2]), "+v"(S[3]), "+v"(S[4]), "+v"(S[5]), "+v"(S[6]), "+v"(S[7]) :: "memory")
#define PV_WAIT0(S) asm volatile("s_waitcnt lgkmcnt(0)" : "+v"(S[0]), "+v"(S[1]), "+v"(S[2]), "+v"(S[3]), "+v"(S[4]), "+v"(S[5]), "+v"(S[6]), "+v"(S[7]) :: "memory")
#define KRD(dst, base, off) asm volatile("ds_read_b128 %0, %1 offset:%2" : "=&v"(dst) : "v"(base), "i"(off) : "memory")
#define QK_LD4(B, da, db) do { KRD(kf[B][0], kb[(da) & 3], ((da) >> 2) * 128); KRD(kf[B][1], kb[(da) & 3], ((da) >> 2) * 128 + 12288); \
                               KRD(kf[B][2], kb[(db) & 3], ((db) >> 2) * 128); KRD(kf[B][3], kb[(db) & 3], ((db) >> 2) * 128 + 12288); } while (0)
#define QK_LD6(B, da, db) do { QK_LD4(B, da, db); KRD(qx[B][0], qsa, ((da) - 8) * 1024); KRD(qx[B][1], qsa, ((db) - 8) * 1024); } while (0)
#define QK_W(N, B)  asm volatile("s_waitcnt lgkmcnt(" #N ")" : "+v"(kf[B][0]), "+v"(kf[B][1]), "+v"(kf[B][2]), "+v"(kf[B][3]) :: "memory")
#define QK_WQ(N, B) asm volatile("s_waitcnt lgkmcnt(" #N ")" : "+v"(kf[B][0]), "+v"(kf[B][1]), "+v"(kf[B][2]), "+v"(kf[B][3]), "+v"(qx[B][0]), "+v"(qx[B][1]) :: "memory")
#define QK_MM(B, qa, qb) do { p0 = __builtin_amdgcn_mfma_f32_32x32x16_bf16(kf[B][0], qa, p0, 0, 0, 0); p1 = __builtin_amdgcn_mfma_f32_32x32x16_bf16(kf[B][1], qa, p1, 0, 0, 0); \
                              p0 = __builtin_amdgcn_mfma_f32_32x32x16_bf16(kf[B][2], qb, p0, 0, 0, 0); p1 = __builtin_amdgcn_mfma_f32_32x32x16_bf16(kf[B][3], qb, p1, 0, 0, 0); } while (0)
    s16x4 sa[8], sb[8]; bf16x8 kf[2][4]; int kb[4];
    if (DO_QK) {
#pragma unroll
        for (int dd = 0; dd < 4; ++dd) kb[dd] = ldsa + OFF_K + KB * SHM_K + k_off(r32, dd * 2 + hi);
    }
    if (DO_PV) {
        PV_RD(sa, 0);
        PV_RD(sb, 1); PV_WAIT8(sa); SBAR(); PV_MM(sa, 0); SBAR();
        PV_RD(sa, 2); PV_WAIT8(sb); SBAR(); PV_MM(sb, 1); SBAR();
        PV_RD(sb, 3); PV_WAIT8(sa); SBAR(); PV_MM(sa, 2); SBAR();
        if (DO_QK) { QK_LD4(0, 0, 1); QK_LD4(1, 2, 3); PV_WAIT8(sb); } else PV_WAIT0(sb);
        SBAR(); PV_MM(sb, 3); SBAR();
    } else if (DO_QK) { QK_LD4(0, 0, 1); QK_LD4(1, 2, 3); }
    if (DO_QK) {
        p0 = f32x16{}; p1 = f32x16{};
        QK_W(4, 0); SBAR(); QK_MM(0, qr[0], qr[1]); SBAR(); QK_LD4(0, 4, 5);
        QK_W(4, 1); SBAR(); QK_MM(1, qr[2], qr[3]); SBAR(); QK_LD4(1, 6, 7);
        QK_W(4, 0); SBAR(); QK_MM(0, qr[4], qr[5]); SBAR(); QK_LD4(0, 8, 9);
        QK_W(4, 1); SBAR(); QK_MM(1, qr[6], qr[7]); SBAR(); QK_LD4(1, 10, 11);
        QK_W(4, 0); SBAR(); QK_MM(0, qr[8], qr[9]); SBAR();
        QK_W(0, 1); SBAR(); QK_MM(1, qr[10], qr[11]); SBAR();
    }
#undef TRRD
#undef PV_RD
#undef PV_MM
#undef PV_WAIT8
#undef PV_WAIT0
#undef KRD
#undef QK_LD4
#undef QK_LD6
#undef QK_W
#undef QK_WQ
#undef QK_MM
}
__device__ __forceinline__ void attn_block(const bf16* Q, int ldq, const float* qnw, const float* cs, int tok0, const bf16* Kh, const bf16* Vh, bf16* O, int ldo, int P0, int rev, LAS char* lds, int tid_, int wid, int lane_) {
    int tid = tid_, lane = lane_;
    asm volatile("" : "+v"(tid), "+v"(lane));
    const int r32 = lane & 31, hi = lane >> 5;
    const int NTL = (P0 + QB) / KVBLK;
    const int qlo = P0 + wid * QBLK, qm = qlo + r32 - 4 * hi;
    LAS float* ws = (LAS float*)(lds + OFF_WS) + wid * 64; LAS float* li_l = ws; LAS float* al_l = ws + 32;
    unsigned ksrc[3], vsrc[2];
#pragma unroll
    for (int i = 0; i < 3; ++i) { const int p = i * 512 + tid, row = p / 24, pc = p % 24, c = pc ^ ((row >> 1) & 7); ksrc[i] = (unsigned)(row * 384 + c * 16); }
#pragma unroll
    for (int i = 0; i < 2; ++i) { const int p = i * 512 + tid; const int kk = ((p >> 7) << 3) | ((p >> 2) & 7), c = (((p >> 5) & 3) << 5) | ((p & 3) << 3);
        const int k = (kk & ~0xC) | ((kk & 4) << 1) | ((kk & 8) >> 1); vsrc[i] = (unsigned)(k * 256 + c * 2); }
#define DMA16(voff_, base_, ldsdst_) asm volatile("s_mov_b32 m0, %2\n\ts_nop 0\n\tglobal_load_lds_dwordx4 %0, %1" :: "v"(voff_), "s"(base_), "s"(ldsdst_) : "memory", "m0")
#define ISSUE_TILE(t, slot) do { const unsigned long long kg_ = (unsigned long long)(uintptr_t)Kh + (unsigned long long)(t) * (KVBLK * 384), vg_ = (unsigned long long)(uintptr_t)Vh + (unsigned long long)(t) * (KVBLK * 256); \
        const int kd_ = __builtin_amdgcn_readfirstlane((int)(uintptr_t)(lds + OFF_K + (slot) * SHM_K + wid * 1024)), vd_ = __builtin_amdgcn_readfirstlane((int)(uintptr_t)(lds + OFF_V + (slot) * SHM_V + wid * 1024)); \
        _Pragma("unroll") for (int i_ = 0; i_ < 3; ++i_) DMA16(ksrc[i_], kg_, kd_ + i_ * 8192); \
        _Pragma("unroll") for (int i_ = 0; i_ < 2; ++i_) DMA16(vsrc[i_], vg_, vd_ + i_ * 8192); } while (0)
#define TIDX(s_) (rev ? NTL - 1 - (s_) : (s_))
    ISSUE_TILE(TIDX(0), 0);
    bf16x8 qr[12];
    LAS char* qs = lds + OFF_Q + wid * 4096 + lane * 16;
    {
        const bf16* qrow = Q + (size_t)(wid * QBLK + r32) * ldq + hi * 8; const float* csr = cs + (size_t)(tok0 + wid * QBLK + r32) * 64 + hi * 8;
        v4u qw[12]; float ss = 0.f;
#pragma unroll
        for (int d0 = 0; d0 < 12; ++d0) qw[d0] = *reinterpret_cast<const v4u*>(qrow + d0 * 16);
#pragma unroll
        for (int d0 = 0; d0 < 12; ++d0) { const v4u w = qw[d0]; const float a0 = bflo(w.x), a1 = bfhi(w.x), a2 = bflo(w.y), a3 = bfhi(w.y), a4 = bflo(w.z), a5 = bfhi(w.z), a6 = bflo(w.w), a7 = bfhi(w.w);
            ss += (a0 * a0 + a1 * a1) + (a2 * a2 + a3 * a3) + (a4 * a4 + a5 * a5) + (a6 * a6 + a7 * a7); }
        ss += shx(ss, 32, lane);
        const float rs = rsqrtf(ss * (1.f / 192.f) + NORM_EPS);
#define QSCALE(X, d0_) do { const v4u w_ = qw[d0_]; const f32x4 g0_ = *(const f32x4*)(qnw + (d0_) * 16 + hi * 8), g1_ = *(const f32x4*)(qnw + (d0_) * 16 + hi * 8 + 4); \
            X[0] = bflo(w_.x) * rs * g0_.x; X[1] = bfhi(w_.x) * rs * g0_.y; X[2] = bflo(w_.y) * rs * g0_.z; X[3] = bfhi(w_.y) * rs * g0_.w; \
            X[4] = bflo(w_.z) * rs * g1_.x; X[5] = bfhi(w_.z) * rs * g1_.y; X[6] = bflo(w_.w) * rs * g1_.z; X[7] = bfhi(w_.w) * rs * g1_.w; } while (0)
#define QPACK(X) ((v4u){cvtpk(X[0], X[1]), cvtpk(X[2], X[3]), cvtpk(X[4], X[5]), cvtpk(X[6], X[7])})
#pragma unroll
        for (int d0 = 0; d0 < 8; ++d0) { float xv[8]; QSCALE(xv, d0); const v4u pk = QPACK(xv); qr[d0] = *reinterpret_cast<const bf16x8*>(&pk); }
#pragma unroll
        for (int d0 = 8; d0 < 10; ++d0) { float x1[8], x2[8], o1[8], o2[8]; QSCALE(x1, d0); QSCALE(x2, d0 + 2);
            const f32x4 c0 = *(const f32x4*)(csr + (d0 - 8) * 16), c1 = *(const f32x4*)(csr + (d0 - 8) * 16 + 4), s0 = *(const f32x4*)(csr + 32 + (d0 - 8) * 16), s1 = *(const f32x4*)(csr + 32 + (d0 - 8) * 16 + 4);
#pragma unroll
            for (int e = 0; e < 8; ++e) { const float c = e < 4 ? c0[e & 3] : c1[e & 3], s = e < 4 ? s0[e & 3] : s1[e & 3]; o1[e] = x1[e] * c - x2[e] * s; o2[e] = x2[e] * c + x1[e] * s; }
            const v4u p1 = QPACK(o1), p2 = QPACK(o2);
            qr[d0] = *reinterpret_cast<const bf16x8*>(&p1); qr[d0 + 2] = *reinterpret_cast<const bf16x8*>(&p2); }
#undef QSCALE
#undef QPACK
    }
    float m_reg = -1e30f, l_reg = 0; f32x16 o[4] = {};
    const int vb0 = (int)(uintptr_t)(lds) + v_rd_base(lane);
    VM_WAIT(); __syncthreads();
#define RESC(a) do { if (__any((a) < 1.f)) { if (hi == 0) al_l[r32] = (a); asm volatile("s_waitcnt lgkmcnt(0)" ::: "memory");              \
                     _Pragma("unroll") for (int d_ = 0; d_ < 4; ++d_) _Pragma("unroll") for (int r = 0; r < 16; ++r) o[d_][r] *= al_l[crow(r, hi)]; } } while (0)
#define STEP(t, SLOT) do { \
        if ((t) + 1 < NTL) ISSUE_TILE(TIDX((t) + 1), (SLOT) ^ 1); \
        const int kb_ = TIDX(t) * KVBLK; \
        if (kb_ <= qlo + QBLK - 1) {                                          \
            f32x16 p0, p1; float mn, al; bf16x8 pa0, pa1, pa2, pa3; \
            mseg<SLOT, SLOT, false, true>(o, vb0, pa0, pa1, pa2, pa3, p0, p1, (int)(uintptr_t)lds, r32, hi, qr, (int)(uintptr_t)qs); \
            if (kb_ + KVBLK - 1 > qlo) mask_tile(p0, p1, qm - kb_); \
            partialSM(p0, p1, m_reg, mn, al); RESC(al); \
            finishSM(p0, p1, al, l_reg, pa0, pa1, pa2, pa3); SBAR(); \
            pv_tile<SLOT>(o, vb0, pa0, pa1, pa2, pa3); } \
        VM_WAIT(); __syncthreads(); } while (0)
    for (int t = 0; t < NTL; t += 2) { STEP(t, 0); STEP(t + 1, 1); }
#undef STEP
#undef RESC
#undef ISSUE_TILE
#undef DMA16
#undef TIDX
    if (hi == 0) li_l[r32] = l_reg; asm volatile("s_waitcnt lgkmcnt(0)" ::: "memory");
    float rli[16];
#pragma unroll
    for (int r = 0; r < 16; ++r) rli[r] = __builtin_amdgcn_rcpf(li_l[crow(r, hi)]);
    int lane2 = lane; asm volatile("" : "+v"(lane2));
    const int r32e = lane2 & 31, hie = lane2 >> 5;
    bf16* Ow = O + (size_t)(wid * QBLK) * ldo;
#pragma unroll
    for (int r = 0; r < 16; ++r) { const int orow = crow(r, hie);
#pragma unroll
        for (int d0 = 0; d0 < 4; ++d0) { const float v = o[d0][r] * rli[r]; const float vn = shx(v, 1, lane);
            if ((r32e & 1) == 0) *(unsigned*)(Ow + (size_t)orow * ldo + d0 * 32 + r32e) = cvtpk(v, vn); } }
    __syncthreads();
}
__device__ __forceinline__ void attn_phase(const bf16* qraw, const float* qnw, const float* cs, const bf16* kf, const bf16* vf, bf16* o, LAS char* lds, int vcu, int G, int tid, int wid, int lane) {
    constexpr int NQB = SEQ / QB, NPAIR = NQB / 2, TOTAL = NB * MLA_H * NPAIR;
    for (int L = vcu; L < TOTAL; L += G) {
        const int bh = L / NPAIR, x = L % NPAIR, b = bh / MLA_H, h = bh % MLA_H;
        const bf16* Kh = kf + (size_t)bh * SEQ * DQK; const bf16* Vh = vf + (size_t)bh * SEQ * DV;
#pragma unroll 1
        for (int pass = 0; pass < 2; ++pass) {
            const int qb = pass ? x : (NQB - 1 - x), P0 = qb * QB, tok0 = b * SEQ + P0;
            attn_block(qraw + (size_t)tok0 * (MLA_H * MLA_QK) + h * MLA_QK, MLA_H * MLA_QK, qnw, cs, tok0, Kh, Vh, o + (size_t)tok0 * (MLA_H * MLA_V) + h * MLA_V, MLA_H * MLA_V, P0, pass, lds, tid, wid, lane);
        }
    }
}
#undef SBAR
}

namespace gdn {
__device__ __forceinline__ int crow(int r, int hi) { return (r & 3) + 8 * (r >> 2) + 4 * hi; }
__device__ __forceinline__ unsigned off_b(unsigned row, unsigned ch) { return 256u * row + 16u * (ch ^ (((row & 3) << 2) | ((row >> 2) & 3))); }
#define MFMA32(a, b, c) __builtin_amdgcn_mfma_f32_32x32x16_bf16((a), (b), (c), 0, 0, 0)
#define MFMA_SETTLE(x) asm volatile("s_nop 7\n\ts_nop 7\n\ts_nop 3" : "+v"(x))
#define BAR_LDS() do { asm volatile("s_waitcnt lgkmcnt(0)" ::: "memory"); __builtin_amdgcn_s_barrier(); asm volatile("" ::: "memory"); } while (0)
#define TR_ISSUE(lo, hi_, a0, a1) asm volatile("ds_read_b64_tr_b16 %0, %2\n\tds_read_b64_tr_b16 %1, %3" : "=&v"(lo), "=&v"(hi_) : "v"(a0), "v"(a1) : "memory")
#define TR_CAT(lo, hi_) ((bf16x8){lo[0], lo[1], lo[2], lo[3], hi_[0], hi_[1], hi_[2], hi_[3]})
__device__ __forceinline__ float softplus_f(float x) { return fmaxf(x, 0.f) + log1pf(__expf(-fabsf(x))); }

__device__ __forceinline__ void phase_halo(const bf16* proj, bf16* halo, int vcu, int G, int tid) {
    for (int u = vcu; u < NB * NCHUNK * 3; u += G) {
        const int j = u % 3, cn = u / 3, n = cn % NCHUNK, b = cn / NCHUNK;
        if (n == 0) continue;
        const v4u* src = (const v4u*)(proj + (size_t)(b * SEQ + 64 * n - 3 + j) * GDN_MAIN); v4u* dst = (v4u*)(halo + (size_t)u * GDN_CONV);
        dst[tid] = src[tid]; dst[512 + tid] = src[512 + tid];
    }
}
constexpr int CV_SLOT = 67 * 256, CONV_LDS = 4 * CV_SLOT;
__device__ __forceinline__ void phase_conv(bf16* proj_, const bf16* halo_, const float* convw, LAS unsigned char* lds, int vcu, int G, int tid, int wid) {
    GAS bf16* proj = (GAS bf16*)proj_; const GAS bf16* halo = (const GAS bf16*)halo_;
    int hg_ = vcu & 63; asm volatile("" : "+s"(hg_));
    const int rg = tid >> 4, cg = tid & 15, hg = hg_, ch0 = hg * 128 + cg * 8, lane = tid & 63;
    constexpr int NU = NB * NCHUNK * 64;
    f32x4 w[4][2];
#pragma unroll
    for (int j = 0; j < 4; ++j) { w[j][0] = *(const f32x4*)(convw + j * GDN_CONV + ch0); w[j][1] = *(const f32x4*)(convw + j * GDN_CONV + ch0 + 4); }
#define CONV_DMA(u_, slot_) do { const int cn_ = (u_) >> 6, n_ = cn_ % NCHUNK, b_ = cn_ / NCHUNK; \
        _Pragma("unroll") for (int i_ = 0; i_ < 3; ++i_) if (i_ < 2 || (wid == 0)) { const int c_ = 512 * i_ + tid; const int ir_ = (c_ < 1072 ? c_ : 1071) >> 4, rr_ = ir_ - 3, cc_ = c_ & 15; \
            const GAS bf16* p_ = (rr_ >= 0 || n_ == 0) ? proj + (size_t)(b_ * SEQ + 64 * n_ + (rr_ >= 0 ? rr_ : 0)) * GDN_MAIN + hg * 128 + cc_ * 8 : halo + (size_t)(cn_ * 3 + ir_) * GDN_CONV + hg * 128 + cc_ * 8; \
            if (i_ < 2 || lane < 48) __builtin_amdgcn_global_load_lds((const GAS unsigned*)p_, (LAS unsigned*)(lds + (slot_) * CV_SLOT + (512 * i_ + wid * 64) * 16), 16, 0, 0); } } while (0)
#define CONV_BODY(u_, slot_) do { const int n_ = ((u_) >> 6) % NCHUNK; \
        v4u X[5]; _Pragma("unroll") for (int j_ = 0; j_ < 5; ++j_) X[j_] = *(const LAS v4u*)(lds + (slot_) * CV_SLOT + (2 * rg + j_) * 256 + cg * 16); \
        if (n_ == 0) { unsigned z_ = 0u; asm volatile("" : "+v"(z_)); _Pragma("unroll") for (int j_ = 0; j_ < 3; ++j_) if (2 * rg + j_ < 3) X[j_] = (v4u){z_, z_, z_, z_}; } \
        float y_[2][8]; float ss_[2]; \
        _Pragma("unroll") for (int o_ = 0; o_ < 2; ++o_) { float a_[8]; _Pragma("unroll") for (int e_ = 0; e_ < 8; ++e_) a_[e_] = 0.f; \
            _Pragma("unroll") for (int j_ = 0; j_ < 4; ++j_) { const v4u xv = X[o_ + j_]; const f32x4 w0 = w[j_][0], w1 = w[j_][1]; \
                a_[0] += w0.x * bflo(xv.x); a_[1] += w0.y * bfhi(xv.x); a_[2] += w0.z * bflo(xv.y); a_[3] += w0.w * bfhi(xv.y); \
                a_[4] += w1.x * bflo(xv.z); a_[5] += w1.y * bfhi(xv.z); a_[6] += w1.z * bflo(xv.w); a_[7] += w1.w * bfhi(xv.w); } \
            float s2_ = 0.f; _Pragma("unroll") for (int e_ = 0; e_ < 8; ++e_) { const float s_ = fsilu(a_[e_]); y_[o_][e_] = s_; s2_ += s_ * s_; } ss_[o_] = s2_; } \
        float sc_[2] = {1.f, 1.f}; \
        if (hg < 32) { _Pragma("unroll") for (int o_ = 0; o_ < 2; ++o_) { float s_ = ss_[o_]; s_ += shx(s_, 1, lane); s_ += shx(s_, 2, lane); s_ += shx(s_, 4, lane); s_ += shx(s_, 8, lane); \
                sc_[o_] = rsqrtf(s_ + NORM_EPS) * (hg < 16 ? 0.08838834764831845f : 1.f); } } \
        const int cn_ = (u_) >> 6, b_ = cn_ / NCHUNK; \
        _Pragma("unroll") for (int o_ = 0; o_ < 2; ++o_) { v4u ov; const float c_ = sc_[o_]; \
            ov.x = pk2(y_[o_][0] * c_, y_[o_][1] * c_); ov.y = pk2(y_[o_][2] * c_, y_[o_][3] * c_); ov.z = pk2(y_[o_][4] * c_, y_[o_][5] * c_); ov.w = pk2(y_[o_][6] * c_, y_[o_][7] * c_); \
            *(GAS v4u*)(proj + (size_t)(b_ * SEQ + 64 * n_ + 2 * rg + o_) * GDN_MAIN + ch0) = ov; } } while (0)
    const int u0 = vcu;
    for (int k = 0; k < 3; ++k) if (u0 + k * G < NU) CONV_DMA(u0 + k * G, k);
    for (int k = 0, u = u0; u < NU; ++k, u += G) {
        const int rem = (NU - 1 - u) / G;
        if (rem >= 2) { if (wid == 0) asm volatile("s_waitcnt vmcnt(6)" ::: "memory"); else asm volatile("s_waitcnt vmcnt(4)" ::: "memory"); }
        else if (rem == 1) { if (wid == 0) asm volatile("s_waitcnt vmcnt(3)" ::: "memory"); else asm volatile("s_waitcnt vmcnt(2)" ::: "memory"); }
        else VM_WAIT();
        BAR_LDS();
        if (rem >= 3) CONV_DMA(u + 3 * G, (k + 3) & 3);
        CONV_BODY(u, k & 3);
    }
#undef CONV_DMA
#undef CONV_BODY
}
constexpr int P_KT = 0, P_QT = 16384, P_L = 32768, P_LSZ = 12288, P_G = P_L + 8 * P_LSZ, P_B = P_G + 2048, PREP_LDS = P_B + 2048;
__device__ __forceinline__ void phase_prep(const bf16* proj_, const float* ba_, const float* a_log, const float* dt_bias, bf16* TB_, bf16* INTRA_, float* gc_,
                                           LAS unsigned char* lds, int vcu, int G, int tid, int wid, int lane) {
    const GAS bf16* proj = (const GAS bf16*)proj_; const GAS float* ba = (const GAS float*)ba_; GAS bf16* TB = (GAS bf16*)TB_; GAS bf16* INTRA = (GAS bf16*)INTRA_; GAS float* gc = (GAS float*)gc_;
    const int r32 = lane & 31, hi = lane >> 5;
    constexpr int NGRP = NB * NCHUNK * GDN_HQK / 4;
    v4u pk[2], pq[2]; float pa = 0.f, pb = 0.f;
#define PREP_LOAD(grp_, s_) do { const int hq_ = ((grp_) & 3) * 4 + (s_), cn_ = (grp_) >> 2; const size_t tk_ = (size_t)(cn_ / NCHUNK) * SEQ + 64 * (cn_ % NCHUNK); \
        _Pragma("unroll") for (int i_ = 0; i_ < 2; ++i_) { const int idx_ = tid + 512 * i_, row_ = idx_ >> 4, ch_ = idx_ & 15; \
            pk[i_] = *(const GAS v4u*)(proj + (tk_ + row_) * GDN_MAIN + GDN_KEY + hq_ * 128 + ch_ * 8); pq[i_] = *(const GAS v4u*)(proj + (tk_ + row_) * GDN_MAIN + hq_ * 128 + ch_ * 8); } \
        if (wid >= 6) { const int h_ = 2 * hq_ + wid - 6; pa = ba[(tk_ + lane) * 64 + 32 + h_]; pb = ba[(tk_ + lane) * 64 + h_]; } } while (0)
    if (vcu < NGRP) PREP_LOAD(vcu, 0);
    for (int grp = vcu; grp < NGRP; grp += G) {
        const int hq0 = (grp & 3) * 4, cn = grp >> 2, n = cn % NCHUNK, b = cn / NCHUNK;
#pragma unroll 1
        for (int s = 0; s < 4; ++s) {
            const int hq = hq0 + s;
#pragma unroll
            for (int i = 0; i < 2; ++i) { const int idx = tid + 512 * i, row = idx >> 4, ch = idx & 15;
                *(LAS v4u*)(lds + P_KT + off_b(row, ch)) = pk[i]; *(LAS v4u*)(lds + P_QT + off_b(row, ch)) = pq[i]; }
            if (wid >= 6) {
                const int vh = wid - 6, h = 2 * hq + vh;
                float gg = -__expf(a_log[h]) * softplus_f(pa + dt_bias[h]);
                int ln = lane; asm volatile("" : "+v"(ln));
#pragma unroll
                for (int o = 1; o < 64; o <<= 1) { const float t = __builtin_bit_cast(float, __builtin_amdgcn_ds_bpermute((ln >= o ? ln - o : ln) << 2, __builtin_bit_cast(int, gg))); if (ln >= o) gg += t; }
                ((LAS float*)(lds + P_G))[(2 * s + vh) * 64 + lane] = gg; ((LAS float*)(lds + P_B))[(2 * s + vh) * 64 + lane] = fsigmoid(pb);
                gc[((size_t)(b * GDN_HV + h)) * SEQ + 64 * n + lane] = gg;
            }
            if (s < 3) PREP_LOAD(grp, s + 1); else if (grp + G < NGRP) PREP_LOAD(grp + G, 0);
            __syncthreads();
            if (wid < 6) {
                const int tw = wid % 3, it = tw > 0 ? 1 : 0, jt = tw > 1 ? 1 : 0; const bool isk = wid < 3;
                const LAS unsigned char* As = lds + (isk ? P_KT : P_QT); const LAS unsigned char* Bs = lds + P_KT;
                f32x16 acc = {};
#pragma unroll
                for (int ks = 0; ks < 8; ++ks) { const bf16x8 a = *(const LAS bf16x8*)(As + off_b(32 * it + r32, 2 * ks + hi)), bb = *(const LAS bf16x8*)(Bs + off_b(32 * jt + r32, 2 * ks + hi));
                    acc = MFMA32(a, bb, acc); }
                const int j = 32 * jt + r32;
#pragma unroll
                for (int vh = 0; vh < 2; ++vh) {
                    const LAS float* Gv = (const LAS float*)(lds + P_G) + (2 * s + vh) * 64; const LAS float* Bv = (const LAS float*)(lds + P_B) + (2 * s + vh) * 64;
                    const float gj = Gv[j];
                    f32x4 gi[4], bi[4];
#pragma unroll
                    for (int g_ = 0; g_ < 4; ++g_) { gi[g_] = *(const LAS f32x4*)(Gv + 32 * it + 8 * g_ + 4 * hi); bi[g_] = *(const LAS f32x4*)(Bv + 32 * it + 8 * g_ + 4 * hi); }
                    __builtin_amdgcn_sched_barrier(0);
                    if (isk) { LAS float* L = (LAS float*)(lds + P_L + (2 * s + vh) * P_LSZ) + (it ? 1024 : 0);
#pragma unroll
                        for (int r = 0; r < 16; ++r) { const int il = crow(r, hi), i = 32 * it + il; const float v = bi[r >> 2][r & 3] * acc[r] * __expf(gi[r >> 2][r & 3] - gj); L[il * (it ? 64 : 32) + j] = (j < i) ? v : 0.f; }
                    } else { GAS bf16* dst = INTRA + ((size_t)(b * GDN_HV + 2 * hq + vh) * NCHUNK + n) * 4096;
#pragma unroll
                        for (int r = 0; r < 16; ++r) { const int i = 32 * it + crow(r, hi); const float v = acc[r] * __expf(gi[r >> 2][r & 3] - gj); dst[i * 64 + j] = (bf16)f2bf((j <= i) ? v : 0.f); }
                    }
                }
            }
            __syncthreads();
        }
        {
            const int hq = hq0 + (wid >> 1), h = 2 * hq + (wid & 1);
            const LAS float* L = (const LAS float*)(lds + P_L + wid * P_LSZ); const float bj = ((const LAS float*)(lds + P_B))[wid * 64 + lane];
            float Tc[64];
            int ln = lane; asm volatile("" : "+v"(ln));
#pragma unroll
            for (int i = 0; i < 64; ++i) Tc[i] = 0.f;
            f32x4 rb[16];
#define INV_LROW(i_) (L + ((i_) < 32 ? (i_) * 32 : 1024 + ((i_) - 32) * 64))
            Tc[0] = (ln == 0) ? 1.f : 0.f;
            rb[0] = *(const LAS f32x4*)(INV_LROW(1));
#pragma unroll
            for (int i = 1; i < 64; ++i) {
                float acc = (ln == i) ? 1.f : 0.f;
#pragma unroll
                for (int c = 0; c < (i + 3) / 4; ++c) { const f32x4 l4 = rb[c];
                    acc -= l4.x * Tc[4 * c]; acc -= l4.y * Tc[4 * c + 1]; acc -= l4.z * Tc[4 * c + 2]; acc -= l4.w * Tc[4 * c + 3];
                    __builtin_amdgcn_sched_barrier(0);
                    if (i + 1 < 64) rb[c] = *(const LAS f32x4*)(INV_LROW(i + 1) + 4 * c);
                    __builtin_amdgcn_sched_barrier(0); }
                if (i + 1 < 64 && (i + 4) / 4 > (i + 3) / 4) rb[(i + 3) / 4] = *(const LAS f32x4*)(INV_LROW(i + 1) + 4 * ((i + 3) / 4));
                Tc[i] = acc;
            }
#undef INV_LROW
            GAS bf16* dst = TB + ((size_t)(b * GDN_HV + h) * NCHUNK + n) * 4096;
#pragma unroll
            for (int i = 0; i < 64; ++i) dst[i * 64 + lane] = (bf16)f2bf(Tc[i] * bj);
        }
        __syncthreads();
    }
#undef PREP_LOAD
}
constexpr int SB_SZ = 55552, S_KT = 0, S_QT = 16384, S_TT = 32768, S_IT = 41984, S_VT = 51200, S_GG = 55296;
constexpr int S_ST = 2 * SB_SZ, ST_P = 272, S_XT = S_ST + 32 * ST_P, XT_P = 144, S_VNT = S_XT + 32 * XT_P, S_VST = S_VNT + 32 * XT_P, S_OT = S_VST + 32 * XT_P, SCAN_LDS = S_OT + 4096;
#define TRW4(a, b, c, d, e, f, g_, h_) asm volatile("s_waitcnt lgkmcnt(0)" : "+v"(a), "+v"(b), "+v"(c), "+v"(d), "+v"(e), "+v"(f), "+v"(g_), "+v"(h_) :: "memory")
struct ScanRegs { v4u k[2], q[2], t, i, v; float g; };
__device__ __forceinline__ void phase_scan(bf16* proj_, const bf16* TB_, const bf16* INTRA_, const float* gc_, LAS unsigned char* lds, int vcu, int G, int tid, int wid, int lane) {
    GAS bf16* proj = (GAS bf16*)proj_; const GAS bf16* TB = (const GAS bf16*)TB_; const GAS bf16* INTRA = (const GAS bf16*)INTRA_; const GAS float* gc = (const GAS float*)gc_;
    const int r32 = lane & 31, hi = lane >> 5, blk = (lane >> 4) & 1, q4 = (lane & 15) >> 2, p4 = lane & 3;
    const unsigned ldsb = (unsigned)(uintptr_t)lds;
    for (int u = vcu; u < NB * GDN_HV * 4; u += G) {
        const int sl = u & 3, bh = u >> 2, h = bh % GDN_HV, b = bh / GDN_HV, hq = h >> 1, e0 = sl * 32;
        ScanRegs RA, RB;
#define SCAN_LOAD(R, n_) do { const int nn_ = (n_) < NCHUNK ? (n_) : NCHUNK - 1; const size_t tok0_ = (size_t)b * SEQ + 64 * nn_; \
            _Pragma("unroll") for (int i_ = 0; i_ < 2; ++i_) { const int idx_ = tid + 512 * i_, row_ = idx_ >> 4, ch_ = idx_ & 15; \
                R.k[i_] = *(const GAS v4u*)(proj + (tok0_ + row_) * GDN_MAIN + GDN_KEY + hq * 128 + ch_ * 8); R.q[i_] = *(const GAS v4u*)(proj + (tok0_ + row_) * GDN_MAIN + hq * 128 + ch_ * 8); } \
            { const size_t mb_ = ((size_t)bh * NCHUNK + nn_) * 4096 + (tid >> 3) * 64 + (tid & 7) * 8; R.t = *(const GAS v4u*)(TB + mb_); R.i = *(const GAS v4u*)(INTRA + mb_); } \
            R.v = *(const GAS v4u*)(proj + (tok0_ + ((tid & 255) >> 2)) * GDN_MAIN + GDN_CONV / 2 + h * 128 + e0 + (tid & 3) * 8); \
            R.g = gc[(size_t)bh * SEQ + 64 * nn_ + (tid & 63)]; } while (0)
#define SCAN_WRITE(R, buf_) do { LAS unsigned char* B_ = lds + (buf_) * SB_SZ; \
            _Pragma("unroll") for (int i_ = 0; i_ < 2; ++i_) { const int idx_ = tid + 512 * i_, row_ = idx_ >> 4, ch_ = idx_ & 15; \
                *(LAS v4u*)(B_ + S_KT + off_b(row_, ch_)) = R.k[i_]; *(LAS v4u*)(B_ + S_QT + off_b(row_, ch_)) = R.q[i_]; } \
            *(LAS v4u*)(B_ + S_TT + (tid >> 3) * 144 + (tid & 7) * 16) = R.t; *(LAS v4u*)(B_ + S_IT + (tid >> 3) * 144 + (tid & 7) * 16) = R.i; \
            if (tid < 256) *(LAS v4u*)(B_ + S_VT + (tid >> 2) * 64 + (tid & 3) * 16) = R.v; \
            if (tid < 64) ((LAS float*)(B_ + S_GG))[tid] = R.g; } while (0)
        SCAN_LOAD(RA, 0);
        { unsigned z = 0u; asm volatile("" : "+v"(z)); for (int i = tid; i < (32 * ST_P) / 16; i += 512) *(LAS v4u*)(lds + S_ST + i * 16) = (v4u){z, z, z, z}; }
        VM_WAIT(); SCAN_WRITE(RA, 0);
        SCAN_LOAD(RB, 1);
        f32x16 Sacc = {};
        __syncthreads();
        const unsigned fx16 = (unsigned)(((((r32 & 3) << 2) | ((r32 >> 2) & 3)) ^ hi) << 4);
        LAS unsigned char* stR = lds + S_ST + r32 * ST_P + 16 * hi;  LAS unsigned char* stW = lds + S_ST + r32 * ST_P + 8 * hi;
        LAS unsigned char* xR = lds + S_XT + r32 * XT_P + 16 * hi;   LAS unsigned char* xW = lds + S_XT + r32 * XT_P + 8 * hi;
#define PK4W(dst, a0_, a1_, a2_, a3_) do { v2u w_; w_.x = pk2(a0_, a1_); w_.y = pk2(a2_, a3_); *(LAS v2u*)(dst) = w_; } while (0)
#define SCAN_STEP(n, RI, RO) do { \
            const int buf = (n) & 1; LAS unsigned char* B = lds + buf * SB_SZ; const LAS float* GG = (const LAS float*)(B + S_GG); \
            if (wid >= 4 && (n) > 0) {                                    \
                const int t_ = tid - 256; const v4u ov = *(const LAS v4u*)(lds + S_OT + t_ * 16); \
                *(GAS v4u*)(proj + ((size_t)b * SEQ + 64 * ((n) - 1) + (t_ >> 2)) * GDN_MAIN + GDN_CONV / 2 + h * 128 + e0 + (t_ & 3) * 8) = ov; } \
            SCAN_LOAD(RI, (n) + 2); \
            f32x16 acc = {}; \
            if (wid < 4) {                                               \
                const LAS unsigned char* Ar = B + (wid < 2 ? S_KT : S_QT) + 256 * (32 * (wid & 1) + r32); \
                bf16x8 af_[8], bf_[8]; \
                _Pragma("unroll") for (int ks = 0; ks < 8; ++ks) { af_[ks] = *(const LAS bf16x8*)(Ar + ((32u * ks) ^ fx16)); bf_[ks] = *(const LAS bf16x8*)(stR + 32 * ks); } \
                __builtin_amdgcn_sched_barrier(0);                       \
                _Pragma("unroll") for (int ks = 0; ks < 8; ++ks) acc = MFMA32(af_[ks], bf_[ks], acc); \
                if (wid < 2) {                                           \
                    f32x4 gg_[4]; unsigned short vv_[16]; \
                    _Pragma("unroll") for (int g_ = 0; g_ < 4; ++g_) { const int c0 = 32 * wid + 8 * g_ + 4 * hi; gg_[g_] = *(const LAS f32x4*)(GG + c0); \
                        _Pragma("unroll") for (int j_ = 0; j_ < 4; ++j_) vv_[4 * g_ + j_] = *(const LAS unsigned short*)(B + S_VT + (c0 + j_) * 64 + r32 * 2); } \
                    __builtin_amdgcn_sched_barrier(0); \
                    _Pragma("unroll") for (int g_ = 0; g_ < 4; ++g_) { float xv[4]; \
                        _Pragma("unroll") for (int j_ = 0; j_ < 4; ++j_) xv[j_] = bf2f(vv_[4 * g_ + j_]) - __expf(gg_[g_][j_]) * acc[4 * g_ + j_]; \
                        PK4W(xW + 64 * wid + 16 * g_, xv[0], xv[1], xv[2], xv[3]); } \
                } \
            } \
            BAR_LDS();                                                      \
            const float gl = GG[63]; \
            if (wid < 2) {                                               \
                f32x16 a3_ = {}; const LAS unsigned char* Ar_ = B + S_TT + (32 * wid + r32) * 144 + 16 * hi; \
                bf16x8 af_[4], bf_[4]; f32x4 gg_[4]; \
                _Pragma("unroll") for (int ks = 0; ks < 4; ++ks) { af_[ks] = *(const LAS bf16x8*)(Ar_ + 32 * ks); bf_[ks] = *(const LAS bf16x8*)(xR + 32 * ks); } \
                _Pragma("unroll") for (int g_ = 0; g_ < 4; ++g_) gg_[g_] = *(const LAS f32x4*)(GG + 32 * wid + 8 * g_ + 4 * hi); \
                __builtin_amdgcn_sched_barrier(0); \
                _Pragma("unroll") for (int ks = 0; ks < 4; ++ks) if (ks < 2 || wid > 0) a3_ = MFMA32(af_[ks], bf_[ks], a3_); \
                MFMA_SETTLE(a3_); \
                _Pragma("unroll") for (int g_ = 0; g_ < 4; ++g_) { const f32x4 gg = gg_[g_]; \
                    PK4W(xW + (S_VNT - S_XT) + 64 * wid + 16 * g_, a3_[4 * g_], a3_[4 * g_ + 1], a3_[4 * g_ + 2], a3_[4 * g_ + 3]); \
                    PK4W(xW + (S_VST - S_XT) + 64 * wid + 16 * g_, a3_[4 * g_] * __expf(gl - gg[0]), a3_[4 * g_ + 1] * __expf(gl - gg[1]), a3_[4 * g_ + 2] * __expf(gl - gg[2]), a3_[4 * g_ + 3] * __expf(gl - gg[3])); } \
            } \
            BAR_LDS();                                                      \
            if (wid == 2 || wid == 3) {                                  \
                const int ct = wid - 2; \
                const LAS unsigned char* Ar_ = B + S_IT + (32 * ct + r32) * 144 + 16 * hi; \
                bf16x8 af_[4], bf_[4]; f32x4 gg_[4]; \
                _Pragma("unroll") for (int g_ = 0; g_ < 4; ++g_) gg_[g_] = *(const LAS f32x4*)(GG + 32 * ct + 8 * g_ + 4 * hi); \
                _Pragma("unroll") for (int ks = 0; ks < 4; ++ks) { af_[ks] = *(const LAS bf16x8*)(Ar_ + 32 * ks); bf_[ks] = *(const LAS bf16x8*)(xR + (S_VNT - S_XT) + 32 * ks); } \
                __builtin_amdgcn_sched_barrier(0); \
                _Pragma("unroll") for (int g_ = 0; g_ < 4; ++g_) _Pragma("unroll") for (int j_ = 0; j_ < 4; ++j_) acc[4 * g_ + j_] *= __expf(gg_[g_][j_]); \
                _Pragma("unroll") for (int ks = 0; ks < 4; ++ks) if (ks < 2 || ct > 0) acc = MFMA32(af_[ks], bf_[ks], acc); \
                MFMA_SETTLE(acc); \
                _Pragma("unroll") for (int r = 0; r < 16; ++r) *(LAS unsigned short*)(lds + S_OT + (32 * ct + crow(r, hi)) * 64 + r32 * 2) = (unsigned short)f2bf(acc[r]); \
            } else if (wid >= 4) {                                       \
                const int dt = wid - 4; const float egl = __expf(gl); \
                _Pragma("unroll") for (int r = 0; r < 16; ++r) Sacc[r] *= egl; \
                  \
                const unsigned chk = (unsigned)(4 * dt + 2 * blk + (p4 >> 1)); \
                const unsigned kb0 = ldsb + buf * SB_SZ + S_KT + 256u * (8 * hi + q4) + 16u * (chk ^ (unsigned)((q4 << 2) | ((2 * hi) & 3))) + 8u * (p4 & 1); \
                const unsigned kb1 = ldsb + buf * SB_SZ + S_KT + 256u * (8 * hi + 4 + q4) + 16u * (chk ^ (unsigned)((q4 << 2) | ((2 * hi + 1) & 3))) + 8u * (p4 & 1); \
                s16x4 al0, ah0, al1, ah1, al2, ah2, al3, ah3; \
                asm volatile("ds_read_b64_tr_b16 %0, %2\n\tds_read_b64_tr_b16 %1, %3" : "=&v"(al0), "=&v"(ah0) : "v"(kb0), "v"(kb1) : "memory"); \
                asm volatile("ds_read_b64_tr_b16 %0, %2 offset:4096\n\tds_read_b64_tr_b16 %1, %3 offset:4096" : "=&v"(al1), "=&v"(ah1) : "v"(kb0), "v"(kb1) : "memory"); \
                asm volatile("ds_read_b64_tr_b16 %0, %2 offset:8192\n\tds_read_b64_tr_b16 %1, %3 offset:8192" : "=&v"(al2), "=&v"(ah2) : "v"(kb0), "v"(kb1) : "memory"); \
                asm volatile("ds_read_b64_tr_b16 %0, %2 offset:12288\n\tds_read_b64_tr_b16 %1, %3 offset:12288" : "=&v"(al3), "=&v"(ah3) : "v"(kb0), "v"(kb1) : "memory"); \
                const bf16x8 b0_ = *(const LAS bf16x8*)(xR + (S_VST - S_XT)), b1_ = *(const LAS bf16x8*)(xR + (S_VST - S_XT) + 32), b2_ = *(const LAS bf16x8*)(xR + (S_VST - S_XT) + 64), b3_ = *(const LAS bf16x8*)(xR + (S_VST - S_XT) + 96); \
                TRW4(al0, ah0, al1, ah1, al2, ah2, al3, ah3); \
                Sacc = MFMA32(TR_CAT(al0, ah0), b0_, Sacc); Sacc = MFMA32(TR_CAT(al1, ah1), b1_, Sacc); Sacc = MFMA32(TR_CAT(al2, ah2), b2_, Sacc); Sacc = MFMA32(TR_CAT(al3, ah3), b3_, Sacc); \
                MFMA_SETTLE(Sacc); \
                _Pragma("unroll") for (int g_ = 0; g_ < 4; ++g_) PK4W(stW + 64 * dt + 16 * g_, Sacc[4 * g_], Sacc[4 * g_ + 1], Sacc[4 * g_ + 2], Sacc[4 * g_ + 3]); \
            } \
            asm volatile("s_waitcnt vmcnt(8)" ::: "memory");              \
            if ((n) + 1 < NCHUNK) SCAN_WRITE(RO, buf ^ 1); \
            BAR_LDS();                                                      \
        } while (0)
        for (int n = 0; n < NCHUNK; n += 2) { SCAN_STEP(n, RA, RB); SCAN_STEP(n + 1, RB, RA); }
        if (wid >= 4) { const int t_ = tid - 256; const v4u ov = *(const LAS v4u*)(lds + S_OT + t_ * 16);
            *(GAS v4u*)(proj + ((size_t)b * SEQ + 64 * (NCHUNK - 1) + (t_ >> 2)) * GDN_MAIN + GDN_CONV / 2 + h * 128 + e0 + (t_ & 3) * 8) = ov; }
        VM_WAIT(); __syncthreads();
#undef SCAN_LOAD
#undef SCAN_WRITE
#undef SCAN_STEP
#undef PK4W
    }
}
#undef TRW4
__device__ __forceinline__ void phase_gate(bf16* proj, const float* out_norm, int gw, int NGW, int lane) {
    const int g = lane >> 4, i = lane & 15; float w[8];
#pragma unroll
    for (int e = 0; e < 8; ++e) w[e] = out_norm[8 * i + e];
    for (int m = gw; m < NT; m += NGW) {
        const bf16* orow = proj + (size_t)m * GDN_MAIN + GDN_CONV / 2; bf16* zrow = proj + (size_t)m * GDN_MAIN + GDN_CONV;
#pragma unroll 4
        for (int it = 0; it < GDN_HV / 4; ++it) {
            const int off = (4 * it + g) * 128 + 8 * i;
            const v4u ov = *(const v4u*)(orow + off), zv = *(const v4u*)(zrow + off);
            float o[8], z[8];
            o[0] = bflo(ov.x); o[1] = bfhi(ov.x); o[2] = bflo(ov.y); o[3] = bfhi(ov.y); o[4] = bflo(ov.z); o[5] = bfhi(ov.z); o[6] = bflo(ov.w); o[7] = bfhi(ov.w);
            z[0] = bflo(zv.x); z[1] = bfhi(zv.x); z[2] = bflo(zv.y); z[3] = bfhi(zv.y); z[4] = bflo(zv.z); z[5] = bfhi(zv.z); z[6] = bflo(zv.w); z[7] = bfhi(zv.w);
            float ss = 0.f;
#pragma unroll
            for (int e = 0; e < 8; ++e) ss += o[e] * o[e];
            ss += shx(ss, 1, lane); ss += shx(ss, 2, lane); ss += shx(ss, 4, lane); ss += shx(ss, 8, lane);
            const float rs = rsqrtf(ss * (1.f / 128.f) + NORM_EPS);
            float r[8];
#pragma unroll
            for (int e = 0; e < 8; ++e) r[e] = o[e] * rs * w[e] * fsilu(z[e]);
            v4u res; res.x = pk2(r[0], r[1]); res.y = pk2(r[2], r[3]); res.z = pk2(r[4], r[5]); res.w = pk2(r[6], r[7]);
            *(v4u*)(zrow + off) = res;
        }
    }
}
#undef MFMA32
#undef BAR_LDS
#undef MFMA_SETTLE
#undef TR_ISSUE
#undef TR_CAT
}

struct Args { const void* in[25]; float* out; unsigned char* ws; };
__device__ __forceinline__ int lane_id_now() { int l; asm volatile("v_mbcnt_lo_u32_b32 %0, -1, 0\n\tv_mbcnt_hi_u32_b32 %0, -1, %0" : "=v"(l)); return l; }
__global__ void __launch_bounds__(NWAVES * 64, 2) mk_fwd(Args a) {
    extern __shared__ __attribute__((aligned(16))) unsigned char lds_raw[];
    LAS unsigned char* lds = (LAS unsigned char*)lds_raw;
    const int tid0 = threadIdx.x; const int wave0 = __builtin_amdgcn_readfirstlane(tid0 >> 6);
    const int G0 = gridDim.x, bx0 = blockIdx.x, vcu0 = (G0 % 8 == 0) ? (bx0 % 8) * (G0 / 8) + bx0 / 8 : bx0;
    volatile LAS unsigned* MISC = (volatile LAS unsigned*)(lds + MISC_OFF);
    if (tid0 < 64) MISC[tid0] = 0u;
    __syncthreads();
    typedef const __attribute__((address_space(4))) unsigned long long* kargp_t;
    const kargp_t kargs0 = (kargp_t)__builtin_amdgcn_kernarg_segment_ptr();
    XcdBarrier bar = xcd_barrier_post((unsigned*)(a.ws + WS_CTL) + CW_BAR, MISC + 8);
#define BTID() (wave0 * 64 + lane_id_now())
#if PROBE_MASK
    if (tid0 == 0) { const unsigned long long t_ = __builtin_amdgcn_s_memrealtime(); MISC[16] = (unsigned)t_; MISC[17] = (unsigned)(t_ >> 32); MISC[18] = 0u; MISC[19] = 0u; }
#define GRID_BAR(cls) do { { XcdBarrier b_ = bar; asm volatile("" : "+s"(b_.bar), "+s"(b_.x)); xcd_barrier(b_, BTID()); } \
        if (BTID() == 0) { const unsigned long long now_ = __builtin_amdgcn_s_memrealtime(); const unsigned long long last_ = ((unsigned long long)MISC[17] << 32) | MISC[16]; \
            if ((cls) & PROBE_MASK) { const unsigned long long a_ = (((unsigned long long)MISC[19] << 32) | MISC[18]) + (now_ - last_); MISC[18] = (unsigned)a_; MISC[19] = (unsigned)(a_ >> 32); } \
            MISC[16] = (unsigned)now_; MISC[17] = (unsigned)(now_ >> 32); } } while (0)
#else
#define GRID_BAR(cls) do { XcdBarrier b_ = bar; asm volatile("" : "+s"(b_.bar), "+s"(b_.x)); xcd_barrier(b_, BTID()); } while (0)
#endif
#define PH() int wave = wave0; asm volatile("" : "+s"(wave)); int tid = wave * 64 + lane_id_now(); const int lane = tid & 63; \
             int G = G0, bx = bx0, vcu = vcu0; asm volatile("" : "+s"(G), "+s"(bx), "+s"(vcu)); const int NGW = G * NWAVES, NGT = G * NWAVES * 64; (void)bx; (void)NGW; (void)NGT; \
             const int gw = vcu * NWAVES + wave, gtid = vcu * (NWAVES * 64) + tid; (void)lane; (void)wave; (void)gw; (void)gtid; \
             kargp_t kp = kargs0; asm volatile("" : "+s"(kp)); unsigned char* ws = (unsigned char*)(GAS unsigned char*)kp[26]; float* out = (float*)(GAS float*)kp[25]; \
             unsigned char* wmix = ws + WS_WMIX; bf16* A0 = (bf16*)(ws + WS_A0); unsigned char* A1 = ws + WS_A1; const float* hin = layer == 0 ? (const float*)(const GAS float*)kp[0] : out; \
             LAS float* scr = (LAS float*)(lds + wave * 16384); \
             (void)out; (void)wmix; (void)A0; (void)A1; (void)hin; (void)scr
#define IN(i) ((const float*)(const GAS float*)kp[i])
#define GEMMX(F16_, EPI, Aptr, Bptr, N_, K_, lda_, ldb_, ...) do { pg8::Gemm g{(const bf16*)(Aptr), (const bf16*)(Bptr), NT, (N_), (K_), (lda_), (ldb_)}; pg8::StaticOrder S; S.init(NT, (N_), G, bx); \
             pg8::EPI E{__VA_ARGS__}; pg8::gemm_phase<pg8::EPI, pg8::StaticOrder, true, true, F16_>(lds, g, S, E, tid); } while (0)
#define GEMM(...) GEMMX(false, __VA_ARGS__)
#define GEMMH(...) GEMMX(true, __VA_ARGS__)
#define COMMA ,
#define SSY ((float*)(ws + WS_SS))
#define SSX1 ((float*)(ws + WS_SS) + 32 * NT)
#define SSX2 ((float*)(ws + WS_SS) + 64 * NT)
#define HBX ((bf16*)(A1 + A1_HBX))
#define HY ((bf16*)out)
    { const int layer = 0; PH(); phase_rope_table((const int*)(const GAS int*)kp[2], (float*)(ws + WS_ROPE), gtid, NGT); }
    { const int layer = 0; PH(); phase_cast_ss(hin, HY, SSY, gw, NGW, lane); }
    for (int layer = 0; layer < DEPTH; ++layer) {
        const int j = layer >> 1; const bool is_mla = (layer & 1) == 0;
        if (is_mla) {
            { PH(); convert_matrix<0, true>(IN(4) + (size_t)j * DM * MLA_IN, IN(3) + layer * DM, DM, MLA_IN, (bf16*)(wmix + WM_MLA_IN), 0, scr, gw, NGW, lane); }
            { PH(); zero_rows((bf16*)(wmix + WM_MLA_IN), DM, MLA_IN, MLA_IN_PAD - MLA_IN, gtid, NGT); }
            { PH(); convert_matrix<0>(IN(7) + (size_t)j * MLA_QL * (MLA_H * MLA_QK), IN(5) + j * MLA_QL, MLA_QL, MLA_H * MLA_QK, (bf16*)(wmix + WM_MLA_UQ), 0, scr, gw, NGW, lane); }
            { PH(); convert_matrix<0>(IN(8) + (size_t)j * MLA_KVL * (MLA_H * 256), IN(6) + j * MLA_KVL, MLA_KVL, MLA_H * 256, (bf16*)(wmix + WM_MLA_UKV), 0, scr, gw, NGW, lane); }
            { PH(); convert_matrix<0>(IN(11) + (size_t)j * DM * DM, nullptr, DM, DM, (bf16*)(wmix + WM_MLA_O), 0, scr, gw, NGW, lane); }
        } else {
            { PH(); convert_matrix<0, true>(IN(12) + (size_t)j * DM * GDN_IN, IN(3) + layer * DM, DM, GDN_IN, (bf16*)(wmix + WM_GDN_IN), 0, scr, gw, NGW, lane); }
            { PH(); zero_rows((bf16*)(wmix + WM_GDN_IN), DM, GDN_IN, GDN_IN_PAD - GDN_IN, gtid, NGT); }
            { PH(); convert_matrix<0>(IN(17) + (size_t)j * GDN_VAL * DM, nullptr, GDN_VAL, DM, (bf16*)(wmix + WM_GDN_OUT), 0, scr, gw, NGW, lane); }
        }
        { PH(); convert_matrix<1, true>(IN(19) + (size_t)layer * DM * (2 * DFF), IN(18) + layer * DM, DM, 2 * DFF, (bf16*)(ws + WS_WGU), 0, scr, gw, NGW, lane); }
        { PH(); convert_matrix<0>(IN(20) + (size_t)layer * DFF * DM, nullptr, DFF, DM, (bf16*)(ws + WS_WDN), 0, scr, gw, NGW, lane); }
        { PH(); convert_matrix<0>(IN(21) + (size_t)layer * PLE_DIM * DM, nullptr, PLE_DIM, DM, (bf16*)(ws + WS_WPP), 0, scr, gw, NGW, lane); }
        { PH(); convert_matrix<0, true>(IN(24) + (size_t)layer * DM * DM, IN(23) + layer * DM, DM, DM, (bf16*)(ws + WS_WPG), 0, scr, gw, NGW, lane); }
        { PH(); phase_cvt_bf16(IN(1) + (size_t)layer * NT * PLE_DIM, (bf16*)(ws + WS_PBF), (size_t)NT * PLE_DIM, gtid, NGT); }
        GRID_BAR(1<<0);
        if (is_mla) {
            { PH(); GEMMH(EpiMlaIn, HY, wmix + WM_MLA_IN, MLA_IN_PAD, DM, DM, DM, (bf16*)(A1 + A1_QKVN), (float*)(A1 + A1_KPE), (float*)(A1 + A1_C), SSY); }
            GRID_BAR(1<<1);
            { PH(); GEMM(EpiBf16Lat, A1 + A1_QKVN, wmix + WM_MLA_UQ, MLA_H * MLA_QK, MLA_QL, 1024, MLA_QL, (bf16*)(A1 + A1_QRAW), MLA_H * MLA_QK, (const float*)(A1 + A1_C), 0); }
            { PH(); GEMM(EpiBf16Lat, (bf16*)(A1 + A1_QKVN) + MLA_QL, wmix + WM_MLA_UKV, MLA_H * 256, MLA_KVL, 1024, MLA_KVL, (bf16*)(A1 + A1_KVRAW), MLA_H * 256, (const float*)(A1 + A1_C), 8); }
            GRID_BAR(1<<1);
            { PH(); phase_mla_finalize_kv((const bf16*)(A1 + A1_KVRAW), (const float*)(A1 + A1_KPE), (const float*)(ws + WS_ROPE), IN(10) + j * MLA_QK, (bf16*)(A1 + A1_KF), (bf16*)(A1 + A1_VF), gw, NGW, lane); }
            GRID_BAR(1<<2);
            { PH(); attn::attn_phase((const bf16*)(A1 + A1_QRAW), IN(9) + j * MLA_QK, (const float*)(ws + WS_ROPE), (const bf16*)(A1 + A1_KF), (const bf16*)(A1 + A1_VF), A0, (LAS char*)lds, vcu, G, tid, wave, lane); }
            GRID_BAR(1<<3);
            { PH(); GEMM(EpiResid, A0, wmix + WM_MLA_O, DM, DM, DM, DM, HY, HBX, DM, SSX1); }
            GRID_BAR(1<<1);
        } else {
            { PH(); GEMMH(EpiGdnProj, HY, wmix + WM_GDN_IN, GDN_IN_PAD, DM, DM, DM, (bf16*)(A1 + A1_PROJ), GDN_MAIN, (float*)(A1 + A1_BA), GDN_MAIN / 256, SSY, (bf16*)(A1 + A1_HALO)); }
            GRID_BAR(1<<4);
            { PH(); gdn::phase_conv((bf16*)(A1 + A1_PROJ), (const bf16*)(A1 + A1_HALO), IN(13) + (size_t)j * 4 * GDN_CONV, lds, vcu, G, tid, wave); }
            GRID_BAR(1<<5);
            { PH(); gdn::phase_prep((const bf16*)(A1 + A1_PROJ), (const float*)(A1 + A1_BA), IN(14) + j * GDN_HV, IN(15) + j * GDN_HV, A0, (bf16*)(A1 + A1_INTRA), (float*)(A1 + A1_GC), lds, vcu, G, tid, wave, lane); }
            GRID_BAR(1<<6);
            { PH(); gdn::phase_scan((bf16*)(A1 + A1_PROJ), A0, (const bf16*)(A1 + A1_INTRA), (const float*)(A1 + A1_GC), lds, vcu, G, tid, wave, lane); }
            GRID_BAR(1<<7);
            { PH(); gdn::phase_gate((bf16*)(A1 + A1_PROJ), IN(16) + j * GDN_DV, gw, NGW, lane); }
            GRID_BAR(1<<8);
            { PH(); GEMM(EpiResid, (bf16*)(A1 + A1_PROJ) + GDN_CONV, wmix + WM_GDN_OUT, DM, GDN_VAL, GDN_MAIN, GDN_VAL, HY, HBX, DM, SSX1); }
            GRID_BAR(1<<9);
        }
        { PH(); GEMMH(EpiSiluMul, HBX, ws + WS_WGU, 2 * DFF, DM, DM, DM, (bf16*)(A1 + A1_ACT), DFF, SSX1); }
        { PH(); GEMM(EpiBf16Plain, ws + WS_PBF, ws + WS_WPP, DM, PLE_DIM, PLE_DIM, PLE_DIM, (bf16*)(A1 + A1_E), DM); }
        GRID_BAR(1<<11);
        { PH(); phase_rstd_e((const bf16*)(A1 + A1_E), (float*)(A1 + A1_RSTDE), gw, NGW, lane); }
        { PH(); GEMM(EpiResid, A1 + A1_ACT, ws + WS_WDN, DM, DFF, DFF, DFF, HBX, HBX, DM, SSX2); }
        GRID_BAR(1<<12);
        if (layer + 1 < DEPTH) { PH(); GEMMH(EpiPleGate<false>, HBX, ws + WS_WPG, DM, DM, DM, DM, HBX, HY, nullptr, DM, (const bf16*)(A1 + A1_E), (const float*)(A1 + A1_RSTDE), IN(22) + layer * DM, SSX2, SSY); }
        else { PH(); GEMMH(EpiPleGate<true>, HBX, ws + WS_WPG, DM, DM, DM, DM, HBX, nullptr, out, DM, (const bf16*)(A1 + A1_E), (const float*)(A1 + A1_RSTDE), IN(22) + layer * DM, SSX2, nullptr); }
        GRID_BAR(1<<14);
    }
#if PROBE_MASK
    if (blockIdx.x == 0 && BTID() == 0) { const unsigned long long acc_ = ((unsigned long long)MISC[19] << 32) | MISC[18]; const unsigned long long t0_ = __builtin_amdgcn_s_memrealtime(); while (__builtin_amdgcn_s_memrealtime() - t0_ < acc_) __builtin_amdgcn_s_sleep(32); }
#endif
}

extern "C" void kernel_launch(void* const* d_in, const int* in_sizes, int n_in, void* d_out, int out_size, void* d_ws, size_t ws_size, hipStream_t stream) {
    static int grid = 0;
    if (grid == 0) {
        if (n_in != 25 || out_size != NT * DM || ws_size < WS_END) { fprintf(stderr, "kernel_launch: unexpected shapes: n_in %d out %d ws %zu (need %zu)\n", n_in, out_size, ws_size, (size_t)WS_END); grid = -1; return; }
        int dev = 0, cus = 0, per_cu = 0;
        if (hipGetDevice(&dev) != hipSuccess || hipDeviceGetAttribute(&cus, hipDeviceAttributeMultiprocessorCount, dev) != hipSuccess) { grid = -1; return; }
        if (hipFuncSetAttribute((const void*)mk_fwd, hipFuncAttributeMaxDynamicSharedMemorySize, LDS_BYTES) != hipSuccess) { fprintf(stderr, "kernel_launch: hipFuncSetAttribute failed\n"); grid = -1; return; }
        if (hipOccupancyMaxActiveBlocksPerMultiprocessor(&per_cu, (const void*)mk_fwd, NWAVES * 64, LDS_BYTES) != hipSuccess || per_cu < 1) { fprintf(stderr, "kernel_launch: occupancy query says %d\n", per_cu); grid = -1; (void)hipGetLastError(); return; }
        grid = cus - cus % 64;
        if (grid < 64) { fprintf(stderr, "kernel_launch: %d CUs: need at least 64\n", cus); grid = -1; return; }
    }
    if (grid < 0) return;
    if (hipMemsetAsync((char*)d_ws + WS_CTL, 0, CTL_ZERO_BYTES, stream) != hipSuccess) return;
    Args a{};
    for (int i = 0; i < 25; ++i) a.in[i] = d_in[i];
    a.out = (float*)d_out; a.ws = (unsigned char*)d_ws;
    hipLaunchKernelGGL(mk_fwd, dim3(grid), dim3(NWAVES * 64), LDS_BYTES, stream, a);
}
```

```cpp
#include <hip/hip_runtime.h>
#include <cstdio>
#include <cstdint>

#ifndef PROBE_SCAN
#define PROBE_SCAN (0)
#endif
#ifndef PROBE_ATTN
#define PROBE_ATTN (0)
#endif
#ifndef PROBE_MASK
#define PROBE_MASK (0)
#endif

#define GAS __attribute__((address_space(1)))
#define LAS __attribute__((address_space(3)))
typedef unsigned short bf16;
typedef unsigned v4u __attribute__((ext_vector_type(4)));
typedef unsigned v2u __attribute__((ext_vector_type(2)));
typedef float f32x4 __attribute__((ext_vector_type(4)));
typedef float f32x16 __attribute__((ext_vector_type(16)));
typedef short bf16x8 __attribute__((ext_vector_type(8)));
typedef short s16x4 __attribute__((ext_vector_type(4)));

constexpr int NB = 2, SEQ = 16384, NT = NB * SEQ, DM = 2048, DEPTH = 4;
constexpr float NORM_EPS = 1e-6f;
constexpr int PLE_DIM = 256;
constexpr int MLA_H = 16, MLA_QL = 512, MLA_KVL = 512, MLA_NOPE = 128, MLA_ROPE = 64, MLA_QK = 192, MLA_V = 128;
constexpr int MLA_IN = MLA_QL + MLA_KVL + MLA_ROPE, MLA_IN_PAD = 1280;
constexpr int GDN_HQK = 16, GDN_HV = 32, GDN_DK = 128, GDN_DV = 128, GDN_KEY = 2048, GDN_VAL = 4096, GDN_CONV = 8192;
constexpr int GDN_MAIN = GDN_CONV + GDN_VAL;
constexpr int GDN_IN = GDN_MAIN + 64, GDN_IN_PAD = GDN_MAIN + 256;
constexpr int NCHUNK = SEQ / 64;
constexpr int DFF = 5632;

constexpr size_t MiB = 1u << 20;
constexpr size_t WS_CTL = 0, CTL_ZERO_BYTES = 64 * 1024;
constexpr size_t WS_WMIX = 1 * MiB, WS_WGU = 66 * MiB, WS_WDN = 110 * MiB, WS_WPP = 132 * MiB, WS_WPG = 133 * MiB, WS_ROPE = 141 * MiB;
constexpr size_t WS_A0 = 149 * MiB, WS_A1 = 277 * MiB, WS_SS = 1277 * MiB, WS_PBF = 1289 * MiB, WS_END = 1305 * MiB;
constexpr size_t A1_HBX = 872 * MiB;
constexpr size_t WM_GDN_IN = 0, WM_GDN_OUT = 49 * MiB;
constexpr size_t WM_MLA_IN = 0, WM_MLA_UQ = 5 * MiB, WM_MLA_UKV = 8 * MiB, WM_MLA_O = 12 * MiB;
constexpr size_t A1_C = 0, A1_QKVN = 160 * MiB, A1_KPE = 224 * MiB, A1_QRAW = 232 * MiB, A1_KVRAW = 424 * MiB, A1_KF = 680 * MiB, A1_VF = 872 * MiB, A1_QF = 0;
constexpr size_t A1_PROJ = 0, A1_BA = 768 * MiB, A1_HALO = 776 * MiB, A1_GC = 800 * MiB, A1_INTRA = 804 * MiB;
constexpr size_t A1_ACT = 0, A1_E = 368 * MiB, A1_RSTDE = 496 * MiB;
constexpr int CW_BAR = 1024;

constexpr int LDS_BYTES = 147456;
constexpr int MISC_OFF = LDS_BYTES - 256;
constexpr int NWAVES = 8;

#define LDS_WAIT() asm volatile("s_waitcnt lgkmcnt(0)" ::: "memory")
#define VM_WAIT() asm volatile("s_waitcnt vmcnt(0)" ::: "memory")
__device__ __forceinline__ unsigned pk2(float lo, float hi) { unsigned r; asm("v_cvt_pk_bf16_f32 %0, %1, %2" : "=v"(r) : "v"(lo), "v"(hi)); return r; }
__device__ __forceinline__ unsigned f2bf(float f) { return pk2(f, f) & 0xffffu; }
typedef _Float16 h16x2 __attribute__((ext_vector_type(2)));
__device__ __forceinline__ unsigned pkh2(float lo, float hi) { const h16x2 v = {(_Float16)lo, (_Float16)hi}; return __builtin_bit_cast(unsigned, v); }
__device__ __forceinline__ float bf2f(unsigned short b) { return __uint_as_float(((unsigned)b) << 16); }
__device__ __forceinline__ float bflo(unsigned w) { return __uint_as_float(w << 16); }
__device__ __forceinline__ float bfhi(unsigned w) { return __uint_as_float(w & 0xffff0000u); }
__device__ __forceinline__ float shx(float v, int mask, int lane) { return __builtin_bit_cast(float, __builtin_amdgcn_ds_bpermute((lane ^ mask) << 2, __builtin_bit_cast(int, v))); }
__device__ __forceinline__ float wave_sum(float v, int lane) {
#pragma unroll
    for (int o = 1; o < 64; o <<= 1) v += shx(v, o, lane);
    return v;
}
__device__ __forceinline__ float fsigmoid(float x) { return __builtin_amdgcn_rcpf(1.0f + __builtin_amdgcn_exp2f(-1.4426950408889634f * x)); }
__device__ __forceinline__ float fsilu(float x) { return x * fsigmoid(x); }

namespace pg8 {
#define PG8_LAS __attribute__((address_space(3)))
typedef unsigned short bf16_t;
typedef short bf16x8 __attribute__((ext_vector_type(8)));
typedef float f32x4 __attribute__((ext_vector_type(4)));
typedef unsigned u32x4 __attribute__((ext_vector_type(4)));
constexpr int BM = 256, BK = 64, HALF = 128, HTB = HALF * BK * 2  , STAGE_BYTES = 8 * HTB, NXCD = 8, WGM = 8;

__host__ __device__ __forceinline__ int lds_byte(int r, int c) { const int st = (r >> 4) * 2 + (c >> 5), rr = r & 15, cc = c & 31, ob = rr * 64 + cc * 2; return st * 1024 + (ob ^ (((ob >> 9) & 1) << 5)); }
__host__ __device__ __forceinline__ void stage_rc(int b, int& R, int& C) { const int st = b / 1024, sb = b % 1024, swz = sb ^ (((sb >> 9) & 1) << 5); R = (st >> 1) * 16 + swz / 64; C = (st & 1) * 32 + (swz % 64) / 2; }
__host__ __device__ __forceinline__ int perm32(int rho) { const int n = rho >> 4, i = rho & 15; return 8 * (i >> 2) + 4 * n + (i & 3); }

struct Unit { int pm, pn; };
struct Gemm { const bf16_t* A; const bf16_t* Bt; int M, N, K, lda, ldb; };

struct StaticOrder {
    int nM, nN, nwg, G, c;
    __host__ __device__ void init(int M, int N, int G_, int c_) { nM = M / BM; nN = N / BM; nwg = nM * nN; G = G_; c = c_; }
    __host__ __device__ bool next(int i, Unit& u) const {
        const long L = (long)i * G + c; if (L >= nwg) return false;
        int wgid = (int)L; { const int q = nwg / NXCD, r = nwg % NXCD, xcd = wgid % NXCD, off = wgid / NXCD; wgid = (xcd < r ? xcd * (q + 1) : r * (q + 1) + (xcd - r) * q) + off; }
        const int nig = WGM * nN, gid = wgid / nig, fm = gid * WGM, gsz = (nM - fm) < WGM ? (nM - fm) : WGM;
        u.pm = fm + ((wgid % nig) % gsz); u.pn = (wgid % nig) / gsz; return true;
    }
    __device__ __forceinline__ void a_ready(const Unit&) const {}
    __device__ __forceinline__ void done(const Unit&) const {}
};

__device__ __forceinline__ unsigned cvt_pk_bf16(float lo, float hi) { unsigned r; asm volatile("v_cvt_pk_bf16_f32 %0, %1, %2" : "=v"(r) : "v"(lo), "v"(hi)); return r; }
typedef float f32x2 __attribute__((ext_vector_type(2)));
__device__ __forceinline__ float fast_sigmoid(float x) { return __builtin_amdgcn_rcpf(1.0f + __builtin_amdgcn_exp2f(-1.4426950408889634f * x)); }

__device__ __forceinline__ float sum_fq(float s) {
    { const auto r = __builtin_amdgcn_permlane16_swap(__float_as_uint(s), __float_as_uint(s), false, false); s = __uint_as_float(r[0]) + __uint_as_float(r[1]); }
    { const auto r = __builtin_amdgcn_permlane32_swap(__float_as_uint(s), __float_as_uint(s), false, false); s = __uint_as_float(r[0]) + __uint_as_float(r[1]); }
    return s;
}
__device__ __forceinline__ float row_rstd(const float* ssp, int row, int fq) {
    const f32x4 a = *(const f32x4*)(ssp + (size_t)row * 32 + fq * 8), b = *(const f32x4*)(ssp + (size_t)row * 32 + fq * 8 + 4);
    float s = ((a[0] + a[1]) + (a[2] + a[3])) + ((b[0] + b[1]) + (b[2] + b[3]));
    s = sum_fq(s);
    return rsqrtf(s * (1.f / 2048.f) + 1e-6f);
}

struct EpiF32Plain {
    static constexpr bool PERM = false, AFTER_DRAIN = false;
    float* C; int ldc; const float* ss;
    __device__ __forceinline__ void operator()(const f32x4 (&acc)[2][2][4][2], const Unit& u, int wr, int wc, int fr, int fq) const {
        const int row0 = u.pm * BM + wr * 64 + fr, col0 = u.pn * BM + wc * 32 + 4 * fq;
#pragma unroll
        for (int ai = 0; ai < 2; ++ai)
#pragma unroll
            for (int m = 0; m < 4; ++m) { const int row = row0 + ai * HALF + m * 16; float* rowp = C + (size_t)row * ldc + col0; const float rs = row_rstd(ss, row, fq);
#pragma unroll
                for (int bj = 0; bj < 2; ++bj)
#pragma unroll
                    for (int n = 0; n < 2; ++n) *(f32x4*)(rowp + bj * HALF + n * 16) = acc[ai][bj][m][n] * rs; }
    }
};
struct EpiMlaIn {
    static constexpr bool PERM = true, AFTER_DRAIN = false;
    bf16_t* O; float* KPE; float* ssl; const float* ss;
    __device__ __forceinline__ void operator()(const f32x4 (&acc)[2][2][4][2], const Unit& u, int wr, int wc, int fr, int fq) const {
        const int row0 = u.pm * BM + wr * 64 + fr;
        if (u.pn < 4) {
            const int col0 = u.pn * BM + wc * 32 + 8 * fq;
#pragma unroll
            for (int ai = 0; ai < 2; ++ai)
#pragma unroll
                for (int m = 0; m < 4; ++m) { const int row = row0 + ai * HALF + m * 16; bf16_t* rowp = O + (size_t)row * 1024 + col0; const float rs = row_rstd(ss, row, fq); float sq = 0.f;
#pragma unroll
                    for (int bj = 0; bj < 2; ++bj) { const f32x4 v0 = acc[ai][bj][m][0] * rs, v1 = acc[ai][bj][m][1] * rs;
                        u32x4 w; w.x = cvt_pk_bf16(v0[0], v0[1]); w.y = cvt_pk_bf16(v0[2], v0[3]); w.z = cvt_pk_bf16(v1[0], v1[1]); w.w = cvt_pk_bf16(v1[2], v1[3]);
                        *(u32x4*)(rowp + bj * HALF) = w;
                        sq += ((v0[0] * v0[0] + v0[1] * v0[1]) + (v0[2] * v0[2] + v0[3] * v0[3])) + ((v1[0] * v1[0] + v1[1] * v1[1]) + (v1[2] * v1[2] + v1[3] * v1[3])); }
                    sq = sum_fq(sq);
                    if (fq == 0) ssl[(size_t)row * 16 + u.pn * 4 + wc] = sq; }
        } else if (wc < 2) {
            const int col0 = wc * 32 + 8 * fq;
#pragma unroll
            for (int ai = 0; ai < 2; ++ai)
#pragma unroll
                for (int m = 0; m < 4; ++m) { const int row = row0 + ai * HALF + m * 16; float* rowp = KPE + (size_t)row * 64 + col0; const float rs = row_rstd(ss, row, fq);
                    *(f32x4*)(rowp) = acc[ai][0][m][0] * rs; *(f32x4*)(rowp + 4) = acc[ai][0][m][1] * rs; }
        }
    }
};
struct EpiBf16Lat {
    static constexpr bool PERM = true, AFTER_DRAIN = false;
    bf16_t* O; int ldc; const float* ssl; int slot0;
    __device__ __forceinline__ void operator()(const f32x4 (&acc)[2][2][4][2], const Unit& u, int wr, int wc, int fr, int fq) const {
        const int row0 = u.pm * BM + wr * 64 + fr, col0 = u.pn * BM + wc * 32 + 8 * fq;
#pragma unroll
        for (int ai = 0; ai < 2; ++ai)
#pragma unroll
            for (int m = 0; m < 4; ++m) { const int row = row0 + ai * HALF + m * 16; bf16_t* rowp = O + (size_t)row * ldc + col0;
                const f32x2 pr = *(const f32x2*)(ssl + (size_t)row * 16 + slot0 + 2 * fq); float s = pr[0] + pr[1]; s = sum_fq(s);
                const float rs = rsqrtf(s * (1.f / 512.f) + 1e-6f);
#pragma unroll
                for (int bj = 0; bj < 2; ++bj) { const f32x4 v0 = acc[ai][bj][m][0] * rs, v1 = acc[ai][bj][m][1] * rs;
                    u32x4 w; w.x = cvt_pk_bf16(v0[0], v0[1]); w.y = cvt_pk_bf16(v0[2], v0[3]); w.z = cvt_pk_bf16(v1[0], v1[1]); w.w = cvt_pk_bf16(v1[2], v1[3]);
                    *(u32x4*)(rowp + bj * HALF) = w; } }
    }
};
struct EpiBf16Plain {
    static constexpr bool PERM = true, AFTER_DRAIN = false;
    bf16_t* O; int ldc;
    __device__ __forceinline__ void operator()(const f32x4 (&acc)[2][2][4][2], const Unit& u, int wr, int wc, int fr, int fq) const {
        const int row0 = u.pm * BM + wr * 64 + fr, col0 = u.pn * BM + wc * 32 + 8 * fq;
#pragma unroll
        for (int ai = 0; ai < 2; ++ai)
#pragma unroll
            for (int m = 0; m < 4; ++m) { bf16_t* rowp = O + (size_t)(row0 + ai * HALF + m * 16) * ldc + col0;
#pragma unroll
                for (int bj = 0; bj < 2; ++bj) { const f32x4 v0 = acc[ai][bj][m][0], v1 = acc[ai][bj][m][1];
                    u32x4 w; w.x = cvt_pk_bf16(v0[0], v0[1]); w.y = cvt_pk_bf16(v0[2], v0[3]); w.z = cvt_pk_bf16(v1[0], v1[1]); w.w = cvt_pk_bf16(v1[2], v1[3]);
                    *(u32x4*)(rowp + bj * HALF) = w; } }
    }
};
struct EpiGdnProj {
    static constexpr bool PERM = true, AFTER_DRAIN = false;
    bf16_t* O; int ldc; float* BA; int ntile_bf; const float* ss; bf16_t* halo;
    __device__ __forceinline__ void operator()(const f32x4 (&acc)[2][2][4][2], const Unit& u, int wr, int wc, int fr, int fq) const {
        const int row0 = u.pm * BM + wr * 64 + fr;
        if (u.pn < ntile_bf) {
            const int col0 = u.pn * BM + wc * 32 + 8 * fq;
#pragma unroll
            for (int ai = 0; ai < 2; ++ai)
#pragma unroll
                for (int m = 0; m < 4; ++m) { const int row = row0 + ai * HALF + m * 16; bf16_t* rowp = O + (size_t)row * ldc + col0; const float rs = row_rstd(ss, row, fq);
#pragma unroll
                    for (int bj = 0; bj < 2; ++bj) { const f32x4 v0 = acc[ai][bj][m][0] * rs, v1 = acc[ai][bj][m][1] * rs;
                        u32x4 w; w.x = cvt_pk_bf16(v0[0], v0[1]); w.y = cvt_pk_bf16(v0[2], v0[3]); w.z = cvt_pk_bf16(v1[0], v1[1]); w.w = cvt_pk_bf16(v1[2], v1[3]);
                        *(u32x4*)(rowp + bj * HALF) = w;
                        if ((row & 63) >= 61 && u.pn < 32 && ((row >> 6) & 255) != 255) *(u32x4*)(halo + ((size_t)((row >> 6) + 1) * 3 + (row & 63) - 61) * 8192 + col0 + bj * HALF) = w; } }
        } else if (wc < 2) {
            const int col0 = wc * 32 + 8 * fq;
#pragma unroll
            for (int ai = 0; ai < 2; ++ai)
#pragma unroll
                for (int m = 0; m < 4; ++m) { const int row = row0 + ai * HALF + m * 16; float* rowp = BA + (size_t)row * 64 + col0; const float rs = row_rstd(ss, row, fq);
                    *(f32x4*)(rowp) = acc[ai][0][m][0] * rs; *(f32x4*)(rowp + 4) = acc[ai][0][m][1] * rs; }
        }
    }
};
struct EpiSiluMul {
    static constexpr bool PERM = true, AFTER_DRAIN = false;
    bf16_t* O; int ldc; const float* ss;
    __device__ __forceinline__ void operator()(const f32x4 (&acc)[2][2][4][2], const Unit& u, int wr, int wc, int fr, int fq) const {
        const int row0 = u.pm * BM + wr * 64 + fr, col0 = u.pn * HALF + wc * 32 + 8 * fq;
#pragma unroll
        for (int ai = 0; ai < 2; ++ai)
#pragma unroll
            for (int m = 0; m < 4; ++m) { const int row = row0 + ai * HALF + m * 16; bf16_t* rowp = O + (size_t)row * ldc + col0; const float rs = row_rstd(ss, row, fq);
                f32x4 r0, r1;
#pragma unroll
                for (int j = 0; j < 4; ++j) { const float g0 = acc[ai][0][m][0][j] * rs, g1 = acc[ai][0][m][1][j] * rs;
                    r0[j] = g0 * fast_sigmoid(g0) * (acc[ai][1][m][0][j] * rs); r1[j] = g1 * fast_sigmoid(g1) * (acc[ai][1][m][1][j] * rs); }
                u32x4 w; w.x = cvt_pk_bf16(r0[0], r0[1]); w.y = cvt_pk_bf16(r0[2], r0[3]); w.z = cvt_pk_bf16(r1[0], r1[1]); w.w = cvt_pk_bf16(r1[2], r1[3]);
                *(u32x4*)(rowp) = w; }
    }
};
typedef _Float16 h2_t __attribute__((ext_vector_type(2)));
__device__ __forceinline__ unsigned pkh(float a, float b) { const h2_t v = {(_Float16)a, (_Float16)b}; return __builtin_bit_cast(unsigned, v); }
__device__ __forceinline__ float hlo(unsigned w) { return (float)__builtin_bit_cast(h2_t, w)[0]; }
__device__ __forceinline__ float hhi(unsigned w) { return (float)__builtin_bit_cast(h2_t, w)[1]; }
struct EpiResid {
    static constexpr bool PERM = true, AFTER_DRAIN = false;
    const bf16_t* base16; bf16_t* out16; int ldc; float* ssout;
    __device__ __forceinline__ void operator()(const f32x4 (&acc)[2][2][4][2], const Unit& u, int wr, int wc, int fr, int fq) const {
        const int row0 = u.pm * BM + wr * 64 + fr, col0 = u.pn * BM + wc * 32 + 8 * fq;
#pragma unroll
        for (int ai = 0; ai < 2; ++ai) {
            u32x4 bs[4][2];
#pragma unroll
            for (int m = 0; m < 4; ++m) { const size_t off = (size_t)(row0 + ai * HALF + m * 16) * ldc + col0; bs[m][0] = *(const u32x4*)(base16 + off); bs[m][1] = *(const u32x4*)(base16 + off + HALF); }
#pragma unroll
            for (int m = 0; m < 4; ++m) { const int row = row0 + ai * HALF + m * 16; const size_t off = (size_t)row * ldc + col0; float sq = 0.f;
#pragma unroll
                for (int bj = 0; bj < 2; ++bj) { const u32x4 b = bs[m][bj]; const f32x4 a0 = acc[ai][bj][m][0], a1 = acc[ai][bj][m][1];
                    const float o0 = hlo(b.x) + a0[0], o1 = hhi(b.x) + a0[1], o2 = hlo(b.y) + a0[2], o3 = hhi(b.y) + a0[3], o4 = hlo(b.z) + a1[0], o5 = hhi(b.z) + a1[1], o6 = hlo(b.w) + a1[2], o7 = hhi(b.w) + a1[3];
                    u32x4 hw; hw.x = pkh(o0, o1); hw.y = pkh(o2, o3); hw.z = pkh(o4, o5); hw.w = pkh(o6, o7); *(u32x4*)(out16 + off + bj * HALF) = hw;
                    sq += ((o0 * o0 + o1 * o1) + (o2 * o2 + o3 * o3)) + ((o4 * o4 + o5 * o5) + (o6 * o6 + o7 * o7)); }
                sq = sum_fq(sq);
                if (fq == 0) ssout[(size_t)row * 32 + u.pn * 4 + wc] = sq; }
            asm volatile("" ::: "memory");
        }
    }
};
template <bool FINAL> struct EpiPleGate {
    static constexpr bool PERM = true, AFTER_DRAIN = false;
    const bf16_t* base16; bf16_t* out16; float* outf; int ldc; const bf16_t* e; const float* rstd; const float* wn; const float* ssin; float* ssout;
    __device__ __forceinline__ void operator()(const f32x4 (&acc)[2][2][4][2], const Unit& u, int wr, int wc, int fr, int fq) const {
        const int row0 = u.pm * BM + wr * 64 + fr, col0 = u.pn * BM + wc * 32 + 8 * fq;
#pragma unroll
        for (int am = 0; am < 4; ++am) { const int ai = am >> 1;
            u32x4 bs[4][2], ev[4][2]; float rs[4], ri[4];
#pragma unroll
            for (int m = 2 * (am & 1); m < 2 * (am & 1) + 2; ++m) { const int row = row0 + ai * HALF + m * 16; const size_t off = (size_t)row * ldc + col0; rs[m] = rstd[row]; ri[m] = row_rstd(ssin, row, fq);
#pragma unroll
                for (int bj = 0; bj < 2; ++bj) { bs[m][bj] = *(const u32x4*)(base16 + off + bj * HALF); ev[m][bj] = *(const u32x4*)(e + off + bj * HALF); } }
#pragma unroll
            for (int m = 2 * (am & 1); m < 2 * (am & 1) + 2; ++m) { const int row = row0 + ai * HALF + m * 16; const size_t off = (size_t)row * ldc + col0; float sq = 0.f;
#pragma unroll
                for (int bj = 0; bj < 2; ++bj) { const f32x4 w0 = *(const f32x4*)(wn + col0 + bj * HALF), w1 = *(const f32x4*)(wn + col0 + bj * HALF + 4); const u32x4 ew = ev[m][bj], b = bs[m][bj];
                    const f32x4 a0 = acc[ai][bj][m][0], a1 = acc[ai][bj][m][1]; const float rsv = rs[m], riv = ri[m];
                    const float o0 = hlo(b.x) + __uint_as_float(ew.x << 16) * rsv * w0[0] * fast_sigmoid(a0[0] * riv), o1 = hhi(b.x) + __uint_as_float(ew.x & 0xffff0000u) * rsv * w0[1] * fast_sigmoid(a0[1] * riv);
                    const float o2 = hlo(b.y) + __uint_as_float(ew.y << 16) * rsv * w0[2] * fast_sigmoid(a0[2] * riv), o3 = hhi(b.y) + __uint_as_float(ew.y & 0xffff0000u) * rsv * w0[3] * fast_sigmoid(a0[3] * riv);
                    const float o4 = hlo(b.z) + __uint_as_float(ew.z << 16) * rsv * w1[0] * fast_sigmoid(a1[0] * riv), o5 = hhi(b.z) + __uint_as_float(ew.z & 0xffff0000u) * rsv * w1[1] * fast_sigmoid(a1[1] * riv);
                    const float o6 = hlo(b.w) + __uint_as_float(ew.w << 16) * rsv * w1[2] * fast_sigmoid(a1[2] * riv), o7 = hhi(b.w) + __uint_as_float(ew.w & 0xffff0000u) * rsv * w1[3] * fast_sigmoid(a1[3] * riv);
                    if constexpr (FINAL) { *(f32x4*)(outf + off + bj * HALF) = (f32x4){o0, o1, o2, o3}; *(f32x4*)(outf + off + bj * HALF + 4) = (f32x4){o4, o5, o6, o7}; }
                    else { u32x4 hw; hw.x = pkh(o0, o1); hw.y = pkh(o2, o3); hw.z = pkh(o4, o5); hw.w = pkh(o6, o7); *(u32x4*)(out16 + off + bj * HALF) = hw;
                        sq += ((o0 * o0 + o1 * o1) + (o2 * o2 + o3 * o3)) + ((o4 * o4 + o5 * o5) + (o6 * o6 + o7 * o7)); } }
                if constexpr (!FINAL) { sq = sum_fq(sq); if (fq == 0) ssout[(size_t)row * 32 + u.pn * 4 + wc] = sq; } }
            asm volatile("" ::: "memory");
        }
    }
};

typedef _Float16 f16x8 __attribute__((ext_vector_type(8)));
template <bool F16> __device__ __forceinline__ f32x4 mma16(bf16x8 b, bf16x8 a, f32x4 c) {
    if constexpr (F16) return __builtin_amdgcn_mfma_f32_16x16x32_f16(__builtin_bit_cast(f16x8, b), __builtin_bit_cast(f16x8, a), c, 0, 0, 0);
    else return __builtin_amdgcn_mfma_f32_16x16x32_bf16(b, a, c, 0, 0, 0);
}
template <class Epi, class Sched, bool ALIGN_EPI = false, bool SP2 = false, bool F16 = false>
__device__ __forceinline__ void gemm_phase(PG8_LAS unsigned char* lds, const Gemm g, const Sched& S, const Epi& E, const int tid_in  ) {
    int tid_ = tid_in; asm volatile("" : "+v"(tid_));
    const int tid = tid_, wid = __builtin_amdgcn_readfirstlane(tid >> 6), lane = tid & 63, wr = wid >> 2, wc = wid & 3, fr = lane & 15, fq = lane >> 4;
    const int K = g.K, nt = K / BK;
    unsigned voffA[2], voffB[2];
#pragma unroll
    for (int i = 0; i < 2; ++i) { int R, C; stage_rc(tid * 16 + i * 8192, R, C); const int Rb = Epi::PERM ? ((R & ~31) + perm32(R & 31)) : R;
        voffA[i] = (unsigned)(R * g.lda + C) * 2u; voffB[i] = (unsigned)(Rb * g.ldb + C) * 2u; }
    const size_t kstep = (size_t)(BK * 2);
    const size_t hstepA = (size_t)HALF * g.lda * 2, hstepB = (size_t)HALF * g.ldb * 2;
    const size_t tstepA = 2 * hstepA, tstepB = 2 * hstepB;
    const unsigned ldsw = (unsigned)wid * 1024u;
    const int aoff = lds_byte(wr * 64 + fr, fq * 8), boff = lds_byte(wc * 32 + fr, fq * 8);
#define PG8_SA(b, h) (((b) * 2 + (h)) * HTB)
#define PG8_SB(b, h) ((4 + (b) * 2 + (h)) * HTB)
#define PG8_STAGE(bufoff, gbase, voff) do { const unsigned long long gb_ = (unsigned long long)(uintptr_t)(gbase); const int ld_ = __builtin_amdgcn_readfirstlane((int)(uintptr_t)(lds + (bufoff) + ldsw)); \
        _Pragma("unroll") for (int _i = 0; _i < 2; ++_i) asm volatile("s_mov_b32 m0, %2\n\ts_nop 0\n\tglobal_load_lds_dwordx4 %0, %1" :: "v"((voff)[_i]), "s"(gb_), "s"(ld_ + _i * 8192) : "memory", "m0"); } while (0)
#define PG8_LDA(dst, b, h) do { _Pragma("unroll") for (int m = 0; m < 4; ++m) _Pragma("unroll") for (int k = 0; k < 2; ++k) dst[m][k] = *(const PG8_LAS bf16x8*)(lds + PG8_SA(b, h) + aoff + m * 2048 + k * 1024); } while (0)
#define PG8_LDB(dst, b, h) do { _Pragma("unroll") for (int n = 0; n < 2; ++n) _Pragma("unroll") for (int k = 0; k < 2; ++k) dst[n][k] = *(const PG8_LAS bf16x8*)(lds + PG8_SB(b, h) + boff + n * 2048 + k * 1024); } while (0)
#define PG8_MMA(ai, bj, At, Bt) do { __builtin_amdgcn_s_setprio(1); _Pragma("unroll") for (int m = 0; m < 4; ++m) _Pragma("unroll") for (int n = 0; n < 2; ++n) _Pragma("unroll") for (int k = 0; k < 2; ++k) \
        acc[ai][bj][m][n] = mma16<F16>(Bt[n][k], At[m][k], acc[ai][bj][m][n]); __builtin_amdgcn_s_setprio(0); } while (0)
#define PG8_MMA_RAW(ai, bj, At, Bt) do { _Pragma("unroll") for (int m = 0; m < 4; ++m) _Pragma("unroll") for (int n = 0; n < 2; ++n) _Pragma("unroll") for (int k = 0; k < 2; ++k) \
        acc[ai][bj][m][n] = mma16<F16>(Bt[n][k], At[m][k], acc[ai][bj][m][n]); } while (0)
#define PG8_MMA2(ai, At, Ba, Bb) do { __builtin_amdgcn_s_setprio(1); PG8_MMA_RAW(ai, 0, At, Ba); PG8_MMA_RAW(ai, 1, At, Bb); __builtin_amdgcn_s_setprio(0); } while (0)
#define PG8_WAIT_V(n) asm volatile("s_waitcnt vmcnt(" #n ")" ::: "memory")
#define PG8_WAIT_L(n) asm volatile("s_waitcnt lgkmcnt(" #n ")" ::: "memory")
#define PG8_BAR __builtin_amdgcn_s_barrier()
#define PG8_SCHED __builtin_amdgcn_sched_barrier(0)
    Unit cur, nxt; int ui = 0;
    if (!S.next(0, cur)) return;
    f32x4 acc[2][2][4][2];
#pragma unroll
    for (int a = 0; a < 2; ++a)
#pragma unroll
        for (int b = 0; b < 2; ++b)
#pragma unroll
            for (int m = 0; m < 4; ++m)
#pragma unroll
                for (int n = 0; n < 2; ++n) acc[a][b][m][n] = (f32x4){0.f, 0.f, 0.f, 0.f};
    bf16x8 At[4][2], B0[2][2], B1[2][2];
    const char* cA = (const char*)g.A + (size_t)cur.pm * tstepA; const char* cB = (const char*)g.Bt + (size_t)cur.pn * tstepB;
    S.a_ready(cur);
    if constexpr (SP2) {
        PG8_STAGE(PG8_SB(0, 0), cB, voffB); PG8_STAGE(PG8_SB(0, 1), cB + hstepB, voffB); PG8_STAGE(PG8_SA(0, 0), cA, voffA); PG8_STAGE(PG8_SA(0, 1), cA + hstepA, voffA);
        if (wr == 1) PG8_BAR;
        PG8_WAIT_V(2); PG8_BAR;
        PG8_STAGE(PG8_SB(1, 0), cB + kstep, voffB); PG8_STAGE(PG8_SA(1, 0), cA + kstep, voffA); PG8_STAGE(PG8_SB(1, 1), cB + hstepB + kstep, voffB);
        PG8_WAIT_V(6); PG8_BAR;
    } else {
        PG8_STAGE(PG8_SB(0, 0), cB, voffB); PG8_STAGE(PG8_SA(0, 0), cA, voffA); PG8_STAGE(PG8_SB(0, 1), cB + hstepB, voffB); PG8_STAGE(PG8_SA(0, 1), cA + hstepA, voffA);
        if (wr == 1) PG8_BAR;
        PG8_WAIT_V(4); PG8_BAR;
        PG8_STAGE(PG8_SB(1, 0), cB + kstep, voffB); PG8_STAGE(PG8_SA(1, 0), cA + kstep, voffA); PG8_STAGE(PG8_SB(1, 1), cB + hstepB + kstep, voffB);
        PG8_WAIT_V(6); PG8_BAR;
    }
    for (;;) {
        const bool has_next = S.next(ui + 1, nxt);
        const char* nA = has_next ? (const char*)g.A + (size_t)nxt.pm * tstepA : cA; const char* nB = has_next ? (const char*)g.Bt + (size_t)nxt.pn * tstepB : cB;
        for (int t = 0; t < nt; t += 2) {
            const bool last = (t == nt - 2);
            const char* a1 = cA + (size_t)(t + 1) * kstep;
            const char* a2 = last ? nA : cA + (size_t)(t + 2) * kstep; const char* b2 = last ? nB : cB + (size_t)(t + 2) * kstep;
            const char* a3 = a2 + kstep; const char* b3 = b2 + kstep;
            if (last && has_next) S.a_ready(nxt);
            if constexpr (SP2) {
            PG8_LDB(B0, 0, 0); PG8_LDB(B1, 0, 1); PG8_SCHED; PG8_LDA(At, 0, 0); PG8_STAGE(PG8_SA(1, 1), a1 + hstepA, voffA);
            PG8_WAIT_V(8); PG8_WAIT_L(0); PG8_BAR; PG8_MMA2(0, At, B0, B1); PG8_BAR; PG8_SCHED;
            PG8_LDA(At, 0, 1); PG8_STAGE(PG8_SB(0, 0), b2, voffB); PG8_STAGE(PG8_SB(0, 1), b2 + hstepB, voffB); PG8_STAGE(PG8_SA(0, 0), a2, voffA);
            PG8_WAIT_V(8); PG8_WAIT_L(0); PG8_BAR; PG8_MMA2(1, At, B0, B1); PG8_BAR; PG8_SCHED;
            PG8_LDB(B0, 1, 0); PG8_LDB(B1, 1, 1); PG8_SCHED; PG8_LDA(At, 1, 0); PG8_STAGE(PG8_SA(0, 1), a2 + hstepA, voffA);
            PG8_WAIT_V(8); PG8_WAIT_L(0); PG8_BAR; PG8_MMA2(0, At, B0, B1); PG8_BAR; PG8_SCHED;
            PG8_LDA(At, 1, 1); PG8_STAGE(PG8_SB(1, 0), b3, voffB); PG8_STAGE(PG8_SB(1, 1), b3 + hstepB, voffB); PG8_STAGE(PG8_SA(1, 0), a3, voffA);
            PG8_WAIT_V(8); PG8_WAIT_L(0); PG8_BAR; PG8_MMA2(1, At, B0, B1); PG8_BAR; PG8_SCHED;
            } else {
            PG8_LDB(B0, 0, 0); PG8_SCHED; PG8_LDA(At, 0, 0); PG8_STAGE(PG8_SA(1, 1), a1 + hstepA, voffA);
            PG8_WAIT_L(8); PG8_BAR; PG8_WAIT_L(0); PG8_MMA(0, 0, At, B0); PG8_BAR; PG8_SCHED;
            PG8_LDB(B1, 0, 1); PG8_STAGE(PG8_SB(0, 0), b2, voffB);
            PG8_BAR; PG8_WAIT_L(0); PG8_MMA(0, 1, At, B1); PG8_BAR;
            PG8_LDA(At, 0, 1); PG8_STAGE(PG8_SA(0, 0), a2, voffA);
            PG8_BAR; PG8_WAIT_L(0); PG8_MMA(1, 0, At, B0); PG8_BAR; PG8_SCHED;
            PG8_STAGE(PG8_SB(0, 1), b2 + hstepB, voffB);
            PG8_WAIT_V(6); PG8_BAR; PG8_MMA(1, 1, At, B1); PG8_BAR;
            PG8_LDB(B0, 1, 0); PG8_SCHED; PG8_LDA(At, 1, 0); PG8_STAGE(PG8_SA(0, 1), a2 + hstepA, voffA);
            PG8_WAIT_L(8); PG8_BAR; PG8_WAIT_L(0); PG8_MMA(0, 0, At, B0); PG8_BAR; PG8_SCHED;
            PG8_LDB(B1, 1, 1); PG8_STAGE(PG8_SB(1, 0), b3, voffB);
            PG8_BAR; PG8_WAIT_L(0); PG8_MMA(0, 1, At, B1); PG8_BAR;
            PG8_LDA(At, 1, 1); PG8_STAGE(PG8_SA(1, 0), a3, voffA);
            PG8_BAR; PG8_WAIT_L(0); PG8_MMA(1, 0, At, B0); PG8_BAR; PG8_SCHED;
            PG8_STAGE(PG8_SB(1, 1), b3 + hstepB, voffB);
            PG8_WAIT_V(6); PG8_BAR; PG8_MMA(1, 1, At, B1); PG8_BAR;
            }
        }
        if constexpr (ALIGN_EPI) { if (wr == 0) PG8_BAR; }
        if constexpr (!Epi::AFTER_DRAIN) { E(acc, cur, wr, wc, fr, fq); S.done(cur); }
        if (!has_next) break;
#pragma unroll
        for (int a = 0; a < 2; ++a)
#pragma unroll
            for (int b = 0; b < 2; ++b)
#pragma unroll
                for (int m = 0; m < 4; ++m)
#pragma unroll
                    for (int n = 0; n < 2; ++n) acc[a][b][m][n] = (f32x4){0.f, 0.f, 0.f, 0.f};
        cur = nxt; cA = nA; cB = nB; ++ui;
        if constexpr (ALIGN_EPI) { if (wr == 1) PG8_BAR; }
    }
    PG8_WAIT_V(0);
    if constexpr (!ALIGN_EPI) { if (wr == 0) PG8_BAR; }
    PG8_BAR;
    if constexpr (Epi::AFTER_DRAIN) { E.fused(acc, cur, wr, wc, fr, fq, lds, wid, lane); S.done(cur); }
#undef PG8_SA
#undef PG8_SB
#undef PG8_STAGE
#undef PG8_LDA
#undef PG8_LDB
#undef PG8_MMA
#undef PG8_MMA_RAW
#undef PG8_MMA2
#undef PG8_WAIT_V
#undef PG8_WAIT_L
#undef PG8_BAR
#undef PG8_SCHED
}
}
#define XB_TMO      128
#define XB_XCNT(j)  (256  + 64 * (j))
#define XB_XSUB(j)  (1280 + 64 * (j))
#define XB_XGEN(j)  (2304 + 64 * (j))
#define XB_TOP      3328
#define XB_TOPGEN   3392
#define XCD_BAR_WORDS 3456
#define XB_SPIN_CAP (1u << 18)

__device__ __forceinline__ unsigned xb_ld(unsigned* p)              { return __hip_atomic_load(p, __ATOMIC_RELAXED, __HIP_MEMORY_SCOPE_AGENT); }
__device__ __forceinline__ unsigned xb_add(unsigned* p, unsigned v) { return __hip_atomic_fetch_add(p, v, __ATOMIC_RELAXED, __HIP_MEMORY_SCOPE_AGENT); }
__device__ __forceinline__ unsigned xb_xcc_id() { return (unsigned)__builtin_amdgcn_s_getreg((3 << 11) | 20) & 0xFu; }
#define XB_SPIN(cond, bar) do { unsigned _sp = 0; while (cond) { __builtin_amdgcn_s_sleep(1); \
    if ((++_sp & 255u) == 0u) { if (xb_ld(&(bar)[XB_TMO])) break; if (_sp > XB_SPIN_CAP) { atomicAdd(&(bar)[XB_TMO], 1u); break; } } } } while (0)

struct XcdBarrier {
    unsigned* bar; unsigned x;
    volatile LAS unsigned* st;
};

__device__ __forceinline__ XcdBarrier xcd_barrier_post(unsigned* bar, volatile LAS unsigned* st) {
    XcdBarrier b; b.bar = bar; b.x = xb_xcc_id(); b.st = st;
    if (threadIdx.x == 0) (void)xb_add(&bar[XB_XCNT(b.x)], 1u);
    return b;
}
__device__ __forceinline__ void xcd_barrier_complete(unsigned* bar, unsigned x, unsigned& nloc, unsigned& nx) {
    const unsigned G = gridDim.x * gridDim.y * gridDim.z;
    unsigned sum, cnt, mine, sp = 0u;
    for (;;) {
        sum = 0u; cnt = 0u; mine = 0u;
#pragma unroll
        for (unsigned j = 0; j < 16; ++j) { const unsigned c = xb_ld(&bar[XB_XCNT(j)]); sum += c; cnt += (c > 0u) ? 1u : 0u; mine = (j == x) ? c : mine; }
        if (sum == G) break;
        __builtin_amdgcn_s_sleep(1);
        if ((++sp & 255u) == 0u) { if (xb_ld(&bar[XB_TMO])) break; if (sp > XB_SPIN_CAP) { atomicAdd(&bar[XB_TMO], 1u); break; } }
    }
    nloc = mine > 0u ? mine : 1u; nx = cnt > 0u ? cnt : 1u;
}

__device__ __forceinline__ void xcd_barrier(const XcdBarrier& b, const int tid_in  ) {
    asm volatile("s_waitcnt vmcnt(0)" ::: "memory");
    __syncthreads();
    if (tid_in == 0) {
        unsigned* bar = b.bar;
        __builtin_amdgcn_s_waitcnt(0);
        unsigned nloc = b.st[0], nx = b.st[1];
        if (nloc == 0u) { xcd_barrier_complete(bar, b.x, nloc, nx); b.st[0] = nloc; b.st[1] = nx; }
        const unsigned old = xb_add(&bar[XB_XSUB(b.x)], 1u);
        const unsigned gen = old / nloc;
        if (old + 1u == (gen + 1u) * nloc) {
            __builtin_amdgcn_fence(__ATOMIC_RELEASE, "agent");
            asm volatile("s_waitcnt vmcnt(0)" ::: "memory");
            const unsigned og = xb_add(&bar[XB_TOP], 1u);
            const unsigned tg = og / nx;
            if (og + 1u == (tg + 1u) * nx) xb_add(&bar[XB_TOPGEN], 1u);
            else XB_SPIN(xb_ld(&bar[XB_TOPGEN]) == tg, bar);
            __builtin_amdgcn_fence(__ATOMIC_ACQUIRE, "agent");
            xb_add(&bar[XB_XGEN(b.x)], 1u);
            asm volatile("s_waitcnt vmcnt(0)" ::: "memory");
        } else {
            XB_SPIN(xb_ld(&bar[XB_XGEN(b.x)]) == gen, bar);
            __builtin_amdgcn_fence(__ATOMIC_ACQUIRE, "agent");
            asm volatile("s_waitcnt vmcnt(0)" ::: "memory");
        }
    }
    __syncthreads();
}
template <int MODE, bool F16>
__device__ __forceinline__ void transpose_item(const float* W, const float* ksc, int K, int N, bf16* WT, int row_off, LAS float* scr_, int item, int lane) {
    LAS unsigned char* scr = (LAS unsigned char*)scr_;
    const int nblk = N / 64, kb = item / nblk, nb = item % nblk, k0 = 64 * kb, n0 = 64 * nb;
    const int n4 = lane & 15, kq = lane >> 4;
#pragma unroll 4
    for (int i = 0; i < 16; ++i) { const int kk = 4 * i + kq; const f32x4 v = *(const f32x4*)(W + (size_t)(k0 + kk) * N + n0 + 4 * n4); const float sc = ksc ? ksc[k0 + kk] : 1.f;
        const unsigned p01 = F16 ? pkh2(v.x * sc, v.y * sc) : pk2(v.x * sc, v.y * sc), p23 = F16 ? pkh2(v.z * sc, v.w * sc) : pk2(v.z * sc, v.w * sc);
        LAS unsigned char* d = scr + (4 * n4) * 144 + (((kk >> 3) ^ (n4 & 7)) << 4) + (kk & 7) * 2;
        *(LAS unsigned short*)(d) = (unsigned short)p01; *(LAS unsigned short*)(d + 144) = (unsigned short)(p01 >> 16);
        *(LAS unsigned short*)(d + 288) = (unsigned short)p23; *(LAS unsigned short*)(d + 432) = (unsigned short)(p23 >> 16); }
    LDS_WAIT(); asm volatile("" ::: "memory");
    int d0;
    if (MODE == 0) d0 = row_off + n0;
    else { const int half = n0 >= DFF ? 1 : 0, nn = n0 - half * DFF; d0 = (nn >> 7) * 256 + half * 128 + (nn & 127); }
#pragma unroll
    for (int t = 0; t < 8; ++t) { const int idx = lane + 64 * t, n = idx >> 3, c = idx & 7;
        const v4u o = *(const LAS v4u*)(scr + n * 144 + ((c ^ ((n >> 2) & 7)) << 4));
        *(v4u*)(WT + (size_t)(d0 + n) * K + k0 + 8 * c) = o; }
    LDS_WAIT(); asm volatile("" ::: "memory");
}
template <int MODE, bool F16 = false>
__device__ __forceinline__ void convert_matrix(const float* W, const float* ksc, int K, int N, bf16* WT, int row_off, LAS float* scr, int gw, int NGW, int lane) {
    const int nitems = (K / 64) * (N / 64);
    for (int it = gw; it < nitems; it += NGW) transpose_item<MODE, F16>(W, ksc, K, N, WT, row_off, scr, it, lane);
}
__device__ __forceinline__ void zero_rows(bf16* WT, int K, int row0, int nrows, int gtid, int NGT) {
    const size_t n16 = (size_t)nrows * K / 8; v4u* p = (v4u*)(WT + (size_t)row0 * K);
    unsigned z = 0u; asm volatile("" : "+v"(z));
    for (size_t i = gtid; i < n16; i += NGT) p[i] = (v4u){z, z, z, z};
}
__device__ __forceinline__ void phase_cast_ss(const float* h, bf16* hb, float* ss, int gw, int NGW, int lane) {
    for (int m = gw; m < NT; m += NGW) {
        const f32x4* xr = (const f32x4*)(h + (size_t)m * DM) + lane; v2u* o8 = (v2u*)(hb + (size_t)m * DM) + lane; float s = 0.f;
#pragma unroll
        for (int j = 0; j < 8; ++j) { const f32x4 v = xr[64 * j]; s += (v.x * v.x + v.y * v.y) + (v.z * v.z + v.w * v.w); v2u o; o.x = pkh2(v.x, v.y); o.y = pkh2(v.z, v.w); o8[64 * j] = o; }
        s = wave_sum(s, lane);
        if (lane < 32) ss[(size_t)m * 32 + lane] = lane == 0 ? s : 0.f;
    }
}
__device__ __forceinline__ void zero_f32(float* p, int n, int gtid, int NGT) { float z = 0.f; asm volatile("" : "+v"(z)); for (int i = gtid; i < n; i += NGT) p[i] = z; }
__device__ __forceinline__ void phase_rope_table(const int* positions, float* cs, int gtid, int NGT) {
    for (int idx = gtid; idx < NT * 32; idx += NGT) {
        const int t = idx >> 5, i = idx & 31;
        const float inv_freq = __builtin_amdgcn_exp2f(-(float)i * (13.287712379549449f / 32.0f));
        const float ang = (float)positions[t] * inv_freq;
        const double rev = (double)ang * 0.15915494309189535; const double fr = rev - floor(rev);
        const float x = (float)(fr * 6.283185307179586);
        cs[(size_t)t * 64 + i] = cosf(x); cs[(size_t)t * 64 + 32 + i] = sinf(x);
    }
}
__device__ __forceinline__ void phase_mla_latnorm(const float* c, const float* wq, const float* wkv, bf16* qkvn, float* kpe, int gw, int NGW, int lane) {
    for (int m = gw; m < NT; m += NGW) {
        const f32x4* cr = (const f32x4*)(c + (size_t)m * MLA_IN_PAD);
        f32x4 a0 = cr[lane], a1 = cr[64 + lane], b0 = cr[128 + lane], b1 = cr[192 + lane];
        float sa = (a0.x * a0.x + a0.y * a0.y) + (a0.z * a0.z + a0.w * a0.w) + (a1.x * a1.x + a1.y * a1.y) + (a1.z * a1.z + a1.w * a1.w);
        float sb = (b0.x * b0.x + b0.y * b0.y) + (b0.z * b0.z + b0.w * b0.w) + (b1.x * b1.x + b1.y * b1.y) + (b1.z * b1.z + b1.w * b1.w);
        const float ra = rsqrtf(wave_sum(sa, lane) * (1.f / 512.f) + NORM_EPS), rb = rsqrtf(wave_sum(sb, lane) * (1.f / 512.f) + NORM_EPS);
        const f32x4 wa0 = ((const f32x4*)wq)[lane], wa1 = ((const f32x4*)wq)[64 + lane], wb0 = ((const f32x4*)wkv)[lane], wb1 = ((const f32x4*)wkv)[64 + lane];
        v2u* o = (v2u*)(qkvn + (size_t)m * 1024); v2u t;
        t.x = pk2(a0.x * ra * wa0.x, a0.y * ra * wa0.y); t.y = pk2(a0.z * ra * wa0.z, a0.w * ra * wa0.w); o[lane] = t;
        t.x = pk2(a1.x * ra * wa1.x, a1.y * ra * wa1.y); t.y = pk2(a1.z * ra * wa1.z, a1.w * ra * wa1.w); o[64 + lane] = t;
        t.x = pk2(b0.x * rb * wb0.x, b0.y * rb * wb0.y); t.y = pk2(b0.z * rb * wb0.z, b0.w * rb * wb0.w); o[128 + lane] = t;
        t.x = pk2(b1.x * rb * wb1.x, b1.y * rb * wb1.y); t.y = pk2(b1.z * rb * wb1.z, b1.w * rb * wb1.w); o[192 + lane] = t;
        if (lane < 16) ((f32x4*)(kpe + (size_t)m * 64))[lane] = cr[256 + lane];
    }
}
__device__ __forceinline__ void phase_mla_finalize_kv(const bf16* kvraw, const float* kpe, const float* cs, const float* knw, bf16* kf, bf16* vf, int gw, int NGW, int lane) {
    const int g = lane >> 4, i = lane & 15, isv = g & 1;
    float wk[8], wpe[8];
#pragma unroll
    for (int e = 0; e < 8; ++e) { wk[e] = knw[8 * i + e]; wpe[e] = knw[128 + 8 * (i & 7) + e]; }
    for (int m = gw; m < NT; m += NGW) {
        const int b = m / SEQ, s = m % SEQ;
        const float pv = kpe[(size_t)m * 64 + lane]; const float pess = wave_sum(pv * pv, lane);
        float pe[8], cv[8], sv[8];
        { const f32x4 a0 = *(const f32x4*)(kpe + (size_t)m * 64 + 8 * (i & 7)), a1 = *(const f32x4*)(kpe + (size_t)m * 64 + 8 * (i & 7) + 4);
          const f32x4 c0 = *(const f32x4*)(cs + (size_t)m * 64 + 8 * (i & 3)), c1 = *(const f32x4*)(cs + (size_t)m * 64 + 8 * (i & 3) + 4);
          const f32x4 s0 = *(const f32x4*)(cs + (size_t)m * 64 + 32 + 8 * (i & 3)), s1 = *(const f32x4*)(cs + (size_t)m * 64 + 32 + 8 * (i & 3) + 4);
#pragma unroll
          for (int e = 0; e < 4; ++e) { pe[e] = a0[e]; pe[4 + e] = a1[e]; cv[e] = c0[e]; cv[4 + e] = c1[e]; sv[e] = s0[e]; sv[4 + e] = s1[e]; } }
        const bf16* kr = kvraw + (size_t)m * (MLA_H * 256);
#pragma unroll 2
        for (int hp = 0; hp < MLA_H / 2; ++hp) {
            const int h = 2 * hp + (g >> 1); const size_t ob = ((size_t)(b * MLA_H + h) * SEQ + s);
            const v4u raw = *(const v4u*)(kr + h * 256 + isv * 128 + 8 * i);
            float x[8]; x[0] = bflo(raw.x); x[1] = bfhi(raw.x); x[2] = bflo(raw.y); x[3] = bfhi(raw.y); x[4] = bflo(raw.z); x[5] = bfhi(raw.z); x[6] = bflo(raw.w); x[7] = bfhi(raw.w);
            float ss = 0.f;
#pragma unroll
            for (int e = 0; e < 8; ++e) ss += x[e] * x[e];
            ss += shx(ss, 1, lane); ss += shx(ss, 2, lane); ss += shx(ss, 4, lane); ss += shx(ss, 8, lane);
            float rs = rsqrtf((ss + pess) * (1.f / 192.f) + NORM_EPS);
            const float rso = shx(rs, 16, lane); if (isv) rs = rso;
            if (!isv) { v4u o; o.x = pk2(x[0] * rs * wk[0], x[1] * rs * wk[1]); o.y = pk2(x[2] * rs * wk[2], x[3] * rs * wk[3]); o.z = pk2(x[4] * rs * wk[4], x[5] * rs * wk[5]); o.w = pk2(x[6] * rs * wk[6], x[7] * rs * wk[7]);
                *(v4u*)(kf + ob * MLA_QK + 8 * i) = o; }
            else *(v4u*)(vf + ob * MLA_V + 8 * i) = raw;
            float y[8], yp[8];
#pragma unroll
            for (int e = 0; e < 8; ++e) { y[e] = pe[e] * rs * wpe[e]; yp[e] = shx(y[e], 4, lane); }
            if (isv && i < 8) { float r[8];
#pragma unroll
                for (int e = 0; e < 8; ++e) r[e] = (i < 4) ? y[e] * cv[e] - yp[e] * sv[e] : y[e] * cv[e] + yp[e] * sv[e];
                v4u o; o.x = pk2(r[0], r[1]); o.y = pk2(r[2], r[3]); o.z = pk2(r[4], r[5]); o.w = pk2(r[6], r[7]);
                *(v4u*)(kf + ob * MLA_QK + 128 + 8 * i) = o; }
        }
    }
}
__device__ __forceinline__ void phase_cvt_bf16(const float* src, bf16* dst, size_t n, int gtid, int NGT) {
    const size_t n8 = n / 8;
    for (size_t i = gtid; i < n8; i += NGT) { const f32x4 a = ((const f32x4*)src)[2 * i], b = ((const f32x4*)src)[2 * i + 1];
        v4u o; o.x = pk2(a.x, a.y); o.y = pk2(a.z, a.w); o.z = pk2(b.x, b.y); o.w = pk2(b.z, b.w); ((v4u*)dst)[i] = o; }
}
__device__ __forceinline__ void phase_rstd_e(const bf16* e, float* rstd, int gw, int NGW, int lane) {
    for (int m = gw; m < NT; m += NGW) {
        const v4u* er = (const v4u*)(e + (size_t)m * DM) + lane; float s = 0.f;
#pragma unroll
        for (int j = 0; j < 4; ++j) { const v4u w = er[64 * j];
            const float a0 = bflo(w.x), a1 = bfhi(w.x), a2 = bflo(w.y), a3 = bfhi(w.y), a4 = bflo(w.z), a5 = bfhi(w.z), a6 = bflo(w.w), a7 = bfhi(w.w);
            s += (a0 * a0 + a1 * a1) + (a2 * a2 + a3 * a3) + (a4 * a4 + a5 * a5) + (a6 * a6 + a7 * a7); }
        s = wave_sum(s, lane);
        if (lane == 0) rstd[m] = rsqrtf(s * (1.f / 2048.f) + NORM_EPS);
    }
}

namespace attn {
constexpr int DQK = 192, DV = 128, QBLK = 32, KVBLK = 64, QB = 256;
constexpr int SHM_V = KVBLK * DV * 2, SHM_K = KVBLK * DQK * 2;
constexpr int OFF_V = 0, OFF_K = 2 * SHM_V, OFF_WS = OFF_K + 2 * SHM_K;
constexpr int OFF_Q = OFF_WS + NWAVES * 64 * 4;
constexpr int ATTN_LDS = OFF_Q + NWAVES * 4096;
constexpr float SCALE = 0.07216878364870322f;
constexpr float THR = 8.f;
#define SBAR() __builtin_amdgcn_sched_barrier(0)
__device__ __forceinline__ int v_rd_base(int lane) { return ((lane & 3) << 3) | (((lane >> 2) & 3) << 6) | (((lane >> 4) & 1) << 5) | (((lane >> 5) & 1) << 8); }
constexpr int v_rd_off(int d0, int ks, int half) { return d0 * 512 + ks * 4096 + half * 2048; }
__device__ __forceinline__ int crow(int r, int hi) { return (r & 3) + 8 * (r >> 2) + 4 * hi; }
__device__ __forceinline__ unsigned cvtpk(float lo, float hi) { unsigned r; asm volatile("v_cvt_pk_bf16_f32 %0, %1, %2" : "=v"(r) : "v"(lo), "v"(hi)); return r; }
__device__ __forceinline__ void mask_tile(f32x16& p0, f32x16& p1, int dq) {
    const float NEG = -__builtin_inff();
#pragma unroll
    for (int r = 0; r < 16; ++r) { const int c = (r & 3) + 8 * (r >> 2);
        if (dq - c < 0) p0[r] = NEG;
        if (dq - c - 32 < 0) p1[r] = NEG; }
}
__device__ __forceinline__ void partialSM(f32x16& p0, f32x16& p1, float& m_reg, float& mn, float& alpha) {
    float pmax = p0[0];
#pragma unroll
    for (int r = 1; r < 16; ++r) pmax = fmaxf(pmax, p0[r]);
#pragma unroll
    for (int r = 0; r < 16; ++r) pmax = fmaxf(pmax, p1[r]);
    { auto rr = __builtin_amdgcn_permlane32_swap(__float_as_uint(pmax), __float_as_uint(pmax), false, false);
      pmax = fmaxf(__uint_as_float(rr[0]), __uint_as_float(rr[1])); }
    constexpr float C2 = 1.4426950408889634f * SCALE;
    if (__builtin_expect(__all((pmax - m_reg) * SCALE <= THR), 1)) { mn = m_reg; alpha = 1.f; }
    else { mn = fmaxf(m_reg, pmax); alpha = __builtin_amdgcn_exp2f((m_reg - mn) * C2); m_reg = mn; }
    const float mnL = -mn * C2;
#pragma unroll
    for (int r = 0; r < 16; ++r) p0[r] = fmaf(p0[r], C2, mnL);
#pragma unroll
    for (int r = 0; r < 16; ++r) p1[r] = fmaf(p1[r], C2, mnL);
#pragma unroll
    for (int r = 0; r < 16; ++r) p0[r] = __builtin_amdgcn_exp2f(p0[r]);
}
__device__ __forceinline__ void finishSM(f32x16& p0, f32x16& p1, float alpha, float& l_reg, bf16x8& pa0, bf16x8& pa1, bf16x8& pa2, bf16x8& pa3) {
#pragma unroll
    for (int r = 0; r < 16; ++r) p1[r] = __builtin_amdgcn_exp2f(p1[r]);
    float ps = 0;
#pragma unroll
    for (int r = 0; r < 16; ++r) ps += p0[r];
#pragma unroll
    for (int r = 0; r < 16; ++r) ps += p1[r];
    { auto rr = __builtin_amdgcn_permlane32_swap(__float_as_uint(ps), __float_as_uint(ps), false, false);
      ps = __uint_as_float(rr[0]) + __uint_as_float(rr[1]); }
    l_reg = l_reg * alpha + ps;
#define PK4(P, B_, OUT) do { unsigned a0 = cvtpk(P[B_+0], P[B_+1]), a1 = cvtpk(P[B_+2], P[B_+3]);                          \
        unsigned b0 = cvtpk(P[B_+4], P[B_+5]), b1 = cvtpk(P[B_+6], P[B_+7]);                                             \
        auto r0 = __builtin_amdgcn_permlane32_swap(a0, b0, false, false); auto r1 = __builtin_amdgcn_permlane32_swap(a1, b1, false, false); \
        v4u w = {r0[0], r1[0], r0[1], r1[1]}; OUT = *reinterpret_cast<bf16x8*>(&w); } while (0)
    PK4(p0, 0, pa0); PK4(p0, 8, pa1); PK4(p1, 0, pa2); PK4(p1, 8, pa3);
#undef PK4
}
__device__ __forceinline__ int k_off(int row, int ch) { return row * 384 + ((ch ^ ((row >> 1) & 7)) << 4); }
template <int KB>
__device__ __forceinline__ void qkt(f32x16& p0, f32x16& p1, const LAS char* lds, int r32, int hi, const bf16x8* qr, const LAS char* qs) {
    p0 = f32x16{}; p1 = f32x16{};
    const LAS char* kb[4];
#pragma unroll
    for (int dd = 0; dd < 4; ++dd) kb[dd] = lds + OFF_K + KB * SHM_K + k_off(r32, dd * 2 + hi);
#if PROBE_MASK
#pragma unroll
    for (int d0 = 0; d0 < 12; ++d0) { const LAS char* a = kb[d0 & 3] + (d0 >> 2) * 128;
        bf16x8 b0 = *reinterpret_cast<const LAS bf16x8*>(a);
        bf16x8 b1 = *reinterpret_cast<const LAS bf16x8*>(a + 32 * 384);
        const bf16x8 qv = d0 < 8 ? qr[d0 < 8 ? d0 : 0] : *reinterpret_cast<const LAS bf16x8*>(qs + (d0 - 8) * 1024);
        p0 = __builtin_amdgcn_mfma_f32_32x32x16_bf16(b0, qv, p0, 0, 0, 0);
        p1 = __builtin_amdgcn_mfma_f32_32x32x16_bf16(b1, qv, p1, 0, 0, 0); }
#else
    bf16x8 kf[2][4], qx[2][2];
#define QKT_LOAD(i_, buf_) do { _Pragma("unroll") for (int e_ = 0; e_ < 2; ++e_) { const int d0_ = 2 * (i_) + e_; const LAS char* a_ = kb[d0_ & 3] + (d0_ >> 2) * 128; \
        kf[buf_][2 * e_] = *reinterpret_cast<const LAS bf16x8*>(a_); kf[buf_][2 * e_ + 1] = *reinterpret_cast<const LAS bf16x8*>(a_ + 32 * 384); \
        if (d0_ >= 8) qx[buf_][e_] = *reinterpret_cast<const LAS bf16x8*>(qs + (d0_ - 8) * 1024); } } while (0)
    QKT_LOAD(0, 0);
#pragma unroll
    for (int i = 0; i < 6; ++i) {
        if (i < 5) QKT_LOAD(i + 1, (i + 1) & 1);
        __builtin_amdgcn_sched_barrier(0);
#pragma unroll
        for (int e = 0; e < 2; ++e) { const int d0 = 2 * i + e; const bf16x8 qv = d0 < 8 ? qr[d0 < 8 ? d0 : 0] : qx[i & 1][e];
            p0 = __builtin_amdgcn_mfma_f32_32x32x16_bf16(kf[i & 1][2 * e], qv, p0, 0, 0, 0);
            p1 = __builtin_amdgcn_mfma_f32_32x32x16_bf16(kf[i & 1][2 * e + 1], qv, p1, 0, 0, 0); }
        __builtin_amdgcn_sched_barrier(0);
    }
#undef QKT_LOAD
#endif
}
template <int VB>
__device__ __forceinline__ void pv_tile(f32x16* o, int vb0, bf16x8 pa0, bf16x8 pa1, bf16x8 pa2, bf16x8 pa3) {
#define TRRD(dst, off) asm volatile("ds_read_b64_tr_b16 %0, %1 offset:%2" : "=&v"(dst) : "v"(vb0), "i"(off) : "memory")
#define PV_RD(S, d0) do { constexpr int b_ = OFF_V + VB * SHM_V + v_rd_off(d0, 0, 0); \
        TRRD(S[0], b_); TRRD(S[1], b_ + 2048); TRRD(S[2], b_ + 4096); TRRD(S[3], b_ + 6144); TRRD(S[4], b_ + 8192); TRRD(S[5], b_ + 10240); TRRD(S[6], b_ + 12288); TRRD(S[7], b_ + 14336); } while (0)
#define PV_MM(S, d0) do { \
        o[d0] = __builtin_amdgcn_mfma_f32_32x32x16_bf16(pa0, (bf16x8){S[0][0], S[0][1], S[0][2], S[0][3], S[1][0], S[1][1], S[1][2], S[1][3]}, o[d0], 0, 0, 0);   \
        o[d0] = __builtin_amdgcn_mfma_f32_32x32x16_bf16(pa1, (bf16x8){S[2][0], S[2][1], S[2][2], S[2][3], S[3][0], S[3][1], S[3][2], S[3][3]}, o[d0], 0, 0, 0);   \
        o[d0] = __builtin_amdgcn_mfma_f32_32x32x16_bf16(pa2, (bf16x8){S[4][0], S[4][1], S[4][2], S[4][3], S[5][0], S[5][1], S[5][2], S[5][3]}, o[d0], 0, 0, 0);   \
        o[d0] = __builtin_amdgcn_mfma_f32_32x32x16_bf16(pa3, (bf16x8){S[6][0], S[6][1], S[6][2], S[6][3], S[7][0], S[7][1], S[7][2], S[7][3]}, o[d0], 0, 0, 0); } while (0)
#define PV_WAIT8(S) asm volatile("s_waitcnt lgkmcnt(8)" : "+v"(S[0]), "+v"(S[1]), "+v"(S[2]), "+v"(S[3]), "+v"(S[4]), "+v"(S[5]), "+v"(S[6]), "+v"(S[7]) :: "memory")
#define PV_WAIT0(S) asm volatile("s_waitcnt lgkmcnt(0)" : "+v"(S[0]), "+v"(S[1]), "+v"(S[2]), "+v"(S[3]), "+v"(S[4]), "+v"(S[5]), "+v"(S[6]), "+v"(S[7]) :: "memory")
    s16x4 sa[8], sb[8];
    PV_RD(sa, 0);
    PV_RD(sb, 1); PV_WAIT8(sa); SBAR(); PV_MM(sa, 0); SBAR();
    PV_RD(sa, 2); PV_WAIT8(sb); SBAR(); PV_MM(sb, 1); SBAR();
    PV_RD(sb, 3); PV_WAIT8(sa); SBAR(); PV_MM(sa, 2); SBAR();
    PV_WAIT0(sb); SBAR(); PV_MM(sb, 3);
#undef PV_RD
#undef PV_MM
#undef PV_WAIT8
#undef PV_WAIT0
#undef TRRD
}
template <int VB, int KB, bool DO_PV, bool DO_QK>
__device__ __forceinline__ void mseg(f32x16* o, int vb0, bf16x8 pa0, bf16x8 pa1, bf16x8 pa2, bf16x8 pa3, f32x16& p0, f32x16& p1, int ldsa, int r32, int hi, const bf16x8* qr, int qsa) {
#define TRRD(dst, off) asm volatile("ds_read_b64_tr_b16 %0, %1 offset:%2" : "=&v"(dst) : "v"(vb0), "i"(off) : "memory")
#define PV_RD(S, d0) do { constexpr int b_ = OFF_V + VB * SHM_V + v_rd_off(d0, 0, 0); \
        TRRD(S[0], b_); TRRD(S[1], b_ + 2048); TRRD(S[2], b_ + 4096); TRRD(S[3], b_ + 6144); TRRD(S[4], b_ + 8192); TRRD(S[5], b_ + 10240); TRRD(S[6], b_ + 12288); TRRD(S[7], b_ + 14336); } while (0)
#define PV_MM(S, d0) do { \
        o[d0] = __builtin_amdgcn_mfma_f32_32x32x16_bf16(pa0, (bf16x8){S[0][0], S[0][1], S[0][2], S[0][3], S[1][0], S[1][1], S[1][2], S[1][3]}, o[d0], 0, 0, 0);   \
        o[d0] = __builtin_amdgcn_mfma_f32_32x32x16_bf16(pa1, (bf16x8){S[2][0], S[2][1], S[2][2], S[2][3], S[3][0], S[3][1], S[3][2], S[3][3]}, o[d0], 0, 0, 0);   \
        o[d0] = __builtin_amdgcn_mfma_f32_32x32x16_bf16(pa2, (bf16x8){S[4][0], S[4][1], S[4][2], S[4][3], S[5][0], S[5][1], S[5][2], S[5][3]}, o[d0], 0, 0, 0);   \
        o[d0] = __builtin_amdgcn_mfma_f32_32x32x16_bf16(pa3, (bf16x8){S[6][0], S[6][1], S[6][2], S[6][3], S[7][0], S[7][1], S[7][2], S[7][3]}, o[d0], 0, 0, 0); } while (0)
#define PV_WAIT8(S) asm volatile("s_waitcnt lgkmcnt(8)" : "+v"(S[0]), "+v"(S[1]), "+v"(S[2]), "+v"(S[3]), "+v"(S[4]), "+v"(S[5]), "+v"(S[6]), "+v"(S[7]) :: "memory")
#define PV_WAIT0(S) asm volatile("s_waitcnt lgkmcnt(0)" : "+v"(S[0]), "+v"(S[1]), "+v"(S[2]), "+v"(S[3]), "+v"(S[4]), "+v"(S[5]), "+v"(S[6]), "+v"(S[7]) :: "memory")
#define KRD(dst, base, off) asm volatile("ds_read_b128 %0, %1 offset:%2" : "=&v"(dst) : "v"(base), "i"(off) : "memory")
#define QK_LD4(B, da, db) do { KRD(kf[B][0], kb[(da) & 3], ((da) >> 2) * 128); KRD(kf[B][1], kb[(da) & 3], ((da) >> 2) * 128 + 12288); \
                               KRD(kf[B][2], kb[(db) & 3], ((db) >> 2) * 128); KRD(kf[B][3], kb[(db) & 3], ((db) >> 2) * 128 + 12288); } while (0)
#define QK_LD6(B, da, db) do { QK_LD4(B, da, db); KRD(qx[B][0], qsa, ((da) - 8) * 1024); KRD(qx[B][1], qsa, ((db) - 8) * 1024); } while (0)
#define QK_W(N, B)  asm volatile("s_waitcnt lgkmcnt(" #N ")" : "+v"(kf[B][0]), "+v"(kf[B][1]), "+v"(kf[B][2]), "+v"(kf[B][3]) :: "memory")
#define QK_WQ(N, B) asm volatile("s_waitcnt lgkmcnt(" #N ")" : "+v"(kf[B][0]), "+v"(kf[B][1]), "+v"(kf[B][2]), "+v"(kf[B][3]), "+v"(qx[B][0]), "+v"(qx[B][1]) :: "memory")
#define QK_MM(B, qa, qb) do { p0 = __builtin_amdgcn_mfma_f32_32x32x16_bf16(kf[B][0], qa, p0, 0, 0, 0); p1 = __builtin_amdgcn_mfma_f32_32x32x16_bf16(kf[B][1], qa, p1, 0, 0, 0); \
                              p0 = __builtin_amdgcn_mfma_f32_32x32x16_bf16(kf[B][2], qb, p0, 0, 0, 0); p1 = __builtin_amdgcn_mfma_f32_32x32x16_bf16(kf[B][3], qb, p1, 0, 0, 0); } while (0)
    s16x4 sa[8], sb[8]; bf16x8 kf[2][4]; int kb[4];
    if (DO_QK) {
#pragma unroll
        for (int dd = 0; dd < 4; ++dd) kb[dd] = ldsa + OFF_K + KB * SHM_K + k_off(r32, dd * 2 + hi);
    }
    if (DO_PV) {
        PV_RD(sa, 0);
        PV_RD(sb, 1); PV_WAIT8(sa); SBAR(); PV_MM(sa, 0); SBAR();
        PV_RD(sa, 2); PV_WAIT8(sb); SBAR(); PV_MM(sb, 1); SBAR();
        PV_RD(sb, 3); PV_WAIT8(sa); SBAR(); PV_MM(sa, 2); SBAR();
        if (DO_QK) { QK_LD4(0, 0, 1); QK_LD4(1, 2, 3); PV_WAIT8(sb); } else PV_WAIT0(sb);
        SBAR(); PV_MM(sb, 3); SBAR();
    } else if (DO_QK) { QK_LD4(0, 0, 1); QK_LD4(1, 2, 3); }
    if (DO_QK) {
        p0 = f32x16{}; p1 = f32x16{};
        QK_W(4, 0); SBAR(); QK_MM(0, qr[0], qr[1]); SBAR(); QK_LD4(0, 4, 5);
        QK_W(4, 1); SBAR(); QK_MM(1, qr[2], qr[3]); SBAR(); QK_LD4(1, 6, 7);
        QK_W(4, 0); SBAR(); QK_MM(0, qr[4], qr[5]); SBAR(); QK_LD4(0, 8, 9);
        QK_W(4, 1); SBAR(); QK_MM(1, qr[6], qr[7]); SBAR(); QK_LD4(1, 10, 11);
        QK_W(4, 0); SBAR(); QK_MM(0, qr[8], qr[9]); SBAR();
        QK_W(0, 1); SBAR(); QK_MM(1, qr[10], qr[11]); SBAR();
    }
#undef TRRD
#undef PV_RD
#undef PV_MM
#undef PV_WAIT8
#undef PV_WAIT0
#undef KRD
#undef QK_LD4
#undef QK_LD6
#undef QK_W
#undef QK_WQ
#undef QK_MM
}
__device__ __forceinline__ void attn_block(const bf16* Q, int ldq, const float* qnw, const float* cs, int tok0, const bf16* Kh, const bf16* Vh, bf16* O, int ldo, int P0, int rev, LAS char* lds, int tid_, int wid, int lane_) {
    int tid = tid_, lane = lane_;
    asm volatile("" : "+v"(tid), "+v"(lane));
    const int r32 = lane & 31, hi = lane >> 5;
    const int NTL = (P0 + QB) / KVBLK;
    const int qlo = P0 + wid * QBLK, qm = qlo + r32 - 4 * hi;
    LAS float* ws = (LAS float*)(lds + OFF_WS) + wid * 64; LAS float* li_l = ws; LAS float* al_l = ws + 32;
    unsigned ksrc[3], vsrc[2];
#pragma unroll
    for (int i = 0; i < 3; ++i) { const int p = i * 512 + tid, row = p / 24, pc = p % 24, c = pc ^ ((row >> 1) & 7); ksrc[i] = (unsigned)(row * 384 + c * 16); }
#pragma unroll
    for (int i = 0; i < 2; ++i) { const int p = i * 512 + tid; const int kk = ((p >> 7) << 3) | ((p >> 2) & 7), c = (((p >> 5) & 3) << 5) | ((p & 3) << 3);
        const int k = (kk & ~0xC) | ((kk & 4) << 1) | ((kk & 8) >> 1); vsrc[i] = (unsigned)(k * 256 + c * 2); }
#define DMA16(voff_, base_, ldsdst_) asm volatile("s_mov_b32 m0, %2\n\ts_nop 0\n\tglobal_load_lds_dwordx4 %0, %1" :: "v"(voff_), "s"(base_), "s"(ldsdst_) : "memory", "m0")
#define ISSUE_TILE(t, slot) do { const unsigned long long kg_ = (unsigned long long)(uintptr_t)Kh + (unsigned long long)(t) * (KVBLK * 384), vg_ = (unsigned long long)(uintptr_t)Vh + (unsigned long long)(t) * (KVBLK * 256); \
        const int kd_ = __builtin_amdgcn_readfirstlane((int)(uintptr_t)(lds + OFF_K + (slot) * SHM_K + wid * 1024)), vd_ = __builtin_amdgcn_readfirstlane((int)(uintptr_t)(lds + OFF_V + (slot) * SHM_V + wid * 1024)); \
        _Pragma("unroll") for (int i_ = 0; i_ < 3; ++i_) DMA16(ksrc[i_], kg_, kd_ + i_ * 8192); \
        _Pragma("unroll") for (int i_ = 0; i_ < 2; ++i_) DMA16(vsrc[i_], vg_, vd_ + i_ * 8192); } while (0)
#define TIDX(s_) (rev ? NTL - 1 - (s_) : (s_))
    ISSUE_TILE(TIDX(0), 0);
    bf16x8 qr[12];
    LAS char* qs = lds + OFF_Q + wid * 4096 + lane * 16;
    {
        const bf16* qrow = Q + (size_t)(wid * QBLK + r32) * ldq + hi * 8; const float* csr = cs + (size_t)(tok0 + wid * QBLK + r32) * 64 + hi * 8;
        v4u qw[12]; float ss = 0.f;
#pragma unroll
        for (int d0 = 0; d0 < 12; ++d0) qw[d0] = *reinterpret_cast<const v4u*>(qrow + d0 * 16);
#pragma unroll
        for (int d0 = 0; d0 < 12; ++d0) { const v4u w = qw[d0]; const float a0 = bflo(w.x), a1 = bfhi(w.x), a2 = bflo(w.y), a3 = bfhi(w.y), a4 = bflo(w.z), a5 = bfhi(w.z), a6 = bflo(w.w), a7 = bfhi(w.w);
            ss += (a0 * a0 + a1 * a1) + (a2 * a2 + a3 * a3) + (a4 * a4 + a5 * a5) + (a6 * a6 + a7 * a7); }
        ss += shx(ss, 32, lane);
        const float rs = rsqrtf(ss * (1.f / 192.f) + NORM_EPS);
#define QSCALE(X, d0_) do { const v4u w_ = qw[d0_]; const f32x4 g0_ = *(const f32x4*)(qnw + (d0_) * 16 + hi * 8), g1_ = *(const f32x4*)(qnw + (d0_) * 16 + hi * 8 + 4); \
            X[0] = bflo(w_.x) * rs * g0_.x; X[1] = bfhi(w_.x) * rs * g0_.y; X[2] = bflo(w_.y) * rs * g0_.z; X[3] = bfhi(w_.y) * rs * g0_.w; \
            X[4] = bflo(w_.z) * rs * g1_.x; X[5] = bfhi(w_.z) * rs * g1_.y; X[6] = bflo(w_.w) * rs * g1_.z; X[7] = bfhi(w_.w) * rs * g1_.w; } while (0)
#define QPACK(X) ((v4u){cvtpk(X[0], X[1]), cvtpk(X[2], X[3]), cvtpk(X[4], X[5]), cvtpk(X[6], X[7])})
#pragma unroll
        for (int d0 = 0; d0 < 8; ++d0) { float xv[8]; QSCALE(xv, d0); const v4u pk = QPACK(xv); qr[d0] = *reinterpret_cast<const bf16x8*>(&pk); }
#pragma unroll
        for (int d0 = 8; d0 < 10; ++d0) { float x1[8], x2[8], o1[8], o2[8]; QSCALE(x1, d0); QSCALE(x2, d0 + 2);
            const f32x4 c0 = *(const f32x4*)(csr + (d0 - 8) * 16), c1 = *(const f32x4*)(csr + (d0 - 8) * 16 + 4), s0 = *(const f32x4*)(csr + 32 + (d0 - 8) * 16), s1 = *(const f32x4*)(csr + 32 + (d0 - 8) * 16 + 4);
#pragma unroll
            for (int e = 0; e < 8; ++e) { const float c = e < 4 ? c0[e & 3] : c1[e & 3], s = e < 4 ? s0[e & 3] : s1[e & 3]; o1[e] = x1[e] * c - x2[e] * s; o2[e] = x2[e] * c + x1[e] * s; }
            const v4u p1 = QPACK(o1), p2 = QPACK(o2);
            qr[d0] = *reinterpret_cast<const bf16x8*>(&p1); qr[d0 + 2] = *reinterpret_cast<const bf16x8*>(&p2); }
#undef QSCALE
#undef QPACK
    }
    float m_reg = -1e30f, l_reg = 0; f32x16 o[4] = {};
    const int vb0 = (int)(uintptr_t)(lds) + v_rd_base(lane);
    VM_WAIT(); __syncthreads();
#define RESC(a) do { if (__any((a) < 1.f)) { if (hi == 0) al_l[r32] = (a); asm volatile("s_waitcnt lgkmcnt(0)" ::: "memory");              \
                     _Pragma("unroll") for (int d_ = 0; d_ < 4; ++d_) _Pragma("unroll") for (int r = 0; r < 16; ++r) o[d_][r] *= al_l[crow(r, hi)]; } } while (0)
#define STEP(t, SLOT) do { \
        if ((t) + 1 < NTL) ISSUE_TILE(TIDX((t) + 1), (SLOT) ^ 1); \
        const int kb_ = TIDX(t) * KVBLK; \
        if (kb_ <= qlo + QBLK - 1) {                                          \
            f32x16 p0, p1; float mn, al; bf16x8 pa0, pa1, pa2, pa3; \
            mseg<SLOT, SLOT, false, true>(o, vb0, pa0, pa1, pa2, pa3, p0, p1, (int)(uintptr_t)lds, r32, hi, qr, (int)(uintptr_t)qs); \
            if (kb_ + KVBLK - 1 > qlo) mask_tile(p0, p1, qm - kb_); \
            partialSM(p0, p1, m_reg, mn, al); RESC(al); \
            finishSM(p0, p1, al, l_reg, pa0, pa1, pa2, pa3); SBAR(); \
            pv_tile<SLOT>(o, vb0, pa0, pa1, pa2, pa3); } \
        VM_WAIT(); __syncthreads(); } while (0)
    for (int t = 0; t < NTL; t += 2) { STEP(t, 0); STEP(t + 1, 1); }
#undef STEP
#undef RESC
#undef ISSUE_TILE
#undef DMA16
#undef TIDX
    if (hi == 0) li_l[r32] = l_reg; asm volatile("s_waitcnt lgkmcnt(0)" ::: "memory");
    float rli[16];
#pragma unroll
    for (int r = 0; r < 16; ++r) rli[r] = __builtin_amdgcn_rcpf(li_l[crow(r, hi)]);
    int lane2 = lane; asm volatile("" : "+v"(lane2));
    const int r32e = lane2 & 31, hie = lane2 >> 5;
    bf16* Ow = O + (size_t)(wid * QBLK) * ldo;
#pragma unroll
    for (int r = 0; r < 16; ++r) { const int orow = crow(r, hie);
#pragma unroll
        for (int d0 = 0; d0 < 4; ++d0) { const float v = o[d0][r] * rli[r]; const float vn = shx(v, 1, lane);
            if ((r32e & 1) == 0) *(unsigned*)(Ow + (size_t)orow * ldo + d0 * 32 + r32e) = cvtpk(v, vn); } }
    __syncthreads();
}
__device__ __forceinline__ void attn_phase(const bf16* qraw, const float* qnw, const float* cs, const bf16* kf, const bf16* vf, bf16* o, LAS char* lds, int vcu, int G, int tid, int wid, int lane) {
    constexpr int NQB = SEQ / QB, NPAIR = NQB / 2, TOTAL = NB * MLA_H * NPAIR;
    for (int L = vcu; L < TOTAL; L += G) {
        const int bh = L / NPAIR, x = L % NPAIR, b = bh / MLA_H, h = bh % MLA_H;
        const bf16* Kh = kf + (size_t)bh * SEQ * DQK; const bf16* Vh = vf + (size_t)bh * SEQ * DV;
#pragma unroll 1
        for (int pass = 0; pass < 2; ++pass) {
            const int qb = pass ? x : (NQB - 1 - x), P0 = qb * QB, tok0 = b * SEQ + P0;
            attn_block(qraw + (size_t)tok0 * (MLA_H * MLA_QK) + h * MLA_QK, MLA_H * MLA_QK, qnw, cs, tok0, Kh, Vh, o + (size_t)tok0 * (MLA_H * MLA_V) + h * MLA_V, MLA_H * MLA_V, P0, pass, lds, tid, wid, lane);
        }
    }
}
#undef SBAR
}

namespace gdn {
__device__ __forceinline__ int crow(int r, int hi) { return (r & 3) + 8 * (r >> 2) + 4 * hi; }
__device__ __forceinline__ unsigned off_b(unsigned row, unsigned ch) { return 256u * row + 16u * (ch ^ (((row & 3) << 2) | ((row >> 2) & 3))); }
#define MFMA32(a, b, c) __builtin_amdgcn_mfma_f32_32x32x16_bf16((a), (b), (c), 0, 0, 0)
#define MFMA_SETTLE(x) asm volatile("s_nop 7\n\ts_nop 7\n\ts_nop 3" : "+v"(x))
#define BAR_LDS() do { asm volatile("s_waitcnt lgkmcnt(0)" ::: "memory"); __builtin_amdgcn_s_barrier(); asm volatile("" ::: "memory"); } while (0)
#define TR_ISSUE(lo, hi_, a0, a1) asm volatile("ds_read_b64_tr_b16 %0, %2\n\tds_read_b64_tr_b16 %1, %3" : "=&v"(lo), "=&v"(hi_) : "v"(a0), "v"(a1) : "memory")
#define TR_CAT(lo, hi_) ((bf16x8){lo[0], lo[1], lo[2], lo[3], hi_[0], hi_[1], hi_[2], hi_[3]})
__device__ __forceinline__ float softplus_f(float x) { return fmaxf(x, 0.f) + log1pf(__expf(-fabsf(x))); }

__device__ __forceinline__ void phase_halo(const bf16* proj, bf16* halo, int vcu, int G, int tid) {
    for (int u = vcu; u < NB * NCHUNK * 3; u += G) {
        const int j = u % 3, cn = u / 3, n = cn % NCHUNK, b = cn / NCHUNK;
        if (n == 0) continue;
        const v4u* src = (const v4u*)(proj + (size_t)(b * SEQ + 64 * n - 3 + j) * GDN_MAIN); v4u* dst = (v4u*)(halo + (size_t)u * GDN_CONV);
        dst[tid] = src[tid]; dst[512 + tid] = src[512 + tid];
    }
}
constexpr int CV_SLOT = 67 * 256, CONV_LDS = 4 * CV_SLOT;
__device__ __forceinline__ void phase_conv(bf16* proj_, const bf16* halo_, const float* convw, LAS unsigned char* lds, int vcu, int G, int tid, int wid) {
    GAS bf16* proj = (GAS bf16*)proj_; const GAS bf16* halo = (const GAS bf16*)halo_;
    int hg_ = vcu & 63; asm volatile("" : "+s"(hg_));
    const int rg = tid >> 4, cg = tid & 15, hg = hg_, ch0 = hg * 128 + cg * 8, lane = tid & 63;
    constexpr int NU = NB * NCHUNK * 64;
    f32x4 w[4][2];
#pragma unroll
    for (int j = 0; j < 4; ++j) { w[j][0] = *(const f32x4*)(convw + j * GDN_CONV + ch0); w[j][1] = *(const f32x4*)(convw + j * GDN_CONV + ch0 + 4); }
#define CONV_DMA(u_, slot_) do { const int cn_ = (u_) >> 6, n_ = cn_ % NCHUNK, b_ = cn_ / NCHUNK; \
        _Pragma("unroll") for (int i_ = 0; i_ < 3; ++i_) if (i_ < 2 || (wid == 0)) { const int c_ = 512 * i_ + tid; const int ir_ = (c_ < 1072 ? c_ : 1071) >> 4, rr_ = ir_ - 3, cc_ = c_ & 15; \
            const GAS bf16* p_ = (rr_ >= 0 || n_ == 0) ? proj + (size_t)(b_ * SEQ + 64 * n_ + (rr_ >= 0 ? rr_ : 0)) * GDN_MAIN + hg * 128 + cc_ * 8 : halo + (size_t)(cn_ * 3 + ir_) * GDN_CONV + hg * 128 + cc_ * 8; \
            if (i_ < 2 || lane < 48) __builtin_amdgcn_global_load_lds((const GAS unsigned*)p_, (LAS unsigned*)(lds + (slot_) * CV_SLOT + (512 * i_ + wid * 64) * 16), 16, 0, 0); } } while (0)
#define CONV_BODY(u_, slot_) do { const int n_ = ((u_) >> 6) % NCHUNK; \
        v4u X[5]; _Pragma("unroll") for (int j_ = 0; j_ < 5; ++j_) X[j_] = *(const LAS v4u*)(lds + (slot_) * CV_SLOT + (2 * rg + j_) * 256 + cg * 16); \
        if (n_ == 0) { unsigned z_ = 0u; asm volatile("" : "+v"(z_)); _Pragma("unroll") for (int j_ = 0; j_ < 3; ++j_) if (2 * rg + j_ < 3) X[j_] = (v4u){z_, z_, z_, z_}; } \
        float y_[2][8]; float ss_[2]; \
        _Pragma("unroll") for (int o_ = 0; o_ < 2; ++o_) { float a_[8]; _Pragma("unroll") for (int e_ = 0; e_ < 8; ++e_) a_[e_] = 0.f; \
            _Pragma("unroll") for (int j_ = 0; j_ < 4; ++j_) { const v4u xv = X[o_ + j_]; const f32x4 w0 = w[j_][0], w1 = w[j_][1]; \
                a_[0] += w0.x * bflo(xv.x); a_[1] += w0.y * bfhi(xv.x); a_[2] += w0.z * bflo(xv.y); a_[3] += w0.w * bfhi(xv.y); \
                a_[4] += w1.x * bflo(xv.z); a_[5] += w1.y * bfhi(xv.z); a_[6] += w1.z * bflo(xv.w); a_[7] += w1.w * bfhi(xv.w); } \
            float s2_ = 0.f; _Pragma("unroll") for (int e_ = 0; e_ < 8; ++e_) { const float s_ = fsilu(a_[e_]); y_[o_][e_] = s_; s2_ += s_ * s_; } ss_[o_] = s2_; } \
        float sc_[2] = {1.f, 1.f}; \
        if (hg < 32) { _Pragma("unroll") for (int o_ = 0; o_ < 2; ++o_) { float s_ = ss_[o_]; s_ += shx(s_, 1, lane); s_ += shx(s_, 2, lane); s_ += shx(s_, 4, lane); s_ += shx(s_, 8, lane); \
                sc_[o_] = rsqrtf(s_ + NORM_EPS) * (hg < 16 ? 0.08838834764831845f : 1.f); } } \
        const int cn_ = (u_) >> 6, b_ = cn_ / NCHUNK; \
        _Pragma("unroll") for (int o_ = 0; o_ < 2; ++o_) { v4u ov; const float c_ = sc_[o_]; \
            ov.x = pk2(y_[o_][0] * c_, y_[o_][1] * c_); ov.y = pk2(y_[o_][2] * c_, y_[o_][3] * c_); ov.z = pk2(y_[o_][4] * c_, y_[o_][5] * c_); ov.w = pk2(y_[o_][6] * c_, y_[o_][7] * c_); \
            *(GAS v4u*)(proj + (size_t)(b_ * SEQ + 64 * n_ + 2 * rg + o_) * GDN_MAIN + ch0) = ov; } } while (0)
    const int u0 = vcu;
    for (int k = 0; k < 3; ++k) if (u0 + k * G < NU) CONV_DMA(u0 + k * G, k);
    for (int k = 0, u = u0; u < NU; ++k, u += G) {
        const int rem = (NU - 1 - u) / G;
        if (rem >= 2) { if (wid == 0) asm volatile("s_waitcnt vmcnt(6)" ::: "memory"); else asm volatile("s_waitcnt vmcnt(4)" ::: "memory"); }
        else if (rem == 1) { if (wid == 0) asm volatile("s_waitcnt vmcnt(3)" ::: "memory"); else asm volatile("s_waitcnt vmcnt(2)" ::: "memory"); }
        else VM_WAIT();
        BAR_LDS();
        if (rem >= 3) CONV_DMA(u + 3 * G, (k + 3) & 3);
        CONV_BODY(u, k & 3);
    }
#undef CONV_DMA
#undef CONV_BODY
}
constexpr int P_KT = 0, P_QT = 16384, P_L = 32768, P_LSZ = 12288, P_G = P_L + 8 * P_LSZ, P_B = P_G + 2048, PREP_LDS = P_B + 2048;
__device__ __forceinline__ void phase_prep(const bf16* proj_, const float* ba_, const float* a_log, const float* dt_bias, bf16* TB_, bf16* INTRA_, float* gc_,
                                           LAS unsigned char* lds, int vcu, int G, int tid, int wid, int lane) {
    const GAS bf16* proj = (const GAS bf16*)proj_; const GAS float* ba = (const GAS float*)ba_; GAS bf16* TB = (GAS bf16*)TB_; GAS bf16* INTRA = (GAS bf16*)INTRA_; GAS float* gc = (GAS float*)gc_;
    const int r32 = lane & 31, hi = lane >> 5;
    constexpr int NGRP = NB * NCHUNK * GDN_HQK / 4;
    v4u pk[2], pq[2]; float pa = 0.f, pb = 0.f;
#define PREP_LOAD(grp_, s_) do { const int hq_ = ((grp_) & 3) * 4 + (s_), cn_ = (grp_) >> 2; const size_t tk_ = (size_t)(cn_ / NCHUNK) * SEQ + 64 * (cn_ % NCHUNK); \
        _Pragma("unroll") for (int i_ = 0; i_ < 2; ++i_) { const int idx_ = tid + 512 * i_, row_ = idx_ >> 4, ch_ = idx_ & 15; \
            pk[i_] = *(const GAS v4u*)(proj + (tk_ + row_) * GDN_MAIN + GDN_KEY + hq_ * 128 + ch_ * 8); pq[i_] = *(const GAS v4u*)(proj + (tk_ + row_) * GDN_MAIN + hq_ * 128 + ch_ * 8); } \
        if (wid >= 6) { const int h_ = 2 * hq_ + wid - 6; pa = ba[(tk_ + lane) * 64 + 32 + h_]; pb = ba[(tk_ + lane) * 64 + h_]; } } while (0)
    if (vcu < NGRP) PREP_LOAD(vcu, 0);
    for (int grp = vcu; grp < NGRP; grp += G) {
        const int hq0 = (grp & 3) * 4, cn = grp >> 2, n = cn % NCHUNK, b = cn / NCHUNK;
#pragma unroll 1
        for (int s = 0; s < 4; ++s) {
            const int hq = hq0 + s;
#pragma unroll
            for (int i = 0; i < 2; ++i) { const int idx = tid + 512 * i, row = idx >> 4, ch = idx & 15;
                *(LAS v4u*)(lds + P_KT + off_b(row, ch)) = pk[i]; *(LAS v4u*)(lds + P_QT + off_b(row, ch)) = pq[i]; }
            if (wid >= 6) {
                const int vh = wid - 6, h = 2 * hq + vh;
                float gg = -__expf(a_log[h]) * softplus_f(pa + dt_bias[h]);
                int ln = lane; asm volatile("" : "+v"(ln));
#pragma unroll
                for (int o = 1; o < 64; o <<= 1) { const float t = __builtin_bit_cast(float, __builtin_amdgcn_ds_bpermute((ln >= o ? ln - o : ln) << 2, __builtin_bit_cast(int, gg))); if (ln >= o) gg += t; }
                ((LAS float*)(lds + P_G))[(2 * s + vh) * 64 + lane] = gg; ((LAS float*)(lds + P_B))[(2 * s + vh) * 64 + lane] = fsigmoid(pb);
                gc[((size_t)(b * GDN_HV + h)) * SEQ + 64 * n + lane] = gg;
            }
            if (s < 3) PREP_LOAD(grp, s + 1); else if (grp + G < NGRP) PREP_LOAD(grp + G, 0);
            __syncthreads();
            if (wid < 6) {
                const int tw = wid % 3, it = tw > 0 ? 1 : 0, jt = tw > 1 ? 1 : 0; const bool isk = wid < 3;
                const LAS unsigned char* As = lds + (isk ? P_KT : P_QT); const LAS unsigned char* Bs = lds + P_KT;
                f32x16 acc = {};
#pragma unroll
                for (int ks = 0; ks < 8; ++ks) { const bf16x8 a = *(const LAS bf16x8*)(As + off_b(32 * it + r32, 2 * ks + hi)), bb = *(const LAS bf16x8*)(Bs + off_b(32 * jt + r32, 2 * ks + hi));
                    acc = MFMA32(a, bb, acc); }
                const int j = 32 * jt + r32;
#pragma unroll
                for (int vh = 0; vh < 2; ++vh) {
                    const LAS float* Gv = (const LAS float*)(lds + P_G) + (2 * s + vh) * 64; const LAS float* Bv = (const LAS float*)(lds + P_B) + (2 * s + vh) * 64;
                    const float gj = Gv[j];
                    f32x4 gi[4], bi[4];
#pragma unroll
                    for (int g_ = 0; g_ < 4; ++g_) { gi[g_] = *(const LAS f32x4*)(Gv + 32 * it + 8 * g_ + 4 * hi); bi[g_] = *(const LAS f32x4*)(Bv + 32 * it + 8 * g_ + 4 * hi); }
                    __builtin_amdgcn_sched_barrier(0);
                    if (isk) { LAS float* L = (LAS float*)(lds + P_L + (2 * s + vh) * P_LSZ) + (it ? 1024 : 0);
#pragma unroll
                        for (int r = 0; r < 16; ++r) { const int il = crow(r, hi), i = 32 * it + il; const float v = bi[r >> 2][r & 3] * acc[r] * __expf(gi[r >> 2][r & 3] - gj); L[il * (it ? 64 : 32) + j] = (j < i) ? v : 0.f; }
                    } else { GAS bf16* dst = INTRA + ((size_t)(b * GDN_HV + 2 * hq + vh) * NCHUNK + n) * 4096;
#pragma unroll
                        for (int r = 0; r < 16; ++r) { const int i = 32 * it + crow(r, hi); const float v = acc[r] * __expf(gi[r >> 2][r & 3] - gj); dst[i * 64 + j] = (bf16)f2bf((j <= i) ? v : 0.f); }
                    }
                }
            }
            __syncthreads();
        }
        {
            const int hq = hq0 + (wid >> 1), h = 2 * hq + (wid & 1);
            const LAS float* L = (const LAS float*)(lds + P_L + wid * P_LSZ); const float bj = ((const LAS float*)(lds + P_B))[wid * 64 + lane];
            float Tc[64];
            int ln = lane; asm volatile("" : "+v"(ln));
#pragma unroll
            for (int i = 0; i < 64; ++i) Tc[i] = 0.f;
            f32x4 rb[16];
#define INV_LROW(i_) (L + ((i_) < 32 ? (i_) * 32 : 1024 + ((i_) - 32) * 64))
            Tc[0] = (ln == 0) ? 1.f : 0.f;
            rb[0] = *(const LAS f32x4*)(INV_LROW(1));
#pragma unroll
            for (int i = 1; i < 64; ++i) {
                float acc = (ln == i) ? 1.f : 0.f;
#pragma unroll
                for (int c = 0; c < (i + 3) / 4; ++c) { const f32x4 l4 = rb[c];
                    acc -= l4.x * Tc[4 * c]; acc -= l4.y * Tc[4 * c + 1]; acc -= l4.z * Tc[4 * c + 2]; acc -= l4.w * Tc[4 * c + 3];
                    __builtin_amdgcn_sched_barrier(0);
                    if (i + 1 < 64) rb[c] = *(const LAS f32x4*)(INV_LROW(i + 1) + 4 * c);
                    __builtin_amdgcn_sched_barrier(0); }
                if (i + 1 < 64 && (i + 4) / 4 > (i + 3) / 4) rb[(i + 3) / 4] = *(const LAS f32x4*)(INV_LROW(i + 1) + 4 * ((i + 3) / 4));
                Tc[i] = acc;
            }
#undef INV_LROW
            GAS bf16* dst = TB + ((size_t)(b * GDN_HV + h) * NCHUNK + n) * 4096;
#pragma unroll
            for (int i = 0; i < 64; ++i) dst[i * 64 + lane] = (bf16)f2bf(Tc[i] * bj);
        }
        __syncthreads();
    }
#undef PREP_LOAD
}
constexpr int SB_SZ = 55552, S_KT = 0, S_QT = 16384, S_TT = 32768, S_IT = 41984, S_VT = 51200, S_GG = 55296;
constexpr int S_ST = 2 * SB_SZ, ST_P = 272, S_XT = S_ST + 32 * ST_P, XT_P = 144, S_VNT = S_XT + 32 * XT_P, S_VST = S_VNT + 32 * XT_P, S_OT = S_VST + 32 * XT_P, SCAN_LDS = S_OT + 4096;
#define TRW4(a, b, c, d, e, f, g_, h_) asm volatile("s_waitcnt lgkmcnt(0)" : "+v"(a), "+v"(b), "+v"(c), "+v"(d), "+v"(e), "+v"(f), "+v"(g_), "+v"(h_) :: "memory")
struct ScanRegs { v4u k[2], q[2], t, i, v; float g; };
__device__ __forceinline__ void phase_scan(bf16* proj_, const bf16* TB_, const bf16* INTRA_, const float* gc_, LAS unsigned char* lds, int vcu, int G, int tid, int wid, int lane) {
    GAS bf16* proj = (GAS bf16*)proj_; const GAS bf16* TB = (const GAS bf16*)TB_; const GAS bf16* INTRA = (const GAS bf16*)INTRA_; const GAS float* gc = (const GAS float*)gc_;
    const int r32 = lane & 31, hi = lane >> 5, blk = (lane >> 4) & 1, q4 = (lane & 15) >> 2, p4 = lane & 3;
    const unsigned ldsb = (unsigned)(uintptr_t)lds;
    for (int u = vcu; u < NB * GDN_HV * 4; u += G) {
        const int sl = u & 3, bh = u >> 2, h = bh % GDN_HV, b = bh / GDN_HV, hq = h >> 1, e0 = sl * 32;
        ScanRegs RA, RB;
#define SCAN_LOAD(R, n_) do { const int nn_ = (n_) < NCHUNK ? (n_) : NCHUNK - 1; const size_t tok0_ = (size_t)b * SEQ + 64 * nn_; \
            _Pragma("unroll") for (int i_ = 0; i_ < 2; ++i_) { const int idx_ = tid + 512 * i_, row_ = idx_ >> 4, ch_ = idx_ & 15; \
                R.k[i_] = *(const GAS v4u*)(proj + (tok0_ + row_) * GDN_MAIN + GDN_KEY + hq * 128 + ch_ * 8); R.q[i_] = *(const GAS v4u*)(proj + (tok0_ + row_) * GDN_MAIN + hq * 128 + ch_ * 8); } \
            { const size_t mb_ = ((size_t)bh * NCHUNK + nn_) * 4096 + (tid >> 3) * 64 + (tid & 7) * 8; R.t = *(const GAS v4u*)(TB + mb_); R.i = *(const GAS v4u*)(INTRA + mb_); } \
            R.v = *(const GAS v4u*)(proj + (tok0_ + ((tid & 255) >> 2)) * GDN_MAIN + GDN_CONV / 2 + h * 128 + e0 + (tid & 3) * 8); \
            R.g = gc[(size_t)bh * SEQ + 64 * nn_ + (tid & 63)]; } while (0)
#define SCAN_WRITE(R, buf_) do { LAS unsigned char* B_ = lds + (buf_) * SB_SZ; \
            _Pragma("unroll") for (int i_ = 0; i_ < 2; ++i_) { const int idx_ = tid + 512 * i_, row_ = idx_ >> 4, ch_ = idx_ & 15; \
                *(LAS v4u*)(B_ + S_KT + off_b(row_, ch_)) = R.k[i_]; *(LAS v4u*)(B_ + S_QT + off_b(row_, ch_)) = R.q[i_]; } \
            *(LAS v4u*)(B_ + S_TT + (tid >> 3) * 144 + (tid & 7) * 16) = R.t; *(LAS v4u*)(B_ + S_IT + (tid >> 3) * 144 + (tid & 7) * 16) = R.i; \
            if (tid < 256) *(LAS v4u*)(B_ + S_VT + (tid >> 2) * 64 + (tid & 3) * 16) = R.v; \
            if (tid < 64) ((LAS float*)(B_ + S_GG))[tid] = R.g; } while (0)
        SCAN_LOAD(RA, 0);
        { unsigned z = 0u; asm volatile("" : "+v"(z)); for (int i = tid; i < (32 * ST_P) / 16; i += 512) *(LAS v4u*)(lds + S_ST + i * 16) = (v4u){z, z, z, z}; }
        VM_WAIT(); SCAN_WRITE(RA, 0);
        SCAN_LOAD(RB, 1);
        f32x16 Sacc = {};
        __syncthreads();
        const unsigned fx16 = (unsigned)(((((r32 & 3) << 2) | ((r32 >> 2) & 3)) ^ hi) << 4);
        LAS unsigned char* stR = lds + S_ST + r32 * ST_P + 16 * hi;  LAS unsigned char* stW = lds + S_ST + r32 * ST_P + 8 * hi;
        LAS unsigned char* xR = lds + S_XT + r32 * XT_P + 16 * hi;   LAS unsigned char* xW = lds + S_XT + r32 * XT_P + 8 * hi;
#define PK4W(dst, a0_, a1_, a2_, a3_) do { v2u w_; w_.x = pk2(a0_, a1_); w_.y = pk2(a2_, a3_); *(LAS v2u*)(dst) = w_; } while (0)
#define SCAN_STEP(n, RI, RO) do { \
            const int buf = (n) & 1; LAS unsigned char* B = lds + buf * SB_SZ; const LAS float* GG = (const LAS float*)(B + S_GG); \
            if (wid >= 4 && (n) > 0) {                                    \
                const int t_ = tid - 256; const v4u ov = *(const LAS v4u*)(lds + S_OT + t_ * 16); \
                *(GAS v4u*)(proj + ((size_t)b * SEQ + 64 * ((n) - 1) + (t_ >> 2)) * GDN_MAIN + GDN_CONV / 2 + h * 128 + e0 + (t_ & 3) * 8) = ov; } \
            SCAN_LOAD(RI, (n) + 2); \
            f32x16 acc = {}; \
            if (wid < 4) {                                               \
                const LAS unsigned char* Ar = B + (wid < 2 ? S_KT : S_QT) + 256 * (32 * (wid & 1) + r32); \
                bf16x8 af_[8], bf_[8]; \
                _Pragma("unroll") for (int ks = 0; ks < 8; ++ks) { af_[ks] = *(const LAS bf16x8*)(Ar + ((32u * ks) ^ fx16)); bf_[ks] = *(const LAS bf16x8*)(stR + 32 * ks); } \
                __builtin_amdgcn_sched_barrier(0);                       \
                _Pragma("unroll") for (int ks = 0; ks < 8; ++ks) acc = MFMA32(af_[ks], bf_[ks], acc); \
                if (wid < 2) {                                           \
                    f32x4 gg_[4]; unsigned short vv_[16]; \
                    _Pragma("unroll") for (int g_ = 0; g_ < 4; ++g_) { const int c0 = 32 * wid + 8 * g_ + 4 * hi; gg_[g_] = *(const LAS f32x4*)(GG + c0); \
                        _Pragma("unroll") for (int j_ = 0; j_ < 4; ++j_) vv_[4 * g_ + j_] = *(const LAS unsigned short*)(B + S_VT + (c0 + j_) * 64 + r32 * 2); } \
                    __builtin_amdgcn_sched_barrier(0); \
                    _Pragma("unroll") for (int g_ = 0; g_ < 4; ++g_) { float xv[4]; \
                        _Pragma("unroll") for (int j_ = 0; j_ < 4; ++j_) xv[j_] = bf2f(vv_[4 * g_ + j_]) - __expf(gg_[g_][j_]) * acc[4 * g_ + j_]; \
                        PK4W(xW + 64 * wid + 16 * g_, xv[0], xv[1], xv[2], xv[3]); } \
                } \
            } \
            BAR_LDS();                                                      \
            const float gl = GG[63]; \
            if (wid < 2) {                                               \
                f32x16 a3_ = {}; const LAS unsigned char* Ar_ = B + S_TT + (32 * wid + r32) * 144 + 16 * hi; \
                bf16x8 af_[4], bf_[4]; f32x4 gg_[4]; \
                _Pragma("unroll") for (int ks = 0; ks < 4; ++ks) { af_[ks] = *(const LAS bf16x8*)(Ar_ + 32 * ks); bf_[ks] = *(const LAS bf16x8*)(xR + 32 * ks); } \
                _Pragma("unroll") for (int g_ = 0; g_ < 4; ++g_) gg_[g_] = *(const LAS f32x4*)(GG + 32 * wid + 8 * g_ + 4 * hi); \
                __builtin_amdgcn_sched_barrier(0); \
                _Pragma("unroll") for (int ks = 0; ks < 4; ++ks) if (ks < 2 || wid > 0) a3_ = MFMA32(af_[ks], bf_[ks], a3_); \
                MFMA_SETTLE(a3_); \
                _Pragma("unroll") for (int g_ = 0; g_ < 4; ++g_) { const f32x4 gg = gg_[g_]; \
                    PK4W(xW + (S_VNT - S_XT) + 64 * wid + 16 * g_, a3_[4 * g_], a3_[4 * g_ + 1], a3_[4 * g_ + 2], a3_[4 * g_ + 3]); \
                    PK4W(xW + (S_VST - S_XT) + 64 * wid + 16 * g_, a3_[4 * g_] * __expf(gl - gg[0]), a3_[4 * g_ + 1] * __expf(gl - gg[1]), a3_[4 * g_ + 2] * __expf(gl - gg[2]), a3_[4 * g_ + 3] * __expf(gl - gg[3])); } \
            } \
            BAR_LDS();                                                      \
            if (wid == 2 || wid == 3) {                                  \
                const int ct = wid - 2; \
                const LAS unsigned char* Ar_ = B + S_IT + (32 * ct + r32) * 144 + 16 * hi; \
                bf16x8 af_[4], bf_[4]; f32x4 gg_[4]; \
                _Pragma("unroll") for (int g_ = 0; g_ < 4; ++g_) gg_[g_] = *(const LAS f32x4*)(GG + 32 * ct + 8 * g_ + 4 * hi); \
                _Pragma("unroll") for (int ks = 0; ks < 4; ++ks) { af_[ks] = *(const LAS bf16x8*)(Ar_ + 32 * ks); bf_[ks] = *(const LAS bf16x8*)(xR + (S_VNT - S_XT) + 32 * ks); } \
                __builtin_amdgcn_sched_barrier(0); \
                _Pragma("unroll") for (int g_ = 0; g_ < 4; ++g_) _Pragma("unroll") for (int j_ = 0; j_ < 4; ++j_) acc[4 * g_ + j_] *= __expf(gg_[g_][j_]); \
                _Pragma("unroll") for (int ks = 0; ks < 4; ++ks) if (ks < 2 || ct > 0) acc = MFMA32(af_[ks], bf_[ks], acc); \
                MFMA_SETTLE(acc); \
                _Pragma("unroll") for (int r = 0; r < 16; ++r) *(LAS unsigned short*)(lds + S_OT + (32 * ct + crow(r, hi)) * 64 + r32 * 2) = (unsigned short)f2bf(acc[r]); \
            } else if (wid >= 4) {                                       \
                const int dt = wid - 4; const float egl = __expf(gl); \
                _Pragma("unroll") for (int r = 0; r < 16; ++r) Sacc[r] *= egl; \
                  \
                const unsigned chk = (unsigned)(4 * dt + 2 * blk + (p4 >> 1)); \
                const unsigned kb0 = ldsb + buf * SB_SZ + S_KT + 256u * (8 * hi + q4) + 16u * (chk ^ (unsigned)((q4 << 2) | ((2 * hi) & 3))) + 8u * (p4 & 1); \
                const unsigned kb1 = ldsb + buf * SB_SZ + S_KT + 256u * (8 * hi + 4 + q4) + 16u * (chk ^ (unsigned)((q4 << 2) | ((2 * hi + 1) & 3))) + 8u * (p4 & 1); \
                s16x4 al0, ah0, al1, ah1, al2, ah2, al3, ah3; \
                asm volatile("ds_read_b64_tr_b16 %0, %2\n\tds_read_b64_tr_b16 %1, %3" : "=&v"(al0), "=&v"(ah0) : "v"(kb0), "v"(kb1) : "memory"); \
                asm volatile("ds_read_b64_tr_b16 %0, %2 offset:4096\n\tds_read_b64_tr_b16 %1, %3 offset:4096" : "=&v"(al1), "=&v"(ah1) : "v"(kb0), "v"(kb1) : "memory"); \
                asm volatile("ds_read_b64_tr_b16 %0, %2 offset:8192\n\tds_read_b64_tr_b16 %1, %3 offset:8192" : "=&v"(al2), "=&v"(ah2) : "v"(kb0), "v"(kb1) : "memory"); \
                asm volatile("ds_read_b64_tr_b16 %0, %2 offset:12288\n\tds_read_b64_tr_b16 %1, %3 offset:12288" : "=&v"(al3), "=&v"(ah3) : "v"(kb0), "v"(kb1) : "memory"); \
                const bf16x8 b0_ = *(const LAS bf16x8*)(xR + (S_VST - S_XT)), b1_ = *(const LAS bf16x8*)(xR + (S_VST - S_XT) + 32), b2_ = *(const LAS bf16x8*)(xR + (S_VST - S_XT) + 64), b3_ = *(const LAS bf16x8*)(xR + (S_VST - S_XT) + 96); \
                TRW4(al0, ah0, al1, ah1, al2, ah2, al3, ah3); \
                Sacc = MFMA32(TR_CAT(al0, ah0), b0_, Sacc); Sacc = MFMA32(TR_CAT(al1, ah1), b1_, Sacc); Sacc = MFMA32(TR_CAT(al2, ah2), b2_, Sacc); Sacc = MFMA32(TR_CAT(al3, ah3), b3_, Sacc); \
                MFMA_SETTLE(Sacc); \
                _Pragma("unroll") for (int g_ = 0; g_ < 4; ++g_) PK4W(stW + 64 * dt + 16 * g_, Sacc[4 * g_], Sacc[4 * g_ + 1], Sacc[4 * g_ + 2], Sacc[4 * g_ + 3]); \
            } \
            asm volatile("s_waitcnt vmcnt(8)" ::: "memory");              \
            if ((n) + 1 < NCHUNK) SCAN_WRITE(RO, buf ^ 1); \
            BAR_LDS();                                                      \
        } while (0)
        for (int n = 0; n < NCHUNK; n += 2) { SCAN_STEP(n, RA, RB); SCAN_STEP(n + 1, RB, RA); }
        if (wid >= 4) { const int t_ = tid - 256; const v4u ov = *(const LAS v4u*)(lds + S_OT + t_ * 16);
            *(GAS v4u*)(proj + ((size_t)b * SEQ + 64 * (NCHUNK - 1) + (t_ >> 2)) * GDN_MAIN + GDN_CONV / 2 + h * 128 + e0 + (t_ & 3) * 8) = ov; }
        VM_WAIT(); __syncthreads();
#undef SCAN_LOAD
#undef SCAN_WRITE
#undef SCAN_STEP
#undef PK4W
    }
}
#undef TRW4
__device__ __forceinline__ void phase_gate(bf16* proj, const float* out_norm, int gw, int NGW, int lane) {
    const int g = lane >> 4, i = lane & 15; float w[8];
#pragma unroll
    for (int e = 0; e < 8; ++e) w[e] = out_norm[8 * i + e];
    for (int m = gw; m < NT; m += NGW) {
        const bf16* orow = proj + (size_t)m * GDN_MAIN + GDN_CONV / 2; bf16* zrow = proj + (size_t)m * GDN_MAIN + GDN_CONV;
#pragma unroll 4
        for (int it = 0; it < GDN_HV / 4; ++it) {
            const int off = (4 * it + g) * 128 + 8 * i;
            const v4u ov = *(const v4u*)(orow + off), zv = *(const v4u*)(zrow + off);
            float o[8], z[8];
            o[0] = bflo(ov.x); o[1] = bfhi(ov.x); o[2] = bflo(ov.y); o[3] = bfhi(ov.y); o[4] = bflo(ov.z); o[5] = bfhi(ov.z); o[6] = bflo(ov.w); o[7] = bfhi(ov.w);
            z[0] = bflo(zv.x); z[1] = bfhi(zv.x); z[2] = bflo(zv.y); z[3] = bfhi(zv.y); z[4] = bflo(zv.z); z[5] = bfhi(zv.z); z[6] = bflo(zv.w); z[7] = bfhi(zv.w);
            float ss = 0.f;
#pragma unroll
            for (int e = 0; e < 8; ++e) ss += o[e] * o[e];
            ss += shx(ss, 1, lane); ss += shx(ss, 2, lane); ss += shx(ss, 4, lane); ss += shx(ss, 8, lane);
            const float rs = rsqrtf(ss * (1.f / 128.f) + NORM_EPS);
            float r[8];
#pragma unroll
            for (int e = 0; e < 8; ++e) r[e] = o[e] * rs * w[e] * fsilu(z[e]);
            v4u res; res.x = pk2(r[0], r[1]); res.y = pk2(r[2], r[3]); res.z = pk2(r[4], r[5]); res.w = pk2(r[6], r[7]);
            *(v4u*)(zrow + off) = res;
        }
    }
}
#undef MFMA32
#undef BAR_LDS
#undef MFMA_SETTLE
#undef TR_ISSUE
#undef TR_CAT
}

struct Args { const void* in[25]; float* out; unsigned char* ws; };
__device__ __forceinline__ int lane_id_now() { int l; asm volatile("v_mbcnt_lo_u32_b32 %0, -1, 0\n\tv_mbcnt_hi_u32_b32 %0, -1, %0" : "=v"(l)); return l; }
__global__ void __launch_bounds__(NWAVES * 64, 2) mk_fwd(Args a) {
    extern __shared__ __attribute__((aligned(16))) unsigned char lds_raw[];
    LAS unsigned char* lds = (LAS unsigned char*)lds_raw;
    const int tid0 = threadIdx.x; const int wave0 = __builtin_amdgcn_readfirstlane(tid0 >> 6);
    const int G0 = gridDim.x, bx0 = blockIdx.x, vcu0 = (G0 % 8 == 0) ? (bx0 % 8) * (G0 / 8) + bx0 / 8 : bx0;
    volatile LAS unsigned* MISC = (volatile LAS unsigned*)(lds + MISC_OFF);
    if (tid0 < 64) MISC[tid0] = 0u;
    __syncthreads();
    typedef const __attribute__((address_space(4))) unsigned long long* kargp_t;
    const kargp_t kargs0 = (kargp_t)__builtin_amdgcn_kernarg_segment_ptr();
    XcdBarrier bar = xcd_barrier_post((unsigned*)(a.ws + WS_CTL) + CW_BAR, MISC + 8);
#define BTID() (wave0 * 64 + lane_id_now())
#if PROBE_MASK
    if (tid0 == 0) { const unsigned long long t_ = __builtin_amdgcn_s_memrealtime(); MISC[16] = (unsigned)t_; MISC[17] = (unsigned)(t_ >> 32); MISC[18] = 0u; MISC[19] = 0u; }
#define GRID_BAR(cls) do { { XcdBarrier b_ = bar; asm volatile("" : "+s"(b_.bar), "+s"(b_.x)); xcd_barrier(b_, BTID()); } \
        if (BTID() == 0) { const unsigned long long now_ = __builtin_amdgcn_s_memrealtime(); const unsigned long long last_ = ((unsigned long long)MISC[17] << 32) | MISC[16]; \
            if ((cls) & PROBE_MASK) { const unsigned long long a_ = (((unsigned long long)MISC[19] << 32) | MISC[18]) + (now_ - last_); MISC[18] = (unsigned)a_; MISC[19] = (unsigned)(a_ >> 32); } \
            MISC[16] = (unsigned)now_; MISC[17] = (unsigned)(now_ >> 32); } } while (0)
#else
#define GRID_BAR(cls) do { XcdBarrier b_ = bar; asm volatile("" : "+s"(b_.bar), "+s"(b_.x)); xcd_barrier(b_, BTID()); } while (0)
#endif
#define PH() int wave = wave0; asm volatile("" : "+s"(wave)); int tid = wave * 64 + lane_id_now(); const int lane = tid & 63; \
             int G = G0, bx = bx0, vcu = vcu0; asm volatile("" : "+s"(G), "+s"(bx), "+s"(vcu)); const int NGW = G * NWAVES, NGT = G * NWAVES * 64; (void)bx; (void)NGW; (void)NGT; \
             const int gw = vcu * NWAVES + wave, gtid = vcu * (NWAVES * 64) + tid; (void)lane; (void)wave; (void)gw; (void)gtid; \
             kargp_t kp = kargs0; asm volatile("" : "+s"(kp)); unsigned char* ws = (unsigned char*)(GAS unsigned char*)kp[26]; float* out = (float*)(GAS float*)kp[25]; \
             unsigned char* wmix = ws + WS_WMIX; bf16* A0 = (bf16*)(ws + WS_A0); unsigned char* A1 = ws + WS_A1; const float* hin = layer == 0 ? (const float*)(const GAS float*)kp[0] : out; \
             LAS float* scr = (LAS float*)(lds + wave * 16384); \
             (void)out; (void)wmix; (void)A0; (void)A1; (void)hin; (void)scr
#define IN(i) ((const float*)(const GAS float*)kp[i])
#define GEMMX(F16_, EPI, Aptr, Bptr, N_, K_, lda_, ldb_, ...) do { pg8::Gemm g{(const bf16*)(Aptr), (const bf16*)(Bptr), NT, (N_), (K_), (lda_), (ldb_)}; pg8::StaticOrder S; S.init(NT, (N_), G, bx); \
             pg8::EPI E{__VA_ARGS__}; pg8::gemm_phase<pg8::EPI, pg8::StaticOrder, true, true, F16_>(lds, g, S, E, tid); } while (0)
#define GEMM(...) GEMMX(false, __VA_ARGS__)
#define GEMMH(...) GEMMX(true, __VA_ARGS__)
#define COMMA ,
#define SSY ((float*)(ws + WS_SS))
#define SSX1 ((float*)(ws + WS_SS) + 32 * NT)
#define SSX2 ((float*)(ws + WS_SS) + 64 * NT)
#define HBX ((bf16*)(A1 + A1_HBX))
#define HY ((bf16*)out)
    { const int layer = 0; PH(); phase_rope_table((const int*)(const GAS int*)kp[2], (float*)(ws + WS_ROPE), gtid, NGT); }
    { const int layer = 0; PH(); phase_cast_ss(hin, HY, SSY, gw, NGW, lane); }
    for (int layer = 0; layer < DEPTH; ++layer) {
        const int j = layer >> 1; const bool is_mla = (layer & 1) == 0;
        if (is_mla) {
            { PH(); convert_matrix<0, true>(IN(4) + (size_t)j * DM * MLA_IN, IN(3) + layer * DM, DM, MLA_IN, (bf16*)(wmix + WM_MLA_IN), 0, scr, gw, NGW, lane); }
            { PH(); zero_rows((bf16*)(wmix + WM_MLA_IN), DM, MLA_IN, MLA_IN_PAD - MLA_IN, gtid, NGT); }
            { PH(); convert_matrix<0>(IN(7) + (size_t)j * MLA_QL * (MLA_H * MLA_QK), IN(5) + j * MLA_QL, MLA_QL, MLA_H * MLA_QK, (bf16*)(wmix + WM_MLA_UQ), 0, scr, gw, NGW, lane); }
            { PH(); convert_matrix<0>(IN(8) + (size_t)j * MLA_KVL * (MLA_H * 256), IN(6) + j * MLA_KVL, MLA_KVL, MLA_H * 256, (bf16*)(wmix + WM_MLA_UKV), 0, scr, gw, NGW, lane); }
            { PH(); convert_matrix<0>(IN(11) + (size_t)j * DM * DM, nullptr, DM, DM, (bf16*)(wmix + WM_MLA_O), 0, scr, gw, NGW, lane); }
        } else {
            { PH(); convert_matrix<0, true>(IN(12) + (size_t)j * DM * GDN_IN, IN(3) + layer * DM, DM, GDN_IN, (bf16*)(wmix + WM_GDN_IN), 0, scr, gw, NGW, lane); }
            { PH(); zero_rows((bf16*)(wmix + WM_GDN_IN), DM, GDN_IN, GDN_IN_PAD - GDN_IN, gtid, NGT); }
            { PH(); convert_matrix<0>(IN(17) + (size_t)j * GDN_VAL * DM, nullptr, GDN_VAL, DM, (bf16*)(wmix + WM_GDN_OUT), 0, scr, gw, NGW, lane); }
        }
        { PH(); convert_matrix<1, true>(IN(19) + (size_t)layer * DM * (2 * DFF), IN(18) + layer * DM, DM, 2 * DFF, (bf16*)(ws + WS_WGU), 0, scr, gw, NGW, lane); }
        { PH(); convert_matrix<0>(IN(20) + (size_t)layer * DFF * DM, nullptr, DFF, DM, (bf16*)(ws + WS_WDN), 0, scr, gw, NGW, lane); }
        { PH(); convert_matrix<0>(IN(21) + (size_t)layer * PLE_DIM * DM, nullptr, PLE_DIM, DM, (bf16*)(ws + WS_WPP), 0, scr, gw, NGW, lane); }
        { PH(); convert_matrix<0, true>(IN(24) + (size_t)layer * DM * DM, IN(23) + layer * DM, DM, DM, (bf16*)(ws + WS_WPG), 0, scr, gw, NGW, lane); }
        { PH(); phase_cvt_bf16(IN(1) + (size_t)layer * NT * PLE_DIM, (bf16*)(ws + WS_PBF), (size_t)NT * PLE_DIM, gtid, NGT); }
        GRID_BAR(1<<0);
        if (is_mla) {
            { PH(); GEMMH(EpiMlaIn, HY, wmix + WM_MLA_IN, MLA_IN_PAD, DM, DM, DM, (bf16*)(A1 + A1_QKVN), (float*)(A1 + A1_KPE), (float*)(A1 + A1_C), SSY); }
            GRID_BAR(1<<1);
            { PH(); GEMM(EpiBf16Lat, A1 + A1_QKVN, wmix + WM_MLA_UQ, MLA_H * MLA_QK, MLA_QL, 1024, MLA_QL, (bf16*)(A1 + A1_QRAW), MLA_H * MLA_QK, (const float*)(A1 + A1_C), 0); }
            { PH(); GEMM(EpiBf16Lat, (bf16*)(A1 + A1_QKVN) + MLA_QL, wmix + WM_MLA_UKV, MLA_H * 256, MLA_KVL, 1024, MLA_KVL, (bf16*)(A1 + A1_KVRAW), MLA_H * 256, (const float*)(A1 + A1_C), 8); }
            GRID_BAR(1<<1);
            { PH(); phase_mla_finalize_kv((const bf16*)(A1 + A1_KVRAW), (const float*)(A1 + A1_KPE), (const float*)(ws + WS_ROPE), IN(10) + j * MLA_QK, (bf16*)(A1 + A1_KF), (bf16*)(A1 + A1_VF), gw, NGW, lane); }
            GRID_BAR(1<<2);
            { PH(); attn::attn_phase((const bf16*)(A1 + A1_QRAW), IN(9) + j * MLA_QK, (const float*)(ws + WS_ROPE), (const bf16*)(A1 + A1_KF), (const bf16*)(A1 + A1_VF), A0, (LAS char*)lds, vcu, G, tid, wave, lane); }
            GRID_BAR(1<<3);
            { PH(); GEMM(EpiResid, A0, wmix + WM_MLA_O, DM, DM, DM, DM, HY, HBX, DM, SSX1); }
            GRID_BAR(1<<1);
        } else {
            { PH(); GEMMH(EpiGdnProj, HY, wmix + WM_GDN_IN, GDN_IN_PAD, DM, DM, DM, (bf16*)(A1 + A1_PROJ), GDN_MAIN, (float*)(A1 + A1_BA), GDN_MAIN / 256, SSY, (bf16*)(A1 + A1_HALO)); }
            GRID_BAR(1<<4);
            { PH(); gdn::phase_conv((bf16*)(A1 + A1_PROJ), (const bf16*)(A1 + A1_HALO), IN(13) + (size_t)j * 4 * GDN_CONV, lds, vcu, G, tid, wave); }
            GRID_BAR(1<<5);
            { PH(); gdn::phase_prep((const bf16*)(A1 + A1_PROJ), (const float*)(A1 + A1_BA), IN(14) + j * GDN_HV, IN(15) + j * GDN_HV, A0, (bf16*)(A1 + A1_INTRA), (float*)(A1 + A1_GC), lds, vcu, G, tid, wave, lane); }
            GRID_BAR(1<<6);
            { PH(); gdn::phase_scan((bf16*)(A1 + A1_PROJ), A0, (const bf16*)(A1 + A1_INTRA), (const float*)(A1 + A1_GC), lds, vcu, G, tid, wave, lane); }
            GRID_BAR(1<<7);
            { PH(); gdn::phase_gate((bf16*)(A1 + A1_PROJ), IN(16) + j * GDN_DV, gw, NGW, lane); }
            GRID_BAR(1<<8);
            { PH(); GEMM(EpiResid, (bf16*)(A1 + A1_PROJ) + GDN_CONV, wmix + WM_GDN_OUT, DM, GDN_VAL, GDN_MAIN, GDN_VAL, HY, HBX, DM, SSX1); }
            GRID_BAR(1<<9);
        }
        { PH(); GEMMH(EpiSiluMul, HBX, ws + WS_WGU, 2 * DFF, DM, DM, DM, (bf16*)(A1 + A1_ACT), DFF, SSX1); }
        { PH(); GEMM(EpiBf16Plain, ws + WS_PBF, ws + WS_WPP, DM, PLE_DIM, PLE_DIM, PLE_DIM, (bf16*)(A1 + A1_E), DM); }
        GRID_BAR(1<<11);
        { PH(); phase_rstd_e((const bf16*)(A1 + A1_E), (float*)(A1 + A1_RSTDE), gw, NGW, lane); }
        { PH(); GEMM(EpiResid, A1 + A1_ACT, ws + WS_WDN, DM, DFF, DFF, DFF, HBX, HBX, DM, SSX2); }
        GRID_BAR(1<<12);
        if (layer + 1 < DEPTH) { PH(); GEMMH(EpiPleGate<false>, HBX, ws + WS_WPG, DM, DM, DM, DM, HBX, HY, nullptr, DM, (const bf16*)(A1 + A1_E), (const float*)(A1 + A1_RSTDE), IN(22) + layer * DM, SSX2, SSY); }
        else { PH(); GEMMH(EpiPleGate<true>, HBX, ws + WS_WPG, DM, DM, DM, DM, HBX, nullptr, out, DM, (const bf16*)(A1 + A1_E), (const float*)(A1 + A1_RSTDE), IN(22) + layer * DM, SSX2, nullptr); }
        GRID_BAR(1<<14);
    }
#if PROBE_MASK
    if (blockIdx.x == 0 && BTID() == 0) { const unsigned long long acc_ = ((unsigned long long)MISC[19] << 32) | MISC[18]; const unsigned long long t0_ = __builtin_amdgcn_s_memrealtime(); while (__builtin_amdgcn_s_memrealtime() - t0_ < acc_) __builtin_amdgcn_s_sleep(32); }
#endif
}

extern "C" void kernel_launch(void* const* d_in, const int* in_sizes, int n_in, void* d_out, int out_size, void* d_ws, size_t ws_size, hipStream_t stream) {
    static int grid = 0;
    if (grid == 0) {
        if (n_in != 25 || out_size != NT * DM || ws_size < WS_END) { fprintf(stderr, "kernel_launch: unexpected shapes: n_in %d out %d ws %zu (need %zu)\n", n_in, out_size, ws_size, (size_t)WS_END); grid = -1; return; }
        int dev = 0, cus = 0, per_cu = 0;
        if (hipGetDevice(&dev) != hipSuccess || hipDeviceGetAttribute(&cus, hipDeviceAttributeMultiprocessorCount, dev) != hipSuccess) { grid = -1; return; }
        if (hipFuncSetAttribute((const void*)mk_fwd, hipFuncAttributeMaxDynamicSharedMemorySize, LDS_BYTES) != hipSuccess) { fprintf(stderr, "kernel_launch: hipFuncSetAttribute failed\n"); grid = -1; return; }
        if (hipOccupancyMaxActiveBlocksPerMultiprocessor(&per_cu, (const void*)mk_fwd, NWAVES * 64, LDS_BYTES) != hipSuccess || per_cu < 1) { fprintf(stderr, "kernel_launch: occupancy query says %d\n", per_cu); grid = -1; (void)hipGetLastError(); return; }
        grid = cus - cus % 64;
        if (grid < 64) { fprintf(stderr, "kernel_launch: %d CUs: need at least 64\n", cus); grid = -1; return; }
    }
    if (grid < 0) return;
    if (hipMemsetAsync((char*)d_ws + WS_CTL, 0, CTL_ZERO_BYTES, stream) != hipSuccess) return;
    Args a{};
    for (int i = 0; i < 25; ++i) a.in[i] = d_in[i];
    a.out = (float*)d_out; a.ws = (unsigned char*)d_ws;
    hipLaunchKernelGGL(mk_fwd, dim3(grid), dim3(NWAVES * 64), LDS_BYTES, stream, a);
}
```
